# Optimizing an MI355X kernel written in HIP

```python
import jax, jax.numpy as jnp
from jax import lax
import numpy as np

D_MODEL = 2048
BATCH = 4
SEQ = 4096
DEPTH = 2

GRID_W = 64
CTX_LEN = 256
RMS_EPS = 1e-6

N_Q_HEADS = 8
N_KV_HEADS = 2
HEAD_DIM = 128
WINDOW = 128
ATTN_BLOCK = 128
ROPE_THETA = 10000.0
ROPE_AXIS_DIM = HEAD_DIM // 2

GLA_HEADS = 4
GLA_DK = 64
GLA_DV = 128
GLA_RANK = 16
GLA_TAU = 16.0
GLA_CHUNK = 16

LRU_WIDTH = 512
LRU_BLOCKS = 8
LRU_BLOCK_W = LRU_WIDTH // LRU_BLOCKS
LRU_C = 8.0
CONV_W = 4
CONV_LEFT = 2

ATTN_Q = N_Q_HEADS * HEAD_DIM
ATTN_KV = N_KV_HEADS * HEAD_DIM
GLA_QK = GLA_HEADS * GLA_DK
GLA_V = GLA_HEADS * GLA_DV
D_MIX = ATTN_Q + GLA_V + LRU_WIDTH
IN_SPLITS = (ATTN_Q, ATTN_KV, ATTN_KV, GLA_QK, GLA_QK, GLA_V, GLA_V, 2 * GLA_RANK, LRU_WIDTH, LRU_WIDTH)
D_IN = 4128

N_GROUPS = 4
EXPERTS_PER_GROUP = 8
N_EXPERTS = N_GROUPS * EXPERTS_PER_GROUP
TOP_K = 2
D_FF_EXPERT = 1024
MOE_BLOCK = 256

kernel_name = 'hybrid_dit_swa_gla_rglru_hmoe'


def rms_norm(x, g):
    x32 = x.astype(jnp.float32)
    y = x32 * lax.rsqrt(jnp.mean(x32 * x32, axis=-1, keepdims=True) + RMS_EPS)
    return (y * g.astype(jnp.float32)).astype(x.dtype)


def modulate(h, shift, scale):
    return h * (1 + scale) + shift


def rev(a):
    return jnp.flip(a, axis=1)


def split_cols(z):
    cuts = np.cumsum(IN_SPLITS)[:-1].tolist()
    return jnp.split(z, cuts, axis=-1)


def axial_rope_angles(n_tokens):
    rows = n_tokens // GRID_W
    row = jnp.repeat(jnp.arange(rows, dtype=jnp.float32), GRID_W)
    col = jnp.tile(jnp.arange(GRID_W, dtype=jnp.float32), rows)
    n_freq = ROPE_AXIS_DIM // 2
    inv = ROPE_THETA ** (-jnp.arange(n_freq, dtype=jnp.float32) / n_freq)
    ang = jnp.concatenate([row[:, None] * inv, col[:, None] * inv], axis=-1)
    return jnp.cos(ang), jnp.sin(ang)


def apply_axial_rope(x, cos, sin):
    xp = x.astype(jnp.float32).reshape(x.shape[:-1] + (HEAD_DIM // 2, 2))
    x1, x2 = xp[..., 0], xp[..., 1]
    cs, sn = cos[None, :, None, :], sin[None, :, None, :]
    out = jnp.stack([x1 * cs - x2 * sn, x1 * sn + x2 * cs], axis=-1)
    return out.reshape(x.shape).astype(x.dtype)


def windowed_attention(q, k, v, k_ctx, v_ctx, sink):
    B, S, Hq, hd = q.shape
    G = Hq // N_KV_HEADS
    nb = S // ATTN_BLOCK
    C = k_ctx.shape[1]
    nk = 3 * ATTN_BLOCK
    scale = HEAD_DIM ** -0.5
    qb = q.reshape(B, nb, ATTN_BLOCK, N_KV_HEADS, G, hd)
    pad = ((0, 0), (ATTN_BLOCK, ATTN_BLOCK), (0, 0), (0, 0))
    kp = jnp.pad(k, pad).reshape(B, nb + 2, ATTN_BLOCK, N_KV_HEADS, hd)
    vp = jnp.pad(v, pad).reshape(B, nb + 2, ATTN_BLOCK, N_KV_HEADS, hd)
    k_band = jnp.concatenate([kp[:, :-2], kp[:, 1:-1], kp[:, 2:]], axis=2)
    v_band = jnp.concatenate([vp[:, :-2], vp[:, 1:-1], vp[:, 2:]], axis=2)
    s_loc = jnp.einsum('bnqhgd,bnkhd->bnhgqk', qb, k_band).astype(jnp.float32) * scale
    s_ctx = jnp.einsum('bnqhgd,bchd->bnhgqc', qb, k_ctx).astype(jnp.float32) * scale
    blk = jnp.arange(nb)[:, None, None]
    qpos = blk * ATTN_BLOCK + jnp.arange(ATTN_BLOCK)[None, :, None]
    kpos = (blk - 1) * ATTN_BLOCK + jnp.arange(nk)[None, None, :]
    valid = (jnp.abs(kpos - qpos) <= WINDOW) & (kpos >= 0) & (kpos < S)
    s_loc = jnp.where(valid[None, :, None, None], s_loc, -jnp.inf)
    sink_col = jnp.broadcast_to(sink.astype(jnp.float32).reshape(N_KV_HEADS, G)[None, None, :, :, None, None], s_loc.shape[:-1] + (1,))
    p = jax.nn.softmax(jnp.concatenate([s_loc, s_ctx, sink_col], axis=-1), axis=-1).astype(v.dtype)
    o = jnp.einsum('bnhgqk,bnkhd->bnqhgd', p[..., :nk], v_band) + jnp.einsum('bnhgqc,bchd->bnqhgd', p[..., nk:nk + C], v_ctx)
    return o.reshape(B, S, Hq * hd)


def context_attention(q, k, v, sink):
    B, C, Hq, hd = q.shape
    G = Hq // N_KV_HEADS
    qg = q.reshape(B, C, N_KV_HEADS, G, hd)
    s = jnp.einsum('bqhgd,bkhd->bhgqk', qg, k).astype(jnp.float32) * (HEAD_DIM ** -0.5)
    sink_col = jnp.broadcast_to(sink.astype(jnp.float32).reshape(N_KV_HEADS, G)[None, :, :, None, None], s.shape[:-1] + (1,))
    p = jax.nn.softmax(jnp.concatenate([s, sink_col], axis=-1), axis=-1)[..., :C].astype(v.dtype)
    o = jnp.einsum('bhgqk,bkhd->bqhgd', p, v)
    return o.reshape(B, C, Hq * hd)


def gla_qkv(gq, gk, gv):
    B, T, _ = gq.shape
    q = gq.reshape(B, T, GLA_HEADS, GLA_DK) * (GLA_DK ** -0.5)
    k = gk.reshape(B, T, GLA_HEADS, GLA_DK)
    v = gv.reshape(B, T, GLA_HEADS, GLA_DV)
    return q, k, v


def gla_log_decay(z_low, w2, b):
    z = (z_low @ w2 + b).astype(jnp.float32)
    return (jax.nn.log_sigmoid(z) / GLA_TAU).reshape(z.shape[:-1] + (GLA_HEADS, GLA_DK))


def gla_chunked(q, k, v, log_a, s0):
    B, T, H, dk = q.shape
    dv = v.shape[-1]
    L = GLA_CHUNK
    nc = T // L
    qc = q.astype(jnp.float32).reshape(B, nc, L, H, dk)
    kc = k.astype(jnp.float32).reshape(B, nc, L, H, dk)
    vc = v.astype(jnp.float32).reshape(B, nc, L, H, dv)
    b = jnp.cumsum(log_a.reshape(B, nc, L, H, dk), axis=2)
    b_last = b[:, :, -1]
    tri = jnp.tril(jnp.ones((L, L), dtype=bool))
    diff = b[:, :, :, None] - b[:, :, None, :]
    decay = jnp.exp(jnp.where(tri[None, None, :, :, None, None], diff, -jnp.inf))
    A = jnp.einsum('bntshd,bnthd,bnshd->bnhts', decay, qc, kc)
    o_intra = jnp.einsum('bnhts,bnshv->bnthv', A, vc)
    contrib = jnp.einsum('bnshd,bnshv->bnhdv', kc * jnp.exp(b_last[:, :, None] - b), vc)
    a_tot = jnp.exp(b_last)

    def step(s, inp):
        a, u = inp
        return a[..., None] * s + u, s

    s_final, s_before = lax.scan(step, s0, (jnp.moveaxis(a_tot, 1, 0), jnp.moveaxis(contrib, 1, 0)))
    s_before = jnp.moveaxis(s_before, 0, 1)
    o_inter = jnp.einsum('bnthd,bnhdv->bnthv', qc * jnp.exp(b), s_before)
    return (o_intra + o_inter).reshape(B, T, H, dv), s_final


def gla_output(o, r, g):
    y = rms_norm(o, g).reshape(o.shape[:2] + (GLA_V,))
    return (y * jax.nn.silu(r.astype(jnp.float32))).astype(r.dtype)


def short_conv(x, w, b):
    T = x.shape[1]
    xp = jnp.pad(x, ((0, 0), (CONV_LEFT, CONV_W - 1 - CONV_LEFT), (0, 0)))
    y = b
    for j in range(CONV_W):
        y = y + xp[:, j:j + T] * w[j]
    return y


def lru_gates(x, wa, ba, wx, bx, lam):
    B, T, _ = x.shape
    xb = x.reshape(B, T, LRU_BLOCKS, LRU_BLOCK_W)
    r = jax.nn.sigmoid((jnp.einsum('btnc,ncd->btnd', xb, wa).reshape(B, T, LRU_WIDTH) + ba).astype(jnp.float32))
    i = jax.nn.sigmoid((jnp.einsum('btnc,ncd->btnd', xb, wx).reshape(B, T, LRU_WIDTH) + bx).astype(jnp.float32))
    log_a = -LRU_C * jax.nn.softplus(-lam.astype(jnp.float32)) * r
    u = jnp.sqrt(-jnp.expm1(2.0 * log_a)) * (i * x.astype(jnp.float32))
    return log_a, u


def _affine_combine(e1, e2):
    a1, b1 = e1
    a2, b2 = e2
    return a1 * a2, a2 * b1 + b2


def linear_scan(log_a, u, h0):
    A, Bv = lax.associative_scan(_affine_combine, (jnp.exp(log_a), u), axis=1)
    h = Bv + A * h0[:, None, :]
    return h, h[:, -1]


def lru_output(h, gate):
    return (h * jax.nn.gelu(gate.astype(jnp.float32))).astype(gate.dtype)


def hybrid_mixer(u_l, u_c, cos, sin, w_in, sink, gla_w2, gla_b, gla_g, conv_w, conv_b, lru_wa, lru_ba, lru_wx, lru_bx, lru_lam, w_out, need_ctx_out):
    B, S, _ = u_l.shape
    C = u_c.shape[1]
    aq_l, ak_l, av_l, gq_l, gk_l, gv_l, gr_l, gz_l, lx_l, lg_l = split_cols(u_l @ w_in)
    aq_c, ak_c, av_c, gq_c, gk_c, gv_c, gr_c, gz_c, lx_c, lg_c = split_cols(u_c @ w_in)

    q_l = apply_axial_rope(aq_l.reshape(B, S, N_Q_HEADS, HEAD_DIM), cos, sin)
    k_l = apply_axial_rope(ak_l.reshape(B, S, N_KV_HEADS, HEAD_DIM), cos, sin)
    v_l = av_l.reshape(B, S, N_KV_HEADS, HEAD_DIM)
    k_c = ak_c.reshape(B, C, N_KV_HEADS, HEAD_DIM)
    v_c = av_c.reshape(B, C, N_KV_HEADS, HEAD_DIM)
    attn_l = windowed_attention(q_l, k_l, v_l, k_c, v_c, sink)

    qg_l, kg_l, vg_l = gla_qkv(gq_l, gk_l, gv_l)
    qg_c, kg_c, vg_c = gla_qkv(gq_c, gk_c, gv_c)
    la_l_f = gla_log_decay(gz_l[..., :GLA_RANK], gla_w2[0], gla_b[0])
    la_l_b = gla_log_decay(gz_l[..., GLA_RANK:], gla_w2[1], gla_b[1])
    la_c_f = gla_log_decay(gz_c[..., :GLA_RANK], gla_w2[0], gla_b[0])
    la_c_b = gla_log_decay(gz_c[..., GLA_RANK:], gla_w2[1], gla_b[1])
    s_zero = jnp.zeros((B, GLA_HEADS, GLA_DK, GLA_DV), jnp.float32)
    oc_f, st_f = gla_chunked(qg_c, kg_c, vg_c, la_c_f, s_zero)
    oc_b, st_b = gla_chunked(rev(qg_c), rev(kg_c), rev(vg_c), rev(la_c_b), s_zero)
    ol_f, _ = gla_chunked(qg_l, kg_l, vg_l, la_l_f, st_f)
    ol_b, _ = gla_chunked(rev(qg_l), rev(kg_l), rev(vg_l), rev(la_l_b), st_b)
    gla_l = gla_output(ol_f + rev(ol_b), gr_l, gla_g)

    xc_l = short_conv(lx_l, conv_w, conv_b)
    xc_c = short_conv(lx_c, conv_w, conv_b)
    h_zero = jnp.zeros((B, LRU_WIDTH), jnp.float32)
    lcf, ucf = lru_gates(xc_c, lru_wa[0], lru_ba[0], lru_wx[0], lru_bx[0], lru_lam[0])
    lcb, ucb = lru_gates(xc_c, lru_wa[1], lru_ba[1], lru_wx[1], lru_bx[1], lru_lam[1])
    llf, ulf = lru_gates(xc_l, lru_wa[0], lru_ba[0], lru_wx[0], lru_bx[0], lru_lam[0])
    llb, ulb = lru_gates(xc_l, lru_wa[1], lru_ba[1], lru_wx[1], lru_bx[1], lru_lam[1])
    hc_f, hs_f = linear_scan(lcf, ucf, h_zero)
    hc_b, hs_b = linear_scan(rev(lcb), rev(ucb), h_zero)
    hl_f, _ = linear_scan(llf, ulf, hs_f)
    hl_b, _ = linear_scan(rev(llb), rev(ulb), hs_b)
    lru_l = lru_output(hl_f + rev(hl_b), lg_l)

    y_l = jnp.concatenate([attn_l, gla_l, lru_l], axis=-1) @ w_out
    if not need_ctx_out:
        return y_l, None
    attn_c = context_attention(aq_c.reshape(B, C, N_Q_HEADS, HEAD_DIM), k_c, v_c, sink)
    gla_c = gla_output(oc_f + rev(oc_b), gr_c, gla_g)
    lru_c = lru_output(hc_f + rev(hc_b), lg_c)
    y_c = jnp.concatenate([attn_c, gla_c, lru_c], axis=-1) @ w_out
    return y_l, y_c


def expert_dispatch(h, experts, gates, w1, w3, w2):
    N, D = h.shape
    M = N * TOP_K
    flat_e = experts.reshape(M).astype(jnp.int32)
    flat_tok = jnp.arange(M, dtype=jnp.int32) // TOP_K
    flat_w = gates.reshape(M)
    order = jnp.argsort(flat_e)
    e_sorted = flat_e[order]
    tok_sorted = flat_tok[order]
    w_sorted = flat_w[order]
    counts = jnp.bincount(flat_e, length=N_EXPERTS).astype(jnp.int32)
    padded = (counts + MOE_BLOCK - 1) // MOE_BLOCK * MOE_BLOCK
    pad_end = jnp.cumsum(padded)
    pad_start = pad_end - padded
    start = jnp.cumsum(counts) - counts
    dest = pad_start[e_sorted] + (jnp.arange(M, dtype=jnp.int32) - start[e_sorted])
    n_blocks = -(-(M + N_EXPERTS * (MOE_BLOCK - 1)) // MOE_BLOCK)
    P = n_blocks * MOE_BLOCK
    src = jnp.full((P,), N, dtype=jnp.int32).at[dest].set(tok_sorted)
    w_pad = jnp.zeros((P,), jnp.float32).at[dest].set(w_sorted)
    h_ext = jnp.concatenate([h, jnp.zeros((1, D), h.dtype)], axis=0)
    xs = h_ext[src].reshape(n_blocks, MOE_BLOCK, D)
    blk_e = jnp.minimum(jnp.searchsorted(pad_end, jnp.arange(n_blocks, dtype=jnp.int32) * MOE_BLOCK, side='right'), N_EXPERTS - 1)

    def expert_block(args):
        xb, e = args
        return (jax.nn.silu(xb @ w1[e]) * (xb @ w3[e])) @ w2[e]

    ys = lax.map(expert_block, (xs, blk_e)).reshape(P, D)
    y = jax.ops.segment_sum(ys * w_pad[:, None].astype(ys.dtype), src, num_segments=N + 1)
    return y[:N]


def hierarchical_moe(h, wg, bg, we, be, w1, w3, w2):
    N, _ = h.shape
    pg = jax.nn.softmax((h @ wg).astype(jnp.float32) + bg.astype(jnp.float32), axis=-1)
    p_grp, grp = lax.top_k(pg, 1)
    le = ((h @ we).astype(jnp.float32) + be.astype(jnp.float32)).reshape(N, N_GROUPS, EXPERTS_PER_GROUP)
    le_sel = jnp.take_along_axis(le, grp[:, :, None], axis=1)[:, 0]
    w_top, e_top = lax.top_k(jax.nn.softmax(le_sel, axis=-1), TOP_K)
    w_top = w_top / jnp.sum(w_top, axis=-1, keepdims=True)
    gates = p_grp * w_top
    experts = grp * EXPERTS_PER_GROUP + e_top
    return expert_dispatch(h, experts, gates, w1, w3, w2)


def setup_inputs(seed: int = 0) -> dict:
    key = jax.random.key(seed)
    ks = jax.random.split(key, 32)
    f32 = jnp.float32
    D, L = D_MODEL, DEPTH

    def nrm(k, shape, scale):
        return jax.random.normal(k, shape, f32) * scale

    lam_u = jax.random.uniform(ks[19], (L, 2, LRU_WIDTH), f32, 0.9, 0.999)
    lam_s = lam_u ** (1.0 / LRU_C)
    return {
        'x': nrm(ks[0], (BATCH, SEQ, D), 1.0),
        'c': nrm(ks[1], (BATCH, D), 1.0),
        'ctx': nrm(ks[2], (BATCH, CTX_LEN, D), 1.0),
        'c_ctx': nrm(ks[3], (D,), 1.0),
        'ada_w': nrm(ks[4], (L, D, 6 * D), 0.5 * D ** -0.5),
        'ada_b': nrm(ks[5], (L, 6 * D), 0.02),
        'norm_mix_g': 1.0 + nrm(ks[6], (L, D), 0.02),
        'norm_ffn_g': 1.0 + nrm(ks[7], (L, D), 0.02),
        'w_in': nrm(ks[8], (L, D, D_IN), D ** -0.5),
        'attn_sink': nrm(ks[9], (L, N_Q_HEADS), 0.5),
        'gla_gate_w2': nrm(ks[10], (L, 2, GLA_RANK, GLA_QK), GLA_RANK ** -0.5),
        'gla_gate_b': nrm(ks[11], (L, 2, GLA_QK), 0.1),
        'gla_norm_g': 1.0 + nrm(ks[12], (L, GLA_DV), 0.02),
        'lru_conv_w': nrm(ks[13], (L, CONV_W, LRU_WIDTH), CONV_W ** -0.5),
        'lru_conv_b': nrm(ks[14], (L, LRU_WIDTH), 0.02),
        'lru_wa': nrm(ks[15], (L, 2, LRU_BLOCKS, LRU_BLOCK_W, LRU_BLOCK_W), LRU_BLOCK_W ** -0.5),
        'lru_ba': nrm(ks[16], (L, 2, LRU_WIDTH), 0.02),
        'lru_wx': nrm(ks[17], (L, 2, LRU_BLOCKS, LRU_BLOCK_W, LRU_BLOCK_W), LRU_BLOCK_W ** -0.5),
        'lru_bx': nrm(ks[18], (L, 2, LRU_WIDTH), 0.02),
        'lru_lambda': jnp.log(lam_s) - jnp.log1p(-lam_s),
        'w_out': nrm(ks[20], (L, D_MIX, D), D_MIX ** -0.5),
        'router_g_w': nrm(ks[21], (L, D, N_GROUPS), D ** -0.5),
        'router_g_b': nrm(ks[22], (L, N_GROUPS), 0.01),
        'router_e_w': nrm(ks[23], (L, D, N_EXPERTS), D ** -0.5),
        'router_e_b': nrm(ks[24], (L, N_EXPERTS), 0.01),
        'moe_w1': nrm(ks[25], (L, N_EXPERTS, D, D_FF_EXPERT), D ** -0.5),
        'moe_w3': nrm(ks[26], (L, N_EXPERTS, D, D_FF_EXPERT), D ** -0.5),
        'moe_w2': nrm(ks[27], (L, N_EXPERTS, D_FF_EXPERT, D), D_FF_EXPERT ** -0.5),
        'final_norm_g': 1.0 + nrm(ks[28], (D,), 0.02),
    }


def reference(x, c, ctx, c_ctx, ada_w, ada_b, norm_mix_g, norm_ffn_g, w_in, attn_sink, gla_gate_w2, gla_gate_b, gla_norm_g, lru_conv_w, lru_conv_b, lru_wa, lru_ba, lru_wx, lru_bx, lru_lambda, w_out, router_g_w, router_g_b, router_e_w, router_e_b, moe_w1, moe_w3, moe_w2, final_norm_g):
    B, S, D = x.shape
    C = ctx.shape[1]
    cos, sin = axial_rope_angles(S)
    cond_l = jax.nn.silu(c)
    cond_c = jax.nn.silu(c_ctx)
    h_lat, h_ctx = x, ctx
    for i in range(DEPTH):
        last = i == DEPTH - 1
        mods_l = [m[:, None, :] for m in jnp.split(cond_l @ ada_w[i] + ada_b[i], 6, axis=-1)]
        mods_c = jnp.split(cond_c @ ada_w[i] + ada_b[i], 6, axis=-1)
        sh1_l, sc1_l, g1_l, sh2_l, sc2_l, g2_l = mods_l
        sh1_c, sc1_c, g1_c, sh2_c, sc2_c, g2_c = mods_c
        u_l = modulate(rms_norm(h_lat, norm_mix_g[i]), sh1_l, sc1_l)
        u_c = modulate(rms_norm(h_ctx, norm_mix_g[i]), sh1_c, sc1_c)
        y_l, y_c = hybrid_mixer(u_l, u_c, cos, sin, w_in[i], attn_sink[i], gla_gate_w2[i], gla_gate_b[i], gla_norm_g[i], lru_conv_w[i], lru_conv_b[i], lru_wa[i], lru_ba[i], lru_wx[i], lru_bx[i], lru_lambda[i], w_out[i], not last)
        h_lat = h_lat + g1_l * y_l
        v_l = modulate(rms_norm(h_lat, norm_ffn_g[i]), sh2_l, sc2_l).reshape(B * S, D)
        moe_args = (router_g_w[i], router_g_b[i], router_e_w[i], router_e_b[i], moe_w1[i], moe_w3[i], moe_w2[i])
        if last:
            f_l = hierarchical_moe(v_l, *moe_args)
        else:
            h_ctx = h_ctx + g1_c * y_c
            v_c = modulate(rms_norm(h_ctx, norm_ffn_g[i]), sh2_c, sc2_c).reshape(B * C, D)
            f = hierarchical_moe(jnp.concatenate([v_l, v_c], axis=0), *moe_args)
            f_l = f[:B * S]
            h_ctx = h_ctx + g2_c * f[B * S:].reshape(B, C, D)
        h_lat = h_lat + g2_l * f_l.reshape(B, S, D)
    return rms_norm(h_lat, final_norm_g)
```

```cpp
#include <hip/hip_runtime.h>
#include <stdint.h>
#include <stdio.h>

#ifndef REP_SUB
#define REP_SUB -1
#endif
#ifndef BG_B0
#define BG_B0 8
#endif
#ifndef BG_B1
#define BG_B1 4
#endif
#ifndef NCONV_WG
#define NCONV_WG 0
#endif
#ifndef FILL_Q
#define FILL_Q 0
#endif
#ifndef MK_ONE_LAUNCH
#define MK_ONE_LAUNCH 1
#endif

typedef unsigned short bf16_t;
typedef short bf16x8 __attribute__((ext_vector_type(8)));
typedef float f32x4 __attribute__((ext_vector_type(4)));
#define DEVI __device__ __forceinline__

constexpr int D = 2048, NB = 4, SEQ = 4096, CTX = 256;
constexpr int NL = NB * SEQ, NC = NB * CTX, NT = NL + NC;
constexpr int NCH = 68;
constexpr int TT = SEQ + CTX;
constexpr int ZLD = 4096;
constexpr int ZQ = 0, ZK = 1024, ZGQ = 1536, ZGK = 1792, ZGR = 2560, ZLX = 3072, ZLG = 3584;
constexpr int NWIN = 4352;
constexpr int TOKCAP = NT;
constexpr int H1ROWS = 43008;

constexpr size_t al256(size_t x) { return (x + 255) & ~(size_t)255; }
constexpr size_t WS_CTL = 0;
constexpr size_t WS_MODS = 65536;
constexpr size_t WS_ROPEC = WS_MODS + al256((size_t)2 * 5 * 12288 * 4);
constexpr size_t WS_ROPES = WS_ROPEC + (size_t)4096 * 64 * 4;
constexpr size_t WS_ROPEF = WS_ROPES + (size_t)4096 * 64 * 4;
constexpr size_t WS_LRUWT = WS_ROPEF + 256;
constexpr size_t WS_WRT = WS_LRUWT + (size_t)2 * 8 * 256 * 64 * 2;
constexpr size_t WS_WINT = WS_WRT + (size_t)2 * 48 * 2048 * 2;
constexpr size_t WS_WOUTT = WS_WINT + (size_t)2 * NWIN * 2048 * 2;
constexpr size_t WS_WUPT = WS_WOUTT + (size_t)2 * 2048 * 2048 * 2;
constexpr size_t WS_WDNT = WS_WUPT + (size_t)2 * 32 * 2048 * 2048 * 2;
constexpr size_t WS_H = WS_WDNT + (size_t)2 * 32 * 2048 * 1024 * 2;
constexpr size_t WS_U = WS_H + (size_t)NT * D * 4;
constexpr size_t WS_Z = WS_U + (size_t)NT * D * 2;
constexpr size_t WS_GZ = WS_Z + (size_t)NT * ZLD * 2;
constexpr size_t WS_VT = WS_GZ + (size_t)NT * 32 * 4;
constexpr size_t WS_GVT = WS_VT + (size_t)8 * 128 * TT * 2;
constexpr size_t WS_MIX = WS_GVT + (size_t)16 * 128 * TT * 2;
constexpr size_t WS_CONTRIB = WS_MIX + (size_t)NT * D * 2;
constexpr size_t WS_SBEF = WS_CONTRIB + (size_t)32 * NCH * 8192 * 4;
constexpr size_t WS_ATOT = WS_SBEF + (size_t)32 * NCH * 8192 * 4;
constexpr size_t WS_LRUA = WS_ATOT + (size_t)32 * NCH * 64 * 4;
constexpr size_t WS_LRUB = WS_LRUA + (size_t)NB * NCH * 2 * 512 * 4;
constexpr size_t WS_LRUC = WS_LRUB + (size_t)NB * NCH * 2 * 512 * 4;
constexpr size_t WS_TOKL = WS_LRUC + (size_t)NB * NCH * 2 * 512 * 4;
constexpr size_t WS_GATEL = WS_TOKL + (size_t)32 * TOKCAP * 4;
constexpr size_t WS_H1 = WS_GATEL + (size_t)32 * TOKCAP * 4;
constexpr size_t WS_SLOTS = WS_H1 + (size_t)H1ROWS * 1024 * 2;
constexpr size_t WS_CUMG = WS_SLOTS + (size_t)NT * 2 * D * 2;
constexpr size_t WS_END = WS_CUMG + (size_t)NB * 4 * NCH * 2 * 4096 * 4;
constexpr int CTL_COUNT = 4096;

constexpr int LDS_BYTES = 155648;
constexpr int LDS_MISC = 139264;

struct Params {
    const float* in[29];
    float* out;
    unsigned char* ws;
    int ph_lo, ph_hi;
};

typedef __attribute__((address_space(1))) const float gcf_t;
typedef __attribute__((address_space(1))) float gf_t;
typedef __attribute__((address_space(1))) unsigned char guc_t;
struct ParamsK {
    gcf_t* in[29];
    gf_t* out;
    guc_t* ws;
    int ph_lo, ph_hi;
};
static_assert(sizeof(ParamsK) == sizeof(Params), "kernarg view");
__device__ __forceinline__ void load_params(Params& q) {
    const __attribute__((address_space(4))) ParamsK* kp = (const __attribute__((address_space(4))) ParamsK*)__builtin_amdgcn_kernarg_segment_ptr();
    asm volatile("" : "+s"(kp));
#pragma unroll
    for (int i = 0; i < 29; ++i) q.in[i] = (const float*)kp->in[i];
    q.out = (float*)kp->out; q.ws = (unsigned char*)kp->ws; q.ph_lo = kp->ph_lo; q.ph_hi = kp->ph_hi;
}

DEVI float bf2f(bf16_t v) { return __uint_as_float(((unsigned)v) << 16); }
DEVI float bflo(unsigned v) { return __uint_as_float(v << 16); }
DEVI float bfhi(unsigned v) { return __uint_as_float(v & 0xffff0000u); }
DEVI unsigned pk2(float lo, float hi) { unsigned r; asm("v_cvt_pk_bf16_f32 %0, %1, %2" : "=v"(r) : "v"(lo), "v"(hi)); return r; }
DEVI bf16_t f2bf(float f) { return (bf16_t)(pk2(f, 0.f) & 0xffffu); }
DEVI float shx(float v, int mask, int lane) { return __int_as_float(__builtin_amdgcn_ds_bpermute((lane ^ mask) << 2, __float_as_int(v))); }
DEVI float shidx(float v, int src) { return __int_as_float(__builtin_amdgcn_ds_bpermute(src << 2, __float_as_int(v))); }
DEVI float shup(float v, int off, int lane) { const int src = lane >= off ? lane - off : lane; return shidx(v, src); }
DEVI float wave_sum(float v, int lane) {
#pragma unroll
    for (int o = 32; o > 0; o >>= 1) v += shx(v, o, lane);
    return v;
}
DEVI float rcpf_(float x) { return __builtin_amdgcn_rcpf(x); }
DEVI float sigmoidf_(float x) { return rcpf_(1.f + __builtin_amdgcn_exp2f(-1.4426950408889634f * x)); }
DEVI float siluf_(float x) { return x * sigmoidf_(x); }
DEVI float gelu_tanh(float x) {
    const float y2 = 1.5957691216057308f * (x + 0.044715f * x * x * x);
    return x * sigmoidf_(y2);
}
DEVI float logsigmoidf_(float z) { return fminf(z, 0.f) - log1pf(expf(-fabsf(z))); }
DEVI bf16x8 mk8(unsigned a, unsigned b, unsigned c, unsigned d) {
    typedef unsigned u4 __attribute__((ext_vector_type(4)));
    u4 t = {a, b, c, d};
    return __builtin_bit_cast(bf16x8, t);
}
DEVI int hw_lane() { int l; asm volatile("v_mbcnt_lo_u32_b32 %0, -1, 0\n\tv_mbcnt_hi_u32_b32 %0, -1, %0" : "=v"(l)); return l; }
DEVI int opaque_tid(int wv) { int t = wv * 64 + hw_lane(); asm volatile("" : "+v"(t)); return t; }
DEVI void lds_sync() { asm volatile("s_waitcnt lgkmcnt(0)" ::: "memory"); __builtin_amdgcn_s_barrier(); asm volatile("" ::: "memory"); }
#define MFMA16(a, b, c) __builtin_amdgcn_mfma_f32_16x16x32_bf16((a), (b), (c), 0, 0, 0)

#define XB_TMO      128
#define XB_XCNT(j)  (256  + 64 * (j))
#define XB_XSUB(j)  (1280 + 64 * (j))
#define XB_XGEN(j)  (2304 + 64 * (j))
#define XB_TOP      3328
#define XB_TOPGEN   3392
#define XCD_BAR_WORDS 3456
#define XB_SPIN_CAP (1u << 18)
#define LAS __attribute__((address_space(3)))

__device__ __forceinline__ unsigned xb_ld(unsigned* p)              { return __hip_atomic_load(p, __ATOMIC_RELAXED, __HIP_MEMORY_SCOPE_AGENT); }
__device__ __forceinline__ unsigned xb_add(unsigned* p, unsigned v) { return __hip_atomic_fetch_add(p, v, __ATOMIC_RELAXED, __HIP_MEMORY_SCOPE_AGENT); }
__device__ __forceinline__ unsigned xb_xcc_id() { return (unsigned)__builtin_amdgcn_s_getreg((3 << 11) | 20) & 0xFu; }
#define XB_SPIN(cond, bar) do { unsigned _sp = 0; while (cond) { __builtin_amdgcn_s_sleep(1); \
    if ((++_sp & 255u) == 0u) { if (xb_ld(&(bar)[XB_TMO])) break; if (_sp > XB_SPIN_CAP) { atomicAdd(&(bar)[XB_TMO], 1u); break; } } } } while (0)

struct XcdBarrier {
    unsigned* bar; unsigned x;
    volatile LAS unsigned* st;
};
__device__ __forceinline__ XcdBarrier xcd_barrier_post(unsigned* bar, volatile LAS unsigned* st, bool t0) {
    XcdBarrier b; b.bar = bar; b.x = xb_xcc_id(); b.st = st;
    if (t0) (void)xb_add(&bar[XB_XCNT(b.x)], 1u);
    return b;
}
__device__ __forceinline__ void xcd_barrier_complete(unsigned* bar, unsigned x, unsigned& nloc, unsigned& nx) {
    const unsigned G = gridDim.x * gridDim.y * gridDim.z;
    unsigned sum, cnt, mine, sp = 0u;
    for (;;) {
        sum = 0u; cnt = 0u; mine = 0u;
#pragma unroll
        for (unsigned j = 0; j < 16; ++j) { const unsigned c = xb_ld(&bar[XB_XCNT(j)]); sum += c; cnt += (c > 0u) ? 1u : 0u; mine = (j == x) ? c : mine; }
        if (sum == G) break;
        __builtin_amdgcn_s_sleep(1);
        if ((++sp & 255u) == 0u) { if (xb_ld(&bar[XB_TMO])) break; if (sp > XB_SPIN_CAP) { atomicAdd(&bar[XB_TMO], 1u); break; } }
    }
    nloc = mine > 0u ? mine : 1u; nx = cnt > 0u ? cnt : 1u;
}
__device__ __forceinline__ void xcd_barrier(const XcdBarrier& b, bool t0) {
    asm volatile("s_waitcnt vmcnt(0)" ::: "memory");
    __syncthreads();
    if (t0) {
        unsigned* bar = b.bar;
        __builtin_amdgcn_s_waitcnt(0);
        unsigned nloc = b.st[0], nx = b.st[1];
        if (nloc == 0u) { xcd_barrier_complete(bar, b.x, nloc, nx); b.st[0] = nloc; b.st[1] = nx; }
        const unsigned old = xb_add(&bar[XB_XSUB(b.x)], 1u);
        const unsigned gen = old / nloc;
        if (old + 1u == (gen + 1u) * nloc) {
            __builtin_amdgcn_fence(__ATOMIC_RELEASE, "agent");
            asm volatile("s_waitcnt vmcnt(0)" ::: "memory");
            const unsigned og = xb_add(&bar[XB_TOP], 1u);
            const unsigned tg = og / nx;
            if (og + 1u == (tg + 1u) * nx) xb_add(&bar[XB_TOPGEN], 1u);
            else XB_SPIN(xb_ld(&bar[XB_TOPGEN]) == tg, bar);
            __builtin_amdgcn_fence(__ATOMIC_ACQUIRE, "agent");
            xb_add(&bar[XB_XGEN(b.x)], 1u);
            asm volatile("s_waitcnt vmcnt(0)" ::: "memory");
        } else {
            XB_SPIN(xb_ld(&bar[XB_XGEN(b.x)]) == gen, bar);
            __builtin_amdgcn_fence(__ATOMIC_ACQUIRE, "agent");
            asm volatile("s_waitcnt vmcnt(0)" ::: "memory");
        }
    }
    __syncthreads();
}

DEVI bool unit_of(int i, int nunits, int& u, int geff = 0) {
    const long Lx = (long)i * (geff ? geff : (int)gridDim.x) + blockIdx.x;
    if (Lx >= nunits) return false;
    const int w = (int)Lx, q = nunits / 8, r = nunits % 8, xcd = w % 8, off = w / 8;
    u = (xcd < r ? xcd * (q + 1) : r * (q + 1) + (xcd - r) * q) + off;
    return true;
}

constexpr int G_BK = 64, G_HALF = 128, G_HT = G_HALF * G_BK;
DEVI int g_lds_byte(int r, int c) {
    int st = (r >> 4) * 2 + (c >> 5), rr = r & 15, cc = c & 31, ob = rr * 64 + cc * 2;
    return st * 1024 + (ob ^ (((ob >> 9) & 1) << 5));
}
DEVI void g_stage_rc(int b, int& R, int& C) {
    int st = b / 1024, sb = b % 1024, swz = sb ^ (((sb >> 9) & 1) << 5);
    R = (st >> 1) * 16 + swz / 64; C = (st & 1) * 32 + (swz % 64) / 2;
}

template <bool GATHER, class Epi>
DEVI void gemm_tile(const int tid_, bf16_t* shm, const bf16_t* __restrict__ A, unsigned lda, unsigned a0, unsigned a1, unsigned a2, unsigned a3,
                    const bf16_t* __restrict__ Bt, int K, const Epi& epi) {
#define SA(b, h) (shm + ((b) * 2 + (h)) * G_HT)
#define SB(b, h) (shm + (4 + (b) * 2 + (h)) * G_HT)
#define STG_A(T, P, h, kt) do { const unsigned so_ = (unsigned)(kt) * 128u + ((GATHER || !(h)) ? 0u : 256u * lda); \
    __builtin_amdgcn_raw_ptr_buffer_load_lds(rsA, (LAS void*)((char*)(P) + ldsw), 16, (GATHER && (h)) ? a2 : a0, so_, 0, 0); \
    __builtin_amdgcn_raw_ptr_buffer_load_lds(rsA, (LAS void*)((char*)(P) + ldsw + 8192), 16, (GATHER && (h)) ? a3 : a1, so_, 0, 0); } while (0)
#define STG_B(T, P, h, kt) do { const unsigned so_ = (unsigned)(kt) * 128u + ((h) ? 256u * (unsigned)K : 0u); \
    __builtin_amdgcn_raw_ptr_buffer_load_lds(rsB, (LAS void*)((char*)(P) + ldsw), 16, b0, so_, 0, 0); \
    __builtin_amdgcn_raw_ptr_buffer_load_lds(rsB, (LAS void*)((char*)(P) + ldsw + 8192), 16, b1, so_, 0, 0); } while (0)
#define LDA(dst, b, h) for (int m = 0; m < 4; ++m) for (int k = 0; k < 2; ++k) \
    dst[m][k] = *reinterpret_cast<const bf16x8*>((char*)SA(b, h) + g_lds_byte(wr * 64 + m * 16 + fr, k * 32 + fq * 8))
#define LDB(dst, b, h) for (int n = 0; n < 2; ++n) for (int k = 0; k < 2; ++k) \
    dst[n][k] = *reinterpret_cast<const bf16x8*>((char*)SB(b, h) + g_lds_byte(wc * 32 + n * 16 + fr, k * 32 + fq * 8))
#define MMA(ai, bj, At_, Bt_) do { __builtin_amdgcn_s_setprio(1); \
    for (int m = 0; m < 4; ++m) for (int n = 0; n < 2; ++n) for (int k = 0; k < 2; ++k) \
        acc[ai][bj][m][n] = __builtin_amdgcn_mfma_f32_16x16x32_bf16(Bt_[n][k], At_[m][k], acc[ai][bj][m][n], 0, 0, 0); \
    __builtin_amdgcn_s_setprio(0); } while (0)
#define WAIT_V(n) asm volatile("s_waitcnt vmcnt(" #n ")" ::: "memory")
#define WAIT_L(n) asm volatile("s_waitcnt lgkmcnt(" #n ")" ::: "memory")
#define BAR __builtin_amdgcn_s_barrier()
#define SCHED __builtin_amdgcn_sched_barrier(0)
    unsigned b0, b1;
    { int r_, c_; g_stage_rc(tid_ * 16, r_, c_); b0 = (unsigned)(r_ * K + c_) * 2u; g_stage_rc(tid_ * 16 + 8192, r_, c_); b1 = (unsigned)(r_ * K + c_) * 2u; }
    const __amdgpu_buffer_rsrc_t rsA = __builtin_amdgcn_make_buffer_rsrc((void*)A, (short)0, 0x7fffffff, 0x00020000);
    const __amdgpu_buffer_rsrc_t rsB = __builtin_amdgcn_make_buffer_rsrc((void*)Bt, (short)0, 0x7fffffff, 0x00020000);
    const unsigned ldsw = (unsigned)__builtin_amdgcn_readfirstlane(tid_ >> 6) * 1024u;
    const int T = tid_;
    int wid = T >> 6, lane = T & 63, wr = wid >> 2, wc = wid & 3, fr = lane & 15, fq = lane >> 4;
    f32x4 acc[2][2][4][2] = {};
    bf16x8 At[4][2], B0[2][2], B1[2][2];
    const int nt = K / G_BK;
    STG_B(T, SB(0, 0), 0, 0); STG_A(T, SA(0, 0), 0, 0);
    STG_B(T, SB(0, 1), 1, 0); STG_A(T, SA(0, 1), 1, 0);
    if (wr == 1) BAR;
    WAIT_V(4); BAR;
    STG_B(T, SB(1, 0), 0, 1); STG_A(T, SA(1, 0), 0, 1); STG_B(T, SB(1, 1), 1, 1);
    WAIT_V(6); BAR;
    for (int t = 0; t < nt - 2; t += 2) {
        LDB(B0, 0, 0); SCHED; LDA(At, 0, 0); STG_A(T, SA(1, 1), 1, t + 1);
        WAIT_L(8); BAR; WAIT_L(0); MMA(0, 0, At, B0); BAR; SCHED;
        LDB(B1, 0, 1); STG_B(T, SB(0, 0), 0, t + 2);
        BAR; WAIT_L(0); MMA(0, 1, At, B1); BAR;
        LDA(At, 0, 1); STG_A(T, SA(0, 0), 0, t + 2);
        BAR; WAIT_L(0); MMA(1, 0, At, B0); BAR; SCHED;
        STG_B(T, SB(0, 1), 1, t + 2);
        WAIT_V(6); BAR; MMA(1, 1, At, B1); BAR;
        LDB(B0, 1, 0); SCHED; LDA(At, 1, 0); STG_A(T, SA(0, 1), 1, t + 2);
        WAIT_L(8); BAR; WAIT_L(0); MMA(0, 0, At, B0); BAR; SCHED;
        LDB(B1, 1, 1); STG_B(T, SB(1, 0), 0, t + 3);
        BAR; WAIT_L(0); MMA(0, 1, At, B1); BAR;
        LDA(At, 1, 1); STG_A(T, SA(1, 0), 0, t + 3);
        BAR; WAIT_L(0); MMA(1, 0, At, B0); BAR; SCHED;
        STG_B(T, SB(1, 1), 1, t + 3);
        WAIT_V(6); BAR; MMA(1, 1, At, B1); BAR;
    }
    int tz = tid_; asm volatile("" : "+v"(tz)); wid = tz >> 6; lane = tz & 63; wr = wid >> 2; wc = wid & 3; fr = lane & 15; fq = lane >> 4;
    { LDB(B0, 0, 0); WAIT_V(0); LDA(At, 0, 0); STG_A(tz, SA(1, 1), 1, nt - 1);
      BAR; WAIT_L(0); MMA(0, 0, At, B0); BAR;
      LDB(B1, 0, 1); BAR; WAIT_L(0); MMA(0, 1, At, B1); BAR;
      LDA(At, 0, 1); WAIT_V(4); BAR; WAIT_L(0); MMA(1, 0, At, B0); MMA(1, 1, At, B1); BAR; }
    { LDB(B0, 1, 0); LDA(At, 1, 0); WAIT_V(2); BAR; WAIT_L(0); MMA(0, 0, At, B0); BAR;
      LDB(B1, 1, 1); WAIT_V(0); BAR; WAIT_L(0); MMA(0, 1, At, B1); BAR;
      LDA(At, 1, 1); BAR; WAIT_L(0); MMA(1, 0, At, B0); MMA(1, 1, At, B1); BAR; }
    if (wr == 0) BAR;
    SCHED;
    epi(acc, wr, wc, fr, fq, tz, (unsigned char*)shm);
#undef SA
#undef SB
#undef STG_A
#undef STG_B
#undef LDA
#undef LDB
#undef MMA
}

DEVI void aoff_plain(const int tid_, int lda, unsigned& a0, unsigned& a1) {
    int r, c;
    g_stage_rc(tid_ * 16, r, c);        a0 = (unsigned)(r * lda + c) * 2u;
    g_stage_rc(tid_ * 16 + 8192, r, c); a1 = (unsigned)(r * lda + c) * 2u;
}

constexpr int NU_WIN = 2 * 68 * 16, NU_WOUT = 2 * 32 * 16, NU_UP = 64 * 32 * 16, NU_DN = 64 * 32 * 8;
constexpr int NU_CONV = NU_WIN + NU_WOUT + NU_UP + NU_DN;
constexpr int NU_ADA = 768, NU_ROPE = 512, NU_LRUW = 512, NU_WR = 384;
constexpr int NU_P0 = NU_CONV + NU_ADA + NU_ROPE + NU_LRUW + NU_WR;

DEVI void conv_decode(const Params& p, int u, const float*& srck, int& ld_src, int& c0, int& nv, bf16_t*& dstn, int& ld_dst) {
    if (u < NU_WIN) {
        const int L = u / 1088, rem = u % 1088, ntile = rem >> 4, ktile = rem & 15, n0 = ntile * 64;
        if (n0 < 3072) { c0 = n0; nv = 64; } else if (n0 < 4096) { c0 = n0 + 32; nv = 64; } else if (n0 == 4096) { c0 = 3072; nv = 32; } else { c0 = 0; nv = 0; }
        srck = p.in[8] + (size_t)L * 2048 * 4128 + (size_t)ktile * 128 * 4128; ld_src = 4128;
        dstn = (bf16_t*)(p.ws + WS_WINT) + ((size_t)L * NWIN + n0) * 2048 + ktile * 128; ld_dst = 2048;
    } else if (u < NU_WIN + NU_WOUT) {
        const int v = u - NU_WIN, L = v >> 9, rem = v & 511, ntile = rem >> 4, ktile = rem & 15;
        srck = p.in[20] + (size_t)L * 2048 * 2048 + (size_t)ktile * 128 * 2048; ld_src = 2048; c0 = ntile * 64; nv = 64;
        dstn = (bf16_t*)(p.ws + WS_WOUTT) + ((size_t)L * 2048 + ntile * 64) * 2048 + ktile * 128; ld_dst = 2048;
    } else if (u < NU_WIN + NU_WOUT + NU_UP) {
        const int v = u - NU_WIN - NU_WOUT, le = v >> 9, rem = v & 511, ntile = rem >> 4, ktile = rem & 15;
        const int nt = ntile >> 2, half = (ntile >> 1) & 1, i0 = (ntile & 1) * 64;
        srck = (half ? p.in[26] : p.in[25]) + (size_t)le * 2048 * 1024 + (size_t)ktile * 128 * 1024; ld_src = 1024; c0 = nt * 128 + i0; nv = 64;
        dstn = (bf16_t*)(p.ws + WS_WUPT) + ((size_t)le * 2048 + ntile * 64) * 2048 + ktile * 128; ld_dst = 2048;
    } else {
        const int v = u - NU_WIN - NU_WOUT - NU_UP, le = v >> 8, rem = v & 255, ntile = rem >> 3, ktile = rem & 7;
        srck = p.in[27] + (size_t)le * 1024 * 2048 + (size_t)ktile * 128 * 2048; ld_src = 2048; c0 = ntile * 64; nv = 64;
        dstn = (bf16_t*)(p.ws + WS_WDNT) + ((size_t)le * 2048 + ntile * 64) * 1024 + ktile * 128; ld_dst = 1024;
    }
}

constexpr int CTL_QHEAD = 4200, CTL_DONE = 4224;
constexpr int QE0 = 1088, QE1 = 1600, QE2 = 17984, QE3 = 26176, QE4 = 27264, QE5 = 27776, QE6 = 44160, QE7 = 52352;
static_assert(QE7 == NU_CONV, "queue length");
DEVI int q_to_unit(int q) {
    if (q < QE0) return q;
    if (q < QE1) return NU_WIN + (q - QE0);
    if (q < QE2) return NU_WIN + NU_WOUT + (q - QE1);
    if (q < QE3) return NU_WIN + NU_WOUT + NU_UP + (q - QE2);
    if (q < QE4) return 1088 + (q - QE3);
    if (q < QE5) return NU_WIN + 512 + (q - QE4);
    if (q < QE6) return NU_WIN + NU_WOUT + 16384 + (q - QE5);
    return NU_WIN + NU_WOUT + NU_UP + 8192 + (q - QE6);
}
DEVI int q_deadline(int k) {
    return k < 1 ? 0 : k < 5 ? QE0 : k < 7 ? QE1 : k < 8 ? QE2 : k < 10 ? QE3 : k < 14 ? QE4 : k < 16 ? QE5 : k < 17 ? QE6 : QE7;
}
typedef unsigned u32x4_t __attribute__((ext_vector_type(4)));
DEVI float4 ntld4(const float* p) { const f32x4 v = __builtin_nontemporal_load((const f32x4*)p); return make_float4(v[0], v[1], v[2], v[3]); }
DEVI void ntst4(const uint4& o, bf16_t* p) { u32x4_t v = {o.x, o.y, o.z, o.w}; __builtin_nontemporal_store(v, (u32x4_t*)p); }
DEVI void conv_run(const int tid_, const Params& p, float* T, int q0, int count) {
    const int t = tid_, n4 = t & 15, kr = t >> 4;
    float4 v0, v1, v2, v3, x0, x1, x2, x3;
    const float* srck; bf16_t* dstn; int ld_src, ld_dst, c0, nv;
    bf16_t* d1 = nullptr; int l1 = 0; bf16_t* d2 = nullptr; int l2 = 0;
#define CV_LOAD(a0_, a1_, a2_, a3_) do { const float* s_ = srck + c0 + n4 * 4; \
        a0_ = make_float4(0.f, 0.f, 0.f, 0.f); a1_ = a0_; a2_ = a0_; a3_ = a0_; \
        if (n4 * 4 < nv) { a0_ = ntld4((s_ + (size_t)(kr) * ld_src)); a1_ = ntld4((s_ + (size_t)(kr + 32) * ld_src)); \
                           a2_ = ntld4((s_ + (size_t)(kr + 64) * ld_src)); a3_ = ntld4((s_ + (size_t)(kr + 96) * ld_src)); } } while (0)
    conv_decode(p, q_to_unit(q0), srck, ld_src, c0, nv, dstn, ld_dst); d1 = dstn; l1 = ld_dst; CV_LOAD(v0, v1, v2, v3);
    x0 = make_float4(0.f, 0.f, 0.f, 0.f); x1 = x0; x2 = x0; x3 = x0;
    if (count > 1) { conv_decode(p, q_to_unit(q0 + 1), srck, ld_src, c0, nv, dstn, ld_dst); d2 = dstn; l2 = ld_dst; CV_LOAD(x0, x1, x2, x3); }
#pragma unroll 1
    for (int i = 0; i < count; ++i) {
        const float4 w0 = v0, w1 = v1, w2 = v2, w3 = v3;
        bf16_t* const dcur = d1; const int ldd = l1;
        v0 = x0; v1 = x1; v2 = x2; v3 = x3; d1 = d2; l1 = l2;
        if (i + 2 < count) { conv_decode(p, q_to_unit(q0 + i + 2), srck, ld_src, c0, nv, dstn, ld_dst); d2 = dstn; l2 = ld_dst; CV_LOAD(x0, x1, x2, x3); }
        lds_sync();
        { float* d = T + kr * 65 + n4 * 4; d[0] = w0.x; d[1] = w0.y; d[2] = w0.z; d[3] = w0.w; }
        { float* d = T + (kr + 32) * 65 + n4 * 4; d[0] = w1.x; d[1] = w1.y; d[2] = w1.z; d[3] = w1.w; }
        { float* d = T + (kr + 64) * 65 + n4 * 4; d[0] = w2.x; d[1] = w2.y; d[2] = w2.z; d[3] = w2.w; }
        { float* d = T + (kr + 96) * 65 + n4 * 4; d[0] = w3.x; d[1] = w3.y; d[2] = w3.z; d[3] = w3.w; }
        lds_sync();
#pragma unroll
        for (int i2 = 0; i2 < 2; ++i2) {
            const int kc = t & 15, n = (t >> 4) + 32 * i2;
            float f[8];
#pragma unroll
            for (int j = 0; j < 8; ++j) f[j] = T[(kc * 8 + j) * 65 + n];
            uint4 o; o.x = pk2(f[0], f[1]); o.y = pk2(f[2], f[3]); o.z = pk2(f[4], f[5]); o.w = pk2(f[6], f[7]);
            ntst4(o, dcur + (size_t)n * ldd + kc * 8);
        }
    }
#undef CV_LOAD
}
DEVI void bg_convert(const int tid_, const Params& p, unsigned char* lds, int k) {
    typedef __attribute__((address_space(1))) unsigned gu32_t;
    gu32_t* ctl = (gu32_t*)(p.ws + WS_CTL);
    volatile int* lw = (volatile int*)(lds + LDS_MISC + 64);
    float* T = (float*)lds;
    const int t = tid_;
    const int deadline = q_deadline(k), G = (int)gridDim.x;
#pragma unroll 1
    for (int stage = (k > 0 && q_deadline(k) == q_deadline(k - 1)) ? 1 : 0; stage < 2; ++stage) {
        if (stage == 1 && t == 0) (void)__hip_atomic_fetch_add(ctl + CTL_DONE + 64 * k, 1u, __ATOMIC_RELAXED, __HIP_MEMORY_SCOPE_AGENT);
        const int batch = (stage == 0) ? BG_B0 : BG_B1;
#pragma unroll 1
        for (;;) {
            if (t == 0) {
                int c = -1;
                const bool want = (stage == 0) ? ((int)__hip_atomic_load(ctl + CTL_QHEAD, __ATOMIC_RELAXED, __HIP_MEMORY_SCOPE_AGENT) < deadline)
                                               : ((int)__hip_atomic_load(ctl + CTL_DONE + 64 * k, __ATOMIC_RELAXED, __HIP_MEMORY_SCOPE_AGENT) < G);
                if (want) { c = (int)__hip_atomic_fetch_add(ctl + CTL_QHEAD, (unsigned)batch, __ATOMIC_RELAXED, __HIP_MEMORY_SCOPE_AGENT); if (c >= NU_CONV) c = -1; }
                lw[0] = c;
            }
            lds_sync();
            const int c = lw[0];
            lds_sync();
            if (c < 0) break;
            conv_run(tid_, p, T, c, (NU_CONV - c) < batch ? (NU_CONV - c) : batch);
        }
    }
}

DEVI void bg_fill(const int tid_, const Params& p, unsigned char* lds, int per_quarter) {
    typedef __attribute__((address_space(1))) unsigned gu32_t;
    gu32_t* ctl = (gu32_t*)(p.ws + WS_CTL);
    volatile int* lw = (volatile int*)(lds + LDS_MISC + 64);
    const int n = (int)(blockIdx.x & 3u) * per_quarter;
    if (n == 0) return;
    if (tid_ == 0) {
        int c = -1;
        if ((int)__hip_atomic_load(ctl + CTL_QHEAD, __ATOMIC_RELAXED, __HIP_MEMORY_SCOPE_AGENT) < NU_CONV) {
            c = (int)__hip_atomic_fetch_add(ctl + CTL_QHEAD, (unsigned)n, __ATOMIC_RELAXED, __HIP_MEMORY_SCOPE_AGENT); if (c >= NU_CONV) c = -1; }
        lw[0] = c;
    }
    lds_sync();
    const int c = lw[0];
    lds_sync();
    if (c >= 0) conv_run(tid_, p, (float*)lds, c, (NU_CONV - c) < n ? (NU_CONV - c) : n);
    lds_sync();
}

__constant__ double c_rope_inv[32] = {
    1.0, 0.7498942093324559, 0.5623413251903491, 0.4216965034285822, 0.31622776601683794, 0.23713737056616552, 0.1778279410038923, 0.1333521432163324,
    0.1, 0.07498942093324558, 0.05623413251903491, 0.042169650342858224, 0.03162277660168379, 0.023713737056616554, 0.01778279410038923, 0.01333521432163324,
    0.01, 0.007498942093324558, 0.005623413251903491, 0.004216965034285823, 0.0031622776601683794, 0.0023713737056616554, 0.0017782794100389228, 0.001333521432163324,
    0.001, 0.0007498942093324559, 0.0005623413251903491, 0.00042169650342858224, 0.00031622776601683794, 0.00023713737056616554, 0.00017782794100389227, 0.0001333521432163324};

DEVI void sincos_f64(double ang, float& sn, float& cs) {
    const double n = __builtin_rint(ang * 0.15915494309189535);
    double r = __builtin_fma(-n, 6.283185307179586, ang);
    r = __builtin_fma(-n, 2.4492935982947064e-16, r);
    const double x = 0.5 * r, x2 = x * x;
    double s = 1.0, c = 1.0;
#pragma unroll
    for (int k = 12; k >= 1; --k) {
        s = 1.0 - s * x2 * (1.0 / (double)((2 * k) * (2 * k + 1)));
        c = 1.0 - c * x2 * (1.0 / (double)((2 * k - 1) * (2 * k)));
    }
    s *= x;
    sn = (float)(2.0 * s * c); cs = (float)(1.0 - 2.0 * s * s);
}

DEVI void phase_prologue(const int tid_, const Params& p, unsigned char* lds) {
    float* T = (float*)lds;
    float* cond = (float*)(lds + 33280);
    float* red = (float*)(lds + 33280 + 40960);
    const int t = tid_;
    for (int i = t; i < 5 * 2048; i += 512) {
        const int r = i >> 11, k = i & 2047;
        const float c = r < 4 ? p.in[1][r * 2048 + k] : p.in[3][k];
        cond[i] = c / (1.f + expf(-c));
    }
    __syncthreads();
    __syncthreads();
    for (int u = NU_CONV + blockIdx.x; u < NU_P0; u += gridDim.x) {
        if (false) {
        } else if (u < NU_CONV + NU_ADA) {
            const int v = u - NU_CONV, L = v / 384, c0 = (v % 384) * 32;
            const float* W = p.in[4] + (size_t)L * 2048 * 12288;
            const int q = t & 7, kg = t >> 3;
            float acc[5][4];
#pragma unroll
            for (int r = 0; r < 5; ++r) { acc[r][0] = 0.f; acc[r][1] = 0.f; acc[r][2] = 0.f; acc[r][3] = 0.f; }
#pragma unroll 4
            for (int k = kg; k < 2048; k += 64) {
                const float4 w = *(const float4*)(W + (size_t)k * 12288 + c0 + q * 4);
#pragma unroll
                for (int r = 0; r < 5; ++r) {
                    const float cv = cond[r * 2048 + k];
                    acc[r][0] += cv * w.x; acc[r][1] += cv * w.y; acc[r][2] += cv * w.z; acc[r][3] += cv * w.w;
                }
            }
#pragma unroll
            for (int r = 0; r < 5; ++r)
#pragma unroll
                for (int j = 0; j < 4; ++j) {
                    float a = acc[r][j];
                    a += shx(a, 8, t & 63); a += shx(a, 16, t & 63); a += shx(a, 32, t & 63);
                    acc[r][j] = a;
                }
            const int lane = t & 63, wave = t >> 6;
            __syncthreads();
            if (lane < 8) {
#pragma unroll
                for (int r = 0; r < 5; ++r)
#pragma unroll
                    for (int j = 0; j < 4; ++j) red[(wave * 8 + lane) * 20 + r * 4 + j] = acc[r][j];
            }
            __syncthreads();
            if (t < 160) {
                const int qq = t / 20, rj = t % 20;
                float s = 0.f;
#pragma unroll
                for (int w = 0; w < 8; ++w) s += red[(w * 8 + qq) * 20 + rj];
                const int r = rj >> 2, j = rj & 3, col = c0 + qq * 4 + j;
                ((float*)(p.ws + WS_MODS))[(size_t)(L * 5 + r) * 12288 + col] = s + p.in[5][L * 12288 + col];
            }
        } else if (u < NU_CONV + NU_ADA + NU_ROPE) {
            const int idx = (u - NU_CONV - NU_ADA) * 512 + t, pos = idx >> 6, i = idx & 63;
            const int coord = i < 32 ? (pos >> 6) : (pos & 63);
            float sn, cs;
            sincos_f64((double)coord * c_rope_inv[i & 31], sn, cs);
            ((float*)(p.ws + WS_ROPEC))[idx] = cs;
            ((float*)(p.ws + WS_ROPES))[idx] = sn;
            if (idx < 32) ((float*)(p.ws + WS_ROPEF))[idx] = (float)(c_rope_inv[idx] * 0.15915494309189535);
        } else if (u < NU_CONV + NU_ADA + NU_ROPE + NU_LRUW) {
            const int idx = (u - NU_CONV - NU_ADA - NU_ROPE) * 512 + t;
            const int c = idx & 63, n = (idx >> 6) & 255, blk = (idx >> 14) & 7, L = idx >> 17;
            const int dg = n >> 6, dir = dg >> 1, gate = dg & 1, dd = n & 63;
            const float* src = gate ? p.in[17] : p.in[15];
            ((bf16_t*)(p.ws + WS_LRUWT))[idx] = f2bf(src[((size_t)((L * 2 + dir) * 8 + blk) * 64 + c) * 64 + dd]);
        } else {
            const int idx = (u - NU_CONV - NU_ADA - NU_ROPE - NU_LRUW) * 512 + t;
            const int k = idx & 2047, n = (idx >> 11) % 48, L = idx / (48 * 2048);
            float v = 0.f;
            if (n < 4) v = p.in[21][((size_t)L * 2048 + k) * 4 + n];
            else if (n < 36) v = p.in[23][((size_t)L * 2048 + k) * 32 + (n - 4)];
            ((bf16_t*)(p.ws + WS_WRT))[idx] = f2bf(v);
        }
    }
}

DEVI void phase_norm1(const int tid_, const Params& p, int L) {
    const int wave = tid_ >> 6, lane = tid_ & 63;
    float* H = (float*)(p.ws + WS_H);
    bf16_t* U = (bf16_t*)(p.ws + WS_U);
    const float* mods = (const float*)(p.ws + WS_MODS);
    const bf16_t* SL = (const bf16_t*)(p.ws + WS_SLOTS);
    const float* gmix = p.in[6] + L * 2048;
    float4 nx[8];
#define N1_SRC(r) (L == 0 ? ((r) < NL ? p.in[0] + (size_t)(r) * D : p.in[2] + (size_t)((r) - NL) * D) : H + (size_t)(r) * D)
    {
        const int r0 = blockIdx.x * 8 + wave;
        if (r0 < NT) { const float* s0 = N1_SRC(r0);
#pragma unroll
            for (int c = 0; c < 8; ++c) nx[c] = *(const float4*)(s0 + c * 256 + lane * 4); }
    }
    for (int row = blockIdx.x * 8 + wave; row < NT; row += gridDim.x * 8) {
        const int mrow = row < NL ? (row >> 12) : 4;
        const float* md = mods + (size_t)(L * 5 + mrow) * 12288;
        float4 hv[8];
#pragma unroll
        for (int c = 0; c < 8; ++c) hv[c] = nx[c];
        {
            const int rn = row + (int)gridDim.x * 8;
            if (rn < NT) { const float* s1 = N1_SRC(rn);
#pragma unroll
                for (int c = 0; c < 8; ++c) nx[c] = *(const float4*)(s1 + c * 256 + lane * 4); }
        }
        if (L == 1) {
            const float* g2 = mods + (size_t)(0 * 5 + mrow) * 12288 + 5 * 2048;
#pragma unroll
            for (int c = 0; c < 8; ++c) {
                const int col = c * 256 + lane * 4;
                const float4 g = *(const float4*)(g2 + col);
                const uint2 a = *(const uint2*)(SL + (size_t)(row * 2) * D + col), b = *(const uint2*)(SL + (size_t)(row * 2 + 1) * D + col);
                hv[c].x += g.x * (bflo(a.x) + bflo(b.x)); hv[c].y += g.y * (bfhi(a.x) + bfhi(b.x));
                hv[c].z += g.z * (bflo(a.y) + bflo(b.y)); hv[c].w += g.w * (bfhi(a.y) + bfhi(b.y));
            }
        }
        float ss = 0.f;
#pragma unroll
        for (int c = 0; c < 8; ++c) {
            if (L == 1) *(float4*)(H + (size_t)row * D + c * 256 + lane * 4) = hv[c];
            ss += hv[c].x * hv[c].x + hv[c].y * hv[c].y + hv[c].z * hv[c].z + hv[c].w * hv[c].w;
        }
        ss = wave_sum(ss, lane);
        const float rstd = rsqrtf(ss * (1.f / 2048.f) + 1e-6f);
#pragma unroll
        for (int c = 0; c < 8; ++c) {
            const int col = c * 256 + lane * 4;
            const float4 gm = *(const float4*)(gmix + col), sh = *(const float4*)(md + col), sc = *(const float4*)(md + 2048 + col);
            const float u0 = hv[c].x * rstd * gm.x * (1.f + sc.x) + sh.x, u1 = hv[c].y * rstd * gm.y * (1.f + sc.y) + sh.y;
            const float u2 = hv[c].z * rstd * gm.z * (1.f + sc.z) + sh.z, u3 = hv[c].w * rstd * gm.w * (1.f + sc.w) + sh.w;
            uint2 o; o.x = pk2(u0, u1); o.y = pk2(u2, u3);
            *(uint2*)(U + (size_t)row * D + col) = o;
        }
    }
#undef N1_SRC
}

DEVI void phase_final(const int tid_, const Params& p) {
    const int wave = tid_ >> 6, lane = tid_ & 63;
    const float* H = (const float*)(p.ws + WS_H);
    const float* mods = (const float*)(p.ws + WS_MODS);
    const bf16_t* SL = (const bf16_t*)(p.ws + WS_SLOTS);
    const float* gf = p.in[28];
    for (int row = blockIdx.x * 8 + wave; row < NL; row += gridDim.x * 8) {
        const int mrow = row >> 12;
        const float* g2 = mods + (size_t)(1 * 5 + mrow) * 12288 + 5 * 2048;
        float4 hv[8];
        float ss = 0.f;
#pragma unroll
        for (int c = 0; c < 8; ++c) {
            const int col = c * 256 + lane * 4;
            hv[c] = *(const float4*)(H + (size_t)row * D + col);
            const float4 g = *(const float4*)(g2 + col);
            const uint2 a = *(const uint2*)(SL + (size_t)(row * 2) * D + col), b = *(const uint2*)(SL + (size_t)(row * 2 + 1) * D + col);
            hv[c].x += g.x * (bflo(a.x) + bflo(b.x)); hv[c].y += g.y * (bfhi(a.x) + bfhi(b.x));
            hv[c].z += g.z * (bflo(a.y) + bflo(b.y)); hv[c].w += g.w * (bfhi(a.y) + bfhi(b.y));
            ss += hv[c].x * hv[c].x + hv[c].y * hv[c].y + hv[c].z * hv[c].z + hv[c].w * hv[c].w;
        }
        ss = wave_sum(ss, lane);
        const float rstd = rsqrtf(ss * (1.f / 2048.f) + 1e-6f);
#pragma unroll
        for (int c = 0; c < 8; ++c) {
            const int col = c * 256 + lane * 4;
            const float4 gm = *(const float4*)(gf + col);
            float4 o; o.x = hv[c].x * rstd * gm.x; o.y = hv[c].y * rstd * gm.y; o.z = hv[c].z * rstd * gm.z; o.w = hv[c].w * rstd * gm.w;
            *(float4*)(p.out + (size_t)row * D + col) = o;
        }
    }
}

constexpr int EP_RS = 528;
struct EpiIn {
    bf16_t* Z; float* GZ; bf16_t* VT; bf16_t* GVT; const float* RC; const float* RS; int brow, pn;
    DEVI void operator()(const f32x4 (&acc)[2][2][4][2], int wr, int wc, int fr, int fq, int tid, unsigned char* stg) const {
        if (pn == 16) {
#pragma unroll
            for (int ai = 0; ai < 2; ++ai)
#pragma unroll
                for (int m = 0; m < 4; ++m) {
                    const int row = brow + ai * 128 + wr * 64 + m * 16 + fr;
#pragma unroll
                    for (int n = 0; n < 2; ++n) { const int colt = wc * 32 + n * 16 + fq * 4; if (colt < 32) *(f32x4*)(GZ + (size_t)row * 32 + colt) = acc[ai][0][m][n]; }
                }
            return;
        }
        const bool tr = (pn == 5 || pn == 8 || pn == 9);
#pragma unroll
        for (int ai = 0; ai < 2; ++ai)
#pragma unroll
            for (int m = 0; m < 4; ++m) {
                const int rloc = ai * 128 + wr * 64 + m * 16 + fr, row = brow + rloc;
#pragma unroll
                for (int bj = 0; bj < 2; ++bj)
#pragma unroll
                    for (int n = 0; n < 2; ++n) {
                        const int colt = bj * 128 + wc * 32 + n * 16 + fq * 4;
                        const f32x4 v = acc[ai][bj][m][n];
                        float o0 = v[0], o1 = v[1], o2 = v[2], o3 = v[3];
                        if (pn <= 4) {
                            if (row < NL) {
                                const int tpos = row & 4095, i0 = (colt & 127) >> 1;
                                const float pos = (float)((i0 < 32) ? (tpos >> 6) : (tpos & 63));
                                const float r0 = pos * RC[i0 & 31], r1 = pos * RC[(i0 & 31) + 1];
                                const float c0 = __builtin_amdgcn_cosf(r0), s0 = __builtin_amdgcn_sinf(r0), c1 = __builtin_amdgcn_cosf(r1), s1 = __builtin_amdgcn_sinf(r1);
                                o0 = v[0] * c0 - v[1] * s0; o1 = v[0] * s0 + v[1] * c0;
                                o2 = v[2] * c1 - v[3] * s1; o3 = v[2] * s1 + v[3] * c1;
                            }
                            if (pn < 4) { o0 *= 0.12751743f; o1 *= 0.12751743f; o2 *= 0.12751743f; o3 *= 0.12751743f; }
                        }
                        if (!tr) { uint2 o; o.x = pk2(o0, o1); o.y = pk2(o2, o3); *(uint2*)(stg + rloc * EP_RS + colt * 2) = o; }
                        else {
                            const unsigned p01 = pk2(o0, o1), p23 = pk2(o2, o3);
                            *(bf16_t*)(stg + (colt + 0) * EP_RS + rloc * 2) = (bf16_t)(p01 & 0xffffu); *(bf16_t*)(stg + (colt + 1) * EP_RS + rloc * 2) = (bf16_t)(p01 >> 16);
                            *(bf16_t*)(stg + (colt + 2) * EP_RS + rloc * 2) = (bf16_t)(p23 & 0xffffu); *(bf16_t*)(stg + (colt + 3) * EP_RS + rloc * 2) = (bf16_t)(p23 >> 16);
                        }
                    }
            }
        lds_sync();
        if (!tr) {
#pragma unroll 4
            for (int c = tid; c < 8192; c += 512) {
                const int r = c >> 5, cc = c & 31;
                *(uint4*)(Z + (size_t)(brow + r) * ZLD + pn * 256 + cc * 8) = *(const uint4*)(stg + r * EP_RS + cc * 16);
            }
        } else {
            int bb, tpos0;
            if (brow < NL) { bb = brow >> 12; tpos0 = brow & 4095; } else { bb = (brow - NL) >> 8; tpos0 = 4096; }
#pragma unroll 4
            for (int c = tid; c < 8192; c += 512) {
                const int col = c >> 5, rc = c & 31;
                bf16_t* dst;
                if (pn == 5) dst = VT + ((size_t)((bb * 2 + (col >> 7)) * 128 + (col & 127))) * TT;
                else { const int cv = (pn - 8) * 256 + col; dst = GVT + ((size_t)((bb * 4 + (cv >> 7)) * 128 + (cv & 127))) * TT; }
                *(uint4*)(dst + tpos0 + rc * 8) = *(const uint4*)(stg + col * EP_RS + rc * 16);
            }
        }
        lds_sync();
    }
};

DEVI void dense_tile_of(int wgid, int nM, int nN, int& pm, int& pn) {
    const int nig = 8 * nN, gid = wgid / nig, fm = gid * 8, gsz = (nM - fm) < 8 ? (nM - fm) : 8;
    pm = fm + ((wgid % nig) % gsz); pn = (wgid % nig) / gsz;
}

DEVI void phase_gemm_in(const int tid_, const Params& p, int L, bf16_t* shm) {
    const int nM = NT / 256, nN = NWIN / 256;
    const bf16_t* U = (const bf16_t*)(p.ws + WS_U);
    bg_fill(tid_, p, (unsigned char*)shm, FILL_Q);
    const int geff = (int)gridDim.x - NCONV_WG;
    if ((int)blockIdx.x >= geff) return;
    for (int i = 0;; ++i) {
        int u; if (!unit_of(i, nM * nN, u, geff)) break;
        int pm, pn; dense_tile_of(u, nM, nN, pm, pn);
        if (L == 1 && pm >= NL / 256 && !(pn == 4 || pn == 5 || pn == 7 || pn == 8 || pn == 9 || pn == 12 || pn == 13 || pn == 16)) continue;
        unsigned a0, a1; aoff_plain(tid_, D, a0, a1);
        const bf16_t* Bt = (const bf16_t*)(p.ws + WS_WINT) + ((size_t)L * NWIN + pn * 256) * 2048;
        EpiIn epi{(bf16_t*)(p.ws + WS_Z), (float*)(p.ws + WS_GZ), (bf16_t*)(p.ws + WS_VT), (bf16_t*)(p.ws + WS_GVT),
                  (const float*)(p.ws + WS_ROPEF), (const float*)(p.ws + WS_ROPES), pm * 256, pn};
        if (REP_SUB == 200) { struct Twice { const EpiIn& e; DEVI void operator()(const f32x4 (&acc)[2][2][4][2], int wr, int wc, int fr, int fq, int tid, unsigned char* stg) const { e(acc, wr, wc, fr, fq, tid, stg); asm volatile("" ::: "memory"); e(acc, wr, wc, fr, fq, tid, stg); } } tw{epi};
            gemm_tile<false>(tid_, shm, U + (size_t)pm * 256 * D, D, a0, a1, 0u, 0u, Bt, 2048, tw); }
        else gemm_tile<false>(tid_, shm, U + (size_t)pm * 256 * D, D, a0, a1, 0u, 0u, Bt, 2048, epi);
    }
}

struct EpiOut {
    float* H; const float* mods; const float* x; const float* ctx; int L, brow, bcol;
    DEVI void operator()(const f32x4 (&acc)[2][2][4][2], int wr, int wc, int fr, int fq, int, unsigned char*) const {
#pragma unroll
        for (int ai = 0; ai < 2; ++ai)
#pragma unroll
            for (int m = 0; m < 4; ++m) {
                const int row = brow + ai * 128 + wr * 64 + m * 16 + fr;
                const int mrow = row < NL ? (row >> 12) : 4;
                const float* g1 = mods + (size_t)(L * 5 + mrow) * 12288 + 2 * 2048;
#pragma unroll
                for (int bj = 0; bj < 2; ++bj)
#pragma unroll
                    for (int n = 0; n < 2; ++n) {
                        const int col = bcol + bj * 128 + wc * 32 + n * 16 + fq * 4;
                        const f32x4 g = *(const f32x4*)(g1 + col);
                        f32x4* hp = (f32x4*)(H + (size_t)row * D + col);
                        const f32x4* rp = (L == 0) ? (const f32x4*)((row < NL ? x + (size_t)row * D : ctx + (size_t)(row - NL) * D) + col) : (const f32x4*)hp;
                        f32x4 h = *rp;
                        h += g * acc[ai][bj][m][n];
                        *hp = h;
                    }
            }
    }
};

DEVI void phase_gemm_out(const int tid_, const Params& p, int L, bf16_t* shm) {
    const int nM = (L == 0 ? NT : NL) / 256, nN = 8;
    const bf16_t* MIX = (const bf16_t*)(p.ws + WS_MIX);
    bg_fill(tid_, p, (unsigned char*)shm, FILL_Q);
    const int geff = (int)gridDim.x - NCONV_WG;
    if ((int)blockIdx.x >= geff) return;
    for (int i = 0;; ++i) {
        int u; if (!unit_of(i, nM * nN, u, geff)) break;
        int pm, pn; dense_tile_of(u, nM, nN, pm, pn);
        unsigned a0, a1; aoff_plain(tid_, D, a0, a1);
        const bf16_t* Bt = (const bf16_t*)(p.ws + WS_WOUTT) + ((size_t)L * 2048 + pn * 256) * 2048;
        EpiOut epi{(float*)(p.ws + WS_H), (const float*)(p.ws + WS_MODS), p.in[0], p.in[2], L, pm * 256, pn * 256};
        gemm_tile<false>(tid_, shm, MIX + (size_t)pm * 256 * D, D, a0, a1, 0u, 0u, Bt, 2048, epi);
    }
}

constexpr int AT_KSTR = 272, AT_VSTR = 144;
DEVI void attn_unit(const int tid_, const Params& p, int L, int a, unsigned char* lds) {
    const bf16_t* Z = (const bf16_t*)(p.ws + WS_Z);
    const bf16_t* VT = (const bf16_t*)(p.ws + WS_VT);
    bf16_t* MIX = (bf16_t*)(p.ws + WS_MIX);
    unsigned char* Ks = lds;
    unsigned char* Vs = lds + 64 * AT_KSTR;
    const int tid = tid_, w = tid >> 6, lane = tid & 63, fr = lane & 15, fq = lane >> 4;
    int b, qb, kvh; bool isctx;
    if (a < 512) { b = a >> 7; qb = (a >> 1) & 63; kvh = a & 1; isctx = false; }
    else { const int a2 = a - 512; b = a2 >> 3; qb = (a2 >> 1) & 3; kvh = a2 & 1; isctx = true; }
    const int row0 = isctx ? NL + b * 256 + qb * 64 : b * 4096 + qb * 64;
    const int head = kvh * 4 + (w >> 1), qh = w & 1;
    bf16x8 Qf[2][4];
#pragma unroll
    for (int nq = 0; nq < 2; ++nq)
#pragma unroll
        for (int ks = 0; ks < 4; ++ks)
            Qf[nq][ks] = *(const bf16x8*)(Z + (size_t)(row0 + qh * 32 + nq * 16 + fr) * ZLD + ZQ + head * 128 + ks * 32 + fq * 8);
    f32x4 ot[8][2];
#pragma unroll
    for (int i = 0; i < 8; ++i) { ot[i][0] = (f32x4){0.f, 0.f, 0.f, 0.f}; ot[i][1] = (f32x4){0.f, 0.f, 0.f, 0.f}; }
    float mrun[2] = {-1e30f, -1e30f}, lrun[2] = {0.f, 0.f};
    int lo, hi;
    if (isctx) { lo = 5; hi = 4; } else { lo = (2 - qb) > 0 ? (2 - qb) : 0; hi = (65 - qb) < 4 ? (65 - qb) : 4; }
    int ti = (lo <= hi) ? lo : 5;
    uint4 kreg0, kreg1, vreg0, vreg1;
    const int kch0 = tid, kch1 = tid + 512;
#define AT_LOAD(tile) do { \
    int krow0_, vt0_; \
    if ((tile) <= 4) { const int j_ = qb - 2 + (tile); krow0_ = b * 4096 + j_ * 64; vt0_ = j_ * 64; } \
    else { const int jj_ = (tile) - 5; krow0_ = NL + b * 256 + jj_ * 64; vt0_ = 4096 + jj_ * 64; } \
    kreg0 = *(const uint4*)(Z + (size_t)(krow0_ + (kch0 >> 4)) * ZLD + ZK + kvh * 128 + (kch0 & 15) * 8); \
    kreg1 = *(const uint4*)(Z + (size_t)(krow0_ + (kch1 >> 4)) * ZLD + ZK + kvh * 128 + (kch1 & 15) * 8); \
    vreg0 = *(const uint4*)(VT + ((size_t)((b * 2 + kvh) * 128 + (kch0 >> 3))) * TT + vt0_ + (kch0 & 7) * 8); \
    vreg1 = *(const uint4*)(VT + ((size_t)((b * 2 + kvh) * 128 + (kch1 >> 3))) * TT + vt0_ + (kch1 & 7) * 8); } while (0)
    AT_LOAD(ti);
    for (;;) {
        __syncthreads();
        *(uint4*)(Ks + (kch0 >> 4) * AT_KSTR + (kch0 & 15) * 16) = kreg0;
        *(uint4*)(Ks + (kch1 >> 4) * AT_KSTR + (kch1 & 15) * 16) = kreg1;
        *(uint4*)(Vs + (kch0 >> 3) * AT_VSTR + (kch0 & 7) * 16) = vreg0;
        *(uint4*)(Vs + (kch1 >> 3) * AT_VSTR + (kch1 & 7) * 16) = vreg1;
        __syncthreads();
        const int cur = ti;
        const int nxt = (cur == hi) ? 5 : cur + 1;
        if (nxt <= 8) AT_LOAD(nxt);
        f32x4 st[4][2];
#pragma unroll
        for (int mt = 0; mt < 4; ++mt) { st[mt][0] = (f32x4){0.f, 0.f, 0.f, 0.f}; st[mt][1] = (f32x4){0.f, 0.f, 0.f, 0.f}; }
        {
            bf16x8 Kc[4], Kn[4];
#pragma unroll
            for (int mt = 0; mt < 4; ++mt) Kc[mt] = *(const bf16x8*)(Ks + (mt * 16 + fr) * AT_KSTR + (fq * 8) * 2);
#pragma unroll
            for (int ks = 0; ks < 4; ++ks) {
                if (ks < 3) {
#pragma unroll
                    for (int mt = 0; mt < 4; ++mt) Kn[mt] = *(const bf16x8*)(Ks + (mt * 16 + fr) * AT_KSTR + ((ks + 1) * 32 + fq * 8) * 2);
                }
                __builtin_amdgcn_sched_barrier(0);
#pragma unroll
                for (int mt = 0; mt < 4; ++mt) {
                    st[mt][0] = MFMA16(Kc[mt], Qf[0][ks], st[mt][0]);
                    st[mt][1] = MFMA16(Kc[mt], Qf[1][ks], st[mt][1]);
                }
                __builtin_amdgcn_sched_barrier(0);
#pragma unroll
                for (int mt = 0; mt < 4; ++mt) Kc[mt] = Kn[mt];
            }
        }
        const int mtype = (cur == 0) ? 1 : ((cur == 4) ? 2 : 0);
        if (mtype != 0) {
#pragma unroll
            for (int mt = 0; mt < 4; ++mt)
#pragma unroll
                for (int nq = 0; nq < 2; ++nq)
#pragma unroll
                    for (int j = 0; j < 4; ++j) {
                        const int c = mt * 16 + fq * 4 + j, aq = qh * 32 + nq * 16 + fr;
                        const bool keep = (mtype == 1) ? (c >= aq) : (c <= aq);
                        if (!keep) st[mt][nq][j] = -1e30f;
                    }
        }
        bf16x8 Pf[2][2];
#pragma unroll
        for (int nq = 0; nq < 2; ++nq) {
            float mx = st[0][nq][0];
#pragma unroll
            for (int mt = 0; mt < 4; ++mt)
#pragma unroll
                for (int j = 0; j < 4; ++j) mx = fmaxf(mx, st[mt][nq][j]);
            mx = fmaxf(mx, shx(mx, 16, lane)); mx = fmaxf(mx, shx(mx, 32, lane));
            const bool upd = mx > mrun[nq] + 8.f;
            if (__builtin_amdgcn_ballot_w64(upd) != 0ull) {
                const float mn2 = upd ? mx : mrun[nq];
                const float al = __builtin_amdgcn_exp2f(mrun[nq] - mn2);
                mrun[nq] = mn2;
                lrun[nq] *= al;
#pragma unroll
                for (int i = 0; i < 8; ++i) ot[i][nq] *= al;
            }
            const float mn = mrun[nq];
            float ps = 0.f;
#pragma unroll
            for (int mt = 0; mt < 4; ++mt)
#pragma unroll
                for (int j = 0; j < 4; ++j) { const float pv = __builtin_amdgcn_exp2f(st[mt][nq][j] - mn); st[mt][nq][j] = pv; ps += pv; }
            lrun[nq] += ps;
#pragma unroll
            for (int k2 = 0; k2 < 2; ++k2)
                Pf[nq][k2] = mk8(pk2(st[2 * k2][nq][0], st[2 * k2][nq][1]), pk2(st[2 * k2][nq][2], st[2 * k2][nq][3]),
                                 pk2(st[2 * k2 + 1][nq][0], st[2 * k2 + 1][nq][1]), pk2(st[2 * k2 + 1][nq][2], st[2 * k2 + 1][nq][3]));
        }
        {
            uint2 va[4][2], vb[4][2];
#pragma unroll
            for (int i = 0; i < 4; ++i) { const unsigned char* vp = Vs + (i * 16 + fr) * AT_VSTR + (fq * 4) * 2; va[i][0] = *(const uint2*)vp; va[i][1] = *(const uint2*)(vp + 32); }
#pragma unroll
            for (int g = 0; g < 4; ++g) {
                if (g < 3) {
                    const int k2n = (g + 1) >> 1, mdn = ((g + 1) & 1) * 4;
#pragma unroll
                    for (int i = 0; i < 4; ++i) { const unsigned char* vp = Vs + ((mdn + i) * 16 + fr) * AT_VSTR + (k2n * 32 + fq * 4) * 2; vb[i][0] = *(const uint2*)vp; vb[i][1] = *(const uint2*)(vp + 32); }
                }
                __builtin_amdgcn_sched_barrier(0);
                const int k2 = g >> 1, md0 = (g & 1) * 4;
#pragma unroll
                for (int i = 0; i < 4; ++i) {
                    const bf16x8 Vf = mk8(va[i][0].x, va[i][0].y, va[i][1].x, va[i][1].y);
                    ot[md0 + i][0] = MFMA16(Vf, Pf[0][k2], ot[md0 + i][0]);
                    ot[md0 + i][1] = MFMA16(Vf, Pf[1][k2], ot[md0 + i][1]);
                }
                __builtin_amdgcn_sched_barrier(0);
#pragma unroll
                for (int i = 0; i < 4; ++i) { va[i][0] = vb[i][0]; va[i][1] = vb[i][1]; }
            }
        }
        if (nxt > 8) break;
        ti = nxt;
    }
#undef AT_LOAD
    const float sk = p.in[9][L * 8 + head] * 1.4426950408889634f;
#pragma unroll
    for (int nq = 0; nq < 2; ++nq) {
        float l = lrun[nq];
        l += shx(l, 16, lane); l += shx(l, 32, lane);
        const float mf = fmaxf(mrun[nq], sk);
        const float al = __builtin_amdgcn_exp2f(mrun[nq] - mf);
        const float lt = l * al + __builtin_amdgcn_exp2f(sk - mf);
        const float sc = al * rcpf_(lt);
        const int row = row0 + qh * 32 + nq * 16 + fr;
#pragma unroll
        for (int md = 0; md < 8; ++md) {
            const f32x4 o = ot[md][nq] * sc;
            uint2 pk; pk.x = pk2(o[0], o[1]); pk.y = pk2(o[2], o[3]);
            *(uint2*)(MIX + (size_t)row * D + head * 128 + md * 16 + fq * 4) = pk;
        }
    }
}

DEVI void gla_chunk_rows(int b, int ci, int& rowbase, int& tpos0) {
    if (ci < 4) { rowbase = NL + b * 256 + ci * 64; tpos0 = 4096 + ci * 64; } else { rowbase = b * 4096 + (ci - 4) * 64; tpos0 = (ci - 4) * 64; }
}
DEVI float logsig_fast(float z) { return fminf(z, 0.f) - __logf(1.f + __expf(-fabsf(z))); }
DEVI int scan_ci(int dir, int s) { return dir == 0 ? s : (s < 4 ? 3 - s : 71 - s); }

constexpr int GP_GZS = 0, GP_CUM = 8192, GP_TOT = 41472, GP_KT = 41984, GP_VT = 60416, GP_KSM = 78848, MX_TAB = 91648;
DEVI void gla_tables(const int tid_, const Params& p, int L, unsigned char* lds) {
    float* tab = (float*)(lds + MX_TAB);
    __syncthreads();
    for (int i = tid_; i < 8192; i += 512) tab[i] = p.in[10][(size_t)L * 8192 + i];
    tab[8192 + tid_] = p.in[11][L * 512 + tid_];
    __syncthreads();
}

DEVI void gla_p1_phase(const int tid_, const Params& p, int L, unsigned char* lds) {
    const bf16_t* Z = (const bf16_t*)(p.ws + WS_Z);
    const bf16_t* GVT = (const bf16_t*)(p.ws + WS_GVT);
    const float* GZ = (const float*)(p.ws + WS_GZ);
    float* gzs = (float*)(lds + GP_GZS); float* cum = (float*)(lds + GP_CUM); float* tot = (float*)(lds + GP_TOT);
    bf16_t* kT = (bf16_t*)(lds + GP_KT); unsigned char* vts = lds + GP_VT; bf16_t* ksm = (bf16_t*)(lds + GP_KSM);
    const float* tab = (const float*)(lds + MX_TAB);
    const int tid = tid_, w = tid >> 6, lane = tid & 63, fr = lane & 15, fq = lane >> 4;
    const int t = tid >> 3, d0 = (tid & 7) * 8;
    gla_tables(tid_, p, L, lds);
    const int nun = NB * 4 * NCH;
    uint4 pgz, pk, pv0, pv1;
#define G1_PREF(uu) do { const int ci_ = (uu) % NCH, bh_ = (uu) / NCH; int rb_, tp_; gla_chunk_rows(bh_ >> 2, ci_, rb_, tp_); \
    pgz = *(const uint4*)(GZ + (size_t)(rb_ + t) * 32 + (tid & 7) * 4); \
    pk = *(const uint4*)(Z + (size_t)(rb_ + t) * ZLD + ZGK + (bh_ & 3) * 64 + d0); \
    pv0 = *(const uint4*)(GVT + ((size_t)(bh_ * 128 + (tid >> 3))) * TT + tp_ + (tid & 7) * 8); \
    pv1 = *(const uint4*)(GVT + ((size_t)(bh_ * 128 + 64 + (tid >> 3))) * TT + tp_ + (tid & 7) * 8); } while (0)
    int u = blockIdx.x;
    if (u < nun) G1_PREF(u);
    for (; u < nun; u += gridDim.x) {
        const int ci = u % NCH, bh = u / NCH, h = bh & 3;
        lds_sync();
        {
            const int r0 = (tid & 7) * 4;
            gzs[(r0 + 0) * 64 + t] = __uint_as_float(pgz.x); gzs[(r0 + 1) * 64 + t] = __uint_as_float(pgz.y);
            gzs[(r0 + 2) * 64 + t] = __uint_as_float(pgz.z); gzs[(r0 + 3) * 64 + t] = __uint_as_float(pgz.w);
        }
        *(uint4*)(vts + (tid >> 3) * 144 + (tid & 7) * 16) = pv0;
        *(uint4*)(vts + (64 + (tid >> 3)) * 144 + (tid & 7) * 16) = pv1;
        *(uint4*)((unsigned char*)ksm + t * 144 + d0 * 2) = pk;
        lds_sync();
        if (u + (int)gridDim.x < nun) G1_PREF(u + (int)gridDim.x);
#pragma unroll
        for (int dir = 0; dir < 2; ++dir) {
            float z[8];
#pragma unroll
            for (int i = 0; i < 8; ++i) z[i] = tab[8192 + dir * 256 + h * 64 + d0 + i];
#pragma unroll
            for (int r = 0; r < 16; ++r) {
                const float g = gzs[(dir * 16 + r) * 64 + t];
                const float4 w0 = *(const float4*)(tab + (dir * 16 + r) * 256 + h * 64 + d0), w1 = *(const float4*)(tab + (dir * 16 + r) * 256 + h * 64 + d0 + 4);
                z[0] += g * w0.x; z[1] += g * w0.y; z[2] += g * w0.z; z[3] += g * w0.w; z[4] += g * w1.x; z[5] += g * w1.y; z[6] += g * w1.z; z[7] += g * w1.w;
            }
#pragma unroll
            for (int i = 0; i < 8; ++i) cum[(dir * 64 + t) * 65 + d0 + i] = logsig_fast(z[i]) * (1.f / 16.f);
        }
        lds_sync();
        if (tid < 128) {
            const int dir = tid >> 6, d = tid & 63;
            float vv[64];
#pragma unroll
            for (int s2 = 0; s2 < 64; ++s2) vv[s2] = cum[(dir * 64 + (dir ? 63 - s2 : s2)) * 65 + d];
            float a = 0.f;
#pragma unroll
            for (int s2 = 0; s2 < 64; ++s2) { a += vv[s2]; vv[s2] = a; }
#pragma unroll
            for (int s2 = 0; s2 < 64; ++s2) cum[(dir * 64 + (dir ? 63 - s2 : s2)) * 65 + d] = vv[s2];
            tot[tid] = a;
        }
        lds_sync();
        {
            float* CG = (float*)(p.ws + WS_CUMG) + ((size_t)u * 2) * 4096;
#pragma unroll
            for (int dir = 0; dir < 2; ++dir) {
                const float tt = tot[dir * 64 + lane];
                float kd[8];
#pragma unroll
                for (int i = 0; i < 8; ++i) {
                    const int ti = w * 8 + i;
                    const float cv = cum[(dir * 64 + ti) * 65 + lane];
                    kd[i] = bf2f(ksm[ti * 72 + lane]) * __expf(tt - cv);
                    CG[(size_t)dir * 4096 + ti * 64 + lane] = cv;
                }
                uint4 o; o.x = pk2(kd[0], kd[1]); o.y = pk2(kd[2], kd[3]); o.z = pk2(kd[4], kd[5]); o.w = pk2(kd[6], kd[7]);
                *(uint4*)((unsigned char*)kT + ((dir * 64 + lane) * 72 + w * 8) * 2) = o;
            }
        }
        lds_sync();
        {
            const bf16x8 Af0 = *(const bf16x8*)(vts + (w * 16 + fr) * 144 + (fq * 8) * 2);
            const bf16x8 Af1 = *(const bf16x8*)(vts + (w * 16 + fr) * 144 + (32 + fq * 8) * 2);
#pragma unroll
            for (int dir = 0; dir < 2; ++dir) {
                f32x4 acc[4];
#pragma unroll
                for (int n = 0; n < 4; ++n) {
                    acc[n] = (f32x4){0.f, 0.f, 0.f, 0.f};
                    const bf16x8 Bf0 = *(const bf16x8*)((const unsigned char*)kT + ((dir * 64 + n * 16 + fr) * 72 + fq * 8) * 2);
                    const bf16x8 Bf1 = *(const bf16x8*)((const unsigned char*)kT + ((dir * 64 + n * 16 + fr) * 72 + 32 + fq * 8) * 2);
                    acc[n] = MFMA16(Af0, Bf0, acc[n]);
                    acc[n] = MFMA16(Af1, Bf1, acc[n]);
                }
                const int sq = bh * 2 + dir;
                float* CT = (float*)(p.ws + WS_CONTRIB) + ((size_t)(sq * NCH + ci)) * 8192;
#pragma unroll
                for (int n = 0; n < 4; ++n)
#pragma unroll
                    for (int j = 0; j < 4; ++j) CT[(w * 16 + fq * 4 + j) * 64 + n * 16 + fr] = acc[n][j];
            }
            if (tid < 128) { const int dir = tid >> 6, d = tid & 63; ((float*)(p.ws + WS_ATOT))[((size_t)((bh * 2 + dir) * NCH + ci)) * 64 + d] = __expf(tot[tid]); }
        }
    }
#undef G1_PREF
}

DEVI void gla_scan(const int tid_, const Params& p) {
    const float* __restrict__ CT = (const float*)(p.ws + WS_CONTRIB);
    const float* __restrict__ AT = (const float*)(p.ws + WS_ATOT);
    unsigned* __restrict__ SB = (unsigned*)(p.ws + WS_SBEF);
    for (int idx = blockIdx.x * 512 + tid_; idx < 32 * 128 * 32; idx += gridDim.x * 512) {
        const int dp = idx & 31, dv = (idx >> 5) & 127, sq = idx >> 12, dir = sq & 1;
        const float* ctp = CT + (size_t)sq * NCH * 8192 + dv * 64 + dp * 2;
        const float* atp = AT + (size_t)sq * NCH * 64 + dp * 2;
        unsigned* sbp = SB + (size_t)sq * NCH * 4096 + dv * 32 + dp;
        float s0 = 0.f, s1 = 0.f;
        float2 c[4], a[4], cn[4], an[4];
#pragma unroll
        for (int q = 0; q < 4; ++q) { const int ci = scan_ci(dir, q); c[q] = *(const float2*)(ctp + (size_t)ci * 8192); a[q] = *(const float2*)(atp + (size_t)ci * 64); }
#pragma unroll 1
        for (int s = 0; s < NCH; s += 4) {
            if (s + 4 < NCH) {
#pragma unroll
                for (int q = 0; q < 4; ++q) { const int ci = scan_ci(dir, s + 4 + q); cn[q] = *(const float2*)(ctp + (size_t)ci * 8192); an[q] = *(const float2*)(atp + (size_t)ci * 64); }
            }
#pragma unroll
            for (int q = 0; q < 4; ++q) {
                const int ci = scan_ci(dir, s + q);
                sbp[(size_t)ci * 4096] = pk2(s0, s1);
                s0 = a[q].x * s0 + c[q].x; s1 = a[q].y * s1 + c[q].y;
            }
#pragma unroll
            for (int q = 0; q < 4; ++q) { c[q] = cn[q]; a[q] = an[q]; }
        }
    }
}

constexpr int G3_QS = 0, G3_KS = 18432, G3_SS = 36864, G3_VT = 73728, G3_PART = 92160, G3_OB = 92672;
DEVI void gla_p3_phase(const int tid_, const Params& p, int L, unsigned char* lds) {
    const bf16_t* Z = (const bf16_t*)(p.ws + WS_Z);
    const bf16_t* GVT = (const bf16_t*)(p.ws + WS_GVT);
    const float* CUMG = (const float*)(p.ws + WS_CUMG);
    const bf16_t* SBEF = (const bf16_t*)(p.ws + WS_SBEF);
    bf16_t* MIX = (bf16_t*)(p.ws + WS_MIX);
    unsigned char* qs = lds + G3_QS; unsigned char* ks = lds + G3_KS; unsigned char* ss = lds + G3_SS; unsigned char* vts = lds + G3_VT;
    float* part = (float*)(lds + G3_PART); float* ob = (float*)(lds + G3_OB);
    const int tid = tid_, w = tid >> 6, lane = tid & 63, fr = lane & 15, fq = lane >> 4;
    const int ntl = w & 3, dvh = w >> 2;
    const int t = tid >> 3, d0 = (tid & 7) * 8, dv0 = (tid & 7) * 16;
    const int cfirst = (L == 0) ? 0 : 4, ncl = NCH - cfirst, nun = NB * 4 * ncl;
    uint4 pq, pk, psf0, psf1, psb0, psb1, pv0, pv1, pg0, pg1;
    float4 pcf0, pcf1, pcb0, pcb1;
#define G3_PREF(uu) do { const int ci_ = cfirst + (uu) % ncl, bh_ = (uu) / ncl; int rb_, tp_; gla_chunk_rows(bh_ >> 2, ci_, rb_, tp_); \
    const size_t u1_ = (size_t)bh_ * NCH + ci_; \
    pq = *(const uint4*)(Z + (size_t)(rb_ + t) * ZLD + ZGQ + (bh_ & 3) * 64 + d0); \
    pk = *(const uint4*)(Z + (size_t)(rb_ + t) * ZLD + ZGK + (bh_ & 3) * 64 + d0); \
    pcf0 = *(const float4*)(CUMG + (u1_ * 2) * 4096 + t * 64 + d0); pcf1 = *(const float4*)(CUMG + (u1_ * 2) * 4096 + t * 64 + d0 + 4); \
    pcb0 = *(const float4*)(CUMG + (u1_ * 2 + 1) * 4096 + t * 64 + d0); pcb1 = *(const float4*)(CUMG + (u1_ * 2 + 1) * 4096 + t * 64 + d0 + 4); \
    { const bf16_t* sf_ = SBEF + ((size_t)((bh_ * 2) * NCH + ci_)) * 8192; const bf16_t* sb_ = SBEF + ((size_t)((bh_ * 2 + 1) * NCH + ci_)) * 8192; \
      psf0 = *(const uint4*)(sf_ + tid * 8); psf1 = *(const uint4*)(sf_ + 4096 + tid * 8); psb0 = *(const uint4*)(sb_ + tid * 8); psb1 = *(const uint4*)(sb_ + 4096 + tid * 8); } \
    pv0 = *(const uint4*)(GVT + ((size_t)(bh_ * 128 + (tid >> 3))) * TT + tp_ + (tid & 7) * 8); \
    pv1 = *(const uint4*)(GVT + ((size_t)(bh_ * 128 + 64 + (tid >> 3))) * TT + tp_ + (tid & 7) * 8); \
    pg0 = *(const uint4*)(Z + (size_t)(rb_ + t) * ZLD + ZGR + (bh_ & 3) * 128 + dv0); \
    pg1 = *(const uint4*)(Z + (size_t)(rb_ + t) * ZLD + ZGR + (bh_ & 3) * 128 + dv0 + 8); } while (0)
    int u = blockIdx.x;
    if (u < nun) G3_PREF(u);
    for (; u < nun; u += gridDim.x) {
        const int ci = cfirst + u % ncl, bh = u / ncl, h = bh & 3;
        int rowbase, tpos0; gla_chunk_rows(bh >> 2, ci, rowbase, tpos0);
        lds_sync();
        {
            const unsigned qw[4] = {pq.x, pq.y, pq.z, pq.w}, kw[4] = {pk.x, pk.y, pk.z, pk.w};
            const float cf[8] = {pcf0.x, pcf0.y, pcf0.z, pcf0.w, pcf1.x, pcf1.y, pcf1.z, pcf1.w};
            const float cb[8] = {pcb0.x, pcb0.y, pcb0.z, pcb0.w, pcb1.x, pcb1.y, pcb1.z, pcb1.w};
#pragma unroll
            for (int dir = 0; dir < 2; ++dir) {
                unsigned qo[4], ko[4];
#pragma unroll
                for (int i = 0; i < 4; ++i) {
                    const float c0 = dir ? cb[2 * i] : cf[2 * i], c1 = dir ? cb[2 * i + 1] : cf[2 * i + 1];
                    qo[i] = pk2(bflo(qw[i]) * 0.125f * __expf(c0), bfhi(qw[i]) * 0.125f * __expf(c1));
                    ko[i] = pk2(bflo(kw[i]) * __expf(fminf(-c0, 80.f)), bfhi(kw[i]) * __expf(fminf(-c1, 80.f)));
                }
                uint4 t4; t4.x = qo[0]; t4.y = qo[1]; t4.z = qo[2]; t4.w = qo[3];
                *(uint4*)(qs + (dir * 64 + t) * 144 + d0 * 2) = t4;
                t4.x = ko[0]; t4.y = ko[1]; t4.z = ko[2]; t4.w = ko[3];
                *(uint4*)(ks + (dir * 64 + t) * 144 + d0 * 2) = t4;
            }
            *(uint4*)(ss + (tid >> 3) * 144 + (tid & 7) * 16) = psf0;
            *(uint4*)(ss + (64 + (tid >> 3)) * 144 + (tid & 7) * 16) = psf1;
            *(uint4*)(ss + (128 + (tid >> 3)) * 144 + (tid & 7) * 16) = psb0;
            *(uint4*)(ss + (192 + (tid >> 3)) * 144 + (tid & 7) * 16) = psb1;
            *(uint4*)(vts + (tid >> 3) * 144 + (tid & 7) * 16) = pv0;
            *(uint4*)(vts + (64 + (tid >> 3)) * 144 + (tid & 7) * 16) = pv1;
        }
        const uint4 gr0 = pg0, gr1 = pg1;
        lds_sync();
        if (u + (int)gridDim.x < nun) G3_PREF(u + (int)gridDim.x);
        f32x4 oacc[4];
#pragma unroll
        for (int i = 0; i < 4; ++i) oacc[i] = (f32x4){0.f, 0.f, 0.f, 0.f};
#pragma unroll
        for (int dir = 0; dir < 2; ++dir) {
            bf16x8 Bq[2];
            f32x4 at[4];
#pragma unroll
            for (int m = 0; m < 4; ++m) at[m] = (f32x4){0.f, 0.f, 0.f, 0.f};
#pragma unroll
            for (int k_ = 0; k_ < 2; ++k_) {
                Bq[k_] = *(const bf16x8*)(qs + (dir * 64 + ntl * 16 + fr) * 144 + (k_ * 32 + fq * 8) * 2);
#pragma unroll
                for (int m = 0; m < 4; ++m) {
                    const bf16x8 Ak = *(const bf16x8*)(ks + (dir * 64 + m * 16 + fr) * 144 + (k_ * 32 + fq * 8) * 2);
                    at[m] = MFMA16(Ak, Bq[k_], at[m]);
                }
            }
            {
                const int tq = ntl * 16 + fr;
#pragma unroll
                for (int m = 0; m < 4; ++m)
#pragma unroll
                    for (int j = 0; j < 4; ++j) {
                        const int s = m * 16 + fq * 4 + j;
                        const bool keep = dir == 0 ? (s <= tq) : (s >= tq);
                        if (!keep) at[m][j] = 0.f;
                    }
            }
#pragma unroll
            for (int k2 = 0; k2 < 2; ++k2) {
                const bf16x8 Pf = mk8(pk2(at[2 * k2][0], at[2 * k2][1]), pk2(at[2 * k2][2], at[2 * k2][3]),
                                      pk2(at[2 * k2 + 1][0], at[2 * k2 + 1][1]), pk2(at[2 * k2 + 1][2], at[2 * k2 + 1][3]));
#pragma unroll
                for (int md = 0; md < 4; ++md) {
                    const unsigned char* vp = vts + (dvh * 64 + md * 16 + fr) * 144 + (k2 * 32 + fq * 4) * 2;
                    const uint2 v0 = *(const uint2*)vp, v1 = *(const uint2*)(vp + 32);
                    oacc[md] = MFMA16(mk8(v0.x, v0.y, v1.x, v1.y), Pf, oacc[md]);
                }
            }
#pragma unroll
            for (int k_ = 0; k_ < 2; ++k_)
#pragma unroll
                for (int md = 0; md < 4; ++md) {
                    const bf16x8 As = *(const bf16x8*)(ss + (dir * 128 + dvh * 64 + md * 16 + fr) * 144 + (k_ * 32 + fq * 8) * 2);
                    oacc[md] = MFMA16(As, Bq[k_], oacc[md]);
                }
        }
        float sq = 0.f;
#pragma unroll
        for (int md = 0; md < 4; ++md)
#pragma unroll
            for (int j = 0; j < 4; ++j) sq += oacc[md][j] * oacc[md][j];
        sq += shx(sq, 16, lane); sq += shx(sq, 32, lane);
        if (fq == 0) part[w * 16 + fr] = sq;
        lds_sync();
        {
            const float tot2 = part[ntl * 16 + fr] + part[(ntl + 4) * 16 + fr];
            const float rstd = rsqrtf(tot2 * (1.f / 128.f) + 1e-6f);
#pragma unroll
            for (int md = 0; md < 4; ++md)
#pragma unroll
                for (int j = 0; j < 4; ++j) ob[(ntl * 16 + fr) * 132 + dvh * 64 + md * 16 + fq * 4 + j] = oacc[md][j] * rstd;
        }
        lds_sync();
        {
            const float* gn = p.in[12] + L * 128;
            const unsigned rw[8] = {gr0.x, gr0.y, gr0.z, gr0.w, gr1.x, gr1.y, gr1.z, gr1.w};
            unsigned o[8];
#pragma unroll
            for (int i4 = 0; i4 < 4; ++i4) {
                const float4 ov = *(const float4*)(ob + t * 132 + dv0 + 4 * i4), gv = *(const float4*)(gn + dv0 + 4 * i4);
                o[2 * i4] = pk2(ov.x * gv.x * siluf_(bflo(rw[2 * i4])), ov.y * gv.y * siluf_(bfhi(rw[2 * i4])));
                o[2 * i4 + 1] = pk2(ov.z * gv.z * siluf_(bflo(rw[2 * i4 + 1])), ov.w * gv.w * siluf_(bfhi(rw[2 * i4 + 1])));
            }
            uint4 a4; a4.x = o[0]; a4.y = o[1]; a4.z = o[2]; a4.w = o[3];
            uint4 b4; b4.x = o[4]; b4.y = o[5]; b4.z = o[6]; b4.w = o[7];
            bf16_t* dst = MIX + (size_t)(rowbase + t) * D + 1024 + h * 128 + dv0;
            *(uint4*)dst = a4; *(uint4*)(dst + 8) = b4;
        }
    }
#undef G3_PREF
}

constexpr int LR_XCF = 17152, LR_XCB = 34560, LR_OUTB = 43776;
template <int CTRL> DEVI float dppf(float oldv, float v) { return __int_as_float(__builtin_amdgcn_update_dpp(__float_as_int(oldv), __float_as_int(v), CTRL, 0xf, 0xf, false)); }
template <int DIR> DEVI void lru_tile_scan(float& A, float& B) {
    constexpr int base = DIR ? 0x100 : 0x110;
    { const float A2 = dppf<base | 1>(1.f, A), B2 = dppf<base | 1>(0.f, B); B = A * B2 + B; A = A * A2; }
    { const float A2 = dppf<base | 2>(1.f, A), B2 = dppf<base | 2>(0.f, B); B = A * B2 + B; A = A * A2; }
    { const float A2 = dppf<base | 4>(1.f, A), B2 = dppf<base | 4>(0.f, B); B = A * B2 + B; A = A * A2; }
    { const float A2 = dppf<base | 8>(1.f, A), B2 = dppf<base | 8>(0.f, B); B = A * B2 + B; A = A * A2; }
}
template <int PASS, int DIR>
DEVI void lru_wave_scan(const float (&av)[4][4], const float (&uv)[4][4], const float (&carry)[4], int lane, int fr, int cb, int fq,
                        float* outb, float* la_out, float* lb_out) {
    float hin[4], pin[4];
#pragma unroll
    for (int r = 0; r < 4; ++r) { hin[r] = (PASS == 3) ? carry[r] : 0.f; pin[r] = 1.f; }
    const int endl = DIR ? (lane & 48) : (lane | 15);
#pragma unroll
    for (int mi = 0; mi < 4; ++mi) {
        const int m = DIR ? 3 - mi : mi;
#pragma unroll
        for (int r = 0; r < 4; ++r) {
            float A = av[m][r], B = uv[m][r];
            lru_tile_scan<DIR>(A, B);
            const float hf = B + A * hin[r];
            if (PASS == 3) outb[(DIR * 64 + m * 16 + fr) * 65 + cb * 16 + fq * 4 + r] = hf;
            hin[r] = shidx(hf, endl);
            if (PASS == 1) pin[r] = shidx(A * pin[r], endl);
        }
    }
    if (PASS == 1 && fr == (DIR ? 0 : 15)) {
#pragma unroll
        for (int r = 0; r < 4; ++r) { la_out[fq * 4 + r] = pin[r]; lb_out[fq * 4 + r] = hin[r]; }
    }
}

template <int PASS>
DEVI void lru_phase(const int tid_, const Params& p, int L, unsigned char* lds) {
    const bf16_t* Z = (const bf16_t*)(p.ws + WS_Z);
    float* xs = (float*)lds; float* xcf = (float*)(lds + LR_XCF); unsigned char* xcb = lds + LR_XCB; float* outb = (float*)(lds + LR_OUTB);
    float* tab = (float*)(lds + MX_TAB);
    const int tid = tid_, w = tid >> 6, lane = tid & 63, fr = lane & 15, fq = lane >> 4;
    const int dir = w >> 2, cb = w & 3;
    const int t = tid >> 3, c0 = (tid & 7) * 8;
    const int cfirst = (PASS == 3 && L == 1) ? 4 : 0, ncl = NCH - cfirst, nun = NB * ncl * 8;
    __syncthreads();
    for (int i = tid; i < 2048; i += 512) tab[i] = p.in[13][(size_t)L * 2048 + i];
    tab[2048 + tid] = p.in[14][L * 512 + tid];
    for (int i = tid; i < 1024; i += 512) {
        tab[2560 + i] = p.in[16][L * 1024 + i]; tab[3584 + i] = p.in[18][L * 1024 + i];
        tab[4608 + i] = -8.f * log1pf(expf(-p.in[19][L * 1024 + i]));
    }
    __syncthreads();
    uint4 px0, px1, plg;
    float4 pcar = make_float4(0.f, 0.f, 0.f, 0.f);
#define LR_DEC(uu, blk_, ci_, b_) const int blk_ = (uu) & 7, ci_ = cfirst + ((uu) >> 3) % ncl, b_ = ((uu) >> 3) / ncl
#define LR_PREF(uu) do { LR_DEC(uu, blk_, ci_, b_); int sr_, sl_, t0_; \
    if (ci_ < 4) { sr_ = NL + b_ * 256; sl_ = 256; t0_ = ci_ * 64; } else { sr_ = b_ * 4096; sl_ = 4096; t0_ = (ci_ - 4) * 64; } \
    { const int tm_ = t0_ - 2 + (tid >> 3); px0 = (tm_ >= 0 && tm_ < sl_) ? *(const uint4*)(Z + (size_t)(sr_ + tm_) * ZLD + ZLX + blk_ * 64 + (tid & 7) * 8) : make_uint4(0u, 0u, 0u, 0u); } \
    { const int tm_ = t0_ - 2 + 64 + (tid >> 3); px1 = (tid < 24 && tm_ < sl_) ? *(const uint4*)(Z + (size_t)(sr_ + tm_) * ZLD + ZLX + blk_ * 64 + (tid & 7) * 8) : make_uint4(0u, 0u, 0u, 0u); } \
    if (PASS == 3) { plg = *(const uint4*)(Z + (size_t)(sr_ + t0_ + t) * ZLD + ZLG + blk_ * 64 + c0); \
        pcar = *(const float4*)((const float*)(p.ws + WS_LRUC) + ((size_t)((b_ * NCH + ci_) * 2 + dir)) * 512 + blk_ * 64 + cb * 16 + fq * 4); } } while (0)
    int u = blockIdx.x;
    if (u < nun) LR_PREF(u);
    for (; u < nun; u += gridDim.x) {
        LR_DEC(u, blk, ci, b);
        const int rowbase = (ci < 4) ? NL + b * 256 + ci * 64 : b * 4096 + (ci - 4) * 64;
        lds_sync();
        {
            float4 f0, f1;
            f0.x = bflo(px0.x); f0.y = bfhi(px0.x); f0.z = bflo(px0.y); f0.w = bfhi(px0.y); f1.x = bflo(px0.z); f1.y = bfhi(px0.z); f1.z = bflo(px0.w); f1.w = bfhi(px0.w);
            *(float4*)(xs + (tid >> 3) * 64 + (tid & 7) * 8) = f0; *(float4*)(xs + (tid >> 3) * 64 + (tid & 7) * 8 + 4) = f1;
            if (tid < 24) {
                f0.x = bflo(px1.x); f0.y = bfhi(px1.x); f0.z = bflo(px1.y); f0.w = bfhi(px1.y); f1.x = bflo(px1.z); f1.y = bfhi(px1.z); f1.z = bflo(px1.w); f1.w = bfhi(px1.w);
                *(float4*)(xs + (64 + (tid >> 3)) * 64 + (tid & 7) * 8) = f0; *(float4*)(xs + (64 + (tid >> 3)) * 64 + (tid & 7) * 8 + 4) = f1;
            }
        }
        const uint4 lgc = plg;
        const float carry[4] = {pcar.x, pcar.y, pcar.z, pcar.w};
        const bf16_t* WT = (const bf16_t*)(p.ws + WS_LRUWT) + (size_t)(L * 8 + blk) * 256 * 64;
        bf16x8 Bw[2][2];
#pragma unroll
        for (int g = 0; g < 2; ++g)
#pragma unroll
            for (int ks = 0; ks < 2; ++ks)
                Bw[g][ks] = *(const bf16x8*)(WT + (size_t)(((dir * 2 + g) * 4 + cb) * 16 + fr) * 64 + ks * 32 + fq * 8);
        lds_sync();
        if (u + (int)gridDim.x < nun) LR_PREF(u + (int)gridDim.x);
        {
            const int ch = blk * 64 + lane;
            float xr[11];
#pragma unroll
            for (int k = 0; k < 11; ++k) xr[k] = xs[(w * 8 + k) * 64 + lane];
            const float cw0 = tab[ch], cw1 = tab[512 + ch], cw2 = tab[1024 + ch], cw3 = tab[1536 + ch], cbv = tab[2048 + ch];
#pragma unroll
            for (int i = 0; i < 8; ++i) {
                const float y = cbv + xr[i] * cw0 + xr[i + 1] * cw1 + xr[i + 2] * cw2 + xr[i + 3] * cw3;
                xcf[(w * 8 + i) * 68 + lane] = y;
                ((bf16_t*)xcb)[(w * 8 + i) * 72 + lane] = f2bf(y);
            }
        }
        lds_sync();
        float av[4][4], uv[4][4];
        {
            f32x4 ga[4], gx[4];
#pragma unroll
            for (int m = 0; m < 4; ++m) { ga[m] = (f32x4){0.f, 0.f, 0.f, 0.f}; gx[m] = (f32x4){0.f, 0.f, 0.f, 0.f}; }
#pragma unroll
            for (int ks = 0; ks < 2; ++ks)
#pragma unroll
                for (int m = 0; m < 4; ++m) {
                    const bf16x8 Af = *(const bf16x8*)(xcb + (m * 16 + fr) * 144 + (ks * 32 + fq * 8) * 2);
                    ga[m] = MFMA16(Bw[0][ks], Af, ga[m]);
                    gx[m] = MFMA16(Bw[1][ks], Af, gx[m]);
                }
            const int chb = blk * 64 + cb * 16 + fq * 4;
            const float4 bav = *(const float4*)(tab + 2560 + dir * 512 + chb), bxv = *(const float4*)(tab + 3584 + dir * 512 + chb), cfv = *(const float4*)(tab + 4608 + dir * 512 + chb);
            const float bal[4] = {bav.x, bav.y, bav.z, bav.w}, bxl[4] = {bxv.x, bxv.y, bxv.z, bxv.w}, cfl[4] = {cfv.x, cfv.y, cfv.z, cfv.w};
#pragma unroll
            for (int m = 0; m < 4; ++m) {
                const float4 xv = *(const float4*)(xcf + (m * 16 + fr) * 68 + cb * 16 + fq * 4);
                const float xl[4] = {xv.x, xv.y, xv.z, xv.w};
#pragma unroll
                for (int r = 0; r < 4; ++r) {
                    const float la = cfl[r] * sigmoidf_(ga[m][r] + bal[r]);
                    const float a = __expf(la);
                    const float x2 = 2.f * la;
                    const float om = (x2 > -0.1f) ? -x2 * (1.f + x2 * (0.5f + x2 * (0.16666667f + x2 * 0.041666668f))) : 1.f - a * a;
                    av[m][r] = a;
                    uv[m][r] = __builtin_amdgcn_sqrtf(om) * sigmoidf_(gx[m][r] + bxl[r]) * xl[r];
                }
            }
        }
        {
            const size_t sbase = ((size_t)((b * NCH + ci) * 2 + dir)) * 512 + blk * 64 + cb * 16;
            float* la_out = (float*)(p.ws + WS_LRUA) + sbase; float* lb_out = (float*)(p.ws + WS_LRUB) + sbase;
            if (dir == 0) lru_wave_scan<PASS, 0>(av, uv, carry, lane, fr, cb, fq, outb, la_out, lb_out);
            else lru_wave_scan<PASS, 1>(av, uv, carry, lane, fr, cb, fq, outb, la_out, lb_out);
        }
        if (PASS == 3) {
            lds_sync();
            const unsigned lw[4] = {lgc.x, lgc.y, lgc.z, lgc.w};
            unsigned o[4];
#pragma unroll
            for (int i = 0; i < 4; ++i) {
                const float h0 = outb[t * 65 + c0 + 2 * i] + outb[(64 + t) * 65 + c0 + 2 * i];
                const float h1 = outb[t * 65 + c0 + 2 * i + 1] + outb[(64 + t) * 65 + c0 + 2 * i + 1];
                o[i] = pk2(h0 * gelu_tanh(bflo(lw[i])), h1 * gelu_tanh(bfhi(lw[i])));
            }
            uint4 o4; o4.x = o[0]; o4.y = o[1]; o4.z = o[2]; o4.w = o[3];
            *(uint4*)((bf16_t*)(p.ws + WS_MIX) + (size_t)(rowbase + t) * D + 1536 + blk * 64 + c0) = o4;
        }
    }
#undef LR_PREF
#undef LR_DEC
}

DEVI void lru_carry_scan(const int tid_, const Params& p) {
    const float* __restrict__ LA = (const float*)(p.ws + WS_LRUA);
    const float* __restrict__ LB = (const float*)(p.ws + WS_LRUB);
    float* __restrict__ LC = (float*)(p.ws + WS_LRUC);
    for (int idx = blockIdx.x * 512 + tid_; idx < 4096; idx += gridDim.x * 512) {
        const int ch = idx & 511, dir = (idx >> 9) & 1, b = idx >> 10;
        float hc = 0.f;
#pragma unroll 1
        for (int s = 0; s < NCH; s += 4) {
            float a[4], bb[4];
#pragma unroll
            for (int q = 0; q < 4; ++q) {
                const size_t si = ((size_t)((b * NCH + scan_ci(dir, s + q)) * 2 + dir)) * 512 + ch;
                a[q] = LA[si]; bb[q] = LB[si];
            }
#pragma unroll
            for (int q = 0; q < 4; ++q) {
                const size_t si = ((size_t)((b * NCH + scan_ci(dir, s + q)) * 2 + dir)) * 512 + ch;
                LC[si] = hc;
                hc = a[q] * hc + bb[q];
            }
        }
    }
}

DEVI void phase_mix_a(const int tid_, const Params& p, int L, unsigned char* lds) {
    const int na = (L == 0) ? 544 : 512;
#pragma unroll 1
    for (int rep = 0; rep < ((REP_SUB == 100 && L == 0) ? 2 : 1); ++rep)
        for (int a = blockIdx.x; a < na; a += gridDim.x) attn_unit(tid_, p, L, a, lds);
    gla_p1_phase(tid_, p, L, lds);
    if (REP_SUB == 101 && L == 0) gla_p1_phase(tid_, p, L, lds);
    lru_phase<1>(tid_, p, L, lds);
    if (REP_SUB == 102 && L == 0) lru_phase<1>(tid_, p, L, lds);
}
DEVI void phase_mix_b(const int tid_, const Params& p) { gla_scan(tid_, p); lru_carry_scan(tid_, p); }
DEVI void phase_mix_c(const int tid_, const Params& p, int L, unsigned char* lds) {
    gla_p3_phase(tid_, p, L, lds);
    if (REP_SUB == 103 && L == 0) gla_p3_phase(tid_, p, L, lds);
    lru_phase<3>(tid_, p, L, lds);
    if (REP_SUB == 104 && L == 0) lru_phase<3>(tid_, p, L, lds);
}

DEVI void phase_norm2(const int tid_, const Params& p, int L, unsigned char* lds, bool dry = false) {
    const int nrows = (L == 0) ? NT : NL;
    const int tid = tid_, w = tid >> 6, lane = tid & 63, fr = lane & 15, fq = lane >> 4;
    const float* H = (const float*)(p.ws + WS_H);
    bf16_t* U = (bf16_t*)(p.ws + WS_U);
    const float* mods = (const float*)(p.ws + WS_MODS);
    const float* gffn = p.in[7] + L * 2048;
    const bf16_t* WR = (const bf16_t*)(p.ws + WS_WRT) + (size_t)L * 48 * 2048;
    unsigned char* vt = lds;
    float* part = (float*)(lds + 65792);
    float* lgt = (float*)(lds + 65792 + 24576);
    unsigned* cnt = (unsigned*)(p.ws + WS_CTL) + (dry ? 8192 : CTL_COUNT) + L * 32;
    int* tokl = (int*)(p.ws + (dry ? WS_END : WS_TOKL));
    float* gatel = (float*)(p.ws + (dry ? WS_END + (size_t)32 * TOKCAP * 4 : WS_GATEL));
    unsigned char* wr2 = lds + 93440;
    __syncthreads();
#pragma unroll
    for (int i = 0; i < 2; ++i) { const int ch = tid + 512 * i; *(uint4*)(wr2 + ch * 16) = *(const uint4*)(WR + (size_t)32 * 2048 + ch * 8); }
    __syncthreads();
    bf16x8 Bf[8][2];
#pragma unroll
    for (int kk = 0; kk < 8; ++kk)
#pragma unroll
        for (int n = 0; n < 2; ++n) Bf[kk][n] = *(const bf16x8*)(WR + (size_t)(n * 16 + fr) * 2048 + w * 256 + kk * 32 + fq * 8);
    int* dec = (int*)(lds + 109824);
    int* lcnt = (int*)(lds + 109824 + 128 * 32);
    if (tid < 64) lcnt[tid] = 0;
    __syncthreads();
    int nloc = 0;
    float4 ha[8], hb[8];
    const int nit = nrows / 16;
    int it = blockIdx.x;
    if (it < nit) {
#pragma unroll
        for (int c = 0; c < 8; ++c) { ha[c] = *(const float4*)(H + (size_t)(it * 16 + w * 2) * D + c * 256 + lane * 4); hb[c] = *(const float4*)(H + (size_t)(it * 16 + w * 2 + 1) * D + c * 256 + lane * 4); }
    }
    for (; it < nit; it += gridDim.x) {
        lds_sync();
#define N2_ROW(hx, rr) do { \
            const int lr = w * 2 + (rr), row = it * 16 + lr; \
            const int mrow = row < NL ? (row >> 12) : 4; \
            const float* md = mods + (size_t)(L * 5 + mrow) * 12288; \
            float ss = 0.f; \
            _Pragma("unroll") for (int c = 0; c < 8; ++c) ss += hx[c].x * hx[c].x + hx[c].y * hx[c].y + hx[c].z * hx[c].z + hx[c].w * hx[c].w; \
            ss = wave_sum(ss, lane); \
            const float rstd = rsqrtf(ss * (1.f / 2048.f) + 1e-6f); \
            _Pragma("unroll") for (int c = 0; c < 8; ++c) { \
                const int col = c * 256 + lane * 4; \
                const float4 gm = *(const float4*)(gffn + col), sh = *(const float4*)(md + 3 * 2048 + col), sc = *(const float4*)(md + 4 * 2048 + col); \
                const float u0 = hx[c].x * rstd * gm.x * (1.f + sc.x) + sh.x, u1 = hx[c].y * rstd * gm.y * (1.f + sc.y) + sh.y; \
                const float u2 = hx[c].z * rstd * gm.z * (1.f + sc.z) + sh.z, u3 = hx[c].w * rstd * gm.w * (1.f + sc.w) + sh.w; \
                uint2 o; o.x = pk2(u0, u1); o.y = pk2(u2, u3); \
                *(uint2*)(U + (size_t)row * D + col) = o; \
                *(uint2*)(vt + lr * 4112 + col * 2) = o; \
                asm volatile("" ::: "memory"); } } while (0)
        N2_ROW(ha, 0);
        N2_ROW(hb, 1);
#undef N2_ROW
        if (it + (int)gridDim.x < nit) {
            const int itn = it + (int)gridDim.x;
#pragma unroll
            for (int c = 0; c < 8; ++c) { ha[c] = *(const float4*)(H + (size_t)(itn * 16 + w * 2) * D + c * 256 + lane * 4); hb[c] = *(const float4*)(H + (size_t)(itn * 16 + w * 2 + 1) * D + c * 256 + lane * 4); }
        }
        lds_sync();
        {
            f32x4 acc[3];
#pragma unroll
            for (int n = 0; n < 3; ++n) acc[n] = (f32x4){0.f, 0.f, 0.f, 0.f};
#pragma unroll
            for (int kk = 0; kk < 8; ++kk) {
                const int k0 = w * 256 + kk * 32 + fq * 8;
                const bf16x8 Af = *(const bf16x8*)(vt + fr * 4112 + k0 * 2);
                acc[0] = MFMA16(Af, Bf[kk][0], acc[0]);
                acc[1] = MFMA16(Af, Bf[kk][1], acc[1]);
                bf16x8 B2 = (bf16x8){0, 0, 0, 0, 0, 0, 0, 0};
                if (fr < 4) B2 = *(const bf16x8*)(wr2 + fr * 4096 + k0 * 2);
                acc[2] = MFMA16(Af, B2, acc[2]);
            }
#pragma unroll
            for (int n = 0; n < 3; ++n)
#pragma unroll
                for (int j = 0; j < 4; ++j) part[(w * 16 + fq * 4 + j) * 48 + n * 16 + fr] = acc[n][j];
        }
        lds_sync();
        for (int i = tid; i < 16 * 48; i += 512) {
            float s = 0.f;
#pragma unroll
            for (int ww = 0; ww < 8; ++ww) s += part[ww * 768 + i];
            lgt[i] = s;
        }
        lds_sync();
        if (tid < 16) {
            const int row = it * 16 + tid;
            const float* lg = lgt + tid * 48;
            float g[4];
#pragma unroll
            for (int j = 0; j < 4; ++j) g[j] = lg[j] + p.in[22][L * 4 + j];
            int gi = 0; float gm = g[0];
#pragma unroll
            for (int j = 1; j < 4; ++j) if (g[j] > gm) { gm = g[j]; gi = j; }
            float gs = 0.f;
#pragma unroll
            for (int j = 0; j < 4; ++j) gs += expf(g[j] - gm);
            const float pg = 1.f / gs;
            float e[8];
#pragma unroll
            for (int j = 0; j < 8; ++j) e[j] = lg[4 + gi * 8 + j] + p.in[24][L * 32 + gi * 8 + j];
            int i1 = 0; float m1 = e[0];
#pragma unroll
            for (int j = 1; j < 8; ++j) if (e[j] > m1) { m1 = e[j]; i1 = j; }
            int i2 = -1; float m2 = -3.4e38f;
#pragma unroll
            for (int j = 0; j < 8; ++j) if (j != i1 && e[j] > m2) { m2 = e[j]; i2 = j; }
            const float w1 = 1.f / (1.f + expf(m2 - m1)), w2 = 1.f - w1;
            const int e1 = gi * 8 + i1, e2 = gi * 8 + i2;
            const int r1 = atomicAdd(&lcnt[e1], 1), r2 = atomicAdd(&lcnt[e2], 1);
            int* dd = dec + (nloc * 16 + tid) * 8;
            dd[0] = row; dd[1] = e1; dd[2] = e2; dd[3] = r1; dd[4] = r2; dd[5] = __float_as_int(pg * w1); dd[6] = __float_as_int(pg * w2);
        }
        ++nloc;
    }
    lds_sync();
    if (tid < 32) { const int c = lcnt[tid]; lcnt[32 + tid] = c ? (int)atomicAdd(&cnt[tid], (unsigned)c) : 0; }
    lds_sync();
    for (int i = tid; i < nloc * 16; i += 512) {
        const int* dd = dec + i * 8;
        const int e1 = dd[1], e2 = dd[2];
        const size_t q1 = (size_t)e1 * TOKCAP + lcnt[32 + e1] + dd[3], q2 = (size_t)e2 * TOKCAP + lcnt[32 + e2] + dd[4];
        tokl[q1] = dd[0] * 2; gatel[q1] = __int_as_float(dd[5]);
        tokl[q2] = dd[0] * 2 + 1; gatel[q2] = __int_as_float(dd[6]);
    }
}

struct EpiUp {
    bf16_t* H1; int prow0, ncol0;
    DEVI void operator()(const f32x4 (&acc)[2][2][4][2], int wr, int wc, int fr, int fq, int tid, unsigned char* stg) const {
#pragma unroll
        for (int ai = 0; ai < 2; ++ai)
#pragma unroll
            for (int m = 0; m < 4; ++m) {
                const int rloc = ai * 128 + wr * 64 + m * 16 + fr;
#pragma unroll
                for (int n = 0; n < 2; ++n) {
                    const f32x4 a = acc[ai][0][m][n], c = acc[ai][1][m][n];
                    uint2 o; o.x = pk2(siluf_(a[0]) * c[0], siluf_(a[1]) * c[1]); o.y = pk2(siluf_(a[2]) * c[2], siluf_(a[3]) * c[3]);
                    *(uint2*)(stg + rloc * 272 + (wc * 32 + n * 16 + fq * 4) * 2) = o;
                }
            }
        lds_sync();
#pragma unroll 4
        for (int c = tid; c < 4096; c += 512) {
            const int r = c >> 4, cc = c & 15;
            *(uint4*)(H1 + (size_t)(prow0 + r) * 1024 + ncol0 + cc * 8) = *(const uint4*)(stg + r * 272 + cc * 16);
        }
        lds_sync();
    }
};
struct EpiDown {
    bf16_t* SL; const int* tokl; const float* gatel; int li0, cnt, bcol;
    DEVI void operator()(const f32x4 (&acc)[2][2][4][2], int wr, int wc, int fr, int fq, int tid, unsigned char* stg) const {
#pragma unroll
        for (int ai = 0; ai < 2; ++ai)
#pragma unroll
            for (int m = 0; m < 4; ++m) {
                const int rloc = ai * 128 + wr * 64 + m * 16 + fr, li = li0 + rloc;
                const float g = li < cnt ? gatel[li] : 0.f;
#pragma unroll
                for (int bj = 0; bj < 2; ++bj)
#pragma unroll
                    for (int n = 0; n < 2; ++n) {
                        const f32x4 v = acc[ai][bj][m][n] * g;
                        uint2 o; o.x = pk2(v[0], v[1]); o.y = pk2(v[2], v[3]);
                        *(uint2*)(stg + rloc * EP_RS + (bj * 128 + wc * 32 + n * 16 + fq * 4) * 2) = o;
                    }
            }
        lds_sync();
#pragma unroll 4
        for (int c = tid; c < 8192; c += 512) {
            const int r = c >> 5, cc = c & 31, li = li0 + r;
            if (li < cnt) *(uint4*)(SL + (size_t)tokl[li] * D + bcol + cc * 8) = *(const uint4*)(stg + r * EP_RS + cc * 16);
        }
        lds_sync();
    }
};

template <int DOWN>
DEVI void phase_moe(const int tid_, const Params& p, int L, unsigned char* lds) {
    bf16_t* shm = (bf16_t*)lds;
    int* tb = (int*)(lds + LDS_MISC + 256);
    const unsigned* cntg = (const unsigned*)(p.ws + WS_CTL) + CTL_COUNT + L * 32;
    __syncthreads();
    if (tid_ == 0) {
        int acc = 0;
        for (int e = 0; e < 32; ++e) { const int c = (int)cntg[e]; tb[64 + e] = c; tb[e] = acc; acc += (c + 255) >> 8; }
        tb[32] = acc;
    }
    __syncthreads();
    const int ntl = tb[32] * 8;
    const int* tokl = (const int*)(p.ws + WS_TOKL);
    bg_fill(tid_, p, lds, DOWN ? FILL_Q / 2 : FILL_Q);
    const int geff = (L == 0) ? (int)gridDim.x - NCONV_WG : (int)gridDim.x;
    if ((int)blockIdx.x >= geff) return;
    for (int i = 0;; ++i) {
        int u; if (!unit_of(i, ntl, u, geff)) break;
        int e = 0;
#pragma unroll 1
        for (int k = 1; k < 32; ++k) if (tb[k] * 8 <= u) e = k;
        const int q = u - tb[e] * 8, nte = tb[e + 1] - tb[e], nt = q / nte, mt = q % nte, cnt_e = tb[64 + e];
        const int prow0 = (tb[e] + mt) * 256;
        if (DOWN == 0) {
            unsigned ao[2][2];
#pragma unroll
            for (int ii = 0; ii < 2; ++ii) {
                int r, c; g_stage_rc(tid_ * 16 + ii * 8192, r, c);
#pragma unroll
                for (int hh = 0; hh < 2; ++hh) {
                    const int li = mt * 256 + hh * 128 + r;
                    const int tok = li < cnt_e ? (tokl[(size_t)e * TOKCAP + li] >> 1) : 0;
                    ao[hh][ii] = ((unsigned)tok * D + c) * 2u;
                }
            }
            const bf16_t* Bt = (const bf16_t*)(p.ws + WS_WUPT) + ((size_t)(L * 32 + e) * 2048 + nt * 256) * 2048;
            EpiUp epi{(bf16_t*)(p.ws + WS_H1), prow0, nt * 128};
            gemm_tile<true>(tid_, shm, (const bf16_t*)(p.ws + WS_U), D, ao[0][0], ao[0][1], ao[1][0], ao[1][1], Bt, 2048, epi);
        } else {
            unsigned a0, a1; aoff_plain(tid_, 1024, a0, a1);
            const bf16_t* Bt = (const bf16_t*)(p.ws + WS_WDNT) + ((size_t)(L * 32 + e) * 2048 + nt * 256) * 1024;
            EpiDown epi{(bf16_t*)(p.ws + WS_SLOTS), tokl + (size_t)e * TOKCAP, (const float*)(p.ws + WS_GATEL) + (size_t)e * TOKCAP, mt * 256, cnt_e, nt * 256};
            gemm_tile<false>(tid_, shm, (const bf16_t*)(p.ws + WS_H1) + (size_t)prow0 * 1024, 1024, a0, a1, 0u, 0u, Bt, 1024, epi);
        }
    }
}

extern __shared__ __attribute__((aligned(16))) unsigned char lds_raw[];

__global__ void __launch_bounds__(512, 2) hybrid_fwd(Params p_unused) {
    unsigned char* lds = lds_raw;
    int lo, hi;
    { Params q; load_params(q); lo = q.ph_lo; hi = q.ph_hi; }
    const int wv_ = __builtin_amdgcn_readfirstlane((int)(threadIdx.x >> 6));
    if (hi - lo > 1) {
        const bool t0 = (opaque_tid(wv_) == 0);
        if (t0) { *(uint4*)(lds + LDS_MISC) = make_uint4(0u, 0u, 0u, 0u); }
        __syncthreads();
        { Params q; load_params(q); (void)xcd_barrier_post((unsigned*)(q.ws + WS_CTL), (volatile LAS unsigned*)(lds + LDS_MISC), t0); }
    }
#ifndef PH_MASK
#define PH_MASK 0x7ff
#endif
#ifndef REP_PHASE
#define REP_PHASE -1
#endif
#ifndef REP_N
#define REP_N 1
#endif
#define PH_(fn, ...) do { asm volatile("; MARK_BEGIN " #fn); Params q__; load_params(q__); fn(opaque_tid(wv_), q__, ##__VA_ARGS__); asm volatile("; MARK_END " #fn); } while (0)
#define EN(j) ((PH_MASK >> (j)) & 1)
#define IN(k) (lo <= (k) && (k) < hi)
#define SEAM(k) do { if (IN(k) && IN((k) + 1)) { { Params qb_; load_params(qb_); bg_convert(opaque_tid(wv_), qb_, lds, (k)); } XcdBarrier bb_; Params q_; load_params(q_); \
    bb_.bar = (unsigned*)(q_.ws + WS_CTL); bb_.x = xb_xcc_id(); bb_.st = (volatile LAS unsigned*)(lds + LDS_MISC); xcd_barrier(bb_, opaque_tid(wv_) == 0); } } while (0)
    if (EN(0) && IN(0)) PH_(phase_prologue, lds);
    if (REP_PHASE == 0) for (int r_ = 0; r_ < REP_N; ++r_) PH_(phase_prologue, lds);
    SEAM(0);
    if (REP_SUB == 300) { for (int r_ = 0; r_ < 10; ++r_) SEAM(0); }
#define LAYER(L) do { constexpr int k0 = 1 + 9 * (L); \
        if (EN(1) && IN(k0 + 0)) PH_(phase_norm1, L); \
        if (REP_PHASE == k0 + 0) for (int r_ = 0; r_ < REP_N; ++r_) PH_(phase_norm1, L); \
        SEAM(k0 + 0); \
        if (EN(2) && IN(k0 + 1)) PH_(phase_gemm_in, L, (bf16_t*)lds); \
        if (REP_PHASE == k0 + 1) for (int r_ = 0; r_ < REP_N; ++r_) PH_(phase_gemm_in, L, (bf16_t*)lds); \
        SEAM(k0 + 1); \
        if (EN(3) && IN(k0 + 2)) PH_(phase_mix_a, L, lds); \
        if (REP_PHASE == k0 + 2) for (int r_ = 0; r_ < REP_N; ++r_) PH_(phase_mix_a, L, lds); \
        SEAM(k0 + 2); \
        if (EN(4) && IN(k0 + 3)) PH_(phase_mix_b); \
        if (REP_PHASE == k0 + 3) for (int r_ = 0; r_ < REP_N; ++r_) PH_(phase_mix_b); \
        SEAM(k0 + 3); \
        if (EN(5) && IN(k0 + 4)) PH_(phase_mix_c, L, lds); \
        if (REP_PHASE == k0 + 4) for (int r_ = 0; r_ < REP_N; ++r_) PH_(phase_mix_c, L, lds); \
        SEAM(k0 + 4); \
        if (EN(6) && IN(k0 + 5)) PH_(phase_gemm_out, L, (bf16_t*)lds); \
        if (REP_PHASE == k0 + 5) for (int r_ = 0; r_ < REP_N; ++r_) PH_(phase_gemm_out, L, (bf16_t*)lds); \
        SEAM(k0 + 5); \
        if (EN(7) && IN(k0 + 6)) PH_(phase_norm2, L, lds); \
        if (REP_PHASE == k0 + 6) for (int r_ = 0; r_ < REP_N; ++r_) PH_(phase_norm2, L, lds, true); \
        SEAM(k0 + 6); \
        if (EN(8) && IN(k0 + 7)) PH_(phase_moe<0>, L, lds); \
        if (REP_PHASE == k0 + 7) for (int r_ = 0; r_ < REP_N; ++r_) PH_(phase_moe<0>, L, lds); \
        SEAM(k0 + 7); \
        if (EN(9) && IN(k0 + 8)) PH_(phase_moe<1>, L, lds); \
        if (REP_PHASE == k0 + 8) for (int r_ = 0; r_ < REP_N; ++r_) PH_(phase_moe<1>, L, lds); \
        SEAM(k0 + 8); } while (0)
    LAYER(0);
    LAYER(1);
#undef LAYER
    if (EN(10) && IN(19)) PH_(phase_final);
#undef IN
#undef SEAM
}

extern "C" void kernel_launch(void* const* d_in, const int* in_sizes, int n_in, void* d_out, int out_size, void* d_ws, size_t ws_size, hipStream_t stream) {
    static int grid = 0;
    if (grid == 0) {
        if (n_in != 29 || ws_size < WS_END) { fprintf(stderr, "kernel_launch: need 29 inputs and >= %zu bytes of workspace (got %d, %zu)\n", (size_t)WS_END, n_in, ws_size); grid = -1; return; }
        int dev = 0, cus = 0, per_cu = 0;
        if (hipGetDevice(&dev) != hipSuccess || hipDeviceGetAttribute(&cus, hipDeviceAttributeMultiprocessorCount, dev) != hipSuccess) { grid = -1; return; }
        if (hipFuncSetAttribute((const void*)hybrid_fwd, hipFuncAttributeMaxDynamicSharedMemorySize, LDS_BYTES) != hipSuccess) { fprintf(stderr, "kernel_launch: hipFuncSetAttribute failed\n"); grid = -1; return; }
        if (hipOccupancyMaxActiveBlocksPerMultiprocessor(&per_cu, (const void*)hybrid_fwd, 512, LDS_BYTES) != hipSuccess || per_cu < 1)
            fprintf(stderr, "kernel_launch: occupancy query reports %d workgroups per CU\n", per_cu);
        (void)hipGetLastError();
        grid = cus;
    }
    if (grid < 0) return;
    (void)hipMemsetAsync((char*)d_ws + WS_CTL, 0, 65536, stream);
    Params p{};
    for (int i = 0; i < 29; ++i) p.in[i] = (const float*)d_in[i];
    p.out = (float*)d_out; p.ws = (unsigned char*)d_ws;
#if MK_ONE_LAUNCH
    p.ph_lo = 0; p.ph_hi = 20;
    hipLaunchKernelGGL(hybrid_fwd, dim3(grid), dim3(512), LDS_BYTES, stream, p);
#else
    for (int k = 0; k < 20; ++k) {
        p.ph_lo = k; p.ph_hi = k + 1;
        hipLaunchKernelGGL(hybrid_fwd, dim3(grid), dim3(512), LDS_BYTES, stream, p);
    }
#endif
}
```

```cpp
#include <hip/hip_runtime.h>
#include <stdint.h>
#include <stdio.h>

#ifndef REP_SUB
#define REP_SUB -1
#endif
#ifndef BG_B0
#define BG_B0 8
#endif
#ifndef BG_B1
#define BG_B1 4
#endif
#ifndef NCONV_WG
#define NCONV_WG 0
#endif
#ifndef PROF_ID
#define PROF_ID 0
#endif
#ifndef PROF_AMP
#define PROF_AMP 4
#endif
#ifndef FILL_Q
#define FILL_Q 0
#endif
#ifndef MK_ONE_LAUNCH
#define MK_ONE_LAUNCH 1
#endif

typedef unsigned short bf16_t;
typedef short bf16x8 __attribute__((ext_vector_type(8)));
typedef float f32x4 __attribute__((ext_vector_type(4)));
#define DEVI __device__ __forceinline__

constexpr int D = 2048, NB = 4, SEQ = 4096, CTX = 256;
constexpr int NL = NB * SEQ, NC = NB * CTX, NT = NL + NC;
constexpr int NCH = 68;
constexpr int TT = SEQ + CTX;
constexpr int ZLD = 4096;
constexpr int ZQ = 0, ZK = 1024, ZGQ = 1536, ZGK = 1792, ZGR = 2560, ZLX = 3072, ZLG = 3584;
constexpr int NWIN = 4352;
constexpr int TOKCAP = NT;
constexpr int H1ROWS = 43008;

constexpr size_t al256(size_t x) { return (x + 255) & ~(size_t)255; }
constexpr size_t WS_CTL = 0;
constexpr size_t WS_MODS = 65536;
constexpr size_t WS_ROPEC = WS_MODS + al256((size_t)2 * 5 * 12288 * 4);
constexpr size_t WS_ROPES = WS_ROPEC + (size_t)4096 * 64 * 4;
constexpr size_t WS_ROPEF = WS_ROPES + (size_t)4096 * 64 * 4;
constexpr size_t WS_LRUWT = WS_ROPEF + 256;
constexpr size_t WS_WRT = WS_LRUWT + (size_t)2 * 8 * 256 * 64 * 2;
constexpr size_t WS_WINT = WS_WRT + (size_t)2 * 48 * 2048 * 2;
constexpr size_t WS_WOUTT = WS_WINT + (size_t)2 * NWIN * 2048 * 2;
constexpr size_t WS_WUPT = WS_WOUTT + (size_t)2 * 2048 * 2048 * 2;
constexpr size_t WS_WDNT = WS_WUPT + (size_t)2 * 32 * 2048 * 2048 * 2;
constexpr size_t WS_H = WS_WDNT + (size_t)2 * 32 * 2048 * 1024 * 2;
constexpr size_t WS_U = WS_H + (size_t)NT * D * 4;
constexpr size_t WS_Z = WS_U + (size_t)NT * D * 2;
constexpr size_t WS_GZ = WS_Z + (size_t)NT * ZLD * 2;
constexpr size_t WS_VT = WS_GZ + (size_t)NT * 32 * 4;
constexpr size_t WS_GVT = WS_VT + (size_t)8 * 128 * TT * 2;
constexpr size_t WS_MIX = WS_GVT + (size_t)16 * 128 * TT * 2;
constexpr size_t WS_CONTRIB = WS_MIX + (size_t)NT * D * 2;
constexpr size_t WS_SBEF = WS_CONTRIB + (size_t)32 * NCH * 8192 * 4;
constexpr size_t WS_ATOT = WS_SBEF + (size_t)32 * NCH * 8192 * 4;
constexpr size_t WS_LRUA = WS_ATOT + (size_t)32 * NCH * 64 * 4;
constexpr size_t WS_LRUB = WS_LRUA + (size_t)NB * NCH * 2 * 512 * 4;
constexpr size_t WS_LRUC = WS_LRUB + (size_t)NB * NCH * 2 * 512 * 4;
constexpr size_t WS_TOKL = WS_LRUC + (size_t)NB * NCH * 2 * 512 * 4;
constexpr size_t WS_GATEL = WS_TOKL + (size_t)32 * TOKCAP * 4;
constexpr size_t WS_H1 = WS_GATEL + (size_t)32 * TOKCAP * 4;
constexpr size_t WS_SLOTS = WS_H1 + (size_t)H1ROWS * 1024 * 2;
constexpr size_t WS_CUMG = WS_SLOTS + (size_t)NT * 2 * D * 2;
constexpr size_t WS_END = WS_CUMG + (size_t)NB * 4 * NCH * 2 * 4096 * 4;
constexpr int CTL_COUNT = 4096;

constexpr int LDS_BYTES = 155648;
constexpr int LDS_MISC = 139264;

struct Params {
    const float* in[29];
    float* out;
    unsigned char* ws;
    int ph_lo, ph_hi;
};

typedef __attribute__((address_space(1))) const float gcf_t;
typedef __attribute__((address_space(1))) float gf_t;
typedef __attribute__((address_space(1))) unsigned char guc_t;
struct ParamsK {
    gcf_t* in[29];
    gf_t* out;
    guc_t* ws;
    int ph_lo, ph_hi;
};
static_assert(sizeof(ParamsK) == sizeof(Params), "kernarg view");
__device__ __forceinline__ void load_params(Params& q) {
    const __attribute__((address_space(4))) ParamsK* kp = (const __attribute__((address_space(4))) ParamsK*)__builtin_amdgcn_kernarg_segment_ptr();
    asm volatile("" : "+s"(kp));
#pragma unroll
    for (int i = 0; i < 29; ++i) q.in[i] = (const float*)kp->in[i];
    q.out = (float*)kp->out; q.ws = (unsigned char*)kp->ws; q.ph_lo = kp->ph_lo; q.ph_hi = kp->ph_hi;
}

DEVI float bf2f(bf16_t v) { return __uint_as_float(((unsigned)v) << 16); }
DEVI float bflo(unsigned v) { return __uint_as_float(v << 16); }
DEVI float bfhi(unsigned v) { return __uint_as_float(v & 0xffff0000u); }
DEVI unsigned pk2(float lo, float hi) { unsigned r; asm("v_cvt_pk_bf16_f32 %0, %1, %2" : "=v"(r) : "v"(lo), "v"(hi)); return r; }
DEVI bf16_t f2bf(float f) { return (bf16_t)(pk2(f, 0.f) & 0xffffu); }
DEVI float shx(float v, int mask, int lane) { return __int_as_float(__builtin_amdgcn_ds_bpermute((lane ^ mask) << 2, __float_as_int(v))); }
DEVI float shidx(float v, int src) { return __int_as_float(__builtin_amdgcn_ds_bpermute(src << 2, __float_as_int(v))); }
DEVI float shup(float v, int off, int lane) { const int src = lane >= off ? lane - off : lane; return shidx(v, src); }
DEVI float wave_sum(float v, int lane) {
#pragma unroll
    for (int o = 32; o > 0; o >>= 1) v += shx(v, o, lane);
    return v;
}
DEVI float rcpf_(float x) { return __builtin_amdgcn_rcpf(x); }
DEVI float sigmoidf_(float x) { return rcpf_(1.f + __builtin_amdgcn_exp2f(-1.4426950408889634f * x)); }
DEVI float siluf_(float x) { return x * sigmoidf_(x); }
DEVI float gelu_tanh(float x) {
    const float y2 = 1.5957691216057308f * (x + 0.044715f * x * x * x);
    return x * sigmoidf_(y2);
}
DEVI float logsigmoidf_(float z) { return fminf(z, 0.f) - log1pf(expf(-fabsf(z))); }
DEVI bf16x8 mk8(unsigned a, unsigned b, unsigned c, unsigned d) {
    typedef unsigned u4 __attribute__((ext_vector_type(4)));
    u4 t = {a, b, c, d};
    return __builtin_bit_cast(bf16x8, t);
}
DEVI int hw_lane() { int l; asm volatile("v_mbcnt_lo_u32_b32 %0, -1, 0\n\tv_mbcnt_hi_u32_b32 %0, -1, %0" : "=v"(l)); return l; }
DEVI int opaque_tid(int wv) { int t = wv * 64 + hw_lane(); asm volatile("" : "+v"(t)); return t; }
DEVI void lds_sync() { asm volatile("s_waitcnt lgkmcnt(0)" ::: "memory"); __builtin_amdgcn_s_barrier(); asm volatile("" ::: "memory"); }
#define MFMA16(a, b, c) __builtin_amdgcn_mfma_f32_16x16x32_bf16((a), (b), (c), 0, 0, 0)

#define XB_TMO      128
#define XB_XCNT(j)  (256  + 64 * (j))
#define XB_XSUB(j)  (1280 + 64 * (j))
#define XB_XGEN(j)  (2304 + 64 * (j))
#define XB_TOP      3328
#define XB_TOPGEN   3392
#define XCD_BAR_WORDS 3456
#define XB_SPIN_CAP (1u << 18)
#define LAS __attribute__((address_space(3)))

__device__ __forceinline__ unsigned xb_ld(unsigned* p)              { return __hip_atomic_load(p, __ATOMIC_RELAXED, __HIP_MEMORY_SCOPE_AGENT); }
__device__ __forceinline__ unsigned xb_add(unsigned* p, unsigned v) { return __hip_atomic_fetch_add(p, v, __ATOMIC_RELAXED, __HIP_MEMORY_SCOPE_AGENT); }
__device__ __forceinline__ unsigned xb_xcc_id() { return (unsigned)__builtin_amdgcn_s_getreg((3 << 11) | 20) & 0xFu; }
#define XB_SPIN(cond, bar) do { unsigned _sp = 0; while (cond) { __builtin_amdgcn_s_sleep(1); \
    if ((++_sp & 255u) == 0u) { if (xb_ld(&(bar)[XB_TMO])) break; if (_sp > XB_SPIN_CAP) { atomicAdd(&(bar)[XB_TMO], 1u); break; } } } } while (0)

struct XcdBarrier {
    unsigned* bar; unsigned x;
    volatile LAS unsigned* st;
};
__device__ __forceinline__ XcdBarrier xcd_barrier_post(unsigned* bar, volatile LAS unsigned* st, bool t0) {
    XcdBarrier b; b.bar = bar; b.x = xb_xcc_id(); b.st = st;
    if (t0) (void)xb_add(&bar[XB_XCNT(b.x)], 1u);
    return b;
}
__device__ __forceinline__ void xcd_barrier_complete(unsigned* bar, unsigned x, unsigned& nloc, unsigned& nx) {
    const unsigned G = gridDim.x * gridDim.y * gridDim.z;
    unsigned sum, cnt, mine, sp = 0u;
    for (;;) {
        sum = 0u; cnt = 0u; mine = 0u;
#pragma unroll
        for (unsigned j = 0; j < 16; ++j) { const unsigned c = xb_ld(&bar[XB_XCNT(j)]); sum += c; cnt += (c > 0u) ? 1u : 0u; mine = (j == x) ? c : mine; }
        if (sum == G) break;
        __builtin_amdgcn_s_sleep(1);
        if ((++sp & 255u) == 0u) { if (xb_ld(&bar[XB_TMO])) break; if (sp > XB_SPIN_CAP) { atomicAdd(&bar[XB_TMO], 1u); break; } }
    }
    nloc = mine > 0u ? mine : 1u; nx = cnt > 0u ? cnt : 1u;
}
__device__ __forceinline__ void xcd_barrier(const XcdBarrier& b, bool t0) {
    asm volatile("s_waitcnt vmcnt(0)" ::: "memory");
    __syncthreads();
    if (t0) {
        unsigned* bar = b.bar;
        __builtin_amdgcn_s_waitcnt(0);
        unsigned nloc = b.st[0], nx = b.st[1];
        if (nloc == 0u) { xcd_barrier_complete(bar, b.x, nloc, nx); b.st[0] = nloc; b.st[1] = nx; }
        const unsigned old = xb_add(&bar[XB_XSUB(b.x)], 1u);
        const unsigned gen = old / nloc;
        if (old + 1u == (gen + 1u) * nloc) {
            __builtin_amdgcn_fence(__ATOMIC_RELEASE, "agent");
            asm volatile("s_waitcnt vmcnt(0)" ::: "memory");
            const unsigned og = xb_add(&bar[XB_TOP], 1u);
            const unsigned tg = og / nx;
            if (og + 1u == (tg + 1u) * nx) xb_add(&bar[XB_TOPGEN], 1u);
            else XB_SPIN(xb_ld(&bar[XB_TOPGEN]) == tg, bar);
            __builtin_amdgcn_fence(__ATOMIC_ACQUIRE, "agent");
            xb_add(&bar[XB_XGEN(b.x)], 1u);
            asm volatile("s_waitcnt vmcnt(0)" ::: "memory");
        } else {
            XB_SPIN(xb_ld(&bar[XB_XGEN(b.x)]) == gen, bar);
            __builtin_amdgcn_fence(__ATOMIC_ACQUIRE, "agent");
            asm volatile("s_waitcnt vmcnt(0)" ::: "memory");
        }
    }
    __syncthreads();
}

#define PROF_WORD(lds) ((volatile unsigned long long*)((lds) + LDS_MISC + 96))
#define PROF_B(id, lds, t0) do { if (PROF_ID == (id) && blockIdx.x == 0 && (t0)) PROF_WORD(lds)[1] = __builtin_amdgcn_s_memrealtime(); } while (0)
#define PROF_E(id, lds, t0) do { if (PROF_ID == (id) && blockIdx.x == 0 && (t0)) PROF_WORD(lds)[0] += __builtin_amdgcn_s_memrealtime() - PROF_WORD(lds)[1]; } while (0)
DEVI bool unit_of(int i, int nunits, int& u, int geff = 0) {
    const long Lx = (long)i * (geff ? geff : (int)gridDim.x) + blockIdx.x;
    if (Lx >= nunits) return false;
    const int w = (int)Lx, q = nunits / 8, r = nunits % 8, xcd = w % 8, off = w / 8;
    u = (xcd < r ? xcd * (q + 1) : r * (q + 1) + (xcd - r) * q) + off;
    return true;
}

constexpr int G_BK = 64, G_HALF = 128, G_HT = G_HALF * G_BK;
DEVI int g_lds_byte(int r, int c) {
    int st = (r >> 4) * 2 + (c >> 5), rr = r & 15, cc = c & 31, ob = rr * 64 + cc * 2;
    return st * 1024 + (ob ^ (((ob >> 9) & 1) << 5));
}
DEVI void g_stage_rc(int b, int& R, int& C) {
    int st = b / 1024, sb = b % 1024, swz = sb ^ (((sb >> 9) & 1) << 5);
    R = (st >> 1) * 16 + swz / 64; C = (st & 1) * 32 + (swz % 64) / 2;
}

template <bool GATHER, class Epi>
DEVI void gemm_tile(const int tid_, bf16_t* shm, const bf16_t* __restrict__ A, unsigned lda, unsigned a0, unsigned a1, unsigned a2, unsigned a3,
                    const bf16_t* __restrict__ Bt, int K, const Epi& epi) {
#define SA(b, h) (shm + ((b) * 2 + (h)) * G_HT)
#define SB(b, h) (shm + (4 + (b) * 2 + (h)) * G_HT)
#define STG_A(T, P, h, kt) do { const unsigned so_ = (unsigned)(kt) * 128u + ((GATHER || !(h)) ? 0u : 256u * lda); \
    __builtin_amdgcn_raw_ptr_buffer_load_lds(rsA, (LAS void*)((char*)(P) + ldsw), 16, (GATHER && (h)) ? a2 : a0, so_, 0, 0); \
    __builtin_amdgcn_raw_ptr_buffer_load_lds(rsA, (LAS void*)((char*)(P) + ldsw + 8192), 16, (GATHER && (h)) ? a3 : a1, so_, 0, 0); } while (0)
#define STG_B(T, P, h, kt) do { const unsigned so_ = (unsigned)(kt) * 128u + ((h) ? 256u * (unsigned)K : 0u); \
    __builtin_amdgcn_raw_ptr_buffer_load_lds(rsB, (LAS void*)((char*)(P) + ldsw), 16, b0, so_, 0, 0); \
    __builtin_amdgcn_raw_ptr_buffer_load_lds(rsB, (LAS void*)((char*)(P) + ldsw + 8192), 16, b1, so_, 0, 0); } while (0)
#define LDA(dst, b, h) for (int m = 0; m < 4; ++m) for (int k = 0; k < 2; ++k) \
    dst[m][k] = *reinterpret_cast<const bf16x8*>((char*)SA(b, h) + g_lds_byte(wr * 64 + m * 16 + fr, k * 32 + fq * 8))
#define LDB(dst, b, h) for (int n = 0; n < 2; ++n) for (int k = 0; k < 2; ++k) \
    dst[n][k] = *reinterpret_cast<const bf16x8*>((char*)SB(b, h) + g_lds_byte(wc * 32 + n * 16 + fr, k * 32 + fq * 8))
#define MMA(ai, bj, At_, Bt_) do { __builtin_amdgcn_s_setprio(1); \
    for (int m = 0; m < 4; ++m) for (int n = 0; n < 2; ++n) for (int k = 0; k < 2; ++k) \
        acc[ai][bj][m][n] = __builtin_amdgcn_mfma_f32_16x16x32_bf16(Bt_[n][k], At_[m][k], acc[ai][bj][m][n], 0, 0, 0); \
    __builtin_amdgcn_s_setprio(0); } while (0)
#define WAIT_V(n) asm volatile("s_waitcnt vmcnt(" #n ")" ::: "memory")
#define WAIT_L(n) asm volatile("s_waitcnt lgkmcnt(" #n ")" ::: "memory")
#define BAR __builtin_amdgcn_s_barrier()
#define SCHED __builtin_amdgcn_sched_barrier(0)
    unsigned b0, b1;
    { int r_, c_; g_stage_rc(tid_ * 16, r_, c_); b0 = (unsigned)(r_ * K + c_) * 2u; g_stage_rc(tid_ * 16 + 8192, r_, c_); b1 = (unsigned)(r_ * K + c_) * 2u; }
    const __amdgpu_buffer_rsrc_t rsA = __builtin_amdgcn_make_buffer_rsrc((void*)A, (short)0, 0x7fffffff, 0x00020000);
    const __amdgpu_buffer_rsrc_t rsB = __builtin_amdgcn_make_buffer_rsrc((void*)Bt, (short)0, 0x7fffffff, 0x00020000);
    const unsigned ldsw = (unsigned)__builtin_amdgcn_readfirstlane(tid_ >> 6) * 1024u;
    const int T = tid_;
    int wid = T >> 6, lane = T & 63, wr = wid >> 2, wc = wid & 3, fr = lane & 15, fq = lane >> 4;
    f32x4 acc[2][2][4][2] = {};
    bf16x8 At[4][2], B0[2][2], B1[2][2];
    const int nt = K / G_BK;
    STG_B(T, SB(0, 0), 0, 0); STG_A(T, SA(0, 0), 0, 0);
    STG_B(T, SB(0, 1), 1, 0); STG_A(T, SA(0, 1), 1, 0);
    if (wr == 1) BAR;
    WAIT_V(4); BAR;
    STG_B(T, SB(1, 0), 0, 1); STG_A(T, SA(1, 0), 0, 1); STG_B(T, SB(1, 1), 1, 1);
    WAIT_V(6); BAR;
    for (int t = 0; t < nt - 2; t += 2) {
        LDB(B0, 0, 0); SCHED; LDA(At, 0, 0); STG_A(T, SA(1, 1), 1, t + 1);
        WAIT_L(8); BAR; WAIT_L(0); MMA(0, 0, At, B0); BAR; SCHED;
        LDB(B1, 0, 1); STG_B(T, SB(0, 0), 0, t + 2);
        BAR; WAIT_L(0); MMA(0, 1, At, B1); BAR;
        LDA(At, 0, 1); STG_A(T, SA(0, 0), 0, t + 2);
        BAR; WAIT_L(0); MMA(1, 0, At, B0); BAR; SCHED;
        STG_B(T, SB(0, 1), 1, t + 2);
        WAIT_V(6); BAR; MMA(1, 1, At, B1); BAR;
        LDB(B0, 1, 0); SCHED; LDA(At, 1, 0); STG_A(T, SA(0, 1), 1, t + 2);
        WAIT_L(8); BAR; WAIT_L(0); MMA(0, 0, At, B0); BAR; SCHED;
        LDB(B1, 1, 1); STG_B(T, SB(1, 0), 0, t + 3);
        BAR; WAIT_L(0); MMA(0, 1, At, B1); BAR;
        LDA(At, 1, 1); STG_A(T, SA(1, 0), 0, t + 3);
        BAR; WAIT_L(0); MMA(1, 0, At, B0); BAR; SCHED;
        STG_B(T, SB(1, 1), 1, t + 3);
        WAIT_V(6); BAR; MMA(1, 1, At, B1); BAR;
    }
    int tz = tid_; asm volatile("" : "+v"(tz)); wid = tz >> 6; lane = tz & 63; wr = wid >> 2; wc = wid & 3; fr = lane & 15; fq = lane >> 4;
    { LDB(B0, 0, 0); WAIT_V(0); LDA(At, 0, 0); STG_A(tz, SA(1, 1), 1, nt - 1);
      BAR; WAIT_L(0); MMA(0, 0, At, B0); BAR;
      LDB(B1, 0, 1); BAR; WAIT_L(0); MMA(0, 1, At, B1); BAR;
      LDA(At, 0, 1); WAIT_V(4); BAR; WAIT_L(0); MMA(1, 0, At, B0); MMA(1, 1, At, B1); BAR; }
    { LDB(B0, 1, 0); LDA(At, 1, 0); WAIT_V(2); BAR; WAIT_L(0); MMA(0, 0, At, B0); BAR;
      LDB(B1, 1, 1); WAIT_V(0); BAR; WAIT_L(0); MMA(0, 1, At, B1); BAR;
      LDA(At, 1, 1); BAR; WAIT_L(0); MMA(1, 0, At, B0); MMA(1, 1, At, B1); BAR; }
    if (wr == 0) BAR;
    SCHED;
    epi(acc, wr, wc, fr, fq, tz, (unsigned char*)shm);
#undef SA
#undef SB
#undef STG_A
#undef STG_B
#undef LDA
#undef LDB
#undef MMA
}

DEVI void aoff_plain(const int tid_, int lda, unsigned& a0, unsigned& a1) {
    int r, c;
    g_stage_rc(tid_ * 16, r, c);        a0 = (unsigned)(r * lda + c) * 2u;
    g_stage_rc(tid_ * 16 + 8192, r, c); a1 = (unsigned)(r * lda + c) * 2u;
}

constexpr int NU_WIN = 2 * 68 * 16, NU_WOUT = 2 * 32 * 16, NU_UP = 64 * 32 * 16, NU_DN = 64 * 32 * 8;
constexpr int NU_CONV = NU_WIN + NU_WOUT + NU_UP + NU_DN;
constexpr int NU_ADA = 768, NU_ROPE = 512, NU_LRUW = 512, NU_WR = 384;
constexpr int NU_P0 = NU_CONV + NU_ADA + NU_ROPE + NU_LRUW + NU_WR;

DEVI void conv_decode(const Params& p, int u, const float*& srck, int& ld_src, int& c0, int& nv, bf16_t*& dstn, int& ld_dst) {
    if (u < NU_WIN) {
        const int L = u / 1088, rem = u % 1088, ntile = rem >> 4, ktile = rem & 15, n0 = ntile * 64;
        if (n0 < 3072) { c0 = n0; nv = 64; } else if (n0 < 4096) { c0 = n0 + 32; nv = 64; } else if (n0 == 4096) { c0 = 3072; nv = 32; } else { c0 = 0; nv = 0; }
        srck = p.in[8] + (size_t)L * 2048 * 4128 + (size_t)ktile * 128 * 4128; ld_src = 4128;
        dstn = (bf16_t*)(p.ws + WS_WINT) + ((size_t)L * NWIN + n0) * 2048 + ktile * 128; ld_dst = 2048;
    } else if (u < NU_WIN + NU_WOUT) {
        const int v = u - NU_WIN, L = v >> 9, rem = v & 511, ntile = rem >> 4, ktile = rem & 15;
        srck = p.in[20] + (size_t)L * 2048 * 2048 + (size_t)ktile * 128 * 2048; ld_src = 2048; c0 = ntile * 64; nv = 64;
        dstn = (bf16_t*)(p.ws + WS_WOUTT) + ((size_t)L * 2048 + ntile * 64) * 2048 + ktile * 128; ld_dst = 2048;
    } else if (u < NU_WIN + NU_WOUT + NU_UP) {
        const int v = u - NU_WIN - NU_WOUT, le = v >> 9, rem = v & 511, ntile = rem >> 4, ktile = rem & 15;
        const int nt = ntile >> 2, half = (ntile >> 1) & 1, i0 = (ntile & 1) * 64;
        srck = (half ? p.in[26] : p.in[25]) + (size_t)le * 2048 * 1024 + (size_t)ktile * 128 * 1024; ld_src = 1024; c0 = nt * 128 + i0; nv = 64;
        dstn = (bf16_t*)(p.ws + WS_WUPT) + ((size_t)le * 2048 + ntile * 64) * 2048 + ktile * 128; ld_dst = 2048;
    } else {
        const int v = u - NU_WIN - NU_WOUT - NU_UP, le = v >> 8, rem = v & 255, ntile = rem >> 3, ktile = rem & 7;
        srck = p.in[27] + (size_t)le * 1024 * 2048 + (size_t)ktile * 128 * 2048; ld_src = 2048; c0 = ntile * 64; nv = 64;
        dstn = (bf16_t*)(p.ws + WS_WDNT) + ((size_t)le * 2048 + ntile * 64) * 1024 + ktile * 128; ld_dst = 1024;
    }
}

constexpr int CTL_QHEAD = 4200, CTL_DONE = 4224;
constexpr int QE0 = 1088, QE1 = 1600, QE2 = 17984, QE3 = 26176, QE4 = 27264, QE5 = 27776, QE6 = 44160, QE7 = 52352;
static_assert(QE7 == NU_CONV, "queue length");
DEVI int q_to_unit(int q) {
    if (q < QE0) return q;
    if (q < QE1) return NU_WIN + (q - QE0);
    if (q < QE2) return NU_WIN + NU_WOUT + (q - QE1);
    if (q < QE3) return NU_WIN + NU_WOUT + NU_UP + (q - QE2);
    if (q < QE4) return 1088 + (q - QE3);
    if (q < QE5) return NU_WIN + 512 + (q - QE4);
    if (q < QE6) return NU_WIN + NU_WOUT + 16384 + (q - QE5);
    return NU_WIN + NU_WOUT + NU_UP + 8192 + (q - QE6);
}
DEVI int q_deadline(int k) {
    return k < 1 ? 0 : k < 5 ? QE0 : k < 7 ? QE1 : k < 8 ? QE2 : k < 10 ? QE3 : k < 14 ? QE4 : k < 16 ? QE5 : k < 17 ? QE6 : QE7;
}
typedef unsigned u32x4_t __attribute__((ext_vector_type(4)));
DEVI float4 ntld4(const float* p) { const f32x4 v = __builtin_nontemporal_load((const f32x4*)p); return make_float4(v[0], v[1], v[2], v[3]); }
DEVI void ntst4(const uint4& o, bf16_t* p) { u32x4_t v = {o.x, o.y, o.z, o.w}; __builtin_nontemporal_store(v, (u32x4_t*)p); }
DEVI void conv_run(const int tid_, const Params& p, float* T, int q0, int count) {
    const int t = tid_, n4 = t & 15, kr = t >> 4;
    float4 v0, v1, v2, v3, x0, x1, x2, x3;
    const float* srck; bf16_t* dstn; int ld_src, ld_dst, c0, nv;
    bf16_t* d1 = nullptr; int l1 = 0; bf16_t* d2 = nullptr; int l2 = 0;
#define CV_LOAD(a0_, a1_, a2_, a3_) do { const float* s_ = srck + c0 + n4 * 4; \
        a0_ = make_float4(0.f, 0.f, 0.f, 0.f); a1_ = a0_; a2_ = a0_; a3_ = a0_; \
        if (n4 * 4 < nv) { a0_ = ntld4((s_ + (size_t)(kr) * ld_src)); a1_ = ntld4((s_ + (size_t)(kr + 32) * ld_src)); \
                           a2_ = ntld4((s_ + (size_t)(kr + 64) * ld_src)); a3_ = ntld4((s_ + (size_t)(kr + 96) * ld_src)); } } while (0)
    conv_decode(p, q_to_unit(q0), srck, ld_src, c0, nv, dstn, ld_dst); d1 = dstn; l1 = ld_dst; CV_LOAD(v0, v1, v2, v3);
    x0 = make_float4(0.f, 0.f, 0.f, 0.f); x1 = x0; x2 = x0; x3 = x0;
    if (count > 1) { conv_decode(p, q_to_unit(q0 + 1), srck, ld_src, c0, nv, dstn, ld_dst); d2 = dstn; l2 = ld_dst; CV_LOAD(x0, x1, x2, x3); }
#pragma unroll 1
    for (int i = 0; i < count; ++i) {
        const float4 w0 = v0, w1 = v1, w2 = v2, w3 = v3;
        bf16_t* const dcur = d1; const int ldd = l1;
        v0 = x0; v1 = x1; v2 = x2; v3 = x3; d1 = d2; l1 = l2;
        if (i + 2 < count) { conv_decode(p, q_to_unit(q0 + i + 2), srck, ld_src, c0, nv, dstn, ld_dst); d2 = dstn; l2 = ld_dst; CV_LOAD(x0, x1, x2, x3); }
        lds_sync();
        { float* d = T + kr * 65 + n4 * 4; d[0] = w0.x; d[1] = w0.y; d[2] = w0.z; d[3] = w0.w; }
        { float* d = T + (kr + 32) * 65 + n4 * 4; d[0] = w1.x; d[1] = w1.y; d[2] = w1.z; d[3] = w1.w; }
        { float* d = T + (kr + 64) * 65 + n4 * 4; d[0] = w2.x; d[1] = w2.y; d[2] = w2.z; d[3] = w2.w; }
        { float* d = T + (kr + 96) * 65 + n4 * 4; d[0] = w3.x; d[1] = w3.y; d[2] = w3.z; d[3] = w3.w; }
        lds_sync();
#pragma unroll
        for (int i2 = 0; i2 < 2; ++i2) {
            const int kc = t & 15, n = (t >> 4) + 32 * i2;
            float f[8];
#pragma unroll
            for (int j = 0; j < 8; ++j) f[j] = T[(kc * 8 + j) * 65 + n];
            uint4 o; o.x = pk2(f[0], f[1]); o.y = pk2(f[2], f[3]); o.z = pk2(f[4], f[5]); o.w = pk2(f[6], f[7]);
            ntst4(o, dcur + (size_t)n * ldd + kc * 8);
        }
    }
#undef CV_LOAD
}
DEVI void bg_convert(const int tid_, const Params& p, unsigned char* lds, int k) {
    typedef __attribute__((address_space(1))) unsigned gu32_t;
    gu32_t* ctl = (gu32_t*)(p.ws + WS_CTL);
    volatile int* lw = (volatile int*)(lds + LDS_MISC + 64);
    float* T = (float*)lds;
    const int t = tid_;
    const int deadline = q_deadline(k), G = (int)gridDim.x;
#pragma unroll 1
    for (int stage = (k > 0 && q_deadline(k) == q_deadline(k - 1)) ? 1 : 0; stage < 2; ++stage) {
        if (stage == 1 && t == 0) (void)__hip_atomic_fetch_add(ctl + CTL_DONE + 64 * k, 1u, __ATOMIC_RELAXED, __HIP_MEMORY_SCOPE_AGENT);
        const int batch = (stage == 0) ? BG_B0 : BG_B1;
#pragma unroll 1
        for (;;) {
            if (t == 0) {
                int c = -1;
                const bool want = (stage == 0) ? ((int)__hip_atomic_load(ctl + CTL_QHEAD, __ATOMIC_RELAXED, __HIP_MEMORY_SCOPE_AGENT) < deadline)
                                               : ((int)__hip_atomic_load(ctl + CTL_DONE + 64 * k, __ATOMIC_RELAXED, __HIP_MEMORY_SCOPE_AGENT) < G);
                if (want) { c = (int)__hip_atomic_fetch_add(ctl + CTL_QHEAD, (unsigned)batch, __ATOMIC_RELAXED, __HIP_MEMORY_SCOPE_AGENT); if (c >= NU_CONV) c = -1; }
                lw[0] = c;
            }
            lds_sync();
            const int c = lw[0];
            lds_sync();
            if (c < 0) break;
            conv_run(tid_, p, T, c, (NU_CONV - c) < batch ? (NU_CONV - c) : batch);
        }
    }
}

DEVI void bg_fill(const int tid_, const Params& p, unsigned char* lds, int per_quarter) {
    typedef __attribute__((address_space(1))) unsigned gu32_t;
    gu32_t* ctl = (gu32_t*)(p.ws + WS_CTL);
    volatile int* lw = (volatile int*)(lds + LDS_MISC + 64);
    const int n = (int)(blockIdx.x & 3u) * per_quarter;
    if (n == 0) return;
    if (tid_ == 0) {
        int c = -1;
        if ((int)__hip_atomic_load(ctl + CTL_QHEAD, __ATOMIC_RELAXED, __HIP_MEMORY_SCOPE_AGENT) < NU_CONV) {
            c = (int)__hip_atomic_fetch_add(ctl + CTL_QHEAD, (unsigned)n, __ATOMIC_RELAXED, __HIP_MEMORY_SCOPE_AGENT); if (c >= NU_CONV) c = -1; }
        lw[0] = c;
    }
    lds_sync();
    const int c = lw[0];
    lds_sync();
    if (c >= 0) conv_run(tid_, p, (float*)lds, c, (NU_CONV - c) < n ? (NU_CONV - c) : n);
    lds_sync();
}

__constant__ double c_rope_inv[32] = {
    1.0, 0.7498942093324559, 0.5623413251903491, 0.4216965034285822, 0.31622776601683794, 0.23713737056616552, 0.1778279410038923, 0.1333521432163324,
    0.1, 0.07498942093324558, 0.05623413251903491, 0.042169650342858224, 0.03162277660168379, 0.023713737056616554, 0.01778279410038923, 0.01333521432163324,
    0.01, 0.007498942093324558, 0.005623413251903491, 0.004216965034285823, 0.0031622776601683794, 0.0023713737056616554, 0.0017782794100389228, 0.001333521432163324,
    0.001, 0.0007498942093324559, 0.0005623413251903491, 0.00042169650342858224, 0.00031622776601683794, 0.00023713737056616554, 0.00017782794100389227, 0.0001333521432163324};

DEVI void sincos_f64(double ang, float& sn, float& cs) {
    const double n = __builtin_rint(ang * 0.15915494309189535);
    double r = __builtin_fma(-n, 6.283185307179586, ang);
    r = __builtin_fma(-n, 2.4492935982947064e-16, r);
    const double x = 0.5 * r, x2 = x * x;
    double s = 1.0, c = 1.0;
#pragma unroll
    for (int k = 12; k >= 1; --k) {
        s = 1.0 - s * x2 * (1.0 / (double)((2 * k) * (2 * k + 1)));
        c = 1.0 - c * x2 * (1.0 / (double)((2 * k - 1) * (2 * k)));
    }
    s *= x;
    sn = (float)(2.0 * s * c); cs = (float)(1.0 - 2.0 * s * s);
}

DEVI void phase_prologue(const int tid_, const Params& p, unsigned char* lds) {
    float* T = (float*)lds;
    float* cond = (float*)(lds + 33280);
    float* red = (float*)(lds + 33280 + 40960);
    const int t = tid_;
    for (int i = t; i < 5 * 2048; i += 512) {
        const int r = i >> 11, k = i & 2047;
        const float c = r < 4 ? p.in[1][r * 2048 + k] : p.in[3][k];
        cond[i] = c / (1.f + expf(-c));
    }
    __syncthreads();
    __syncthreads();
    for (int u = NU_CONV + blockIdx.x; u < NU_P0; u += gridDim.x) {
        if (false) {
        } else if (u < NU_CONV + NU_ADA) {
            const int v = u - NU_CONV, L = v / 384, c0 = (v % 384) * 32;
            const float* W = p.in[4] + (size_t)L * 2048 * 12288;
            const int q = t & 7, kg = t >> 3;
            float acc[5][4];
#pragma unroll
            for (int r = 0; r < 5; ++r) { acc[r][0] = 0.f; acc[r][1] = 0.f; acc[r][2] = 0.f; acc[r][3] = 0.f; }
#pragma unroll 4
            for (int k = kg; k < 2048; k += 64) {
                const float4 w = *(const float4*)(W + (size_t)k * 12288 + c0 + q * 4);
#pragma unroll
                for (int r = 0; r < 5; ++r) {
                    const float cv = cond[r * 2048 + k];
                    acc[r][0] += cv * w.x; acc[r][1] += cv * w.y; acc[r][2] += cv * w.z; acc[r][3] += cv * w.w;
                }
            }
#pragma unroll
            for (int r = 0; r < 5; ++r)
#pragma unroll
                for (int j = 0; j < 4; ++j) {
                    float a = acc[r][j];
                    a += shx(a, 8, t & 63); a += shx(a, 16, t & 63); a += shx(a, 32, t & 63);
                    acc[r][j] = a;
                }
            const int lane = t & 63, wave = t >> 6;
            __syncthreads();
            if (lane < 8) {
#pragma unroll
                for (int r = 0; r < 5; ++r)
#pragma unroll
                    for (int j = 0; j < 4; ++j) red[(wave * 8 + lane) * 20 + r * 4 + j] = acc[r][j];
            }
            __syncthreads();
            if (t < 160) {
                const int qq = t / 20, rj = t % 20;
                float s = 0.f;
#pragma unroll
                for (int w = 0; w < 8; ++w) s += red[(w * 8 + qq) * 20 + rj];
                const int r = rj >> 2, j = rj & 3, col = c0 + qq * 4 + j;
                ((float*)(p.ws + WS_MODS))[(size_t)(L * 5 + r) * 12288 + col] = s + p.in[5][L * 12288 + col];
            }
        } else if (u < NU_CONV + NU_ADA + NU_ROPE) {
            const int idx = (u - NU_CONV - NU_ADA) * 512 + t, pos = idx >> 6, i = idx & 63;
            const int coord = i < 32 ? (pos >> 6) : (pos & 63);
            float sn, cs;
            sincos_f64((double)coord * c_rope_inv[i & 31], sn, cs);
            ((float*)(p.ws + WS_ROPEC))[idx] = cs;
            ((float*)(p.ws + WS_ROPES))[idx] = sn;
            if (idx < 32) ((float*)(p.ws + WS_ROPEF))[idx] = (float)(c_rope_inv[idx] * 0.15915494309189535);
        } else if (u < NU_CONV + NU_ADA + NU_ROPE + NU_LRUW) {
            const int idx = (u - NU_CONV - NU_ADA - NU_ROPE) * 512 + t;
            const int c = idx & 63, n = (idx >> 6) & 255, blk = (idx >> 14) & 7, L = idx >> 17;
            const int dg = n >> 6, dir = dg >> 1, gate = dg & 1, dd = n & 63;
            const float* src = gate ? p.in[17] : p.in[15];
            ((bf16_t*)(p.ws + WS_LRUWT))[idx] = f2bf(src[((size_t)((L * 2 + dir) * 8 + blk) * 64 + c) * 64 + dd]);
        } else {
            const int idx = (u - NU_CONV - NU_ADA - NU_ROPE - NU_LRUW) * 512 + t;
            const int k = idx & 2047, n = (idx >> 11) % 48, L = idx / (48 * 2048);
            float v = 0.f;
            if (n < 4) v = p.in[21][((size_t)L * 2048 + k) * 4 + n];
            else if (n < 36) v = p.in[23][((size_t)L * 2048 + k) * 32 + (n - 4)];
            ((bf16_t*)(p.ws + WS_WRT))[idx] = f2bf(v);
        }
    }
}

DEVI void phase_norm1(const int tid_, const Params& p, int L) {
    const int wave = tid_ >> 6, lane = tid_ & 63;
    float* H = (float*)(p.ws + WS_H);
    bf16_t* U = (bf16_t*)(p.ws + WS_U);
    const float* mods = (const float*)(p.ws + WS_MODS);
    const bf16_t* SL = (const bf16_t*)(p.ws + WS_SLOTS);
    const float* gmix = p.in[6] + L * 2048;
    float4 nx[8];
#define N1_SRC(r) (L == 0 ? ((r) < NL ? p.in[0] + (size_t)(r) * D : p.in[2] + (size_t)((r) - NL) * D) : H + (size_t)(r) * D)
    {
        const int r0 = blockIdx.x * 8 + wave;
        if (r0 < NT) { const float* s0 = N1_SRC(r0);
#pragma unroll
            for (int c = 0; c < 8; ++c) nx[c] = *(const float4*)(s0 + c * 256 + lane * 4); }
    }
    for (int row = blockIdx.x * 8 + wave; row < NT; row += gridDim.x * 8) {
        const int mrow = row < NL ? (row >> 12) : 4;
        const float* md = mods + (size_t)(L * 5 + mrow) * 12288;
        float4 hv[8];
#pragma unroll
        for (int c = 0; c < 8; ++c) hv[c] = nx[c];
        {
            const int rn = row + (int)gridDim.x * 8;
            if (rn < NT) { const float* s1 = N1_SRC(rn);
#pragma unroll
                for (int c = 0; c < 8; ++c) nx[c] = *(const float4*)(s1 + c * 256 + lane * 4); }
        }
        if (L == 1) {
            const float* g2 = mods + (size_t)(0 * 5 + mrow) * 12288 + 5 * 2048;
#pragma unroll
            for (int c = 0; c < 8; ++c) {
                const int col = c * 256 + lane * 4;
                const float4 g = *(const float4*)(g2 + col);
                const uint2 a = *(const uint2*)(SL + (size_t)(row * 2) * D + col), b = *(const uint2*)(SL + (size_t)(row * 2 + 1) * D + col);
                hv[c].x += g.x * (bflo(a.x) + bflo(b.x)); hv[c].y += g.y * (bfhi(a.x) + bfhi(b.x));
                hv[c].z += g.z * (bflo(a.y) + bflo(b.y)); hv[c].w += g.w * (bfhi(a.y) + bfhi(b.y));
            }
        }
        float ss = 0.f;
#pragma unroll
        for (int c = 0; c < 8; ++c) {
            if (L == 1) *(float4*)(H + (size_t)row * D + c * 256 + lane * 4) = hv[c];
            ss += hv[c].x * hv[c].x + hv[c].y * hv[c].y + hv[c].z * hv[c].z + hv[c].w * hv[c].w;
        }
        ss = wave_sum(ss, lane);
        const float rstd = rsqrtf(ss * (1.f / 2048.f) + 1e-6f);
#pragma unroll
        for (int c = 0; c < 8; ++c) {
            const int col = c * 256 + lane * 4;
            const float4 gm = *(const float4*)(gmix + col), sh = *(const float4*)(md + col), sc = *(const float4*)(md + 2048 + col);
            const float u0 = hv[c].x * rstd * gm.x * (1.f + sc.x) + sh.x, u1 = hv[c].y * rstd * gm.y * (1.f + sc.y) + sh.y;
            const float u2 = hv[c].z * rstd * gm.z * (1.f + sc.z) + sh.z, u3 = hv[c].w * rstd * gm.w * (1.f + sc.w) + sh.w;
            uint2 o; o.x = pk2(u0, u1); o.y = pk2(u2, u3);
            *(uint2*)(U + (size_t)row * D + col) = o;
        }
    }
#undef N1_SRC
}

DEVI void phase_final(const int tid_, const Params& p) {
    const int wave = tid_ >> 6, lane = tid_ & 63;
    const float* H = (const float*)(p.ws + WS_H);
    const float* mods = (const float*)(p.ws + WS_MODS);
    const bf16_t* SL = (const bf16_t*)(p.ws + WS_SLOTS);
    const float* gf = p.in[28];
    for (int row = blockIdx.x * 8 + wave; row < NL; row += gridDim.x * 8) {
        const int mrow = row >> 12;
        const float* g2 = mods + (size_t)(1 * 5 + mrow) * 12288 + 5 * 2048;
        float4 hv[8];
        float ss = 0.f;
#pragma unroll
        for (int c = 0; c < 8; ++c) {
            const int col = c * 256 + lane * 4;
            hv[c] = *(const float4*)(H + (size_t)row * D + col);
            const float4 g = *(const float4*)(g2 + col);
            const uint2 a = *(const uint2*)(SL + (size_t)(row * 2) * D + col), b = *(const uint2*)(SL + (size_t)(row * 2 + 1) * D + col);
            hv[c].x += g.x * (bflo(a.x) + bflo(b.x)); hv[c].y += g.y * (bfhi(a.x) + bfhi(b.x));
            hv[c].z += g.z * (bflo(a.y) + bflo(b.y)); hv[c].w += g.w * (bfhi(a.y) + bfhi(b.y));
            ss += hv[c].x * hv[c].x + hv[c].y * hv[c].y + hv[c].z * hv[c].z + hv[c].w * hv[c].w;
        }
        ss = wave_sum(ss, lane);
        const float rstd = rsqrtf(ss * (1.f / 2048.f) + 1e-6f);
#pragma unroll
        for (int c = 0; c < 8; ++c) {
            const int col = c * 256 + lane * 4;
            const float4 gm = *(const float4*)(gf + col);
            float4 o; o.x = hv[c].x * rstd * gm.x; o.y = hv[c].y * rstd * gm.y; o.z = hv[c].z * rstd * gm.z; o.w = hv[c].w * rstd * gm.w;
            *(float4*)(p.out + (size_t)row * D + col) = o;
        }
    }
}

constexpr int EP_RS = 528;
struct EpiIn {
    bf16_t* Z; float* GZ; bf16_t* VT; bf16_t* GVT; const float* RC; const float* RS; int brow, pn;
    DEVI void operator()(const f32x4 (&acc)[2][2][4][2], int wr, int wc, int fr, int fq, int tid, unsigned char* stg) const {
        if (pn == 16) {
#pragma unroll
            for (int ai = 0; ai < 2; ++ai)
#pragma unroll
                for (int m = 0; m < 4; ++m) {
                    const int row = brow + ai * 128 + wr * 64 + m * 16 + fr;
#pragma unroll
                    for (int n = 0; n < 2; ++n) { const int colt = wc * 32 + n * 16 + fq * 4; if (colt < 32) *(f32x4*)(GZ + (size_t)row * 32 + colt) = acc[ai][0][m][n]; }
                }
            return;
        }
        const bool tr = (pn == 5 || pn == 8 || pn == 9);
#pragma unroll
        for (int ai = 0; ai < 2; ++ai)
#pragma unroll
            for (int m = 0; m < 4; ++m) {
                const int rloc = ai * 128 + wr * 64 + m * 16 + fr, row = brow + rloc;
#pragma unroll
                for (int bj = 0; bj < 2; ++bj)
#pragma unroll
                    for (int n = 0; n < 2; ++n) {
                        const int colt = bj * 128 + wc * 32 + n * 16 + fq * 4;
                        const f32x4 v = acc[ai][bj][m][n];
                        float o0 = v[0], o1 = v[1], o2 = v[2], o3 = v[3];
                        if (pn <= 4) {
                            if (row < NL) {
                                const int tpos = row & 4095, i0 = (colt & 127) >> 1;
                                const float pos = (float)((i0 < 32) ? (tpos >> 6) : (tpos & 63));
                                const float r0 = pos * RC[i0 & 31], r1 = pos * RC[(i0 & 31) + 1];
                                const float c0 = __builtin_amdgcn_cosf(r0), s0 = __builtin_amdgcn_sinf(r0), c1 = __builtin_amdgcn_cosf(r1), s1 = __builtin_amdgcn_sinf(r1);
                                o0 = v[0] * c0 - v[1] * s0; o1 = v[0] * s0 + v[1] * c0;
                                o2 = v[2] * c1 - v[3] * s1; o3 = v[2] * s1 + v[3] * c1;
                            }
                            if (pn < 4) { o0 *= 0.12751743f; o1 *= 0.12751743f; o2 *= 0.12751743f; o3 *= 0.12751743f; }
                        }
                        if (!tr) { uint2 o; o.x = pk2(o0, o1); o.y = pk2(o2, o3); *(uint2*)(stg + rloc * EP_RS + colt * 2) = o; }
                        else {
                            const unsigned p01 = pk2(o0, o1), p23 = pk2(o2, o3);
                            *(bf16_t*)(stg + (colt + 0) * EP_RS + rloc * 2) = (bf16_t)(p01 & 0xffffu); *(bf16_t*)(stg + (colt + 1) * EP_RS + rloc * 2) = (bf16_t)(p01 >> 16);
                            *(bf16_t*)(stg + (colt + 2) * EP_RS + rloc * 2) = (bf16_t)(p23 & 0xffffu); *(bf16_t*)(stg + (colt + 3) * EP_RS + rloc * 2) = (bf16_t)(p23 >> 16);
                        }
                    }
            }
        lds_sync();
        if (!tr) {
#pragma unroll 4
            for (int c = tid; c < 8192; c += 512) {
                const int r = c >> 5, cc = c & 31;
                *(uint4*)(Z + (size_t)(brow + r) * ZLD + pn * 256 + cc * 8) = *(const uint4*)(stg + r * EP_RS + cc * 16);
            }
        } else {
            int bb, tpos0;
            if (brow < NL) { bb = brow >> 12; tpos0 = brow & 4095; } else { bb = (brow - NL) >> 8; tpos0 = 4096; }
#pragma unroll 4
            for (int c = tid; c < 8192; c += 512) {
                const int col = c >> 5, rc = c & 31;
                bf16_t* dst;
                if (pn == 5) dst = VT + ((size_t)((bb * 2 + (col >> 7)) * 128 + (col & 127))) * TT;
                else { const int cv = (pn - 8) * 256 + col; dst = GVT + ((size_t)((bb * 4 + (cv >> 7)) * 128 + (cv & 127))) * TT; }
                *(uint4*)(dst + tpos0 + rc * 8) = *(const uint4*)(stg + col * EP_RS + rc * 16);
            }
        }
        lds_sync();
    }
};

DEVI void dense_tile_of(int wgid, int nM, int nN, int& pm, int& pn) {
    const int nig = 8 * nN, gid = wgid / nig, fm = gid * 8, gsz = (nM - fm) < 8 ? (nM - fm) : 8;
    pm = fm + ((wgid % nig) % gsz); pn = (wgid % nig) / gsz;
}

DEVI void phase_gemm_in(const int tid_, const Params& p, int L, bf16_t* shm) {
    const int nM = NT / 256, nN = NWIN / 256;
    const bf16_t* U = (const bf16_t*)(p.ws + WS_U);
    bg_fill(tid_, p, (unsigned char*)shm, FILL_Q);
    const int geff = (int)gridDim.x - NCONV_WG;
    if ((int)blockIdx.x >= geff) return;
    for (int i = 0;; ++i) {
        int u; if (!unit_of(i, nM * nN, u, geff)) break;
        int pm, pn; dense_tile_of(u, nM, nN, pm, pn);
        if (L == 1 && pm >= NL / 256 && !(pn == 4 || pn == 5 || pn == 7 || pn == 8 || pn == 9 || pn == 12 || pn == 13 || pn == 16)) continue;
        unsigned a0, a1; aoff_plain(tid_, D, a0, a1);
        const bf16_t* Bt = (const bf16_t*)(p.ws + WS_WINT) + ((size_t)L * NWIN + pn * 256) * 2048;
        EpiIn epi{(bf16_t*)(p.ws + WS_Z), (float*)(p.ws + WS_GZ), (bf16_t*)(p.ws + WS_VT), (bf16_t*)(p.ws + WS_GVT),
                  (const float*)(p.ws + WS_ROPEF), (const float*)(p.ws + WS_ROPES), pm * 256, pn};
        if (REP_SUB == 200) { struct Twice { const EpiIn& e; DEVI void operator()(const f32x4 (&acc)[2][2][4][2], int wr, int wc, int fr, int fq, int tid, unsigned char* stg) const { e(acc, wr, wc, fr, fq, tid, stg); asm volatile("" ::: "memory"); e(acc, wr, wc, fr, fq, tid, stg); } } tw{epi};
            gemm_tile<false>(tid_, shm, U + (size_t)pm * 256 * D, D, a0, a1, 0u, 0u, Bt, 2048, tw); }
        else gemm_tile<false>(tid_, shm, U + (size_t)pm * 256 * D, D, a0, a1, 0u, 0u, Bt, 2048, epi);
    }
}

struct EpiOut {
    float* H; const float* mods; const float* x; const float* ctx; int L, brow, bcol;
    DEVI void operator()(const f32x4 (&acc)[2][2][4][2], int wr, int wc, int fr, int fq, int, unsigned char*) const {
#pragma unroll
        for (int ai = 0; ai < 2; ++ai)
#pragma unroll
            for (int m = 0; m < 4; ++m) {
                const int row = brow + ai * 128 + wr * 64 + m * 16 + fr;
                const int mrow = row < NL ? (row >> 12) : 4;
                const float* g1 = mods + (size_t)(L * 5 + mrow) * 12288 + 2 * 2048;
#pragma unroll
                for (int bj = 0; bj < 2; ++bj)
#pragma unroll
                    for (int n = 0; n < 2; ++n) {
                        const int col = bcol + bj * 128 + wc * 32 + n * 16 + fq * 4;
                        const f32x4 g = *(const f32x4*)(g1 + col);
                        f32x4* hp = (f32x4*)(H + (size_t)row * D + col);
                        const f32x4* rp = (L == 0) ? (const f32x4*)((row < NL ? x + (size_t)row * D : ctx + (size_t)(row - NL) * D) + col) : (const f32x4*)hp;
                        f32x4 h = *rp;
                        h += g * acc[ai][bj][m][n];
                        *hp = h;
                    }
            }
    }
};

DEVI void phase_gemm_out(const int tid_, const Params& p, int L, bf16_t* shm) {
    const int nM = (L == 0 ? NT : NL) / 256, nN = 8;
    const bf16_t* MIX = (const bf16_t*)(p.ws + WS_MIX);
    bg_fill(tid_, p, (unsigned char*)shm, FILL_Q);
    const int geff = (int)gridDim.x - NCONV_WG;
    if ((int)blockIdx.x >= geff) return;
    for (int i = 0;; ++i) {
        int u; if (!unit_of(i, nM * nN, u, geff)) break;
        int pm, pn; dense_tile_of(u, nM, nN, pm, pn);
        unsigned a0, a1; aoff_plain(tid_, D, a0, a1);
        const bf16_t* Bt = (const bf16_t*)(p.ws + WS_WOUTT) + ((size_t)L * 2048 + pn * 256) * 2048;
        EpiOut epi{(float*)(p.ws + WS_H), (const float*)(p.ws + WS_MODS), p.in[0], p.in[2], L, pm * 256, pn * 256};
        gemm_tile<false>(tid_, shm, MIX + (size_t)pm * 256 * D, D, a0, a1, 0u, 0u, Bt, 2048, epi);
    }
}

constexpr int AT_KSTR = 272, AT_VSTR = 144;
DEVI void attn_unit(const int tid_, const Params& p, int L, int a, unsigned char* lds) {
    const bf16_t* Z = (const bf16_t*)(p.ws + WS_Z);
    const bf16_t* VT = (const bf16_t*)(p.ws + WS_VT);
    bf16_t* MIX = (bf16_t*)(p.ws + WS_MIX);
    unsigned char* Ks = lds;
    unsigned char* Vs = lds + 64 * AT_KSTR;
    const int tid = tid_, w = tid >> 6, lane = tid & 63, fr = lane & 15, fq = lane >> 4;
    int b, qb, kvh; bool isctx;
    if (a < 512) { b = a >> 7; qb = (a >> 1) & 63; kvh = a & 1; isctx = false; }
    else { const int a2 = a - 512; b = a2 >> 3; qb = (a2 >> 1) & 3; kvh = a2 & 1; isctx = true; }
    const int row0 = isctx ? NL + b * 256 + qb * 64 : b * 4096 + qb * 64;
    const int head = kvh * 4 + (w >> 1), qh = w & 1;
    bf16x8 Qf[2][4];
#pragma unroll
    for (int nq = 0; nq < 2; ++nq)
#pragma unroll
        for (int ks = 0; ks < 4; ++ks)
            Qf[nq][ks] = *(const bf16x8*)(Z + (size_t)(row0 + qh * 32 + nq * 16 + fr) * ZLD + ZQ + head * 128 + ks * 32 + fq * 8);
    f32x4 ot[8][2];
#pragma unroll
    for (int i = 0; i < 8; ++i) { ot[i][0] = (f32x4){0.f, 0.f, 0.f, 0.f}; ot[i][1] = (f32x4){0.f, 0.f, 0.f, 0.f}; }
    float mrun[2] = {-1e30f, -1e30f}, lrun[2] = {0.f, 0.f};
    int lo, hi;
    if (isctx) { lo = 5; hi = 4; } else { lo = (2 - qb) > 0 ? (2 - qb) : 0; hi = (65 - qb) < 4 ? (65 - qb) : 4; }
    int ti = (lo <= hi) ? lo : 5;
    uint4 kreg0, kreg1, vreg0, vreg1;
    const int kch0 = tid, kch1 = tid + 512;
#define AT_LOAD(tile) do { \
    int krow0_, vt0_; \
    if ((tile) <= 4) { const int j_ = qb - 2 + (tile); krow0_ = b * 4096 + j_ * 64; vt0_ = j_ * 64; } \
    else { const int jj_ = (tile) - 5; krow0_ = NL + b * 256 + jj_ * 64; vt0_ = 4096 + jj_ * 64; } \
    kreg0 = *(const uint4*)(Z + (size_t)(krow0_ + (kch0 >> 4)) * ZLD + ZK + kvh * 128 + (kch0 & 15) * 8); \
    kreg1 = *(const uint4*)(Z + (size_t)(krow0_ + (kch1 >> 4)) * ZLD + ZK + kvh * 128 + (kch1 & 15) * 8); \
    vreg0 = *(const uint4*)(VT + ((size_t)((b * 2 + kvh) * 128 + (kch0 >> 3))) * TT + vt0_ + (kch0 & 7) * 8); \
    vreg1 = *(const uint4*)(VT + ((size_t)((b * 2 + kvh) * 128 + (kch1 >> 3))) * TT + vt0_ + (kch1 & 7) * 8); } while (0)
    AT_LOAD(ti);
    for (;;) {
        PROF_B(11, lds, tid == 0);
        __syncthreads();
        *(uint4*)(Ks + (kch0 >> 4) * AT_KSTR + (kch0 & 15) * 16) = kreg0;
        *(uint4*)(Ks + (kch1 >> 4) * AT_KSTR + (kch1 & 15) * 16) = kreg1;
        *(uint4*)(Vs + (kch0 >> 3) * AT_VSTR + (kch0 & 7) * 16) = vreg0;
        *(uint4*)(Vs + (kch1 >> 3) * AT_VSTR + (kch1 & 7) * 16) = vreg1;
        __syncthreads();
        PROF_E(11, lds, tid == 0);
        const int cur = ti;
        const int nxt = (cur == hi) ? 5 : cur + 1;
        if (nxt <= 8) AT_LOAD(nxt);
        f32x4 st[4][2];
#pragma unroll
        for (int mt = 0; mt < 4; ++mt) { st[mt][0] = (f32x4){0.f, 0.f, 0.f, 0.f}; st[mt][1] = (f32x4){0.f, 0.f, 0.f, 0.f}; }
        {
            bf16x8 Kc[4], Kn[4];
#pragma unroll
            for (int mt = 0; mt < 4; ++mt) Kc[mt] = *(const bf16x8*)(Ks + (mt * 16 + fr) * AT_KSTR + (fq * 8) * 2);
#pragma unroll
            for (int ks = 0; ks < 4; ++ks) {
                if (ks < 3) {
#pragma unroll
                    for (int mt = 0; mt < 4; ++mt) Kn[mt] = *(const bf16x8*)(Ks + (mt * 16 + fr) * AT_KSTR + ((ks + 1) * 32 + fq * 8) * 2);
                }
                __builtin_amdgcn_sched_barrier(0);
#pragma unroll
                for (int mt = 0; mt < 4; ++mt) {
                    st[mt][0] = MFMA16(Kc[mt], Qf[0][ks], st[mt][0]);
                    st[mt][1] = MFMA16(Kc[mt], Qf[1][ks], st[mt][1]);
                }
                __builtin_amdgcn_sched_barrier(0);
#pragma unroll
                for (int mt = 0; mt < 4; ++mt) Kc[mt] = Kn[mt];
            }
        }
        const int mtype = (cur == 0) ? 1 : ((cur == 4) ? 2 : 0);
        if (mtype != 0) {
#pragma unroll
            for (int mt = 0; mt < 4; ++mt)
#pragma unroll
                for (int nq = 0; nq < 2; ++nq)
#pragma unroll
                    for (int j = 0; j < 4; ++j) {
                        const int c = mt * 16 + fq * 4 + j, aq = qh * 32 + nq * 16 + fr;
                        const bool keep = (mtype == 1) ? (c >= aq) : (c <= aq);
                        if (!keep) st[mt][nq][j] = -1e30f;
                    }
        }
        bf16x8 Pf[2][2];
#pragma unroll
        for (int nq = 0; nq < 2; ++nq) {
            float mx = st[0][nq][0];
#pragma unroll
            for (int mt = 0; mt < 4; ++mt)
#pragma unroll
                for (int j = 0; j < 4; ++j) mx = fmaxf(mx, st[mt][nq][j]);
            mx = fmaxf(mx, shx(mx, 16, lane)); mx = fmaxf(mx, shx(mx, 32, lane));
            const bool upd = mx > mrun[nq] + 8.f;
            if (__builtin_amdgcn_ballot_w64(upd) != 0ull) {
                const float mn2 = upd ? mx : mrun[nq];
                const float al = __builtin_amdgcn_exp2f(mrun[nq] - mn2);
                mrun[nq] = mn2;
                lrun[nq] *= al;
#pragma unroll
                for (int i = 0; i < 8; ++i) ot[i][nq] *= al;
            }
            const float mn = mrun[nq];
            float ps = 0.f;
#pragma unroll
            for (int mt = 0; mt < 4; ++mt)
#pragma unroll
                for (int j = 0; j < 4; ++j) { const float pv = __builtin_amdgcn_exp2f(st[mt][nq][j] - mn); st[mt][nq][j] = pv; ps += pv; }
            lrun[nq] += ps;
#pragma unroll
            for (int k2 = 0; k2 < 2; ++k2)
                Pf[nq][k2] = mk8(pk2(st[2 * k2][nq][0], st[2 * k2][nq][1]), pk2(st[2 * k2][nq][2], st[2 * k2][nq][3]),
                                 pk2(st[2 * k2 + 1][nq][0], st[2 * k2 + 1][nq][1]), pk2(st[2 * k2 + 1][nq][2], st[2 * k2 + 1][nq][3]));
        }
        {
            uint2 va[4][2], vb[4][2];
#pragma unroll
            for (int i = 0; i < 4; ++i) { const unsigned char* vp = Vs + (i * 16 + fr) * AT_VSTR + (fq * 4) * 2; va[i][0] = *(const uint2*)vp; va[i][1] = *(const uint2*)(vp + 32); }
#pragma unroll
            for (int g = 0; g < 4; ++g) {
                if (g < 3) {
                    const int k2n = (g + 1) >> 1, mdn = ((g + 1) & 1) * 4;
#pragma unroll
                    for (int i = 0; i < 4; ++i) { const unsigned char* vp = Vs + ((mdn + i) * 16 + fr) * AT_VSTR + (k2n * 32 + fq * 4) * 2; vb[i][0] = *(const uint2*)vp; vb[i][1] = *(const uint2*)(vp + 32); }
                }
                __builtin_amdgcn_sched_barrier(0);
                const int k2 = g >> 1, md0 = (g & 1) * 4;
#pragma unroll
                for (int i = 0; i < 4; ++i) {
                    const bf16x8 Vf = mk8(va[i][0].x, va[i][0].y, va[i][1].x, va[i][1].y);
                    ot[md0 + i][0] = MFMA16(Vf, Pf[0][k2], ot[md0 + i][0]);
                    ot[md0 + i][1] = MFMA16(Vf, Pf[1][k2], ot[md0 + i][1]);
                }
                __builtin_amdgcn_sched_barrier(0);
#pragma unroll
                for (int i = 0; i < 4; ++i) { va[i][0] = vb[i][0]; va[i][1] = vb[i][1]; }
            }
        }
        if (nxt > 8) break;
        ti = nxt;
    }
#undef AT_LOAD
    const float sk = p.in[9][L * 8 + head] * 1.4426950408889634f;
#pragma unroll
    for (int nq = 0; nq < 2; ++nq) {
        float l = lrun[nq];
        l += shx(l, 16, lane); l += shx(l, 32, lane);
        const float mf = fmaxf(mrun[nq], sk);
        const float al = __builtin_amdgcn_exp2f(mrun[nq] - mf);
        const float lt = l * al + __builtin_amdgcn_exp2f(sk - mf);
        const float sc = al * rcpf_(lt);
        const int row = row0 + qh * 32 + nq * 16 + fr;
#pragma unroll
        for (int md = 0; md < 8; ++md) {
            const f32x4 o = ot[md][nq] * sc;
            uint2 pk; pk.x = pk2(o[0], o[1]); pk.y = pk2(o[2], o[3]);
            *(uint2*)(MIX + (size_t)row * D + head * 128 + md * 16 + fq * 4) = pk;
        }
    }
}

DEVI void gla_chunk_rows(int b, int ci, int& rowbase, int& tpos0) {
    if (ci < 4) { rowbase = NL + b * 256 + ci * 64; tpos0 = 4096 + ci * 64; } else { rowbase = b * 4096 + (ci - 4) * 64; tpos0 = (ci - 4) * 64; }
}
DEVI float logsig_fast(float z) { return fminf(z, 0.f) - __logf(1.f + __expf(-fabsf(z))); }
DEVI int scan_ci(int dir, int s) { return dir == 0 ? s : (s < 4 ? 3 - s : 71 - s); }

constexpr int GP_GZS = 0, GP_CUM = 8192, GP_TOT = 41472, GP_KT = 41984, GP_VT = 60416, GP_KSM = 78848, MX_TAB = 91648;
DEVI void gla_tables(const int tid_, const Params& p, int L, unsigned char* lds) {
    float* tab = (float*)(lds + MX_TAB);
    __syncthreads();
    for (int i = tid_; i < 8192; i += 512) tab[i] = p.in[10][(size_t)L * 8192 + i];
    tab[8192 + tid_] = p.in[11][L * 512 + tid_];
    __syncthreads();
}

DEVI void gla_p1_phase(const int tid_, const Params& p, int L, unsigned char* lds) {
    const bf16_t* Z = (const bf16_t*)(p.ws + WS_Z);
    const bf16_t* GVT = (const bf16_t*)(p.ws + WS_GVT);
    const float* GZ = (const float*)(p.ws + WS_GZ);
    float* gzs = (float*)(lds + GP_GZS); float* cum = (float*)(lds + GP_CUM); float* tot = (float*)(lds + GP_TOT);
    bf16_t* kT = (bf16_t*)(lds + GP_KT); unsigned char* vts = lds + GP_VT; bf16_t* ksm = (bf16_t*)(lds + GP_KSM);
    const float* tab = (const float*)(lds + MX_TAB);
    const int tid = tid_, w = tid >> 6, lane = tid & 63, fr = lane & 15, fq = lane >> 4;
    const int t = tid >> 3, d0 = (tid & 7) * 8;
    gla_tables(tid_, p, L, lds);
    const int nun = NB * 4 * NCH;
    uint4 pgz, pk, pv0, pv1;
#define G1_PREF(uu) do { const int ci_ = (uu) % NCH, bh_ = (uu) / NCH; int rb_, tp_; gla_chunk_rows(bh_ >> 2, ci_, rb_, tp_); \
    pgz = *(const uint4*)(GZ + (size_t)(rb_ + t) * 32 + (tid & 7) * 4); \
    pk = *(const uint4*)(Z + (size_t)(rb_ + t) * ZLD + ZGK + (bh_ & 3) * 64 + d0); \
    pv0 = *(const uint4*)(GVT + ((size_t)(bh_ * 128 + (tid >> 3))) * TT + tp_ + (tid & 7) * 8); \
    pv1 = *(const uint4*)(GVT + ((size_t)(bh_ * 128 + 64 + (tid >> 3))) * TT + tp_ + (tid & 7) * 8); } while (0)
    int u = blockIdx.x;
    if (u < nun) G1_PREF(u);
    for (; u < nun; u += gridDim.x) {
        const int ci = u % NCH, bh = u / NCH, h = bh & 3;
        lds_sync();
        {
            const int r0 = (tid & 7) * 4;
            gzs[(r0 + 0) * 64 + t] = __uint_as_float(pgz.x); gzs[(r0 + 1) * 64 + t] = __uint_as_float(pgz.y);
            gzs[(r0 + 2) * 64 + t] = __uint_as_float(pgz.z); gzs[(r0 + 3) * 64 + t] = __uint_as_float(pgz.w);
        }
        *(uint4*)(vts + (tid >> 3) * 144 + (tid & 7) * 16) = pv0;
        *(uint4*)(vts + (64 + (tid >> 3)) * 144 + (tid & 7) * 16) = pv1;
        *(uint4*)((unsigned char*)ksm + t * 144 + d0 * 2) = pk;
        lds_sync();
        if (u + (int)gridDim.x < nun) G1_PREF(u + (int)gridDim.x);
#pragma unroll
        for (int dir = 0; dir < 2; ++dir) {
            float z[8];
#pragma unroll
            for (int i = 0; i < 8; ++i) z[i] = tab[8192 + dir * 256 + h * 64 + d0 + i];
#pragma unroll
            for (int r = 0; r < 16; ++r) {
                const float g = gzs[(dir * 16 + r) * 64 + t];
                const float4 w0 = *(const float4*)(tab + (dir * 16 + r) * 256 + h * 64 + d0), w1 = *(const float4*)(tab + (dir * 16 + r) * 256 + h * 64 + d0 + 4);
                z[0] += g * w0.x; z[1] += g * w0.y; z[2] += g * w0.z; z[3] += g * w0.w; z[4] += g * w1.x; z[5] += g * w1.y; z[6] += g * w1.z; z[7] += g * w1.w;
            }
#pragma unroll
            for (int i = 0; i < 8; ++i) cum[(dir * 64 + t) * 65 + d0 + i] = logsig_fast(z[i]) * (1.f / 16.f);
        }
        lds_sync();
        if (tid < 128) {
            const int dir = tid >> 6, d = tid & 63;
            float vv[64];
#pragma unroll
            for (int s2 = 0; s2 < 64; ++s2) vv[s2] = cum[(dir * 64 + (dir ? 63 - s2 : s2)) * 65 + d];
            float a = 0.f;
#pragma unroll
            for (int s2 = 0; s2 < 64; ++s2) { a += vv[s2]; vv[s2] = a; }
#pragma unroll
            for (int s2 = 0; s2 < 64; ++s2) cum[(dir * 64 + (dir ? 63 - s2 : s2)) * 65 + d] = vv[s2];
            tot[tid] = a;
        }
        lds_sync();
        {
            float* CG = (float*)(p.ws + WS_CUMG) + ((size_t)u * 2) * 4096;
#pragma unroll
            for (int dir = 0; dir < 2; ++dir) {
                const float tt = tot[dir * 64 + lane];
                float kd[8];
#pragma unroll
                for (int i = 0; i < 8; ++i) {
                    const int ti = w * 8 + i;
                    const float cv = cum[(dir * 64 + ti) * 65 + lane];
                    kd[i] = bf2f(ksm[ti * 72 + lane]) * __expf(tt - cv);
                    CG[(size_t)dir * 4096 + ti * 64 + lane] = cv;
                }
                uint4 o; o.x = pk2(kd[0], kd[1]); o.y = pk2(kd[2], kd[3]); o.z = pk2(kd[4], kd[5]); o.w = pk2(kd[6], kd[7]);
                *(uint4*)((unsigned char*)kT + ((dir * 64 + lane) * 72 + w * 8) * 2) = o;
            }
        }
        lds_sync();
        {
            const bf16x8 Af0 = *(const bf16x8*)(vts + (w * 16 + fr) * 144 + (fq * 8) * 2);
            const bf16x8 Af1 = *(const bf16x8*)(vts + (w * 16 + fr) * 144 + (32 + fq * 8) * 2);
#pragma unroll
            for (int dir = 0; dir < 2; ++dir) {
                f32x4 acc[4];
#pragma unroll
                for (int n = 0; n < 4; ++n) {
                    acc[n] = (f32x4){0.f, 0.f, 0.f, 0.f};
                    const bf16x8 Bf0 = *(const bf16x8*)((const unsigned char*)kT + ((dir * 64 + n * 16 + fr) * 72 + fq * 8) * 2);
                    const bf16x8 Bf1 = *(const bf16x8*)((const unsigned char*)kT + ((dir * 64 + n * 16 + fr) * 72 + 32 + fq * 8) * 2);
                    acc[n] = MFMA16(Af0, Bf0, acc[n]);
                    acc[n] = MFMA16(Af1, Bf1, acc[n]);
                }
                const int sq = bh * 2 + dir;
                float* CT = (float*)(p.ws + WS_CONTRIB) + ((size_t)(sq * NCH + ci)) * 8192;
#pragma unroll
                for (int n = 0; n < 4; ++n)
#pragma unroll
                    for (int j = 0; j < 4; ++j) CT[(w * 16 + fq * 4 + j) * 64 + n * 16 + fr] = acc[n][j];
            }
            if (tid < 128) { const int dir = tid >> 6, d = tid & 63; ((float*)(p.ws + WS_ATOT))[((size_t)((bh * 2 + dir) * NCH + ci)) * 64 + d] = __expf(tot[tid]); }
        }
    }
#undef G1_PREF
}

DEVI void gla_scan(const int tid_, const Params& p) {
    const float* __restrict__ CT = (const float*)(p.ws + WS_CONTRIB);
    const float* __restrict__ AT = (const float*)(p.ws + WS_ATOT);
    unsigned* __restrict__ SB = (unsigned*)(p.ws + WS_SBEF);
    for (int idx = blockIdx.x * 512 + tid_; idx < 32 * 128 * 32; idx += gridDim.x * 512) {
        const int dp = idx & 31, dv = (idx >> 5) & 127, sq = idx >> 12, dir = sq & 1;
        const float* ctp = CT + (size_t)sq * NCH * 8192 + dv * 64 + dp * 2;
        const float* atp = AT + (size_t)sq * NCH * 64 + dp * 2;
        unsigned* sbp = SB + (size_t)sq * NCH * 4096 + dv * 32 + dp;
        float s0 = 0.f, s1 = 0.f;
        float2 c[4], a[4], cn[4], an[4];
#pragma unroll
        for (int q = 0; q < 4; ++q) { const int ci = scan_ci(dir, q); c[q] = *(const float2*)(ctp + (size_t)ci * 8192); a[q] = *(const float2*)(atp + (size_t)ci * 64); }
#pragma unroll 1
        for (int s = 0; s < NCH; s += 4) {
            if (s + 4 < NCH) {
#pragma unroll
                for (int q = 0; q < 4; ++q) { const int ci = scan_ci(dir, s + 4 + q); cn[q] = *(const float2*)(ctp + (size_t)ci * 8192); an[q] = *(const float2*)(atp + (size_t)ci * 64); }
            }
#pragma unroll
            for (int q = 0; q < 4; ++q) {
                const int ci = scan_ci(dir, s + q);
                sbp[(size_t)ci * 4096] = pk2(s0, s1);
                s0 = a[q].x * s0 + c[q].x; s1 = a[q].y * s1 + c[q].y;
            }
#pragma unroll
            for (int q = 0; q < 4; ++q) { c[q] = cn[q]; a[q] = an[q]; }
        }
    }
}

constexpr int G3_QS = 0, G3_KS = 18432, G3_SS = 36864, G3_VT = 73728, G3_PART = 92160, G3_OB = 92672;
DEVI void gla_p3_phase(const int tid_, const Params& p, int L, unsigned char* lds) {
    const bf16_t* Z = (const bf16_t*)(p.ws + WS_Z);
    const bf16_t* GVT = (const bf16_t*)(p.ws + WS_GVT);
    const float* CUMG = (const float*)(p.ws + WS_CUMG);
    const bf16_t* SBEF = (const bf16_t*)(p.ws + WS_SBEF);
    bf16_t* MIX = (bf16_t*)(p.ws + WS_MIX);
    unsigned char* qs = lds + G3_QS; unsigned char* ks = lds + G3_KS; unsigned char* ss = lds + G3_SS; unsigned char* vts = lds + G3_VT;
    float* part = (float*)(lds + G3_PART); float* ob = (float*)(lds + G3_OB);
    const int tid = tid_, w = tid >> 6, lane = tid & 63, fr = lane & 15, fq = lane >> 4;
    const int ntl = w & 3, dvh = w >> 2;
    const int t = tid >> 3, d0 = (tid & 7) * 8, dv0 = (tid & 7) * 16;
    const int cfirst = (L == 0) ? 0 : 4, ncl = NCH - cfirst, nun = NB * 4 * ncl;
    uint4 pq, pk, psf0, psf1, psb0, psb1, pv0, pv1, pg0, pg1;
    float4 pcf0, pcf1, pcb0, pcb1;
#define G3_PREF(uu) do { const int ci_ = cfirst + (uu) % ncl, bh_ = (uu) / ncl; int rb_, tp_; gla_chunk_rows(bh_ >> 2, ci_, rb_, tp_); \
    const size_t u1_ = (size_t)bh_ * NCH + ci_; \
    pq = *(const uint4*)(Z + (size_t)(rb_ + t) * ZLD + ZGQ + (bh_ & 3) * 64 + d0); \
    pk = *(const uint4*)(Z + (size_t)(rb_ + t) * ZLD + ZGK + (bh_ & 3) * 64 + d0); \
    pcf0 = *(const float4*)(CUMG + (u1_ * 2) * 4096 + t * 64 + d0); pcf1 = *(const float4*)(CUMG + (u1_ * 2) * 4096 + t * 64 + d0 + 4); \
    pcb0 = *(const float4*)(CUMG + (u1_ * 2 + 1) * 4096 + t * 64 + d0); pcb1 = *(const float4*)(CUMG + (u1_ * 2 + 1) * 4096 + t * 64 + d0 + 4); \
    { const bf16_t* sf_ = SBEF + ((size_t)((bh_ * 2) * NCH + ci_)) * 8192; const bf16_t* sb_ = SBEF + ((size_t)((bh_ * 2 + 1) * NCH + ci_)) * 8192; \
      psf0 = *(const uint4*)(sf_ + tid * 8); psf1 = *(const uint4*)(sf_ + 4096 + tid * 8); psb0 = *(const uint4*)(sb_ + tid * 8); psb1 = *(const uint4*)(sb_ + 4096 + tid * 8); } \
    pv0 = *(const uint4*)(GVT + ((size_t)(bh_ * 128 + (tid >> 3))) * TT + tp_ + (tid & 7) * 8); \
    pv1 = *(const uint4*)(GVT + ((size_t)(bh_ * 128 + 64 + (tid >> 3))) * TT + tp_ + (tid & 7) * 8); \
    pg0 = *(const uint4*)(Z + (size_t)(rb_ + t) * ZLD + ZGR + (bh_ & 3) * 128 + dv0); \
    pg1 = *(const uint4*)(Z + (size_t)(rb_ + t) * ZLD + ZGR + (bh_ & 3) * 128 + dv0 + 8); } while (0)
    int u = blockIdx.x;
    if (u < nun) G3_PREF(u);
    for (; u < nun; u += gridDim.x) {
        const int ci = cfirst + u % ncl, bh = u / ncl, h = bh & 3;
        int rowbase, tpos0; gla_chunk_rows(bh >> 2, ci, rowbase, tpos0);
        lds_sync();
        {
            const unsigned qw[4] = {pq.x, pq.y, pq.z, pq.w}, kw[4] = {pk.x, pk.y, pk.z, pk.w};
            const float cf[8] = {pcf0.x, pcf0.y, pcf0.z, pcf0.w, pcf1.x, pcf1.y, pcf1.z, pcf1.w};
            const float cb[8] = {pcb0.x, pcb0.y, pcb0.z, pcb0.w, pcb1.x, pcb1.y, pcb1.z, pcb1.w};
#pragma unroll
            for (int dir = 0; dir < 2; ++dir) {
                unsigned qo[4], ko[4];
#pragma unroll
                for (int i = 0; i < 4; ++i) {
                    const float c0 = dir ? cb[2 * i] : cf[2 * i], c1 = dir ? cb[2 * i + 1] : cf[2 * i + 1];
                    qo[i] = pk2(bflo(qw[i]) * 0.125f * __expf(c0), bfhi(qw[i]) * 0.125f * __expf(c1));
                    ko[i] = pk2(bflo(kw[i]) * __expf(fminf(-c0, 80.f)), bfhi(kw[i]) * __expf(fminf(-c1, 80.f)));
                }
                uint4 t4; t4.x = qo[0]; t4.y = qo[1]; t4.z = qo[2]; t4.w = qo[3];
                *(uint4*)(qs + (dir * 64 + t) * 144 + d0 * 2) = t4;
                t4.x = ko[0]; t4.y = ko[1]; t4.z = ko[2]; t4.w = ko[3];
                *(uint4*)(ks + (dir * 64 + t) * 144 + d0 * 2) = t4;
            }
            *(uint4*)(ss + (tid >> 3) * 144 + (tid & 7) * 16) = psf0;
            *(uint4*)(ss + (64 + (tid >> 3)) * 144 + (tid & 7) * 16) = psf1;
            *(uint4*)(ss + (128 + (tid >> 3)) * 144 + (tid & 7) * 16) = psb0;
            *(uint4*)(ss + (192 + (tid >> 3)) * 144 + (tid & 7) * 16) = psb1;
            *(uint4*)(vts + (tid >> 3) * 144 + (tid & 7) * 16) = pv0;
            *(uint4*)(vts + (64 + (tid >> 3)) * 144 + (tid & 7) * 16) = pv1;
        }
        const uint4 gr0 = pg0, gr1 = pg1;
        lds_sync();
        if (u + (int)gridDim.x < nun) G3_PREF(u + (int)gridDim.x);
        f32x4 oacc[4];
#pragma unroll
        for (int i = 0; i < 4; ++i) oacc[i] = (f32x4){0.f, 0.f, 0.f, 0.f};
#pragma unroll
        for (int dir = 0; dir < 2; ++dir) {
            bf16x8 Bq[2];
            f32x4 at[4];
#pragma unroll
            for (int m = 0; m < 4; ++m) at[m] = (f32x4){0.f, 0.f, 0.f, 0.f};
#pragma unroll
            for (int k_ = 0; k_ < 2; ++k_) {
                Bq[k_] = *(const bf16x8*)(qs + (dir * 64 + ntl * 16 + fr) * 144 + (k_ * 32 + fq * 8) * 2);
#pragma unroll
                for (int m = 0; m < 4; ++m) {
                    const bf16x8 Ak = *(const bf16x8*)(ks + (dir * 64 + m * 16 + fr) * 144 + (k_ * 32 + fq * 8) * 2);
                    at[m] = MFMA16(Ak, Bq[k_], at[m]);
                }
            }
            {
                const int tq = ntl * 16 + fr;
#pragma unroll
                for (int m = 0; m < 4; ++m)
#pragma unroll
                    for (int j = 0; j < 4; ++j) {
                        const int s = m * 16 + fq * 4 + j;
                        const bool keep = dir == 0 ? (s <= tq) : (s >= tq);
                        if (!keep) at[m][j] = 0.f;
                    }
            }
#pragma unroll
            for (int k2 = 0; k2 < 2; ++k2) {
                const bf16x8 Pf = mk8(pk2(at[2 * k2][0], at[2 * k2][1]), pk2(at[2 * k2][2], at[2 * k2][3]),
                                      pk2(at[2 * k2 + 1][0], at[2 * k2 + 1][1]), pk2(at[2 * k2 + 1][2], at[2 * k2 + 1][3]));
#pragma unroll
                for (int md = 0; md < 4; ++md) {
                    const unsigned char* vp = vts + (dvh * 64 + md * 16 + fr) * 144 + (k2 * 32 + fq * 4) * 2;
                    const uint2 v0 = *(const uint2*)vp, v1 = *(const uint2*)(vp + 32);
                    oacc[md] = MFMA16(mk8(v0.x, v0.y, v1.x, v1.y), Pf, oacc[md]);
                }
            }
#pragma unroll
            for (int k_ = 0; k_ < 2; ++k_)
#pragma unroll
                for (int md = 0; md < 4; ++md) {
                    const bf16x8 As = *(const bf16x8*)(ss + (dir * 128 + dvh * 64 + md * 16 + fr) * 144 + (k_ * 32 + fq * 8) * 2);
                    oacc[md] = MFMA16(As, Bq[k_], oacc[md]);
                }
        }
        float sq = 0.f;
#pragma unroll
        for (int md = 0; md < 4; ++md)
#pragma unroll
            for (int j = 0; j < 4; ++j) sq += oacc[md][j] * oacc[md][j];
        sq += shx(sq, 16, lane); sq += shx(sq, 32, lane);
        if (fq == 0) part[w * 16 + fr] = sq;
        lds_sync();
        {
            const float tot2 = part[ntl * 16 + fr] + part[(ntl + 4) * 16 + fr];
            const float rstd = rsqrtf(tot2 * (1.f / 128.f) + 1e-6f);
#pragma unroll
            for (int md = 0; md < 4; ++md)
#pragma unroll
                for (int j = 0; j < 4; ++j) ob[(ntl * 16 + fr) * 132 + dvh * 64 + md * 16 + fq * 4 + j] = oacc[md][j] * rstd;
        }
        lds_sync();
        {
            const float* gn = p.in[12] + L * 128;
            const unsigned rw[8] = {gr0.x, gr0.y, gr0.z, gr0.w, gr1.x, gr1.y, gr1.z, gr1.w};
            unsigned o[8];
#pragma unroll
            for (int i4 = 0; i4 < 4; ++i4) {
                const float4 ov = *(const float4*)(ob + t * 132 + dv0 + 4 * i4), gv = *(const float4*)(gn + dv0 + 4 * i4);
                o[2 * i4] = pk2(ov.x * gv.x * siluf_(bflo(rw[2 * i4])), ov.y * gv.y * siluf_(bfhi(rw[2 * i4])));
                o[2 * i4 + 1] = pk2(ov.z * gv.z * siluf_(bflo(rw[2 * i4 + 1])), ov.w * gv.w * siluf_(bfhi(rw[2 * i4 + 1])));
            }
            uint4 a4; a4.x = o[0]; a4.y = o[1]; a4.z = o[2]; a4.w = o[3];
            uint4 b4; b4.x = o[4]; b4.y = o[5]; b4.z = o[6]; b4.w = o[7];
            bf16_t* dst = MIX + (size_t)(rowbase + t) * D + 1024 + h * 128 + dv0;
            *(uint4*)dst = a4; *(uint4*)(dst + 8) = b4;
        }
    }
#undef G3_PREF
}

constexpr int LR_XCF = 17152, LR_XCB = 34560, LR_OUTB = 43776;
template <int CTRL> DEVI float dppf(float oldv, float v) { return __int_as_float(__builtin_amdgcn_update_dpp(__float_as_int(oldv), __float_as_int(v), CTRL, 0xf, 0xf, false)); }
template <int DIR> DEVI void lru_tile_scan(float& A, float& B) {
    constexpr int base = DIR ? 0x100 : 0x110;
    { const float A2 = dppf<base | 1>(1.f, A), B2 = dppf<base | 1>(0.f, B); B = A * B2 + B; A = A * A2; }
    { const float A2 = dppf<base | 2>(1.f, A), B2 = dppf<base | 2>(0.f, B); B = A * B2 + B; A = A * A2; }
    { const float A2 = dppf<base | 4>(1.f, A), B2 = dppf<base | 4>(0.f, B); B = A * B2 + B; A = A * A2; }
    { const float A2 = dppf<base | 8>(1.f, A), B2 = dppf<base | 8>(0.f, B); B = A * B2 + B; A = A * A2; }
}
template <int PASS, int DIR>
DEVI void lru_wave_scan(const float (&av)[4][4], const float (&uv)[4][4], const float (&carry)[4], int lane, int fr, int cb, int fq,
                        float* outb, float* la_out, float* lb_out) {
    float hin[4], pin[4];
#pragma unroll
    for (int r = 0; r < 4; ++r) { hin[r] = (PASS == 3) ? carry[r] : 0.f; pin[r] = 1.f; }
    const int endl = DIR ? (lane & 48) : (lane | 15);
#pragma unroll
    for (int mi = 0; mi < 4; ++mi) {
        const int m = DIR ? 3 - mi : mi;
#pragma unroll
        for (int r = 0; r < 4; ++r) {
            float A = av[m][r], B = uv[m][r];
            lru_tile_scan<DIR>(A, B);
            const float hf = B + A * hin[r];
            if (PASS == 3) outb[(DIR * 64 + m * 16 + fr) * 65 + cb * 16 + fq * 4 + r] = hf;
            hin[r] = shidx(hf, endl);
            if (PASS == 1) pin[r] = shidx(A * pin[r], endl);
        }
    }
    if (PASS == 1 && fr == (DIR ? 0 : 15)) {
#pragma unroll
        for (int r = 0; r < 4; ++r) { la_out[fq * 4 + r] = pin[r]; lb_out[fq * 4 + r] = hin[r]; }
    }
}

template <int PASS>
DEVI void lru_phase(const int tid_, const Params& p, int L, unsigned char* lds) {
    const bf16_t* Z = (const bf16_t*)(p.ws + WS_Z);
    float* xs = (float*)lds; float* xcf = (float*)(lds + LR_XCF); unsigned char* xcb = lds + LR_XCB; float* outb = (float*)(lds + LR_OUTB);
    float* tab = (float*)(lds + MX_TAB);
    const int tid = tid_, w = tid >> 6, lane = tid & 63, fr = lane & 15, fq = lane >> 4;
    const int dir = w >> 2, cb = w & 3;
    const int t = tid >> 3, c0 = (tid & 7) * 8;
    const int cfirst = (PASS == 3 && L == 1) ? 4 : 0, ncl = NCH - cfirst, nun = NB * ncl * 8;
    __syncthreads();
    for (int i = tid; i < 2048; i += 512) tab[i] = p.in[13][(size_t)L * 2048 + i];
    tab[2048 + tid] = p.in[14][L * 512 + tid];
    for (int i = tid; i < 1024; i += 512) {
        tab[2560 + i] = p.in[16][L * 1024 + i]; tab[3584 + i] = p.in[18][L * 1024 + i];
        tab[4608 + i] = -8.f * log1pf(expf(-p.in[19][L * 1024 + i]));
    }
    __syncthreads();
    uint4 px0, px1, plg;
    float4 pcar = make_float4(0.f, 0.f, 0.f, 0.f);
#define LR_DEC(uu, blk_, ci_, b_) const int blk_ = (uu) & 7, ci_ = cfirst + ((uu) >> 3) % ncl, b_ = ((uu) >> 3) / ncl
#define LR_PREF(uu) do { LR_DEC(uu, blk_, ci_, b_); int sr_, sl_, t0_; \
    if (ci_ < 4) { sr_ = NL + b_ * 256; sl_ = 256; t0_ = ci_ * 64; } else { sr_ = b_ * 4096; sl_ = 4096; t0_ = (ci_ - 4) * 64; } \
    { const int tm_ = t0_ - 2 + (tid >> 3); px0 = (tm_ >= 0 && tm_ < sl_) ? *(const uint4*)(Z + (size_t)(sr_ + tm_) * ZLD + ZLX + blk_ * 64 + (tid & 7) * 8) : make_uint4(0u, 0u, 0u, 0u); } \
    { const int tm_ = t0_ - 2 + 64 + (tid >> 3); px1 = (tid < 24 && tm_ < sl_) ? *(const uint4*)(Z + (size_t)(sr_ + tm_) * ZLD + ZLX + blk_ * 64 + (tid & 7) * 8) : make_uint4(0u, 0u, 0u, 0u); } \
    if (PASS == 3) { plg = *(const uint4*)(Z + (size_t)(sr_ + t0_ + t) * ZLD + ZLG + blk_ * 64 + c0); \
        pcar = *(const float4*)((const float*)(p.ws + WS_LRUC) + ((size_t)((b_ * NCH + ci_) * 2 + dir)) * 512 + blk_ * 64 + cb * 16 + fq * 4); } } while (0)
    int u = blockIdx.x;
    if (u < nun) LR_PREF(u);
    for (; u < nun; u += gridDim.x) {
        LR_DEC(u, blk, ci, b);
        const int rowbase = (ci < 4) ? NL + b * 256 + ci * 64 : b * 4096 + (ci - 4) * 64;
        lds_sync();
        {
            float4 f0, f1;
            f0.x = bflo(px0.x); f0.y = bfhi(px0.x); f0.z = bflo(px0.y); f0.w = bfhi(px0.y); f1.x = bflo(px0.z); f1.y = bfhi(px0.z); f1.z = bflo(px0.w); f1.w = bfhi(px0.w);
            *(float4*)(xs + (tid >> 3) * 64 + (tid & 7) * 8) = f0; *(float4*)(xs + (tid >> 3) * 64 + (tid & 7) * 8 + 4) = f1;
            if (tid < 24) {
                f0.x = bflo(px1.x); f0.y = bfhi(px1.x); f0.z = bflo(px1.y); f0.w = bfhi(px1.y); f1.x = bflo(px1.z); f1.y = bfhi(px1.z); f1.z = bflo(px1.w); f1.w = bfhi(px1.w);
                *(float4*)(xs + (64 + (tid >> 3)) * 64 + (tid & 7) * 8) = f0; *(float4*)(xs + (64 + (tid >> 3)) * 64 + (tid & 7) * 8 + 4) = f1;
            }
        }
        const uint4 lgc = plg;
        const float carry[4] = {pcar.x, pcar.y, pcar.z, pcar.w};
        const bf16_t* WT = (const bf16_t*)(p.ws + WS_LRUWT) + (size_t)(L * 8 + blk) * 256 * 64;
        bf16x8 Bw[2][2];
#pragma unroll
        for (int g = 0; g < 2; ++g)
#pragma unroll
            for (int ks = 0; ks < 2; ++ks)
                Bw[g][ks] = *(const bf16x8*)(WT + (size_t)(((dir * 2 + g) * 4 + cb) * 16 + fr) * 64 + ks * 32 + fq * 8);
        lds_sync();
        if (u + (int)gridDim.x < nun) LR_PREF(u + (int)gridDim.x);
        {
            const int ch = blk * 64 + lane;
            float xr[11];
#pragma unroll
            for (int k = 0; k < 11; ++k) xr[k] = xs[(w * 8 + k) * 64 + lane];
            const float cw0 = tab[ch], cw1 = tab[512 + ch], cw2 = tab[1024 + ch], cw3 = tab[1536 + ch], cbv = tab[2048 + ch];
#pragma unroll
            for (int i = 0; i < 8; ++i) {
                const float y = cbv + xr[i] * cw0 + xr[i + 1] * cw1 + xr[i + 2] * cw2 + xr[i + 3] * cw3;
                xcf[(w * 8 + i) * 68 + lane] = y;
                ((bf16_t*)xcb)[(w * 8 + i) * 72 + lane] = f2bf(y);
            }
        }
        lds_sync();
        float av[4][4], uv[4][4];
        {
            f32x4 ga[4], gx[4];
#pragma unroll
            for (int m = 0; m < 4; ++m) { ga[m] = (f32x4){0.f, 0.f, 0.f, 0.f}; gx[m] = (f32x4){0.f, 0.f, 0.f, 0.f}; }
#pragma unroll
            for (int ks = 0; ks < 2; ++ks)
#pragma unroll
                for (int m = 0; m < 4; ++m) {
                    const bf16x8 Af = *(const bf16x8*)(xcb + (m * 16 + fr) * 144 + (ks * 32 + fq * 8) * 2);
                    ga[m] = MFMA16(Bw[0][ks], Af, ga[m]);
                    gx[m] = MFMA16(Bw[1][ks], Af, gx[m]);
                }
            const int chb = blk * 64 + cb * 16 + fq * 4;
            const float4 bav = *(const float4*)(tab + 2560 + dir * 512 + chb), bxv = *(const float4*)(tab + 3584 + dir * 512 + chb), cfv = *(const float4*)(tab + 4608 + dir * 512 + chb);
            const float bal[4] = {bav.x, bav.y, bav.z, bav.w}, bxl[4] = {bxv.x, bxv.y, bxv.z, bxv.w}, cfl[4] = {cfv.x, cfv.y, cfv.z, cfv.w};
#pragma unroll
            for (int m = 0; m < 4; ++m) {
                const float4 xv = *(const float4*)(xcf + (m * 16 + fr) * 68 + cb * 16 + fq * 4);
                const float xl[4] = {xv.x, xv.y, xv.z, xv.w};
#pragma unroll
                for (int r = 0; r < 4; ++r) {
                    const float la = cfl[r] * sigmoidf_(ga[m][r] + bal[r]);
                    const float a = __expf(la);
                    const float om = __builtin_fmaf(-a, a, 1.f);
                    av[m][r] = a;
                    uv[m][r] = __builtin_amdgcn_sqrtf(om) * sigmoidf_(gx[m][r] + bxl[r]) * xl[r];
                }
            }
        }
        {
            const size_t sbase = ((size_t)((b * NCH + ci) * 2 + dir)) * 512 + blk * 64 + cb * 16;
            float* la_out = (float*)(p.ws + WS_LRUA) + sbase; float* lb_out = (float*)(p.ws + WS_LRUB) + sbase;
            if (dir == 0) lru_wave_scan<PASS, 0>(av, uv, carry, lane, fr, cb, fq, outb, la_out, lb_out);
            else lru_wave_scan<PASS, 1>(av, uv, carry, lane, fr, cb, fq, outb, la_out, lb_out);
        }
        if (PASS == 3) {
            lds_sync();
            const unsigned lw[4] = {lgc.x, lgc.y, lgc.z, lgc.w};
            unsigned o[4];
#pragma unroll
            for (int i = 0; i < 4; ++i) {
                const float h0 = outb[t * 65 + c0 + 2 * i] + outb[(64 + t) * 65 + c0 + 2 * i];
                const float h1 = outb[t * 65 + c0 + 2 * i + 1] + outb[(64 + t) * 65 + c0 + 2 * i + 1];
                o[i] = pk2(h0 * gelu_tanh(bflo(lw[i])), h1 * gelu_tanh(bfhi(lw[i])));
            }
            uint4 o4; o4.x = o[0]; o4.y = o[1]; o4.z = o[2]; o4.w = o[3];
            *(uint4*)((bf16_t*)(p.ws + WS_MIX) + (size_t)(rowbase + t) * D + 1536 + blk * 64 + c0) = o4;
        }
    }
#undef LR_PREF
#undef LR_DEC
}

DEVI void lru_carry_scan(const int tid_, const Params& p) {
    const float* __restrict__ LA = (const float*)(p.ws + WS_LRUA);
    const float* __restrict__ LB = (const float*)(p.ws + WS_LRUB);
    float* __restrict__ LC = (float*)(p.ws + WS_LRUC);
    for (int idx = blockIdx.x * 512 + tid_; idx < 4096; idx += gridDim.x * 512) {
        const int ch = idx & 511, dir = (idx >> 9) & 1, b = idx >> 10;
        float hc = 0.f;
#pragma unroll 1
        for (int s = 0; s < NCH; s += 4) {
            float a[4], bb[4];
#pragma unroll
            for (int q = 0; q < 4; ++q) {
                const size_t si = ((size_t)((b * NCH + scan_ci(dir, s + q)) * 2 + dir)) * 512 + ch;
                a[q] = LA[si]; bb[q] = LB[si];
            }
#pragma unroll
            for (int q = 0; q < 4; ++q) {
                const size_t si = ((size_t)((b * NCH + scan_ci(dir, s + q)) * 2 + dir)) * 512 + ch;
                LC[si] = hc;
                hc = a[q] * hc + bb[q];
            }
        }
    }
}

DEVI void phase_mix_a(const int tid_, const Params& p, int L, unsigned char* lds) {
    const int na = (L == 0) ? 544 : 512;
    PROF_B(10, lds, tid_ == 0);
#pragma unroll 1
    for (int rep = 0; rep < ((REP_SUB == 100 && L == 0) ? 2 : 1); ++rep)
        for (int a = blockIdx.x; a < na; a += gridDim.x) attn_unit(tid_, p, L, a, lds);
    PROF_E(10, lds, tid_ == 0);
    PROF_B(12, lds, tid_ == 0);
    gla_p1_phase(tid_, p, L, lds);
    PROF_E(12, lds, tid_ == 0);
    if (REP_SUB == 101 && L == 0) gla_p1_phase(tid_, p, L, lds);
    PROF_B(13, lds, tid_ == 0);
    lru_phase<1>(tid_, p, L, lds);
    PROF_E(13, lds, tid_ == 0);
    if (REP_SUB == 102 && L == 0) lru_phase<1>(tid_, p, L, lds);
}
DEVI void phase_mix_b(const int tid_, const Params& p) { gla_scan(tid_, p); lru_carry_scan(tid_, p); }
DEVI void phase_mix_c(const int tid_, const Params& p, int L, unsigned char* lds) {
    PROF_B(14, lds, tid_ == 0);
    gla_p3_phase(tid_, p, L, lds);
    PROF_E(14, lds, tid_ == 0);
    if (REP_SUB == 103 && L == 0) gla_p3_phase(tid_, p, L, lds);
    PROF_B(15, lds, tid_ == 0);
    lru_phase<3>(tid_, p, L, lds);
    PROF_E(15, lds, tid_ == 0);
    if (REP_SUB == 104 && L == 0) lru_phase<3>(tid_, p, L, lds);
}

DEVI void phase_norm2(const int tid_, const Params& p, int L, unsigned char* lds, bool dry = false) {
    const int nrows = (L == 0) ? NT : NL;
    const int tid = tid_, w = tid >> 6, lane = tid & 63, fr = lane & 15, fq = lane >> 4;
    const float* H = (const float*)(p.ws + WS_H);
    bf16_t* U = (bf16_t*)(p.ws + WS_U);
    const float* mods = (const float*)(p.ws + WS_MODS);
    const float* gffn = p.in[7] + L * 2048;
    const bf16_t* WR = (const bf16_t*)(p.ws + WS_WRT) + (size_t)L * 48 * 2048;
    unsigned char* vt = lds;
    float* part = (float*)(lds + 65792);
    float* lgt = (float*)(lds + 65792 + 24576);
    unsigned* cnt = (unsigned*)(p.ws + WS_CTL) + (dry ? 8192 : CTL_COUNT) + L * 32;
    int* tokl = (int*)(p.ws + (dry ? WS_END : WS_TOKL));
    float* gatel = (float*)(p.ws + (dry ? WS_END + (size_t)32 * TOKCAP * 4 : WS_GATEL));
    unsigned char* wr2 = lds + 93440;
    __syncthreads();
#pragma unroll
    for (int i = 0; i < 2; ++i) { const int ch = tid + 512 * i; *(uint4*)(wr2 + ch * 16) = *(const uint4*)(WR + (size_t)32 * 2048 + ch * 8); }
    __syncthreads();
    bf16x8 Bf[8][2];
#pragma unroll
    for (int kk = 0; kk < 8; ++kk)
#pragma unroll
        for (int n = 0; n < 2; ++n) Bf[kk][n] = *(const bf16x8*)(WR + (size_t)(n * 16 + fr) * 2048 + w * 256 + kk * 32 + fq * 8);
    int* dec = (int*)(lds + 109824);
    int* lcnt = (int*)(lds + 109824 + 128 * 32);
    if (tid < 64) lcnt[tid] = 0;
    __syncthreads();
    int nloc = 0;
    float4 ha[8], hb[8];
    const int nit = nrows / 16;
    int it = blockIdx.x;
    if (it < nit) {
#pragma unroll
        for (int c = 0; c < 8; ++c) { ha[c] = *(const float4*)(H + (size_t)(it * 16 + w * 2) * D + c * 256 + lane * 4); hb[c] = *(const float4*)(H + (size_t)(it * 16 + w * 2 + 1) * D + c * 256 + lane * 4); }
    }
    for (; it < nit; it += gridDim.x) {
        lds_sync();
#define N2_ROW(hx, rr) do { \
            const int lr = w * 2 + (rr), row = it * 16 + lr; \
            const int mrow = row < NL ? (row >> 12) : 4; \
            const float* md = mods + (size_t)(L * 5 + mrow) * 12288; \
            float ss = 0.f; \
            _Pragma("unroll") for (int c = 0; c < 8; ++c) ss += hx[c].x * hx[c].x + hx[c].y * hx[c].y + hx[c].z * hx[c].z + hx[c].w * hx[c].w; \
            ss = wave_sum(ss, lane); \
            const float rstd = rsqrtf(ss * (1.f / 2048.f) + 1e-6f); \
            _Pragma("unroll") for (int c = 0; c < 8; ++c) { \
                const int col = c * 256 + lane * 4; \
                const float4 gm = *(const float4*)(gffn + col), sh = *(const float4*)(md + 3 * 2048 + col), sc = *(const float4*)(md + 4 * 2048 + col); \
                const float u0 = hx[c].x * rstd * gm.x * (1.f + sc.x) + sh.x, u1 = hx[c].y * rstd * gm.y * (1.f + sc.y) + sh.y; \
                const float u2 = hx[c].z * rstd * gm.z * (1.f + sc.z) + sh.z, u3 = hx[c].w * rstd * gm.w * (1.f + sc.w) + sh.w; \
                uint2 o; o.x = pk2(u0, u1); o.y = pk2(u2, u3); \
                *(uint2*)(U + (size_t)row * D + col) = o; \
                *(uint2*)(vt + lr * 4112 + col * 2) = o; \
                asm volatile("" ::: "memory"); } } while (0)
        N2_ROW(ha, 0);
        N2_ROW(hb, 1);
#undef N2_ROW
        if (it + (int)gridDim.x < nit) {
            const int itn = it + (int)gridDim.x;
#pragma unroll
            for (int c = 0; c < 8; ++c) { ha[c] = *(const float4*)(H + (size_t)(itn * 16 + w * 2) * D + c * 256 + lane * 4); hb[c] = *(const float4*)(H + (size_t)(itn * 16 + w * 2 + 1) * D + c * 256 + lane * 4); }
        }
        lds_sync();
        {
            f32x4 acc[3];
#pragma unroll
            for (int n = 0; n < 3; ++n) acc[n] = (f32x4){0.f, 0.f, 0.f, 0.f};
#pragma unroll
            for (int kk = 0; kk < 8; ++kk) {
                const int k0 = w * 256 + kk * 32 + fq * 8;
                const bf16x8 Af = *(const bf16x8*)(vt + fr * 4112 + k0 * 2);
                acc[0] = MFMA16(Af, Bf[kk][0], acc[0]);
                acc[1] = MFMA16(Af, Bf[kk][1], acc[1]);
                bf16x8 B2 = (bf16x8){0, 0, 0, 0, 0, 0, 0, 0};
                if (fr < 4) B2 = *(const bf16x8*)(wr2 + fr * 4096 + k0 * 2);
                acc[2] = MFMA16(Af, B2, acc[2]);
            }
#pragma unroll
            for (int n = 0; n < 3; ++n)
#pragma unroll
                for (int j = 0; j < 4; ++j) part[(w * 16 + fq * 4 + j) * 48 + n * 16 + fr] = acc[n][j];
        }
        lds_sync();
        for (int i = tid; i < 16 * 48; i += 512) {
            float s = 0.f;
#pragma unroll
            for (int ww = 0; ww < 8; ++ww) s += part[ww * 768 + i];
            lgt[i] = s;
        }
        lds_sync();
        if (tid < 16) {
            const int row = it * 16 + tid;
            const float* lg = lgt + tid * 48;
            float g[4];
#pragma unroll
            for (int j = 0; j < 4; ++j) g[j] = lg[j] + p.in[22][L * 4 + j];
            int gi = 0; float gm = g[0];
#pragma unroll
            for (int j = 1; j < 4; ++j) if (g[j] > gm) { gm = g[j]; gi = j; }
            float gs = 0.f;
#pragma unroll
            for (int j = 0; j < 4; ++j) gs += expf(g[j] - gm);
            const float pg = 1.f / gs;
            float e[8];
#pragma unroll
            for (int j = 0; j < 8; ++j) e[j] = lg[4 + gi * 8 + j] + p.in[24][L * 32 + gi * 8 + j];
            int i1 = 0; float m1 = e[0];
#pragma unroll
            for (int j = 1; j < 8; ++j) if (e[j] > m1) { m1 = e[j]; i1 = j; }
            int i2 = -1; float m2 = -3.4e38f;
#pragma unroll
            for (int j = 0; j < 8; ++j) if (j != i1 && e[j] > m2) { m2 = e[j]; i2 = j; }
            const float w1 = 1.f / (1.f + expf(m2 - m1)), w2 = 1.f - w1;
            const int e1 = gi * 8 + i1, e2 = gi * 8 + i2;
            const int r1 = atomicAdd(&lcnt[e1], 1), r2 = atomicAdd(&lcnt[e2], 1);
            int* dd = dec + (nloc * 16 + tid) * 8;
            dd[0] = row; dd[1] = e1; dd[2] = e2; dd[3] = r1; dd[4] = r2; dd[5] = __float_as_int(pg * w1); dd[6] = __float_as_int(pg * w2);
        }
        ++nloc;
    }
    lds_sync();
    if (tid < 32) { const int c = lcnt[tid]; lcnt[32 + tid] = c ? (int)atomicAdd(&cnt[tid], (unsigned)c) : 0; }
    lds_sync();
    for (int i = tid; i < nloc * 16; i += 512) {
        const int* dd = dec + i * 8;
        const int e1 = dd[1], e2 = dd[2];
        const size_t q1 = (size_t)e1 * TOKCAP + lcnt[32 + e1] + dd[3], q2 = (size_t)e2 * TOKCAP + lcnt[32 + e2] + dd[4];
        tokl[q1] = dd[0] * 2; gatel[q1] = __int_as_float(dd[5]);
        tokl[q2] = dd[0] * 2 + 1; gatel[q2] = __int_as_float(dd[6]);
    }
}

struct EpiUp {
    bf16_t* H1; int prow0, ncol0;
    DEVI void operator()(const f32x4 (&acc)[2][2][4][2], int wr, int wc, int fr, int fq, int tid, unsigned char* stg) const {
#pragma unroll
        for (int ai = 0; ai < 2; ++ai)
#pragma unroll
            for (int m = 0; m < 4; ++m) {
                const int rloc = ai * 128 + wr * 64 + m * 16 + fr;
#pragma unroll
                for (int n = 0; n < 2; ++n) {
                    const f32x4 a = acc[ai][0][m][n], c = acc[ai][1][m][n];
                    uint2 o; o.x = pk2(siluf_(a[0]) * c[0], siluf_(a[1]) * c[1]); o.y = pk2(siluf_(a[2]) * c[2], siluf_(a[3]) * c[3]);
                    *(uint2*)(stg + rloc * 272 + (wc * 32 + n * 16 + fq * 4) * 2) = o;
                }
            }
        lds_sync();
#pragma unroll 4
        for (int c = tid; c < 4096; c += 512) {
            const int r = c >> 4, cc = c & 15;
            *(uint4*)(H1 + (size_t)(prow0 + r) * 1024 + ncol0 + cc * 8) = *(const uint4*)(stg + r * 272 + cc * 16);
        }
        lds_sync();
    }
};
struct EpiDown {
    bf16_t* SL; const int* tokl; const float* gatel; int li0, cnt, bcol;
    DEVI void operator()(const f32x4 (&acc)[2][2][4][2], int wr, int wc, int fr, int fq, int tid, unsigned char* stg) const {
#pragma unroll
        for (int ai = 0; ai < 2; ++ai)
#pragma unroll
            for (int m = 0; m < 4; ++m) {
                const int rloc = ai * 128 + wr * 64 + m * 16 + fr, li = li0 + rloc;
                const float g = li < cnt ? gatel[li] : 0.f;
#pragma unroll
                for (int bj = 0; bj < 2; ++bj)
#pragma unroll
                    for (int n = 0; n < 2; ++n) {
                        const f32x4 v = acc[ai][bj][m][n] * g;
                        uint2 o; o.x = pk2(v[0], v[1]); o.y = pk2(v[2], v[3]);
                        *(uint2*)(stg + rloc * EP_RS + (bj * 128 + wc * 32 + n * 16 + fq * 4) * 2) = o;
                    }
            }
        lds_sync();
#pragma unroll 4
        for (int c = tid; c < 8192; c += 512) {
            const int r = c >> 5, cc = c & 31, li = li0 + r;
            if (li < cnt) *(uint4*)(SL + (size_t)tokl[li] * D + bcol + cc * 8) = *(const uint4*)(stg + r * EP_RS + cc * 16);
        }
        lds_sync();
    }
};

template <int DOWN>
DEVI void phase_moe(const int tid_, const Params& p, int L, unsigned char* lds) {
    bf16_t* shm = (bf16_t*)lds;
    int* tb = (int*)(lds + LDS_MISC + 256);
    const unsigned* cntg = (const unsigned*)(p.ws + WS_CTL) + CTL_COUNT + L * 32;
    __syncthreads();
    if (tid_ == 0) {
        int acc = 0;
        for (int e = 0; e < 32; ++e) { const int c = (int)cntg[e]; tb[64 + e] = c; tb[e] = acc; acc += (c + 255) >> 8; }
        tb[32] = acc;
    }
    __syncthreads();
    const int ntl = tb[32] * 8;
    const int* tokl = (const int*)(p.ws + WS_TOKL);
    bg_fill(tid_, p, lds, DOWN ? FILL_Q / 2 : FILL_Q);
    const int geff = (L == 0) ? (int)gridDim.x - NCONV_WG : (int)gridDim.x;
    if ((int)blockIdx.x >= geff) return;
    for (int i = 0;; ++i) {
        int u; if (!unit_of(i, ntl, u, geff)) break;
        int e = 0;
#pragma unroll 1
        for (int k = 1; k < 32; ++k) if (tb[k] * 8 <= u) e = k;
        const int q = u - tb[e] * 8, nte = tb[e + 1] - tb[e], nt = q / nte, mt = q % nte, cnt_e = tb[64 + e];
        const int prow0 = (tb[e] + mt) * 256;
        if (DOWN == 0) {
            unsigned ao[2][2];
#pragma unroll
            for (int ii = 0; ii < 2; ++ii) {
                int r, c; g_stage_rc(tid_ * 16 + ii * 8192, r, c);
#pragma unroll
                for (int hh = 0; hh < 2; ++hh) {
                    const int li = mt * 256 + hh * 128 + r;
                    const int tok = li < cnt_e ? (tokl[(size_t)e * TOKCAP + li] >> 1) : 0;
                    ao[hh][ii] = ((unsigned)tok * D + c) * 2u;
                }
            }
            const bf16_t* Bt = (const bf16_t*)(p.ws + WS_WUPT) + ((size_t)(L * 32 + e) * 2048 + nt * 256) * 2048;
            EpiUp epi{(bf16_t*)(p.ws + WS_H1), prow0, nt * 128};
            gemm_tile<true>(tid_, shm, (const bf16_t*)(p.ws + WS_U), D, ao[0][0], ao[0][1], ao[1][0], ao[1][1], Bt, 2048, epi);
        } else {
            unsigned a0, a1; aoff_plain(tid_, 1024, a0, a1);
            const bf16_t* Bt = (const bf16_t*)(p.ws + WS_WDNT) + ((size_t)(L * 32 + e) * 2048 + nt * 256) * 1024;
            EpiDown epi{(bf16_t*)(p.ws + WS_SLOTS), tokl + (size_t)e * TOKCAP, (const float*)(p.ws + WS_GATEL) + (size_t)e * TOKCAP, mt * 256, cnt_e, nt * 256};
            gemm_tile<false>(tid_, shm, (const bf16_t*)(p.ws + WS_H1) + (size_t)prow0 * 1024, 1024, a0, a1, 0u, 0u, Bt, 1024, epi);
        }
    }
}

extern __shared__ __attribute__((aligned(16))) unsigned char lds_raw[];

__global__ void __launch_bounds__(512, 2) hybrid_fwd(Params p_unused) {
    unsigned char* lds = lds_raw;
    int lo, hi;
    { Params q; load_params(q); lo = q.ph_lo; hi = q.ph_hi; }
    const int wv_ = __builtin_amdgcn_readfirstlane((int)(threadIdx.x >> 6));
    if (hi - lo > 1) {
        const bool t0 = (opaque_tid(wv_) == 0);
        if (t0) { *(uint4*)(lds + LDS_MISC) = make_uint4(0u, 0u, 0u, 0u); *(uint4*)(lds + LDS_MISC + 96) = make_uint4(0u, 0u, 0u, 0u); }
        __syncthreads();
        { Params q; load_params(q); (void)xcd_barrier_post((unsigned*)(q.ws + WS_CTL), (volatile LAS unsigned*)(lds + LDS_MISC), t0); }
    }
#ifndef PH_MASK
#define PH_MASK 0x7ff
#endif
#ifndef REP_PHASE
#define REP_PHASE -1
#endif
#ifndef REP_N
#define REP_N 1
#endif
#define PH_(fn, ...) do { asm volatile("; MARK_BEGIN " #fn); Params q__; load_params(q__); fn(opaque_tid(wv_), q__, ##__VA_ARGS__); asm volatile("; MARK_END " #fn); } while (0)
#define EN(j) ((PH_MASK >> (j)) & 1)
#define IN(k) (lo <= (k) && (k) < hi)
#define SEAM(k) do { if (IN(k) && IN((k) + 1)) { { Params qb_; load_params(qb_); bg_convert(opaque_tid(wv_), qb_, lds, (k)); } XcdBarrier bb_; Params q_; load_params(q_); \
    bb_.bar = (unsigned*)(q_.ws + WS_CTL); bb_.x = xb_xcc_id(); bb_.st = (volatile LAS unsigned*)(lds + LDS_MISC); xcd_barrier(bb_, opaque_tid(wv_) == 0); } } while (0)
    if (EN(0) && IN(0)) PH_(phase_prologue, lds);
    if (REP_PHASE == 0) for (int r_ = 0; r_ < REP_N; ++r_) PH_(phase_prologue, lds);
    SEAM(0);
    if (REP_SUB == 300) { for (int r_ = 0; r_ < 10; ++r_) SEAM(0); }
#define LAYER(L) do { constexpr int k0 = 1 + 9 * (L); \
        if (EN(1) && IN(k0 + 0)) PH_(phase_norm1, L); \
        if (REP_PHASE == k0 + 0) for (int r_ = 0; r_ < REP_N; ++r_) PH_(phase_norm1, L); \
        SEAM(k0 + 0); \
        if (EN(2) && IN(k0 + 1)) PH_(phase_gemm_in, L, (bf16_t*)lds); \
        if (REP_PHASE == k0 + 1) for (int r_ = 0; r_ < REP_N; ++r_) PH_(phase_gemm_in, L, (bf16_t*)lds); \
        SEAM(k0 + 1); \
        if (EN(3) && IN(k0 + 2)) PH_(phase_mix_a, L, lds); \
        if (REP_PHASE == k0 + 2) for (int r_ = 0; r_ < REP_N; ++r_) PH_(phase_mix_a, L, lds); \
        SEAM(k0 + 2); \
        if (EN(4) && IN(k0 + 3)) PH_(phase_mix_b); \
        if (REP_PHASE == k0 + 3) for (int r_ = 0; r_ < REP_N; ++r_) PH_(phase_mix_b); \
        SEAM(k0 + 3); \
        if (EN(5) && IN(k0 + 4)) PH_(phase_mix_c, L, lds); \
        if (REP_PHASE == k0 + 4) for (int r_ = 0; r_ < REP_N; ++r_) PH_(phase_mix_c, L, lds); \
        SEAM(k0 + 4); \
        if (EN(6) && IN(k0 + 5)) PH_(phase_gemm_out, L, (bf16_t*)lds); \
        if (REP_PHASE == k0 + 5) for (int r_ = 0; r_ < REP_N; ++r_) PH_(phase_gemm_out, L, (bf16_t*)lds); \
        SEAM(k0 + 5); \
        if (EN(7) && IN(k0 + 6)) PH_(phase_norm2, L, lds); \
        if (REP_PHASE == k0 + 6) for (int r_ = 0; r_ < REP_N; ++r_) PH_(phase_norm2, L, lds, true); \
        SEAM(k0 + 6); \
        if (EN(8) && IN(k0 + 7)) PH_(phase_moe<0>, L, lds); \
        if (REP_PHASE == k0 + 7) for (int r_ = 0; r_ < REP_N; ++r_) PH_(phase_moe<0>, L, lds); \
        SEAM(k0 + 7); \
        if (EN(9) && IN(k0 + 8)) PH_(phase_moe<1>, L, lds); \
        if (REP_PHASE == k0 + 8) for (int r_ = 0; r_ < REP_N; ++r_) PH_(phase_moe<1>, L, lds); \
        SEAM(k0 + 8); } while (0)
    LAYER(0);
    LAYER(1);
#undef LAYER
    if (EN(10) && IN(19)) PH_(phase_final);
    if (PROF_ID != 0 && blockIdx.x == 0 && opaque_tid(wv_) == 0) {
        const unsigned long long acc = PROF_WORD(lds)[0], t_start = __builtin_amdgcn_s_memrealtime();
        while (__builtin_amdgcn_s_memrealtime() - t_start < acc * PROF_AMP) __builtin_amdgcn_s_sleep(8);
    }
#undef IN
#undef SEAM
}

extern "C" void kernel_launch(void* const* d_in, const int* in_sizes, int n_in, void* d_out, int out_size, void* d_ws, size_t ws_size, hipStream_t stream) {
    static int grid = 0;
    if (grid == 0) {
        if (n_in != 29 || ws_size < WS_END) { fprintf(stderr, "kernel_launch: need 29 inputs and >= %zu bytes of workspace (got %d, %zu)\n", (size_t)WS_END, n_in, ws_size); grid = -1; return; }
        int dev = 0, cus = 0, per_cu = 0;
        if (hipGetDevice(&dev) != hipSuccess || hipDeviceGetAttribute(&cus, hipDeviceAttributeMultiprocessorCount, dev) != hipSuccess) { grid = -1; return; }
        if (hipFuncSetAttribute((const void*)hybrid_fwd, hipFuncAttributeMaxDynamicSharedMemorySize, LDS_BYTES) != hipSuccess) { fprintf(stderr, "kernel_launch: hipFuncSetAttribute failed\n"); grid = -1; return; }
        if (hipOccupancyMaxActiveBlocksPerMultiprocessor(&per_cu, (const void*)hybrid_fwd, 512, LDS_BYTES) != hipSuccess || per_cu < 1)
            fprintf(stderr, "kernel_launch: occupancy query reports %d workgroups per CU\n", per_cu);
        (void)hipGetLastError();
        grid = cus;
    }
    if (grid < 0) return;
    (void)hipMemsetAsync((char*)d_ws + WS_CTL, 0, 65536, stream);
    Params p{};
    for (int i = 0; i < 29; ++i) p.in[i] = (const float*)d_in[i];
    p.out = (float*)d_out; p.ws = (unsigned char*)d_ws;
#if MK_ONE_LAUNCH
    p.ph_lo = 0; p.ph_hi = 20;
    hipLaunchKernelGGL(hybrid_fwd, dim3(grid), dim3(512), LDS_BYTES, stream, p);
#else
    for (int k = 0; k < 20; ++k) {
        p.ph_lo = k; p.ph_hi = k + 1;
        hipLaunchKernelGGL(hybrid_fwd, dim3(grid), dim3(512), LDS_BYTES, stream, p);
    }
#endif
}
```

```cpp
#include <hip/hip_runtime.h>
#include <stdint.h>
#include <stdio.h>

#ifndef REP_SUB
#define REP_SUB -1
#endif
#ifndef BG_B0
#define BG_B0 8
#endif
#ifndef BG_B1
#define BG_B1 4
#endif
#ifndef NCONV_WG
#define NCONV_WG 0
#endif
#ifndef PROF_ID
#define PROF_ID 0
#endif
#ifndef PROF_AMP
#define PROF_AMP 4
#endif
#ifndef FILL_Q
#define FILL_Q 0
#endif
#ifndef MK_ONE_LAUNCH
#define MK_ONE_LAUNCH 1
#endif

typedef unsigned short bf16_t;
typedef short bf16x8 __attribute__((ext_vector_type(8)));
typedef float f32x4 __attribute__((ext_vector_type(4)));
#define DEVI __device__ __forceinline__

constexpr int D = 2048, NB = 4, SEQ = 4096, CTX = 256;
constexpr int NL = NB * SEQ, NC = NB * CTX, NT = NL + NC;
constexpr int NCH = 68;
constexpr int TT = SEQ + CTX;
constexpr int ZLD = 4096;
constexpr int ZQ = 0, ZK = 1024, ZGQ = 1536, ZGK = 1792, ZGR = 2560, ZLX = 3072, ZLG = 3584;
constexpr int NWIN = 4352;
constexpr int TOKCAP = NT;
constexpr int H1ROWS = 43008;

constexpr size_t al256(size_t x) { return (x + 255) & ~(size_t)255; }
constexpr size_t WS_CTL = 0;
constexpr size_t WS_MODS = 65536;
constexpr size_t WS_ROPEC = WS_MODS + al256((size_t)2 * 5 * 12288 * 4);
constexpr size_t WS_ROPES = WS_ROPEC + (size_t)4096 * 64 * 4;
constexpr size_t WS_ROPEF = WS_ROPES + (size_t)4096 * 64 * 4;
constexpr size_t WS_LRUWT = WS_ROPEF + 256;
constexpr size_t WS_WRT = WS_LRUWT + (size_t)2 * 8 * 256 * 64 * 2;
constexpr size_t WS_WINT = WS_WRT + (size_t)2 * 48 * 2048 * 2;
constexpr size_t WS_WOUTT = WS_WINT + (size_t)2 * NWIN * 2048 * 2;
constexpr size_t WS_WUPT = WS_WOUTT + (size_t)2 * 2048 * 2048 * 2;
constexpr size_t WS_WDNT = WS_WUPT + (size_t)2 * 32 * 2048 * 2048 * 2;
constexpr size_t WS_H = WS_WDNT + (size_t)2 * 32 * 2048 * 1024 * 2;
constexpr size_t WS_U = WS_H + (size_t)NT * D * 4;
constexpr size_t WS_Z = WS_U + (size_t)NT * D * 2;
constexpr size_t WS_GZ = WS_Z + (size_t)NT * ZLD * 2;
constexpr size_t WS_VT = WS_GZ + (size_t)NT * 32 * 4;
constexpr size_t WS_GVT = WS_VT + (size_t)8 * 128 * TT * 2;
constexpr size_t WS_MIX = WS_GVT + (size_t)16 * 128 * TT * 2;
constexpr size_t WS_CONTRIB = WS_MIX + (size_t)NT * D * 2;
constexpr size_t WS_SBEF = WS_CONTRIB + (size_t)32 * NCH * 8192 * 4;
constexpr size_t WS_ATOT = WS_SBEF + (size_t)32 * NCH * 8192 * 4;
constexpr size_t WS_LRUA = WS_ATOT + (size_t)32 * NCH * 64 * 4;
constexpr size_t WS_LRUB = WS_LRUA + (size_t)NB * NCH * 2 * 512 * 4;
constexpr size_t WS_LRUC = WS_LRUB + (size_t)NB * NCH * 2 * 512 * 4;
constexpr size_t WS_TOKL = WS_LRUC + (size_t)NB * NCH * 2 * 512 * 4;
constexpr size_t WS_GATEL = WS_TOKL + (size_t)32 * TOKCAP * 4;
constexpr size_t WS_H1 = WS_GATEL + (size_t)32 * TOKCAP * 4;
constexpr size_t WS_SLOTS = WS_H1 + (size_t)H1ROWS * 1024 * 2;
constexpr size_t WS_CUMG = WS_SLOTS + (size_t)NT * 2 * D * 2;
constexpr size_t WS_END = WS_CUMG + (size_t)NB * 4 * NCH * 2 * 4096 * 4;
constexpr int CTL_COUNT = 4096;

constexpr int LDS_BYTES = 155648;
constexpr int LDS_MISC = 139264;

struct Params {
    const float* in[29];
    float* out;
    unsigned char* ws;
    int ph_lo, ph_hi;
};

typedef __attribute__((address_space(1))) const float gcf_t;
typedef __attribute__((address_space(1))) float gf_t;
typedef __attribute__((address_space(1))) unsigned char guc_t;
struct ParamsK {
    gcf_t* in[29];
    gf_t* out;
    guc_t* ws;
    int ph_lo, ph_hi;
};
static_assert(sizeof(ParamsK) == sizeof(Params), "kernarg view");
__device__ __forceinline__ void load_params(Params& q) {
    const __attribute__((address_space(4))) ParamsK* kp = (const __attribute__((address_space(4))) ParamsK*)__builtin_amdgcn_kernarg_segment_ptr();
    asm volatile("" : "+s"(kp));
#pragma unroll
    for (int i = 0; i < 29; ++i) q.in[i] = (const float*)kp->in[i];
    q.out = (float*)kp->out; q.ws = (unsigned char*)kp->ws; q.ph_lo = kp->ph_lo; q.ph_hi = kp->ph_hi;
}

DEVI float bf2f(bf16_t v) { return __uint_as_float(((unsigned)v) << 16); }
DEVI float bflo(unsigned v) { return __uint_as_float(v << 16); }
DEVI float bfhi(unsigned v) { return __uint_as_float(v & 0xffff0000u); }
DEVI unsigned pk2(float lo, float hi) { unsigned r; asm("v_cvt_pk_bf16_f32 %0, %1, %2" : "=v"(r) : "v"(lo), "v"(hi)); return r; }
DEVI bf16_t f2bf(float f) { return (bf16_t)(pk2(f, 0.f) & 0xffffu); }
DEVI float shx(float v, int mask, int lane) { return __int_as_float(__builtin_amdgcn_ds_bpermute((lane ^ mask) << 2, __float_as_int(v))); }
DEVI float shidx(float v, int src) { return __int_as_float(__builtin_amdgcn_ds_bpermute(src << 2, __float_as_int(v))); }
DEVI float shup(float v, int off, int lane) { const int src = lane >= off ? lane - off : lane; return shidx(v, src); }
DEVI float wave_sum(float v, int lane) {
#pragma unroll
    for (int o = 32; o > 0; o >>= 1) v += shx(v, o, lane);
    return v;
}
DEVI float rcpf_(float x) { return __builtin_amdgcn_rcpf(x); }
DEVI float sigmoidf_(float x) { return rcpf_(1.f + __builtin_amdgcn_exp2f(-1.4426950408889634f * x)); }
DEVI float siluf_(float x) { return x * sigmoidf_(x); }
DEVI float gelu_tanh(float x) {
    const float y2 = 1.5957691216057308f * (x + 0.044715f * x * x * x);
    return x * sigmoidf_(y2);
}
DEVI float logsigmoidf_(float z) { return fminf(z, 0.f) - log1pf(expf(-fabsf(z))); }
DEVI bf16x8 mk8(unsigned a, unsigned b, unsigned c, unsigned d) {
    typedef unsigned u4 __attribute__((ext_vector_type(4)));
    u4 t = {a, b, c, d};
    return __builtin_bit_cast(bf16x8, t);
}
DEVI int hw_lane() { int l; asm volatile("v_mbcnt_lo_u32_b32 %0, -1, 0\n\tv_mbcnt_hi_u32_b32 %0, -1, %0" : "=v"(l)); return l; }
DEVI int opaque_tid(int wv) { int t = wv * 64 + hw_lane(); asm volatile("" : "+v"(t)); return t; }
DEVI void lds_sync() { asm volatile("s_waitcnt lgkmcnt(0)" ::: "memory"); __builtin_amdgcn_s_barrier(); asm volatile("" ::: "memory"); }
#define MFMA16(a, b, c) __builtin_amdgcn_mfma_f32_16x16x32_bf16((a), (b), (c), 0, 0, 0)

#define XB_TMO      128
#define XB_XCNT(j)  (256  + 64 * (j))
#define XB_XSUB(j)  (1280 + 64 * (j))
#define XB_XGEN(j)  (2304 + 64 * (j))
#define XB_TOP      3328
#define XB_TOPGEN   3392
#define XCD_BAR_WORDS 3456
#define XB_SPIN_CAP (1u << 18)
#define LAS __attribute__((address_space(3)))

__device__ __forceinline__ unsigned xb_ld(unsigned* p)              { return __hip_atomic_load(p, __ATOMIC_RELAXED, __HIP_MEMORY_SCOPE_AGENT); }
__device__ __forceinline__ unsigned xb_add(unsigned* p, unsigned v) { return __hip_atomic_fetch_add(p, v, __ATOMIC_RELAXED, __HIP_MEMORY_SCOPE_AGENT); }
__device__ __forceinline__ unsigned xb_xcc_id() { return (unsigned)__builtin_amdgcn_s_getreg((3 << 11) | 20) & 0xFu; }
#define XB_SPIN(cond, bar) do { unsigned _sp = 0; while (cond) { __builtin_amdgcn_s_sleep(1); \
    if ((++_sp & 255u) == 0u) { if (xb_ld(&(bar)[XB_TMO])) break; if (_sp > XB_SPIN_CAP) { atomicAdd(&(bar)[XB_TMO], 1u); break; } } } } while (0)

struct XcdBarrier {
    unsigned* bar; unsigned x;
    volatile LAS unsigned* st;
};
__device__ __forceinline__ XcdBarrier xcd_barrier_post(unsigned* bar, volatile LAS unsigned* st, bool t0) {
    XcdBarrier b; b.bar = bar; b.x = xb_xcc_id(); b.st = st;
    if (t0) (void)xb_add(&bar[XB_XCNT(b.x)], 1u);
    return b;
}
__device__ __forceinline__ void xcd_barrier_complete(unsigned* bar, unsigned x, unsigned& nloc, unsigned& nx) {
    const unsigned G = gridDim.x * gridDim.y * gridDim.z;
    unsigned sum, cnt, mine, sp = 0u;
    for (;;) {
        sum = 0u; cnt = 0u; mine = 0u;
#pragma unroll
        for (unsigned j = 0; j < 16; ++j) { const unsigned c = xb_ld(&bar[XB_XCNT(j)]); sum += c; cnt += (c > 0u) ? 1u : 0u; mine = (j == x) ? c : mine; }
        if (sum == G) break;
        __builtin_amdgcn_s_sleep(1);
        if ((++sp & 255u) == 0u) { if (xb_ld(&bar[XB_TMO])) break; if (sp > XB_SPIN_CAP) { atomicAdd(&bar[XB_TMO], 1u); break; } }
    }
    nloc = mine > 0u ? mine : 1u; nx = cnt > 0u ? cnt : 1u;
}
__device__ __forceinline__ void xcd_barrier(const XcdBarrier& b, bool t0) {
    asm volatile("s_waitcnt vmcnt(0)" ::: "memory");
    __syncthreads();
    if (t0) {
        unsigned* bar = b.bar;
        __builtin_amdgcn_s_waitcnt(0);
        unsigned nloc = b.st[0], nx = b.st[1];
        if (nloc == 0u) { xcd_barrier_complete(bar, b.x, nloc, nx); b.st[0] = nloc; b.st[1] = nx; }
        const unsigned old = xb_add(&bar[XB_XSUB(b.x)], 1u);
        const unsigned gen = old / nloc;
        if (old + 1u == (gen + 1u) * nloc) {
            __builtin_amdgcn_fence(__ATOMIC_RELEASE, "agent");
            asm volatile("s_waitcnt vmcnt(0)" ::: "memory");
            const unsigned og = xb_add(&bar[XB_TOP], 1u);
            const unsigned tg = og / nx;
            if (og + 1u == (tg + 1u) * nx) xb_add(&bar[XB_TOPGEN], 1u);
            else XB_SPIN(xb_ld(&bar[XB_TOPGEN]) == tg, bar);
            __builtin_amdgcn_fence(__ATOMIC_ACQUIRE, "agent");
            xb_add(&bar[XB_XGEN(b.x)], 1u);
            asm volatile("s_waitcnt vmcnt(0)" ::: "memory");
        } else {
            XB_SPIN(xb_ld(&bar[XB_XGEN(b.x)]) == gen, bar);
            __builtin_amdgcn_fence(__ATOMIC_ACQUIRE, "agent");
            asm volatile("s_waitcnt vmcnt(0)" ::: "memory");
        }
    }
    __syncthreads();
}

#define PROF_WORD(lds) ((volatile unsigned long long*)((lds) + LDS_MISC + 96))
#define PROF_B(id, lds, t0) do { if (PROF_ID == (id) && blockIdx.x == 0 && (t0)) PROF_WORD(lds)[1] = __builtin_amdgcn_s_memrealtime(); } while (0)
#define PROF_E(id, lds, t0) do { if (PROF_ID == (id) && blockIdx.x == 0 && (t0)) PROF_WORD(lds)[0] += __builtin_amdgcn_s_memrealtime() - PROF_WORD(lds)[1]; } while (0)
DEVI bool unit_of(int i, int nunits, int& u, int geff = 0) {
    const long Lx = (long)i * (geff ? geff : (int)gridDim.x) + blockIdx.x;
    if (Lx >= nunits) return false;
    const int w = (int)Lx, q = nunits / 8, r = nunits % 8, xcd = w % 8, off = w / 8;
    u = (xcd < r ? xcd * (q + 1) : r * (q + 1) + (xcd - r) * q) + off;
    return true;
}

constexpr int G_BK = 64, G_HALF = 128, G_HT = G_HALF * G_BK;
DEVI int g_lds_byte(int r, int c) {
    int st = (r >> 4) * 2 + (c >> 5), rr = r & 15, cc = c & 31, ob = rr * 64 + cc * 2;
    return st * 1024 + (ob ^ (((ob >> 9) & 1) << 5));
}
DEVI void g_stage_rc(int b, int& R, int& C) {
    int st = b / 1024, sb = b % 1024, swz = sb ^ (((sb >> 9) & 1) << 5);
    R = (st >> 1) * 16 + swz / 64; C = (st & 1) * 32 + (swz % 64) / 2;
}

template <bool GATHER, class Epi>
DEVI void gemm_tile(const int tid_, bf16_t* shm, const bf16_t* __restrict__ A, unsigned lda, unsigned a0, unsigned a1, unsigned a2, unsigned a3,
                    const bf16_t* __restrict__ Bt, int K, const Epi& epi) {
#define SA(b, h) (shm + ((b) * 2 + (h)) * G_HT)
#define SB(b, h) (shm + (4 + (b) * 2 + (h)) * G_HT)
#define STG_A(T, P, h, kt) do { const unsigned so_ = (unsigned)(kt) * 128u + ((GATHER || !(h)) ? 0u : 256u * lda); \
    __builtin_amdgcn_raw_ptr_buffer_load_lds(rsA, (LAS void*)((char*)(P) + ldsw), 16, (GATHER && (h)) ? a2 : a0, so_, 0, 0); \
    __builtin_amdgcn_raw_ptr_buffer_load_lds(rsA, (LAS void*)((char*)(P) + ldsw + 8192), 16, (GATHER && (h)) ? a3 : a1, so_, 0, 0); } while (0)
#define STG_B(T, P, h, kt) do { const unsigned so_ = (unsigned)(kt) * 128u + ((h) ? 256u * (unsigned)K : 0u); \
    __builtin_amdgcn_raw_ptr_buffer_load_lds(rsB, (LAS void*)((char*)(P) + ldsw), 16, b0, so_, 0, 0); \
    __builtin_amdgcn_raw_ptr_buffer_load_lds(rsB, (LAS void*)((char*)(P) + ldsw + 8192), 16, b1, so_, 0, 0); } while (0)
#define LDA(dst, b, h) for (int m = 0; m < 4; ++m) for (int k = 0; k < 2; ++k) \
    dst[m][k] = *reinterpret_cast<const bf16x8*>((char*)SA(b, h) + g_lds_byte(wr * 64 + m * 16 + fr, k * 32 + fq * 8))
#define LDB(dst, b, h) for (int n = 0; n < 2; ++n) for (int k = 0; k < 2; ++k) \
    dst[n][k] = *reinterpret_cast<const bf16x8*>((char*)SB(b, h) + g_lds_byte(wc * 32 + n * 16 + fr, k * 32 + fq * 8))
#define MMA(ai, bj, At_, Bt_) do { __builtin_amdgcn_s_setprio(1); \
    for (int m = 0; m < 4; ++m) for (int n = 0; n < 2; ++n) for (int k = 0; k < 2; ++k) \
        acc[ai][bj][m][n] = __builtin_amdgcn_mfma_f32_16x16x32_bf16(Bt_[n][k], At_[m][k], acc[ai][bj][m][n], 0, 0, 0); \
    __builtin_amdgcn_s_setprio(0); } while (0)
#define WAIT_V(n) asm volatile("s_waitcnt vmcnt(" #n ")" ::: "memory")
#define WAIT_L(n) asm volatile("s_waitcnt lgkmcnt(" #n ")" ::: "memory")
#define BAR __builtin_amdgcn_s_barrier()
#define SCHED __builtin_amdgcn_sched_barrier(0)
    unsigned b0, b1;
    { int r_, c_; g_stage_rc(tid_ * 16, r_, c_); b0 = (unsigned)(r_ * K + c_) * 2u; g_stage_rc(tid_ * 16 + 8192, r_, c_); b1 = (unsigned)(r_ * K + c_) * 2u; }
    const __amdgpu_buffer_rsrc_t rsA = __builtin_amdgcn_make_buffer_rsrc((void*)A, (short)0, 0x7fffffff, 0x00020000);
    const __amdgpu_buffer_rsrc_t rsB = __builtin_amdgcn_make_buffer_rsrc((void*)Bt, (short)0, 0x7fffffff, 0x00020000);
    const unsigned ldsw = (unsigned)__builtin_amdgcn_readfirstlane(tid_ >> 6) * 1024u;
    const int T = tid_;
    int wid = T >> 6, lane = T & 63, wr = wid >> 2, wc = wid & 3, fr = lane & 15, fq = lane >> 4;
    f32x4 acc[2][2][4][2] = {};
    bf16x8 At[4][2], B0[2][2], B1[2][2];
    const int nt = K / G_BK;
    STG_B(T, SB(0, 0), 0, 0); STG_A(T, SA(0, 0), 0, 0);
    STG_B(T, SB(0, 1), 1, 0); STG_A(T, SA(0, 1), 1, 0);
    if (wr == 1) BAR;
    WAIT_V(4); BAR;
    STG_B(T, SB(1, 0), 0, 1); STG_A(T, SA(1, 0), 0, 1); STG_B(T, SB(1, 1), 1, 1);
    WAIT_V(6); BAR;
    for (int t = 0; t < nt - 2; t += 2) {
        LDB(B0, 0, 0); SCHED; LDA(At, 0, 0); STG_A(T, SA(1, 1), 1, t + 1);
        WAIT_L(8); BAR; WAIT_L(0); MMA(0, 0, At, B0); BAR; SCHED;
        LDB(B1, 0, 1); STG_B(T, SB(0, 0), 0, t + 2);
        BAR; WAIT_L(0); MMA(0, 1, At, B1); BAR;
        LDA(At, 0, 1); STG_A(T, SA(0, 0), 0, t + 2);
        BAR; WAIT_L(0); MMA(1, 0, At, B0); BAR; SCHED;
        STG_B(T, SB(0, 1), 1, t + 2);
        WAIT_V(6); BAR; MMA(1, 1, At, B1); BAR;
        LDB(B0, 1, 0); SCHED; LDA(At, 1, 0); STG_A(T, SA(0, 1), 1, t + 2);
        WAIT_L(8); BAR; WAIT_L(0); MMA(0, 0, At, B0); BAR; SCHED;
        LDB(B1, 1, 1); STG_B(T, SB(1, 0), 0, t + 3);
        BAR; WAIT_L(0); MMA(0, 1, At, B1); BAR;
        LDA(At, 1, 1); STG_A(T, SA(1, 0), 0, t + 3);
        BAR; WAIT_L(0); MMA(1, 0, At, B0); BAR; SCHED;
        STG_B(T, SB(1, 1), 1, t + 3);
        WAIT_V(6); BAR; MMA(1, 1, At, B1); BAR;
    }
    int tz = tid_; asm volatile("" : "+v"(tz)); wid = tz >> 6; lane = tz & 63; wr = wid >> 2; wc = wid & 3; fr = lane & 15; fq = lane >> 4;
    { LDB(B0, 0, 0); WAIT_V(0); LDA(At, 0, 0); STG_A(tz, SA(1, 1), 1, nt - 1);
      BAR; WAIT_L(0); MMA(0, 0, At, B0); BAR;
      LDB(B1, 0, 1); BAR; WAIT_L(0); MMA(0, 1, At, B1); BAR;
      LDA(At, 0, 1); WAIT_V(4); BAR; WAIT_L(0); MMA(1, 0, At, B0); MMA(1, 1, At, B1); BAR; }
    { LDB(B0, 1, 0); LDA(At, 1, 0); WAIT_V(2); BAR; WAIT_L(0); MMA(0, 0, At, B0); BAR;
      LDB(B1, 1, 1); WAIT_V(0); BAR; WAIT_L(0); MMA(0, 1, At, B1); BAR;
      LDA(At, 1, 1); BAR; WAIT_L(0); MMA(1, 0, At, B0); MMA(1, 1, At, B1); BAR; }
    if (wr == 0) BAR;
    SCHED;
    epi(acc, wr, wc, fr, fq, tz, (unsigned char*)shm);
#undef SA
#undef SB
#undef STG_A
#undef STG_B
#undef LDA
#undef LDB
#undef MMA
}

DEVI void aoff_plain(const int tid_, int lda, unsigned& a0, unsigned& a1) {
    int r, c;
    g_stage_rc(tid_ * 16, r, c);        a0 = (unsigned)(r * lda + c) * 2u;
    g_stage_rc(tid_ * 16 + 8192, r, c); a1 = (unsigned)(r * lda + c) * 2u;
}

constexpr int NU_WIN = 2 * 68 * 16, NU_WOUT = 2 * 32 * 16, NU_UP = 64 * 32 * 16, NU_DN = 64 * 32 * 8;
constexpr int NU_CONV = NU_WIN + NU_WOUT + NU_UP + NU_DN;
constexpr int NU_ADA = 768, NU_ROPE = 512, NU_LRUW = 512, NU_WR = 384;
constexpr int NU_P0 = NU_CONV + NU_ADA + NU_ROPE + NU_LRUW + NU_WR;

DEVI void conv_decode(const Params& p, int u, const float*& srck, int& ld_src, int& c0, int& nv, bf16_t*& dstn, int& ld_dst) {
    if (u < NU_WIN) {
        const int L = u / 1088, rem = u % 1088, ntile = rem >> 4, ktile = rem & 15, n0 = ntile * 64;
        if (n0 < 3072) { c0 = n0; nv = 64; } else if (n0 < 4096) { c0 = n0 + 32; nv = 64; } else if (n0 == 4096) { c0 = 3072; nv = 32; } else { c0 = 0; nv = 0; }
        srck = p.in[8] + (size_t)L * 2048 * 4128 + (size_t)ktile * 128 * 4128; ld_src = 4128;
        dstn = (bf16_t*)(p.ws + WS_WINT) + ((size_t)L * NWIN + n0) * 2048 + ktile * 128; ld_dst = 2048;
    } else if (u < NU_WIN + NU_WOUT) {
        const int v = u - NU_WIN, L = v >> 9, rem = v & 511, ntile = rem >> 4, ktile = rem & 15;
        srck = p.in[20] + (size_t)L * 2048 * 2048 + (size_t)ktile * 128 * 2048; ld_src = 2048; c0 = ntile * 64; nv = 64;
        dstn = (bf16_t*)(p.ws + WS_WOUTT) + ((size_t)L * 2048 + ntile * 64) * 2048 + ktile * 128; ld_dst = 2048;
    } else if (u < NU_WIN + NU_WOUT + NU_UP) {
        const int v = u - NU_WIN - NU_WOUT, le = v >> 9, rem = v & 511, ntile = rem >> 4, ktile = rem & 15;
        const int nt = ntile >> 2, half = (ntile >> 1) & 1, i0 = (ntile & 1) * 64;
        srck = (half ? p.in[26] : p.in[25]) + (size_t)le * 2048 * 1024 + (size_t)ktile * 128 * 1024; ld_src = 1024; c0 = nt * 128 + i0; nv = 64;
        dstn = (bf16_t*)(p.ws + WS_WUPT) + ((size_t)le * 2048 + ntile * 64) * 2048 + ktile * 128; ld_dst = 2048;
    } else {
        const int v = u - NU_WIN - NU_WOUT - NU_UP, le = v >> 8, rem = v & 255, ntile = rem >> 3, ktile = rem & 7;
        srck = p.in[27] + (size_t)le * 1024 * 2048 + (size_t)ktile * 128 * 2048; ld_src = 2048; c0 = ntile * 64; nv = 64;
        dstn = (bf16_t*)(p.ws + WS_WDNT) + ((size_t)le * 2048 + ntile * 64) * 1024 + ktile * 128; ld_dst = 1024;
    }
}

constexpr int CTL_QHEAD = 4200, CTL_DONE = 4224;
constexpr int QE0 = 1088, QE1 = 1600, QE2 = 17984, QE3 = 26176, QE4 = 27264, QE5 = 27776, QE6 = 44160, QE7 = 52352;
static_assert(QE7 == NU_CONV, "queue length");
DEVI int q_to_unit(int q) {
    if (q < QE0) return q;
    if (q < QE1) return NU_WIN + (q - QE0);
    if (q < QE2) return NU_WIN + NU_WOUT + (q - QE1);
    if (q < QE3) return NU_WIN + NU_WOUT + NU_UP + (q - QE2);
    if (q < QE4) return 1088 + (q - QE3);
    if (q < QE5) return NU_WIN + 512 + (q - QE4);
    if (q < QE6) return NU_WIN + NU_WOUT + 16384 + (q - QE5);
    return NU_WIN + NU_WOUT + NU_UP + 8192 + (q - QE6);
}
DEVI int q_deadline(int k) {
    return k < 1 ? 0 : k < 5 ? QE0 : k < 7 ? QE1 : k < 8 ? QE2 : k < 10 ? QE3 : k < 14 ? QE4 : k < 16 ? QE5 : k < 17 ? QE6 : QE7;
}
typedef unsigned u32x4_t __attribute__((ext_vector_type(4)));
DEVI float4 ntld4(const float* p) { const f32x4 v = __builtin_nontemporal_load((const f32x4*)p); return make_float4(v[0], v[1], v[2], v[3]); }
DEVI void ntst4(const uint4& o, bf16_t* p) { u32x4_t v = {o.x, o.y, o.z, o.w}; __builtin_nontemporal_store(v, (u32x4_t*)p); }
DEVI void conv_run(const int tid_, const Params& p, float* T, int q0, int count) {
    const int t = tid_, n4 = t & 15, kr = t >> 4;
    float4 v0, v1, v2, v3, x0, x1, x2, x3;
    const float* srck; bf16_t* dstn; int ld_src, ld_dst, c0, nv;
    bf16_t* d1 = nullptr; int l1 = 0; bf16_t* d2 = nullptr; int l2 = 0;
#define CV_LOAD(a0_, a1_, a2_, a3_) do { const float* s_ = srck + c0 + n4 * 4; \
        a0_ = make_float4(0.f, 0.f, 0.f, 0.f); a1_ = a0_; a2_ = a0_; a3_ = a0_; \
        if (n4 * 4 < nv) { a0_ = ntld4((s_ + (size_t)(kr) * ld_src)); a1_ = ntld4((s_ + (size_t)(kr + 32) * ld_src)); \
                           a2_ = ntld4((s_ + (size_t)(kr + 64) * ld_src)); a3_ = ntld4((s_ + (size_t)(kr + 96) * ld_src)); } } while (0)
    conv_decode(p, q_to_unit(q0), srck, ld_src, c0, nv, dstn, ld_dst); d1 = dstn; l1 = ld_dst; CV_LOAD(v0, v1, v2, v3);
    x0 = make_float4(0.f, 0.f, 0.f, 0.f); x1 = x0; x2 = x0; x3 = x0;
    if (count > 1) { conv_decode(p, q_to_unit(q0 + 1), srck, ld_src, c0, nv, dstn, ld_dst); d2 = dstn; l2 = ld_dst; CV_LOAD(x0, x1, x2, x3); }
#pragma unroll 1
    for (int i = 0; i < count; ++i) {
        const float4 w0 = v0, w1 = v1, w2 = v2, w3 = v3;
        bf16_t* const dcur = d1; const int ldd = l1;
        v0 = x0; v1 = x1; v2 = x2; v3 = x3; d1 = d2; l1 = l2;
        if (i + 2 < count) { conv_decode(p, q_to_unit(q0 + i + 2), srck, ld_src, c0, nv, dstn, ld_dst); d2 = dstn; l2 = ld_dst; CV_LOAD(x0, x1, x2, x3); }
        lds_sync();
        { float* d = T + kr * 65 + n4 * 4; d[0] = w0.x; d[1] = w0.y; d[2] = w0.z; d[3] = w0.w; }
        { float* d = T + (kr + 32) * 65 + n4 * 4; d[0] = w1.x; d[1] = w1.y; d[2] = w1.z; d[3] = w1.w; }
        { float* d = T + (kr + 64) * 65 + n4 * 4; d[0] = w2.x; d[1] = w2.y; d[2] = w2.z; d[3] = w2.w; }
        { float* d = T + (kr + 96) * 65 + n4 * 4; d[0] = w3.x; d[1] = w3.y; d[2] = w3.z; d[3] = w3.w; }
        lds_sync();
#pragma unroll
        for (int i2 = 0; i2 < 2; ++i2) {
            const int kc = t & 15, n = (t >> 4) + 32 * i2;
            float f[8];
#pragma unroll
            for (int j = 0; j < 8; ++j) f[j] = T[(kc * 8 + j) * 65 + n];
            uint4 o; o.x = pk2(f[0], f[1]); o.y = pk2(f[2], f[3]); o.z = pk2(f[4], f[5]); o.w = pk2(f[6], f[7]);
            ntst4(o, dcur + (size_t)n * ldd + kc * 8);
        }
    }
#undef CV_LOAD
}
DEVI void bg_convert(const int tid_, const Params& p, unsigned char* lds, int k) {
    typedef __attribute__((address_space(1))) unsigned gu32_t;
    gu32_t* ctl = (gu32_t*)(p.ws + WS_CTL);
    volatile int* lw = (volatile int*)(lds + LDS_MISC + 64);
    float* T = (float*)lds;
    const int t = tid_;
    const int deadline = q_deadline(k), G = (int)gridDim.x;
#pragma unroll 1
    for (int stage = (k > 0 && q_deadline(k) == q_deadline(k - 1)) ? 1 : 0; stage < 2; ++stage) {
        if (stage == 1 && t == 0) (void)__hip_atomic_fetch_add(ctl + CTL_DONE + 64 * k, 1u, __ATOMIC_RELAXED, __HIP_MEMORY_SCOPE_AGENT);
        const int batch = (stage == 0) ? BG_B0 : BG_B1;
#pragma unroll 1
        for (;;) {
            if (t == 0) {
                int c = -1;
                const bool want = (stage == 0) ? ((int)__hip_atomic_load(ctl + CTL_QHEAD, __ATOMIC_RELAXED, __HIP_MEMORY_SCOPE_AGENT) < deadline)
                                               : ((int)__hip_atomic_load(ctl + CTL_DONE + 64 * k, __ATOMIC_RELAXED, __HIP_MEMORY_SCOPE_AGENT) < G);
                if (want) { c = (int)__hip_atomic_fetch_add(ctl + CTL_QHEAD, (unsigned)batch, __ATOMIC_RELAXED, __HIP_MEMORY_SCOPE_AGENT); if (c >= NU_CONV) c = -1; }
                lw[0] = c;
            }
            lds_sync();
            const int c = lw[0];
            lds_sync();
            if (c < 0) break;
            conv_run(tid_, p, T, c, (NU_CONV - c) < batch ? (NU_CONV - c) : batch);
        }
    }
}

DEVI void bg_fill(const int tid_, const Params& p, unsigned char* lds, int per_quarter) {
    typedef __attribute__((address_space(1))) unsigned gu32_t;
    gu32_t* ctl = (gu32_t*)(p.ws + WS_CTL);
    volatile int* lw = (volatile int*)(lds + LDS_MISC + 64);
    const int n = (int)(blockIdx.x & 3u) * per_quarter;
    if (n == 0) return;
    if (tid_ == 0) {
        int c = -1;
        if ((int)__hip_atomic_load(ctl + CTL_QHEAD, __ATOMIC_RELAXED, __HIP_MEMORY_SCOPE_AGENT) < NU_CONV) {
            c = (int)__hip_atomic_fetch_add(ctl + CTL_QHEAD, (unsigned)n, __ATOMIC_RELAXED, __HIP_MEMORY_SCOPE_AGENT); if (c >= NU_CONV) c = -1; }
        lw[0] = c;
    }
    lds_sync();
    const int c = lw[0];
    lds_sync();
    if (c >= 0) conv_run(tid_, p, (float*)lds, c, (NU_CONV - c) < n ? (NU_CONV - c) : n);
    lds_sync();
}

__constant__ double c_rope_inv[32] = {
    1.0, 0.7498942093324559, 0.5623413251903491, 0.4216965034285822, 0.31622776601683794, 0.23713737056616552, 0.1778279410038923, 0.1333521432163324,
    0.1, 0.07498942093324558, 0.05623413251903491, 0.042169650342858224, 0.03162277660168379, 0.023713737056616554, 0.01778279410038923, 0.01333521432163324,
    0.01, 0.007498942093324558, 0.005623413251903491, 0.004216965034285823, 0.0031622776601683794, 0.0023713737056616554, 0.0017782794100389228, 0.001333521432163324,
    0.001, 0.0007498942093324559, 0.0005623413251903491, 0.00042169650342858224, 0.00031622776601683794, 0.00023713737056616554, 0.00017782794100389227, 0.0001333521432163324};

DEVI void sincos_f64(double ang, float& sn, float& cs) {
    const double n = __builtin_rint(ang * 0.15915494309189535);
    double r = __builtin_fma(-n, 6.283185307179586, ang);
    r = __builtin_fma(-n, 2.4492935982947064e-16, r);
    const double x = 0.5 * r, x2 = x * x;
    double s = 1.0, c = 1.0;
#pragma unroll
    for (int k = 12; k >= 1; --k) {
        s = 1.0 - s * x2 * (1.0 / (double)((2 * k) * (2 * k + 1)));
        c = 1.0 - c * x2 * (1.0 / (double)((2 * k - 1) * (2 * k)));
    }
    s *= x;
    sn = (float)(2.0 * s * c); cs = (float)(1.0 - 2.0 * s * s);
}

DEVI void phase_prologue(const int tid_, const Params& p, unsigned char* lds) {
    float* T = (float*)lds;
    float* cond = (float*)(lds + 33280);
    float* red = (float*)(lds + 33280 + 40960);
    const int t = tid_;
    for (int i = t; i < 5 * 2048; i += 512) {
        const int r = i >> 11, k = i & 2047;
        const float c = r < 4 ? p.in[1][r * 2048 + k] : p.in[3][k];
        cond[i] = c / (1.f + expf(-c));
    }
    __syncthreads();
    __syncthreads();
    for (int u = NU_CONV + blockIdx.x; u < NU_P0; u += gridDim.x) {
        if (false) {
        } else if (u < NU_CONV + NU_ADA) {
            const int v = u - NU_CONV, L = v / 384, c0 = (v % 384) * 32;
            const float* W = p.in[4] + (size_t)L * 2048 * 12288;
            const int q = t & 7, kg = t >> 3;
            float acc[5][4];
#pragma unroll
            for (int r = 0; r < 5; ++r) { acc[r][0] = 0.f; acc[r][1] = 0.f; acc[r][2] = 0.f; acc[r][3] = 0.f; }
#pragma unroll 4
            for (int k = kg; k < 2048; k += 64) {
                const float4 w = *(const float4*)(W + (size_t)k * 12288 + c0 + q * 4);
#pragma unroll
                for (int r = 0; r < 5; ++r) {
                    const float cv = cond[r * 2048 + k];
                    acc[r][0] += cv * w.x; acc[r][1] += cv * w.y; acc[r][2] += cv * w.z; acc[r][3] += cv * w.w;
                }
            }
#pragma unroll
            for (int r = 0; r < 5; ++r)
#pragma unroll
                for (int j = 0; j < 4; ++j) {
                    float a = acc[r][j];
                    a += shx(a, 8, t & 63); a += shx(a, 16, t & 63); a += shx(a, 32, t & 63);
                    acc[r][j] = a;
                }
            const int lane = t & 63, wave = t >> 6;
            __syncthreads();
            if (lane < 8) {
#pragma unroll
                for (int r = 0; r < 5; ++r)
#pragma unroll
                    for (int j = 0; j < 4; ++j) red[(wave * 8 + lane) * 20 + r * 4 + j] = acc[r][j];
            }
            __syncthreads();
            if (t < 160) {
                const int qq = t / 20, rj = t % 20;
                float s = 0.f;
#pragma unroll
                for (int w = 0; w < 8; ++w) s += red[(w * 8 + qq) * 20 + rj];
                const int r = rj >> 2, j = rj & 3, col = c0 + qq * 4 + j;
                ((float*)(p.ws + WS_MODS))[(size_t)(L * 5 + r) * 12288 + col] = s + p.in[5][L * 12288 + col];
            }
        } else if (u < NU_CONV + NU_ADA + NU_ROPE) {
            const int idx = (u - NU_CONV - NU_ADA) * 512 + t, pos = idx >> 6, i = idx & 63;
            const int coord = i < 32 ? (pos >> 6) : (pos & 63);
            float sn, cs;
            sincos_f64((double)coord * c_rope_inv[i & 31], sn, cs);
            ((float*)(p.ws + WS_ROPEC))[idx] = cs;
            ((float*)(p.ws + WS_ROPES))[idx] = sn;
            if (idx < 32) ((float*)(p.ws + WS_ROPEF))[idx] = (float)(c_rope_inv[idx] * 0.15915494309189535);
        } else if (u < NU_CONV + NU_ADA + NU_ROPE + NU_LRUW) {
            const int idx = (u - NU_CONV - NU_ADA - NU_ROPE) * 512 + t;
            const int c = idx & 63, n = (idx >> 6) & 255, blk = (idx >> 14) & 7, L = idx >> 17;
            const int dg = n >> 6, dir = dg >> 1, gate = dg & 1, dd = n & 63;
            const float* src = gate ? p.in[17] : p.in[15];
            ((bf16_t*)(p.ws + WS_LRUWT))[idx] = f2bf(src[((size_t)((L * 2 + dir) * 8 + blk) * 64 + c) * 64 + dd]);
        } else {
            const int idx = (u - NU_CONV - NU_ADA - NU_ROPE - NU_LRUW) * 512 + t;
            const int k = idx & 2047, n = (idx >> 11) % 48, L = idx / (48 * 2048);
            float v = 0.f;
            if (n < 4) v = p.in[21][((size_t)L * 2048 + k) * 4 + n];
            else if (n < 36) v = p.in[23][((size_t)L * 2048 + k) * 32 + (n - 4)];
            ((bf16_t*)(p.ws + WS_WRT))[idx] = f2bf(v);
        }
    }
}

DEVI void phase_norm1(const int tid_, const Params& p, int L) {
    const int wave = tid_ >> 6, lane = tid_ & 63;
    float* H = (float*)(p.ws + WS_H);
    bf16_t* U = (bf16_t*)(p.ws + WS_U);
    const float* mods = (const float*)(p.ws + WS_MODS);
    const bf16_t* SL = (const bf16_t*)(p.ws + WS_SLOTS);
    const float* gmix = p.in[6] + L * 2048;
    float4 nx[8];
#define N1_SRC(r) (L == 0 ? ((r) < NL ? p.in[0] + (size_t)(r) * D : p.in[2] + (size_t)((r) - NL) * D) : H + (size_t)(r) * D)
    {
        const int r0 = blockIdx.x * 8 + wave;
        if (r0 < NT) { const float* s0 = N1_SRC(r0);
#pragma unroll
            for (int c = 0; c < 8; ++c) nx[c] = *(const float4*)(s0 + c * 256 + lane * 4); }
    }
    for (int row = blockIdx.x * 8 + wave; row < NT; row += gridDim.x * 8) {
        const int mrow = row < NL ? (row >> 12) : 4;
        const float* md = mods + (size_t)(L * 5 + mrow) * 12288;
        float4 hv[8];
#pragma unroll
        for (int c = 0; c < 8; ++c) hv[c] = nx[c];
        {
            const int rn = row + (int)gridDim.x * 8;
            if (rn < NT) { const float* s1 = N1_SRC(rn);
#pragma unroll
                for (int c = 0; c < 8; ++c) nx[c] = *(const float4*)(s1 + c * 256 + lane * 4); }
        }
        if (L == 1) {
            const float* g2 = mods + (size_t)(0 * 5 + mrow) * 12288 + 5 * 2048;
#pragma unroll
            for (int c = 0; c < 8; ++c) {
                const int col = c * 256 + lane * 4;
                const float4 g = *(const float4*)(g2 + col);
                const uint2 a = *(const uint2*)(SL + (size_t)(row * 2) * D + col), b = *(const uint2*)(SL + (size_t)(row * 2 + 1) * D + col);
                hv[c].x += g.x * (bflo(a.x) + bflo(b.x)); hv[c].y += g.y * (bfhi(a.x) + bfhi(b.x));
                hv[c].z += g.z * (bflo(a.y) + bflo(b.y)); hv[c].w += g.w * (bfhi(a.y) + bfhi(b.y));
            }
        }
        float ss = 0.f;
#pragma unroll
        for (int c = 0; c < 8; ++c) {
            if (L == 1) *(float4*)(H + (size_t)row * D + c * 256 + lane * 4) = hv[c];
            ss += hv[c].x * hv[c].x + hv[c].y * hv[c].y + hv[c].z * hv[c].z + hv[c].w * hv[c].w;
        }
        ss = wave_sum(ss, lane);
        const float rstd = rsqrtf(ss * (1.f / 2048.f) + 1e-6f);
#pragma unroll
        for (int c = 0; c < 8; ++c) {
            const int col = c * 256 + lane * 4;
            const float4 gm = *(const float4*)(gmix + col), sh = *(const float4*)(md + col), sc = *(const float4*)(md + 2048 + col);
            const float u0 = hv[c].x * rstd * gm.x * (1.f + sc.x) + sh.x, u1 = hv[c].y * rstd * gm.y * (1.f + sc.y) + sh.y;
            const float u2 = hv[c].z * rstd * gm.z * (1.f + sc.z) + sh.z, u3 = hv[c].w * rstd * gm.w * (1.f + sc.w) + sh.w;
            uint2 o; o.x = pk2(u0, u1); o.y = pk2(u2, u3);
            *(uint2*)(U + (size_t)row * D + col) = o;
        }
    }
#undef N1_SRC
}

DEVI void phase_final(const int tid_, const Params& p) {
    const int wave = tid_ >> 6, lane = tid_ & 63;
    const float* H = (const float*)(p.ws + WS_H);
    const float* mods = (const float*)(p.ws + WS_MODS);
    const bf16_t* SL = (const bf16_t*)(p.ws + WS_SLOTS);
    const float* gf = p.in[28];
    for (int row = blockIdx.x * 8 + wave; row < NL; row += gridDim.x * 8) {
        const int mrow = row >> 12;
        const float* g2 = mods + (size_t)(1 * 5 + mrow) * 12288 + 5 * 2048;
        float4 hv[8];
        float ss = 0.f;
#pragma unroll
        for (int c = 0; c < 8; ++c) {
            const int col = c * 256 + lane * 4;
            hv[c] = *(const float4*)(H + (size_t)row * D + col);
            const float4 g = *(const float4*)(g2 + col);
            const uint2 a = *(const uint2*)(SL + (size_t)(row * 2) * D + col), b = *(const uint2*)(SL + (size_t)(row * 2 + 1) * D + col);
            hv[c].x += g.x * (bflo(a.x) + bflo(b.x)); hv[c].y += g.y * (bfhi(a.x) + bfhi(b.x));
            hv[c].z += g.z * (bflo(a.y) + bflo(b.y)); hv[c].w += g.w * (bfhi(a.y) + bfhi(b.y));
            ss += hv[c].x * hv[c].x + hv[c].y * hv[c].y + hv[c].z * hv[c].z + hv[c].w * hv[c].w;
        }
        ss = wave_sum(ss, lane);
        const float rstd = rsqrtf(ss * (1.f / 2048.f) + 1e-6f);
#pragma unroll
        for (int c = 0; c < 8; ++c) {
            const int col = c * 256 + lane * 4;
            const float4 gm = *(const float4*)(gf + col);
            float4 o; o.x = hv[c].x * rstd * gm.x; o.y = hv[c].y * rstd * gm.y; o.z = hv[c].z * rstd * gm.z; o.w = hv[c].w * rstd * gm.w;
            *(float4*)(p.out + (size_t)row * D + col) = o;
        }
    }
}

constexpr int EP_RS = 528;
struct EpiIn {
    bf16_t* Z; float* GZ; bf16_t* VT; bf16_t* GVT; const float* RC; const float* RS; int brow, pn;
    DEVI void operator()(const f32x4 (&acc)[2][2][4][2], int wr, int wc, int fr, int fq, int tid, unsigned char* stg) const {
        if (pn == 16) {
#pragma unroll
            for (int ai = 0; ai < 2; ++ai)
#pragma unroll
                for (int m = 0; m < 4; ++m) {
                    const int row = brow + ai * 128 + wr * 64 + m * 16 + fr;
#pragma unroll
                    for (int n = 0; n < 2; ++n) { const int colt = wc * 32 + n * 16 + fq * 4; if (colt < 32) *(f32x4*)(GZ + (size_t)row * 32 + colt) = acc[ai][0][m][n]; }
                }
            return;
        }
        const bool tr = (pn == 5 || pn == 8 || pn == 9);
#pragma unroll
        for (int ai = 0; ai < 2; ++ai)
#pragma unroll
            for (int m = 0; m < 4; ++m) {
                const int rloc = ai * 128 + wr * 64 + m * 16 + fr, row = brow + rloc;
#pragma unroll
                for (int bj = 0; bj < 2; ++bj)
#pragma unroll
                    for (int n = 0; n < 2; ++n) {
                        const int colt = bj * 128 + wc * 32 + n * 16 + fq * 4;
                        const f32x4 v = acc[ai][bj][m][n];
                        float o0 = v[0], o1 = v[1], o2 = v[2], o3 = v[3];
                        if (pn <= 4) {
                            if (row < NL) {
                                const int tpos = row & 4095, i0 = (colt & 127) >> 1;
                                const float pos = (float)((i0 < 32) ? (tpos >> 6) : (tpos & 63));
                                const float r0 = pos * RC[i0 & 31], r1 = pos * RC[(i0 & 31) + 1];
                                const float c0 = __builtin_amdgcn_cosf(r0), s0 = __builtin_amdgcn_sinf(r0), c1 = __builtin_amdgcn_cosf(r1), s1 = __builtin_amdgcn_sinf(r1);
                                o0 = v[0] * c0 - v[1] * s0; o1 = v[0] * s0 + v[1] * c0;
                                o2 = v[2] * c1 - v[3] * s1; o3 = v[2] * s1 + v[3] * c1;
                            }
                            if (pn < 4) { o0 *= 0.12751743f; o1 *= 0.12751743f; o2 *= 0.12751743f; o3 *= 0.12751743f; }
                        }
                        if (!tr) { uint2 o; o.x = pk2(o0, o1); o.y = pk2(o2, o3); *(uint2*)(stg + rloc * EP_RS + colt * 2) = o; }
                        else {
                            const unsigned p01 = pk2(o0, o1), p23 = pk2(o2, o3);
                            *(bf16_t*)(stg + (colt + 0) * EP_RS + rloc * 2) = (bf16_t)(p01 & 0xffffu); *(bf16_t*)(stg + (colt + 1) * EP_RS + rloc * 2) = (bf16_t)(p01 >> 16);
                            *(bf16_t*)(stg + (colt + 2) * EP_RS + rloc * 2) = (bf16_t)(p23 & 0xffffu); *(bf16_t*)(stg + (colt + 3) * EP_RS + rloc * 2) = (bf16_t)(p23 >> 16);
                        }
                    }
            }
        lds_sync();
        if (!tr) {
#pragma unroll 4
            for (int c = tid; c < 8192; c += 512) {
                const int r = c >> 5, cc = c & 31;
                *(uint4*)(Z + (size_t)(brow + r) * ZLD + pn * 256 + cc * 8) = *(const uint4*)(stg + r * EP_RS + cc * 16);
            }
        } else {
            int bb, tpos0;
            if (brow < NL) { bb = brow >> 12; tpos0 = brow & 4095; } else { bb = (brow - NL) >> 8; tpos0 = 4096; }
#pragma unroll 4
            for (int c = tid; c < 8192; c += 512) {
                const int col = c >> 5, rc = c & 31;
                bf16_t* dst;
                if (pn == 5) dst = VT + ((size_t)((bb * 2 + (col >> 7)) * 128 + (col & 127))) * TT;
                else { const int cv = (pn - 8) * 256 + col; dst = GVT + ((size_t)((bb * 4 + (cv >> 7)) * 128 + (cv & 127))) * TT; }
                *(uint4*)(dst + tpos0 + rc * 8) = *(const uint4*)(stg + col * EP_RS + rc * 16);
            }
        }
        lds_sync();
    }
};

DEVI void dense_tile_of(int wgid, int nM, int nN, int& pm, int& pn) {
    const int nig = 8 * nN, gid = wgid / nig, fm = gid * 8, gsz = (nM - fm) < 8 ? (nM - fm) : 8;
    pm = fm + ((wgid % nig) % gsz); pn = (wgid % nig) / gsz;
}

DEVI void phase_gemm_in(const int tid_, const Params& p, int L, bf16_t* shm) {
    const int nM = NT / 256, nN = NWIN / 256;
    const bf16_t* U = (const bf16_t*)(p.ws + WS_U);
    bg_fill(tid_, p, (unsigned char*)shm, FILL_Q);
    const int geff = (int)gridDim.x - NCONV_WG;
    if ((int)blockIdx.x >= geff) return;
    for (int i = 0;; ++i) {
        int u; if (!unit_of(i, nM * nN, u, geff)) break;
        int pm, pn; dense_tile_of(u, nM, nN, pm, pn);
        if (L == 1 && pm >= NL / 256 && !(pn == 4 || pn == 5 || pn == 7 || pn == 8 || pn == 9 || pn == 12 || pn == 13 || pn == 16)) continue;
        unsigned a0, a1; aoff_plain(tid_, D, a0, a1);
        const bf16_t* Bt = (const bf16_t*)(p.ws + WS_WINT) + ((size_t)L * NWIN + pn * 256) * 2048;
        EpiIn epi{(bf16_t*)(p.ws + WS_Z), (float*)(p.ws + WS_GZ), (bf16_t*)(p.ws + WS_VT), (bf16_t*)(p.ws + WS_GVT),
                  (const float*)(p.ws + WS_ROPEF), (const float*)(p.ws + WS_ROPES), pm * 256, pn};
        if (REP_SUB == 200) { struct Twice { const EpiIn& e; DEVI void operator()(const f32x4 (&acc)[2][2][4][2], int wr, int wc, int fr, int fq, int tid, unsigned char* stg) const { e(acc, wr, wc, fr, fq, tid, stg); asm volatile("" ::: "memory"); e(acc, wr, wc, fr, fq, tid, stg); } } tw{epi};
            gemm_tile<false>(tid_, shm, U + (size_t)pm * 256 * D, D, a0, a1, 0u, 0u, Bt, 2048, tw); }
        else gemm_tile<false>(tid_, shm, U + (size_t)pm * 256 * D, D, a0, a1, 0u, 0u, Bt, 2048, epi);
    }
}

struct EpiOut {
    float* H; const float* mods; const float* x; const float* ctx; int L, brow, bcol;
    DEVI void operator()(const f32x4 (&acc)[2][2][4][2], int wr, int wc, int fr, int fq, int, unsigned char*) const {
#pragma unroll
        for (int ai = 0; ai < 2; ++ai)
#pragma unroll
            for (int m = 0; m < 4; ++m) {
                const int row = brow + ai * 128 + wr * 64 + m * 16 + fr;
                const int mrow = row < NL ? (row >> 12) : 4;
                const float* g1 = mods + (size_t)(L * 5 + mrow) * 12288 + 2 * 2048;
#pragma unroll
                for (int bj = 0; bj < 2; ++bj)
#pragma unroll
                    for (int n = 0; n < 2; ++n) {
                        const int col = bcol + bj * 128 + wc * 32 + n * 16 + fq * 4;
                        const f32x4 g = *(const f32x4*)(g1 + col);
                        f32x4* hp = (f32x4*)(H + (size_t)row * D + col);
                        const f32x4* rp = (L == 0) ? (const f32x4*)((row < NL ? x + (size_t)row * D : ctx + (size_t)(row - NL) * D) + col) : (const f32x4*)hp;
                        f32x4 h = *rp;
                        h += g * acc[ai][bj][m][n];
                        *hp = h;
                    }
            }
    }
};

DEVI void phase_gemm_out(const int tid_, const Params& p, int L, bf16_t* shm) {
    const int nM = (L == 0 ? NT : NL) / 256, nN = 8;
    const bf16_t* MIX = (const bf16_t*)(p.ws + WS_MIX);
    bg_fill(tid_, p, (unsigned char*)shm, FILL_Q);
    const int geff = (int)gridDim.x - NCONV_WG;
    if ((int)blockIdx.x >= geff) return;
    for (int i = 0;; ++i) {
        int u; if (!unit_of(i, nM * nN, u, geff)) break;
        int pm, pn; dense_tile_of(u, nM, nN, pm, pn);
        unsigned a0, a1; aoff_plain(tid_, D, a0, a1);
        const bf16_t* Bt = (const bf16_t*)(p.ws + WS_WOUTT) + ((size_t)L * 2048 + pn * 256) * 2048;
        EpiOut epi{(float*)(p.ws + WS_H), (const float*)(p.ws + WS_MODS), p.in[0], p.in[2], L, pm * 256, pn * 256};
        gemm_tile<false>(tid_, shm, MIX + (size_t)pm * 256 * D, D, a0, a1, 0u, 0u, Bt, 2048, epi);
    }
}

constexpr int AT_KSTR = 272, AT_VSTR = 144;
DEVI void attn_unit(const int tid_, const Params& p, int L, int a, unsigned char* lds) {
    const bf16_t* Z = (const bf16_t*)(p.ws + WS_Z);
    const bf16_t* VT = (const bf16_t*)(p.ws + WS_VT);
    bf16_t* MIX = (bf16_t*)(p.ws + WS_MIX);
    unsigned char* Ks = lds;
    unsigned char* Vs = lds + 64 * AT_KSTR;
    const int tid = tid_, w = tid >> 6, lane = tid & 63, fr = lane & 15, fq = lane >> 4;
    int b, qb, kvh; bool isctx;
    if (a < 512) { b = a >> 7; qb = (a >> 1) & 63; kvh = a & 1; isctx = false; }
    else { const int a2 = a - 512; b = a2 >> 3; qb = (a2 >> 1) & 3; kvh = a2 & 1; isctx = true; }
    const int row0 = isctx ? NL + b * 256 + qb * 64 : b * 4096 + qb * 64;
    const int head = kvh * 4 + (w >> 1), qh = w & 1;
    bf16x8 Qf[2][4];
#pragma unroll
    for (int nq = 0; nq < 2; ++nq)
#pragma unroll
        for (int ks = 0; ks < 4; ++ks)
            Qf[nq][ks] = *(const bf16x8*)(Z + (size_t)(row0 + qh * 32 + nq * 16 + fr) * ZLD + ZQ + head * 128 + ks * 32 + fq * 8);
    f32x4 ot[8][2];
#pragma unroll
    for (int i = 0; i < 8; ++i) { ot[i][0] = (f32x4){0.f, 0.f, 0.f, 0.f}; ot[i][1] = (f32x4){0.f, 0.f, 0.f, 0.f}; }
    float mrun[2] = {-1e30f, -1e30f}, lrun[2] = {0.f, 0.f};
    int lo, hi;
    if (isctx) { lo = 5; hi = 4; } else { lo = (2 - qb) > 0 ? (2 - qb) : 0; hi = (65 - qb) < 4 ? (65 - qb) : 4; }
    int ti = (lo <= hi) ? lo : 5;
    uint4 kreg0, kreg1, vreg0, vreg1;
    const int kch0 = tid, kch1 = tid + 512;
#define AT_LOAD(tile) do { \
    int krow0_, vt0_; \
    if ((tile) <= 4) { const int j_ = qb - 2 + (tile); krow0_ = b * 4096 + j_ * 64; vt0_ = j_ * 64; } \
    else { const int jj_ = (tile) - 5; krow0_ = NL + b * 256 + jj_ * 64; vt0_ = 4096 + jj_ * 64; } \
    kreg0 = *(const uint4*)(Z + (size_t)(krow0_ + (kch0 >> 4)) * ZLD + ZK + kvh * 128 + (kch0 & 15) * 8); \
    kreg1 = *(const uint4*)(Z + (size_t)(krow0_ + (kch1 >> 4)) * ZLD + ZK + kvh * 128 + (kch1 & 15) * 8); \
    vreg0 = *(const uint4*)(VT + ((size_t)((b * 2 + kvh) * 128 + (kch0 >> 3))) * TT + vt0_ + (kch0 & 7) * 8); \
    vreg1 = *(const uint4*)(VT + ((size_t)((b * 2 + kvh) * 128 + (kch1 >> 3))) * TT + vt0_ + (kch1 & 7) * 8); } while (0)
    AT_LOAD(ti);
    for (;;) {
        PROF_B(11, lds, tid == 0);
        __syncthreads();
        *(uint4*)(Ks + (kch0 >> 4) * AT_KSTR + (kch0 & 15) * 16) = kreg0;
        *(uint4*)(Ks + (kch1 >> 4) * AT_KSTR + (kch1 & 15) * 16) = kreg1;
        *(uint4*)(Vs + (kch0 >> 3) * AT_VSTR + (kch0 & 7) * 16) = vreg0;
        *(uint4*)(Vs + (kch1 >> 3) * AT_VSTR + (kch1 & 7) * 16) = vreg1;
        __syncthreads();
        PROF_E(11, lds, tid == 0);
        const int cur = ti;
        const int nxt = (cur == hi) ? 5 : cur + 1;
        if (nxt <= 8) AT_LOAD(nxt);
        f32x4 st[4][2];
#pragma unroll
        for (int mt = 0; mt < 4; ++mt) { st[mt][0] = (f32x4){0.f, 0.f, 0.f, 0.f}; st[mt][1] = (f32x4){0.f, 0.f, 0.f, 0.f}; }
        {
            bf16x8 Kc[4], Kn[4];
#pragma unroll
            for (int mt = 0; mt < 4; ++mt) Kc[mt] = *(const bf16x8*)(Ks + (mt * 16 + fr) * AT_KSTR + (fq * 8) * 2);
#pragma unroll
            for (int ks = 0; ks < 4; ++ks) {
                if (ks < 3) {
#pragma unroll
                    for (int mt = 0; mt < 4; ++mt) Kn[mt] = *(const bf16x8*)(Ks + (mt * 16 + fr) * AT_KSTR + ((ks + 1) * 32 + fq * 8) * 2);
                }
                __builtin_amdgcn_sched_barrier(0);
#pragma unroll
                for (int mt = 0; mt < 4; ++mt) {
                    st[mt][0] = MFMA16(Kc[mt], Qf[0][ks], st[mt][0]);
                    st[mt][1] = MFMA16(Kc[mt], Qf[1][ks], st[mt][1]);
                }
                __builtin_amdgcn_sched_barrier(0);
#pragma unroll
                for (int mt = 0; mt < 4; ++mt) Kc[mt] = Kn[mt];
            }
        }
        const int mtype = (cur == 0) ? 1 : ((cur == 4) ? 2 : 0);
        if (mtype != 0) {
#pragma unroll
            for (int mt = 0; mt < 4; ++mt)
#pragma unroll
                for (int nq = 0; nq < 2; ++nq)
#pragma unroll
                    for (int j = 0; j < 4; ++j) {
                        const int c = mt * 16 + fq * 4 + j, aq = qh * 32 + nq * 16 + fr;
                        const bool keep = (mtype == 1) ? (c >= aq) : (c <= aq);
                        if (!keep) st[mt][nq][j] = -1e30f;
                    }
        }
        bf16x8 Pf[2][2];
#pragma unroll
        for (int nq = 0; nq < 2; ++nq) {
            float mx = st[0][nq][0];
#pragma unroll
            for (int mt = 0; mt < 4; ++mt)
#pragma unroll
                for (int j = 0; j < 4; ++j) mx = fmaxf(mx, st[mt][nq][j]);
            mx = fmaxf(mx, shx(mx, 16, lane)); mx = fmaxf(mx, shx(mx, 32, lane));
            const bool upd = mx > mrun[nq] + 8.f;
            if (__builtin_amdgcn_ballot_w64(upd) != 0ull) {
                const float mn2 = upd ? mx : mrun[nq];
                const float al = __builtin_amdgcn_exp2f(mrun[nq] - mn2);
                mrun[nq] = mn2;
                lrun[nq] *= al;
#pragma unroll
                for (int i = 0; i < 8; ++i) ot[i][nq] *= al;
            }
            const float mn = mrun[nq];
            float ps = 0.f;
#pragma unroll
            for (int mt = 0; mt < 4; ++mt)
#pragma unroll
                for (int j = 0; j < 4; ++j) { const float pv = __builtin_amdgcn_exp2f(st[mt][nq][j] - mn); st[mt][nq][j] = pv; ps += pv; }
            lrun[nq] += ps;
#pragma unroll
            for (int k2 = 0; k2 < 2; ++k2)
                Pf[nq][k2] = mk8(pk2(st[2 * k2][nq][0], st[2 * k2][nq][1]), pk2(st[2 * k2][nq][2], st[2 * k2][nq][3]),
                                 pk2(st[2 * k2 + 1][nq][0], st[2 * k2 + 1][nq][1]), pk2(st[2 * k2 + 1][nq][2], st[2 * k2 + 1][nq][3]));
        }
        {
            uint2 va[4][2], vb[4][2];
#pragma unroll
            for (int i = 0; i < 4; ++i) { const unsigned char* vp = Vs + (i * 16 + fr) * AT_VSTR + (fq * 4) * 2; va[i][0] = *(const uint2*)vp; va[i][1] = *(const uint2*)(vp + 32); }
#pragma unroll
            for (int g = 0; g < 4; ++g) {
                if (g < 3) {
                    const int k2n = (g + 1) >> 1, mdn = ((g + 1) & 1) * 4;
#pragma unroll
                    for (int i = 0; i < 4; ++i) { const unsigned char* vp = Vs + ((mdn + i) * 16 + fr) * AT_VSTR + (k2n * 32 + fq * 4) * 2; vb[i][0] = *(const uint2*)vp; vb[i][1] = *(const uint2*)(vp + 32); }
                }
                __builtin_amdgcn_sched_barrier(0);
                const int k2 = g >> 1, md0 = (g & 1) * 4;
#pragma unroll
                for (int i = 0; i < 4; ++i) {
                    const bf16x8 Vf = mk8(va[i][0].x, va[i][0].y, va[i][1].x, va[i][1].y);
                    ot[md0 + i][0] = MFMA16(Vf, Pf[0][k2], ot[md0 + i][0]);
                    ot[md0 + i][1] = MFMA16(Vf, Pf[1][k2], ot[md0 + i][1]);
                }
                __builtin_amdgcn_sched_barrier(0);
#pragma unroll
                for (int i = 0; i < 4; ++i) { va[i][0] = vb[i][0]; va[i][1] = vb[i][1]; }
            }
        }
        if (nxt > 8) break;
        ti = nxt;
    }
#undef AT_LOAD
    const float sk = p.in[9][L * 8 + head] * 1.4426950408889634f;
#pragma unroll
    for (int nq = 0; nq < 2; ++nq) {
        float l = lrun[nq];
        l += shx(l, 16, lane); l += shx(l, 32, lane);
        const float mf = fmaxf(mrun[nq], sk);
        const float al = __builtin_amdgcn_exp2f(mrun[nq] - mf);
        const float lt = l * al + __builtin_amdgcn_exp2f(sk - mf);
        const float sc = al * rcpf_(lt);
        const int row = row0 + qh * 32 + nq * 16 + fr;
#pragma unroll
        for (int md = 0; md < 8; ++md) {
            const f32x4 o = ot[md][nq] * sc;
            uint2 pk; pk.x = pk2(o[0], o[1]); pk.y = pk2(o[2], o[3]);
            *(uint2*)(MIX + (size_t)row * D + head * 128 + md * 16 + fq * 4) = pk;
        }
    }
}

DEVI void gla_chunk_rows(int b, int ci, int& rowbase, int& tpos0) {
    if (ci < 4) { rowbase = NL + b * 256 + ci * 64; tpos0 = 4096 + ci * 64; } else { rowbase = b * 4096 + (ci - 4) * 64; tpos0 = (ci - 4) * 64; }
}
DEVI float logsig_fast(float z) { return fminf(z, 0.f) - __logf(1.f + __expf(-fabsf(z))); }
DEVI int scan_ci(int dir, int s) { return dir == 0 ? s : (s < 4 ? 3 - s : 71 - s); }

constexpr int GP_GZS = 0, GP_CUM = 8192, GP_TOT = 41472, GP_KT = 41984, GP_VT = 60416, GP_KSM = 78848, MX_TAB = 91648;
DEVI void gla_tables(const int tid_, const Params& p, int L, unsigned char* lds) {
    float* tab = (float*)(lds + MX_TAB);
    __syncthreads();
    for (int i = tid_; i < 8192; i += 512) tab[i] = p.in[10][(size_t)L * 8192 + i];
    tab[8192 + tid_] = p.in[11][L * 512 + tid_];
    __syncthreads();
}

DEVI void gla_p1_phase(const int tid_, const Params& p, int L, unsigned char* lds) {
    const bf16_t* Z = (const bf16_t*)(p.ws + WS_Z);
    const bf16_t* GVT = (const bf16_t*)(p.ws + WS_GVT);
    const float* GZ = (const float*)(p.ws + WS_GZ);
    float* gzs = (float*)(lds + GP_GZS); float* cum = (float*)(lds + GP_CUM); float* tot = (float*)(lds + GP_TOT);
    bf16_t* kT = (bf16_t*)(lds + GP_KT); unsigned char* vts = lds + GP_VT; bf16_t* ksm = (bf16_t*)(lds + GP_KSM);
    const float* tab = (const float*)(lds + MX_TAB);
    const int tid = tid_, w = tid >> 6, lane = tid & 63, fr = lane & 15, fq = lane >> 4;
    const int t = tid >> 3, d0 = (tid & 7) * 8;
    gla_tables(tid_, p, L, lds);
    const int nun = NB * 4 * NCH;
    uint4 pgz, pk, pv0, pv1;
#define G1_PREF(uu) do { const int ci_ = (uu) % NCH, bh_ = (uu) / NCH; int rb_, tp_; gla_chunk_rows(bh_ >> 2, ci_, rb_, tp_); \
    pgz = *(const uint4*)(GZ + (size_t)(rb_ + t) * 32 + (tid & 7) * 4); \
    pk = *(const uint4*)(Z + (size_t)(rb_ + t) * ZLD + ZGK + (bh_ & 3) * 64 + d0); \
    pv0 = *(const uint4*)(GVT + ((size_t)(bh_ * 128 + (tid >> 3))) * TT + tp_ + (tid & 7) * 8); \
    pv1 = *(const uint4*)(GVT + ((size_t)(bh_ * 128 + 64 + (tid >> 3))) * TT + tp_ + (tid & 7) * 8); } while (0)
    int u = blockIdx.x;
    if (u < nun) G1_PREF(u);
    for (; u < nun; u += gridDim.x) {
        const int ci = u % NCH, bh = u / NCH, h = bh & 3;
        lds_sync();
        {
            const int r0 = (tid & 7) * 4;
            gzs[(r0 + 0) * 64 + t] = __uint_as_float(pgz.x); gzs[(r0 + 1) * 64 + t] = __uint_as_float(pgz.y);
            gzs[(r0 + 2) * 64 + t] = __uint_as_float(pgz.z); gzs[(r0 + 3) * 64 + t] = __uint_as_float(pgz.w);
        }
        *(uint4*)(vts + (tid >> 3) * 144 + (tid & 7) * 16) = pv0;
        *(uint4*)(vts + (64 + (tid >> 3)) * 144 + (tid & 7) * 16) = pv1;
        *(uint4*)((unsigned char*)ksm + t * 144 + d0 * 2) = pk;
        lds_sync();
        if (u + (int)gridDim.x < nun) G1_PREF(u + (int)gridDim.x);
#pragma unroll
        for (int dir = 0; dir < 2; ++dir) {
            float z[8];
#pragma unroll
            for (int i = 0; i < 8; ++i) z[i] = tab[8192 + dir * 256 + h * 64 + d0 + i];
#pragma unroll
            for (int r = 0; r < 16; ++r) {
                const float g = gzs[(dir * 16 + r) * 64 + t];
                const float4 w0 = *(const float4*)(tab + (dir * 16 + r) * 256 + h * 64 + d0), w1 = *(const float4*)(tab + (dir * 16 + r) * 256 + h * 64 + d0 + 4);
                z[0] += g * w0.x; z[1] += g * w0.y; z[2] += g * w0.z; z[3] += g * w0.w; z[4] += g * w1.x; z[5] += g * w1.y; z[6] += g * w1.z; z[7] += g * w1.w;
            }
#pragma unroll
            for (int i = 0; i < 8; ++i) cum[(dir * 64 + t) * 65 + d0 + i] = logsig_fast(z[i]) * (1.f / 16.f);
        }
        lds_sync();
        if (tid < 128) {
            const int dir = tid >> 6, d = tid & 63;
            float vv[64];
#pragma unroll
            for (int s2 = 0; s2 < 64; ++s2) vv[s2] = cum[(dir * 64 + (dir ? 63 - s2 : s2)) * 65 + d];
            float a = 0.f;
#pragma unroll
            for (int s2 = 0; s2 < 64; ++s2) { a += vv[s2]; vv[s2] = a; }
#pragma unroll
            for (int s2 = 0; s2 < 64; ++s2) cum[(dir * 64 + (dir ? 63 - s2 : s2)) * 65 + d] = vv[s2];
            tot[tid] = a;
        }
        lds_sync();
        {
            float* CG = (float*)(p.ws + WS_CUMG) + ((size_t)u * 2) * 4096;
#pragma unroll
            for (int dir = 0; dir < 2; ++dir) {
                const float tt = tot[dir * 64 + lane];
                float kd[8];
#pragma unroll
                for (int i = 0; i < 8; ++i) {
                    const int ti = w * 8 + i;
                    const float cv = cum[(dir * 64 + ti) * 65 + lane];
                    kd[i] = bf2f(ksm[ti * 72 + lane]) * __expf(tt - cv);
                    CG[(size_t)dir * 4096 + ti * 64 + lane] = cv;
                }
                uint4 o; o.x = pk2(kd[0], kd[1]); o.y = pk2(kd[2], kd[3]); o.z = pk2(kd[4], kd[5]); o.w = pk2(kd[6], kd[7]);
                *(uint4*)((unsigned char*)kT + ((dir * 64 + lane) * 72 + w * 8) * 2) = o;
            }
        }
        lds_sync();
        {
            const bf16x8 Af0 = *(const bf16x8*)(vts + (w * 16 + fr) * 144 + (fq * 8) * 2);
            const bf16x8 Af1 = *(const bf16x8*)(vts + (w * 16 + fr) * 144 + (32 + fq * 8) * 2);
#pragma unroll
            for (int dir = 0; dir < 2; ++dir) {
                f32x4 acc[4];
#pragma unroll
                for (int n = 0; n < 4; ++n) {
                    acc[n] = (f32x4){0.f, 0.f, 0.f, 0.f};
                    const bf16x8 Bf0 = *(const bf16x8*)((const unsigned char*)kT + ((dir * 64 + n * 16 + fr) * 72 + fq * 8) * 2);
                    const bf16x8 Bf1 = *(const bf16x8*)((const unsigned char*)kT + ((dir * 64 + n * 16 + fr) * 72 + 32 + fq * 8) * 2);
                    acc[n] = MFMA16(Af0, Bf0, acc[n]);
                    acc[n] = MFMA16(Af1, Bf1, acc[n]);
                }
                const int sq = bh * 2 + dir;
                float* CT = (float*)(p.ws + WS_CONTRIB) + ((size_t)(sq * NCH + ci)) * 8192;
#pragma unroll
                for (int n = 0; n < 4; ++n)
#pragma unroll
                    for (int j = 0; j < 4; ++j) CT[(w * 16 + fq * 4 + j) * 64 + n * 16 + fr] = acc[n][j];
            }
            if (tid < 128) { const int dir = tid >> 6, d = tid & 63; ((float*)(p.ws + WS_ATOT))[((size_t)((bh * 2 + dir) * NCH + ci)) * 64 + d] = __expf(tot[tid]); }
        }
    }
#undef G1_PREF
}

DEVI void gla_scan(const int tid_, const Params& p) {
    const float* __restrict__ CT = (const float*)(p.ws + WS_CONTRIB);
    const float* __restrict__ AT = (const float*)(p.ws + WS_ATOT);
    unsigned* __restrict__ SB = (unsigned*)(p.ws + WS_SBEF);
    for (int idx = blockIdx.x * 512 + tid_; idx < 32 * 128 * 32; idx += gridDim.x * 512) {
        const int dp = idx & 31, dv = (idx >> 5) & 127, sq = idx >> 12, dir = sq & 1;
        const float* ctp = CT + (size_t)sq * NCH * 8192 + dv * 64 + dp * 2;
        const float* atp = AT + (size_t)sq * NCH * 64 + dp * 2;
        unsigned* sbp = SB + (size_t)sq * NCH * 4096 + dv * 32 + dp;
        float s0 = 0.f, s1 = 0.f;
        float2 c[4], a[4], cn[4], an[4];
#pragma unroll
        for (int q = 0; q < 4; ++q) { const int ci = scan_ci(dir, q); c[q] = *(const float2*)(ctp + (size_t)ci * 8192); a[q] = *(const float2*)(atp + (size_t)ci * 64); }
#pragma unroll 1
        for (int s = 0; s < NCH; s += 4) {
            if (s + 4 < NCH) {
#pragma unroll
                for (int q = 0; q < 4; ++q) { const int ci = scan_ci(dir, s + 4 + q); cn[q] = *(const float2*)(ctp + (size_t)ci * 8192); an[q] = *(const float2*)(atp + (size_t)ci * 64); }
            }
#pragma unroll
            for (int q = 0; q < 4; ++q) {
                const int ci = scan_ci(dir, s + q);
                sbp[(size_t)ci * 4096] = pk2(s0, s1);
                s0 = a[q].x * s0 + c[q].x; s1 = a[q].y * s1 + c[q].y;
            }
#pragma unroll
            for (int q = 0; q < 4; ++q) { c[q] = cn[q]; a[q] = an[q]; }
        }
    }
}

constexpr int G3_QS = 0, G3_KS = 18432, G3_SS = 36864, G3_VT = 73728, G3_PART = 92160, G3_OB = 92672;
DEVI void gla_p3_phase(const int tid_, const Params& p, int L, unsigned char* lds) {
    const bf16_t* Z = (const bf16_t*)(p.ws + WS_Z);
    const bf16_t* GVT = (const bf16_t*)(p.ws + WS_GVT);
    const float* CUMG = (const float*)(p.ws + WS_CUMG);
    const bf16_t* SBEF = (const bf16_t*)(p.ws + WS_SBEF);
    bf16_t* MIX = (bf16_t*)(p.ws + WS_MIX);
    unsigned char* qs = lds + G3_QS; unsigned char* ks = lds + G3_KS; unsigned char* ss = lds + G3_SS; unsigned char* vts = lds + G3_VT;
    float* part = (float*)(lds + G3_PART); float* ob = (float*)(lds + G3_OB);
    const int tid = tid_, w = tid >> 6, lane = tid & 63, fr = lane & 15, fq = lane >> 4;
    const int ntl = w & 3, dvh = w >> 2;
    const int t = tid >> 3, d0 = (tid & 7) * 8, dv0 = (tid & 7) * 16;
    const int cfirst = (L == 0) ? 0 : 4, ncl = NCH - cfirst, nun = NB * 4 * ncl;
    uint4 pq, pk, psf0, psf1, psb0, psb1, pv0, pv1, pg0, pg1;
    float4 pcf0, pcf1, pcb0, pcb1;
#define G3_PREF(uu) do { const int ci_ = cfirst + (uu) % ncl, bh_ = (uu) / ncl; int rb_, tp_; gla_chunk_rows(bh_ >> 2, ci_, rb_, tp_); \
    const size_t u1_ = (size_t)bh_ * NCH + ci_; \
    pq = *(const uint4*)(Z + (size_t)(rb_ + t) * ZLD + ZGQ + (bh_ & 3) * 64 + d0); \
    pk = *(const uint4*)(Z + (size_t)(rb_ + t) * ZLD + ZGK + (bh_ & 3) * 64 + d0); \
    pcf0 = *(const float4*)(CUMG + (u1_ * 2) * 4096 + t * 64 + d0); pcf1 = *(const float4*)(CUMG + (u1_ * 2) * 4096 + t * 64 + d0 + 4); \
    pcb0 = *(const float4*)(CUMG + (u1_ * 2 + 1) * 4096 + t * 64 + d0); pcb1 = *(const float4*)(CUMG + (u1_ * 2 + 1) * 4096 + t * 64 + d0 + 4); \
    { const bf16_t* sf_ = SBEF + ((size_t)((bh_ * 2) * NCH + ci_)) * 8192; const bf16_t* sb_ = SBEF + ((size_t)((bh_ * 2 + 1) * NCH + ci_)) * 8192; \
      psf0 = *(const uint4*)(sf_ + tid * 8); psf1 = *(const uint4*)(sf_ + 4096 + tid * 8); psb0 = *(const uint4*)(sb_ + tid * 8); psb1 = *(const uint4*)(sb_ + 4096 + tid * 8); } \
    pv0 = *(const uint4*)(GVT + ((size_t)(bh_ * 128 + (tid >> 3))) * TT + tp_ + (tid & 7) * 8); \
    pv1 = *(const uint4*)(GVT + ((size_t)(bh_ * 128 + 64 + (tid >> 3))) * TT + tp_ + (tid & 7) * 8); \
    pg0 = *(const uint4*)(Z + (size_t)(rb_ + t) * ZLD + ZGR + (bh_ & 3) * 128 + dv0); \
    pg1 = *(const uint4*)(Z + (size_t)(rb_ + t) * ZLD + ZGR + (bh_ & 3) * 128 + dv0 + 8); } while (0)
    int u = blockIdx.x;
    if (u < nun) G3_PREF(u);
    for (; u < nun; u += gridDim.x) {
        const int ci = cfirst + u % ncl, bh = u / ncl, h = bh & 3;
        int rowbase, tpos0; gla_chunk_rows(bh >> 2, ci, rowbase, tpos0);
        lds_sync();
        {
            const unsigned qw[4] = {pq.x, pq.y, pq.z, pq.w}, kw[4] = {pk.x, pk.y, pk.z, pk.w};
            const float cf[8] = {pcf0.x, pcf0.y, pcf0.z, pcf0.w, pcf1.x, pcf1.y, pcf1.z, pcf1.w};
            const float cb[8] = {pcb0.x, pcb0.y, pcb0.z, pcb0.w, pcb1.x, pcb1.y, pcb1.z, pcb1.w};
#pragma unroll
            for (int dir = 0; dir < 2; ++dir) {
                unsigned qo[4], ko[4];
#pragma unroll
                for (int i = 0; i < 4; ++i) {
                    const float c0 = dir ? cb[2 * i] : cf[2 * i], c1 = dir ? cb[2 * i + 1] : cf[2 * i + 1];
                    qo[i] = pk2(bflo(qw[i]) * 0.125f * __expf(c0), bfhi(qw[i]) * 0.125f * __expf(c1));
                    ko[i] = pk2(bflo(kw[i]) * __expf(fminf(-c0, 80.f)), bfhi(kw[i]) * __expf(fminf(-c1, 80.f)));
                }
                uint4 t4; t4.x = qo[0]; t4.y = qo[1]; t4.z = qo[2]; t4.w = qo[3];
                *(uint4*)(qs + (dir * 64 + t) * 144 + d0 * 2) = t4;
                t4.x = ko[0]; t4.y = ko[1]; t4.z = ko[2]; t4.w = ko[3];
                *(uint4*)(ks + (dir * 64 + t) * 144 + d0 * 2) = t4;
            }
            *(uint4*)(ss + (tid >> 3) * 144 + (tid & 7) * 16) = psf0;
            *(uint4*)(ss + (64 + (tid >> 3)) * 144 + (tid & 7) * 16) = psf1;
            *(uint4*)(ss + (128 + (tid >> 3)) * 144 + (tid & 7) * 16) = psb0;
            *(uint4*)(ss + (192 + (tid >> 3)) * 144 + (tid & 7) * 16) = psb1;
            *(uint4*)(vts + (tid >> 3) * 144 + (tid & 7) * 16) = pv0;
            *(uint4*)(vts + (64 + (tid >> 3)) * 144 + (tid & 7) * 16) = pv1;
        }
        const uint4 gr0 = pg0, gr1 = pg1;
        lds_sync();
        if (u + (int)gridDim.x < nun) G3_PREF(u + (int)gridDim.x);
        f32x4 oacc[4];
#pragma unroll
        for (int i = 0; i < 4; ++i) oacc[i] = (f32x4){0.f, 0.f, 0.f, 0.f};
#pragma unroll
        for (int dir = 0; dir < 2; ++dir) {
            bf16x8 Bq[2];
            f32x4 at[4];
#pragma unroll
            for (int m = 0; m < 4; ++m) at[m] = (f32x4){0.f, 0.f, 0.f, 0.f};
#pragma unroll
            for (int k_ = 0; k_ < 2; ++k_) {
                Bq[k_] = *(const bf16x8*)(qs + (dir * 64 + ntl * 16 + fr) * 144 + (k_ * 32 + fq * 8) * 2);
#pragma unroll
                for (int m = 0; m < 4; ++m) {
                    const bf16x8 Ak = *(const bf16x8*)(ks + (dir * 64 + m * 16 + fr) * 144 + (k_ * 32 + fq * 8) * 2);
                    at[m] = MFMA16(Ak, Bq[k_], at[m]);
                }
            }
            {
                const int tq = ntl * 16 + fr;
#pragma unroll
                for (int m = 0; m < 4; ++m)
#pragma unroll
                    for (int j = 0; j < 4; ++j) {
                        const int s = m * 16 + fq * 4 + j;
                        const bool keep = dir == 0 ? (s <= tq) : (s >= tq);
                        if (!keep) at[m][j] = 0.f;
                    }
            }
#pragma unroll
            for (int k2 = 0; k2 < 2; ++k2) {
                const bf16x8 Pf = mk8(pk2(at[2 * k2][0], at[2 * k2][1]), pk2(at[2 * k2][2], at[2 * k2][3]),
                                      pk2(at[2 * k2 + 1][0], at[2 * k2 + 1][1]), pk2(at[2 * k2 + 1][2], at[2 * k2 + 1][3]));
#pragma unroll
                for (int md = 0; md < 4; ++md) {
                    const unsigned char* vp = vts + (dvh * 64 + md * 16 + fr) * 144 + (k2 * 32 + fq * 4) * 2;
                    const uint2 v0 = *(const uint2*)vp, v1 = *(const uint2*)(vp + 32);
                    oacc[md] = MFMA16(mk8(v0.x, v0.y, v1.x, v1.y), Pf, oacc[md]);
                }
            }
#pragma unroll
            for (int k_ = 0; k_ < 2; ++k_)
#pragma unroll
                for (int md = 0; md < 4; ++md) {
                    const bf16x8 As = *(const bf16x8*)(ss + (dir * 128 + dvh * 64 + md * 16 + fr) * 144 + (k_ * 32 + fq * 8) * 2);
                    oacc[md] = MFMA16(As, Bq[k_], oacc[md]);
                }
        }
        float sq = 0.f;
#pragma unroll
        for (int md = 0; md < 4; ++md)
#pragma unroll
            for (int j = 0; j < 4; ++j) sq += oacc[md][j] * oacc[md][j];
        sq += shx(sq, 16, lane); sq += shx(sq, 32, lane);
        if (fq == 0) part[w * 16 + fr] = sq;
        lds_sync();
        {
            const float tot2 = part[ntl * 16 + fr] + part[(ntl + 4) * 16 + fr];
            const float rstd = rsqrtf(tot2 * (1.f / 128.f) + 1e-6f);
#pragma unroll
            for (int md = 0; md < 4; ++md)
#pragma unroll
                for (int j = 0; j < 4; ++j) ob[(ntl * 16 + fr) * 132 + dvh * 64 + md * 16 + fq * 4 + j] = oacc[md][j] * rstd;
        }
        lds_sync();
        {
            const float* gn = p.in[12] + L * 128;
            const unsigned rw[8] = {gr0.x, gr0.y, gr0.z, gr0.w, gr1.x, gr1.y, gr1.z, gr1.w};
            unsigned o[8];
#pragma unroll
            for (int i4 = 0; i4 < 4; ++i4) {
                const float4 ov = *(const float4*)(ob + t * 132 + dv0 + 4 * i4), gv = *(const float4*)(gn + dv0 + 4 * i4);
                o[2 * i4] = pk2(ov.x * gv.x * siluf_(bflo(rw[2 * i4])), ov.y * gv.y * siluf_(bfhi(rw[2 * i4])));
                o[2 * i4 + 1] = pk2(ov.z * gv.z * siluf_(bflo(rw[2 * i4 + 1])), ov.w * gv.w * siluf_(bfhi(rw[2 * i4 + 1])));
            }
            uint4 a4; a4.x = o[0]; a4.y = o[1]; a4.z = o[2]; a4.w = o[3];
            uint4 b4; b4.x = o[4]; b4.y = o[5]; b4.z = o[6]; b4.w = o[7];
            bf16_t* dst = MIX + (size_t)(rowbase + t) * D + 1024 + h * 128 + dv0;
            *(uint4*)dst = a4; *(uint4*)(dst + 8) = b4;
        }
    }
#undef G3_PREF
}

constexpr int LR_XCF = 17152, LR_XCB = 34560, LR_OUTB = 43776;
template <int CTRL> DEVI float dppf(float oldv, float v) { return __int_as_float(__builtin_amdgcn_update_dpp(__float_as_int(oldv), __float_as_int(v), CTRL, 0xf, 0xf, false)); }
template <int DIR> DEVI void lru_tile_scan(float& A, float& B) {
    constexpr int base = DIR ? 0x100 : 0x110;
    { const float A2 = dppf<base | 1>(1.f, A), B2 = dppf<base | 1>(0.f, B); B = A * B2 + B; A = A * A2; }
    { const float A2 = dppf<base | 2>(1.f, A), B2 = dppf<base | 2>(0.f, B); B = A * B2 + B; A = A * A2; }
    { const float A2 = dppf<base | 4>(1.f, A), B2 = dppf<base | 4>(0.f, B); B = A * B2 + B; A = A * A2; }
    { const float A2 = dppf<base | 8>(1.f, A), B2 = dppf<base | 8>(0.f, B); B = A * B2 + B; A = A * A2; }
}
template <int PASS, int DIR>
DEVI void lru_wave_scan(const float (&av)[4][4], const float (&uv)[4][4], const float carry, int lane, int fr, int cb, int fq,
                        float* outb, float* la_out, float* lb_out) {
    float hin = (PASS == 3) ? carry : 0.f, pin = 1.f;
    const int l1 = DIR ? lane + 16 : lane - 16, l2 = DIR ? lane + 32 : lane - 32;
    const bool ok1 = DIR ? (fq <= 2) : (fq >= 1), ok2 = DIR ? (fq <= 1) : (fq >= 2);
    const int lend = DIR ? fr : 48 + fr;
#pragma unroll
    for (int mi = 0; mi < 4; ++mi) {
        const int m = DIR ? 3 - mi : mi;
        float Aj[4], Bj[4];
        float A = 1.f, B = 0.f;
#pragma unroll
        for (int jj = 0; jj < 4; ++jj) {
            const int j = DIR ? 3 - jj : jj;
            B = av[m][j] * B + uv[m][j]; A = A * av[m][j];
            Aj[j] = A; Bj[j] = B;
        }
        float Ai = A, Bi = B;
        { const float A2 = shidx(Ai, l1 & 63), B2 = shidx(Bi, l1 & 63); if (ok1) { Bi = Ai * B2 + Bi; Ai = Ai * A2; } }
        { const float A2 = shidx(Ai, l2 & 63), B2 = shidx(Bi, l2 & 63); if (ok2) { Bi = Ai * B2 + Bi; Ai = Ai * A2; } }
        float Ae = shidx(Ai, l1 & 63), Be = shidx(Bi, l1 & 63);
        if (!ok1) { Ae = 1.f; Be = 0.f; }
        const float hlane = Be + Ae * hin;
#pragma unroll
        for (int j = 0; j < 4; ++j) {
            const float hf = Bj[j] + Aj[j] * hlane;
            if (PASS == 3) outb[(DIR * 64 + m * 16 + fq * 4 + j) * 65 + cb * 16 + fr] = hf;
        }
        const float hend = Bi + Ai * hin;
        hin = shidx(hend, lend);
        if (PASS == 1) pin = shidx(Ai * pin, lend);
    }
    if (PASS == 1 && fq == 0) { la_out[fr] = pin; lb_out[fr] = hin; }
}

template <int PASS>
DEVI void lru_phase(const int tid_, const Params& p, int L, unsigned char* lds) {
    const bf16_t* Z = (const bf16_t*)(p.ws + WS_Z);
    float* xs = (float*)lds; float* xcf = (float*)(lds + LR_XCF); unsigned char* xcb = lds + LR_XCB; float* outb = (float*)(lds + LR_OUTB);
    float* tab = (float*)(lds + MX_TAB);
    const int tid = tid_, w = tid >> 6, lane = tid & 63, fr = lane & 15, fq = lane >> 4;
    const int dir = w >> 2, cb = w & 3;
    const int t = tid >> 3, c0 = (tid & 7) * 8;
    const int cfirst = (PASS == 3 && L == 1) ? 4 : 0, ncl = NCH - cfirst, nun = NB * ncl * 8;
    __syncthreads();
    for (int i = tid; i < 2048; i += 512) tab[i] = p.in[13][(size_t)L * 2048 + i];
    tab[2048 + tid] = p.in[14][L * 512 + tid];
    for (int i = tid; i < 1024; i += 512) {
        tab[2560 + i] = p.in[16][L * 1024 + i]; tab[3584 + i] = p.in[18][L * 1024 + i];
        tab[4608 + i] = -8.f * log1pf(expf(-p.in[19][L * 1024 + i]));
    }
    __syncthreads();
    uint4 px0, px1, plg;
    float pcar = 0.f;
#define LR_DEC(uu, blk_, ci_, b_) const int blk_ = (uu) & 7, ci_ = cfirst + ((uu) >> 3) % ncl, b_ = ((uu) >> 3) / ncl
#define LR_PREF(uu) do { LR_DEC(uu, blk_, ci_, b_); int sr_, sl_, t0_; \
    if (ci_ < 4) { sr_ = NL + b_ * 256; sl_ = 256; t0_ = ci_ * 64; } else { sr_ = b_ * 4096; sl_ = 4096; t0_ = (ci_ - 4) * 64; } \
    { const int tm_ = t0_ - 2 + (tid >> 3); px0 = (tm_ >= 0 && tm_ < sl_) ? *(const uint4*)(Z + (size_t)(sr_ + tm_) * ZLD + ZLX + blk_ * 64 + (tid & 7) * 8) : make_uint4(0u, 0u, 0u, 0u); } \
    { const int tm_ = t0_ - 2 + 64 + (tid >> 3); px1 = (tid < 24 && tm_ < sl_) ? *(const uint4*)(Z + (size_t)(sr_ + tm_) * ZLD + ZLX + blk_ * 64 + (tid & 7) * 8) : make_uint4(0u, 0u, 0u, 0u); } \
    if (PASS == 3) { plg = *(const uint4*)(Z + (size_t)(sr_ + t0_ + t) * ZLD + ZLG + blk_ * 64 + c0); \
        pcar = ((const float*)(p.ws + WS_LRUC))[((size_t)((b_ * NCH + ci_) * 2 + dir)) * 512 + blk_ * 64 + cb * 16 + fr]; } } while (0)
    int u = blockIdx.x;
    if (u < nun) LR_PREF(u);
    for (; u < nun; u += gridDim.x) {
        LR_DEC(u, blk, ci, b);
        const int rowbase = (ci < 4) ? NL + b * 256 + ci * 64 : b * 4096 + (ci - 4) * 64;
        lds_sync();
        {
            float4 f0, f1;
            f0.x = bflo(px0.x); f0.y = bfhi(px0.x); f0.z = bflo(px0.y); f0.w = bfhi(px0.y); f1.x = bflo(px0.z); f1.y = bfhi(px0.z); f1.z = bflo(px0.w); f1.w = bfhi(px0.w);
            *(float4*)(xs + (tid >> 3) * 64 + (tid & 7) * 8) = f0; *(float4*)(xs + (tid >> 3) * 64 + (tid & 7) * 8 + 4) = f1;
            if (tid < 24) {
                f0.x = bflo(px1.x); f0.y = bfhi(px1.x); f0.z = bflo(px1.y); f0.w = bfhi(px1.y); f1.x = bflo(px1.z); f1.y = bfhi(px1.z); f1.z = bflo(px1.w); f1.w = bfhi(px1.w);
                *(float4*)(xs + (64 + (tid >> 3)) * 64 + (tid & 7) * 8) = f0; *(float4*)(xs + (64 + (tid >> 3)) * 64 + (tid & 7) * 8 + 4) = f1;
            }
        }
        const uint4 lgc = plg;
        const float carry = pcar;
        const bf16_t* WT = (const bf16_t*)(p.ws + WS_LRUWT) + (size_t)(L * 8 + blk) * 256 * 64;
        bf16x8 Bw[2][2];
#pragma unroll
        for (int g = 0; g < 2; ++g)
#pragma unroll
            for (int ks = 0; ks < 2; ++ks)
                Bw[g][ks] = *(const bf16x8*)(WT + (size_t)(((dir * 2 + g) * 4 + cb) * 16 + fr) * 64 + ks * 32 + fq * 8);
        lds_sync();
        if (u + (int)gridDim.x < nun) LR_PREF(u + (int)gridDim.x);
        {
            const int ch = blk * 64 + lane;
            float xr[11];
#pragma unroll
            for (int k = 0; k < 11; ++k) xr[k] = xs[(w * 8 + k) * 64 + lane];
            const float cw0 = tab[ch], cw1 = tab[512 + ch], cw2 = tab[1024 + ch], cw3 = tab[1536 + ch], cbv = tab[2048 + ch];
#pragma unroll
            for (int i = 0; i < 8; ++i) {
                const float y = cbv + xr[i] * cw0 + xr[i + 1] * cw1 + xr[i + 2] * cw2 + xr[i + 3] * cw3;
                xcf[(w * 8 + i) * 68 + lane] = y;
                ((bf16_t*)xcb)[(w * 8 + i) * 72 + lane] = f2bf(y);
            }
        }
        lds_sync();
        float av[4][4], uv[4][4];
        {
            f32x4 ga[4], gx[4];
#pragma unroll
            for (int m = 0; m < 4; ++m) { ga[m] = (f32x4){0.f, 0.f, 0.f, 0.f}; gx[m] = (f32x4){0.f, 0.f, 0.f, 0.f}; }
#pragma unroll
            for (int ks = 0; ks < 2; ++ks)
#pragma unroll
                for (int m = 0; m < 4; ++m) {
                    const bf16x8 Af = *(const bf16x8*)(xcb + (m * 16 + fr) * 144 + (ks * 32 + fq * 8) * 2);
                    ga[m] = MFMA16(Af, Bw[0][ks], ga[m]);
                    gx[m] = MFMA16(Af, Bw[1][ks], gx[m]);
                }
            const int ch = blk * 64 + cb * 16 + fr;
            const float bal = tab[2560 + dir * 512 + ch], bxl = tab[3584 + dir * 512 + ch], cfl = tab[4608 + dir * 512 + ch];
#pragma unroll
            for (int m = 0; m < 4; ++m)
#pragma unroll
                for (int j = 0; j < 4; ++j) {
                    const float xl = xcf[(m * 16 + fq * 4 + j) * 68 + cb * 16 + fr];
                    const float la = cfl * sigmoidf_(ga[m][j] + bal);
                    const float a = __expf(la);
                    const float om = __builtin_fmaf(-a, a, 1.f);
                    av[m][j] = a;
                    uv[m][j] = __builtin_amdgcn_sqrtf(om) * sigmoidf_(gx[m][j] + bxl) * xl;
                }
        }
        {
            const size_t sbase = ((size_t)((b * NCH + ci) * 2 + dir)) * 512 + blk * 64 + cb * 16;
            float* la_out = (float*)(p.ws + WS_LRUA) + sbase; float* lb_out = (float*)(p.ws + WS_LRUB) + sbase;
            if (dir == 0) lru_wave_scan<PASS, 0>(av, uv, carry, lane, fr, cb, fq, outb, la_out, lb_out);
            else lru_wave_scan<PASS, 1>(av, uv, carry, lane, fr, cb, fq, outb, la_out, lb_out);
        }
        if (PASS == 3) {
            lds_sync();
            const unsigned lw[4] = {lgc.x, lgc.y, lgc.z, lgc.w};
            unsigned o[4];
#pragma unroll
            for (int i = 0; i < 4; ++i) {
                const float h0 = outb[t * 65 + c0 + 2 * i] + outb[(64 + t) * 65 + c0 + 2 * i];
                const float h1 = outb[t * 65 + c0 + 2 * i + 1] + outb[(64 + t) * 65 + c0 + 2 * i + 1];
                o[i] = pk2(h0 * gelu_tanh(bflo(lw[i])), h1 * gelu_tanh(bfhi(lw[i])));
            }
            uint4 o4; o4.x = o[0]; o4.y = o[1]; o4.z = o[2]; o4.w = o[3];
            *(uint4*)((bf16_t*)(p.ws + WS_MIX) + (size_t)(rowbase + t) * D + 1536 + blk * 64 + c0) = o4;
        }
    }
#undef LR_PREF
#undef LR_DEC
}

DEVI void lru_carry_scan(const int tid_, const Params& p) {
    const float* __restrict__ LA = (const float*)(p.ws + WS_LRUA);
    const float* __restrict__ LB = (const float*)(p.ws + WS_LRUB);
    float* __restrict__ LC = (float*)(p.ws + WS_LRUC);
    for (int idx = blockIdx.x * 512 + tid_; idx < 4096; idx += gridDim.x * 512) {
        const int ch = idx & 511, dir = (idx >> 9) & 1, b = idx >> 10;
        float hc = 0.f;
#pragma unroll 1
        for (int s = 0; s < NCH; s += 4) {
            float a[4], bb[4];
#pragma unroll
            for (int q = 0; q < 4; ++q) {
                const size_t si = ((size_t)((b * NCH + scan_ci(dir, s + q)) * 2 + dir)) * 512 + ch;
                a[q] = LA[si]; bb[q] = LB[si];
            }
#pragma unroll
            for (int q = 0; q < 4; ++q) {
                const size_t si = ((size_t)((b * NCH + scan_ci(dir, s + q)) * 2 + dir)) * 512 + ch;
                LC[si] = hc;
                hc = a[q] * hc + bb[q];
            }
        }
    }
}

DEVI void phase_mix_a(const int tid_, const Params& p, int L, unsigned char* lds) {
    const int na = (L == 0) ? 544 : 512;
    PROF_B(10, lds, tid_ == 0);
#pragma unroll 1
    for (int rep = 0; rep < ((REP_SUB == 100 && L == 0) ? 2 : 1); ++rep)
        for (int a = blockIdx.x; a < na; a += gridDim.x) attn_unit(tid_, p, L, a, lds);
    PROF_E(10, lds, tid_ == 0);
    PROF_B(12, lds, tid_ == 0);
    gla_p1_phase(tid_, p, L, lds);
    PROF_E(12, lds, tid_ == 0);
    if (REP_SUB == 101 && L == 0) gla_p1_phase(tid_, p, L, lds);
    PROF_B(13, lds, tid_ == 0);
    lru_phase<1>(tid_, p, L, lds);
    PROF_E(13, lds, tid_ == 0);
    if (REP_SUB == 102 && L == 0) lru_phase<1>(tid_, p, L, lds);
}
DEVI void phase_mix_b(const int tid_, const Params& p) { gla_scan(tid_, p); lru_carry_scan(tid_, p); }
DEVI void phase_mix_c(const int tid_, const Params& p, int L, unsigned char* lds) {
    PROF_B(14, lds, tid_ == 0);
    gla_p3_phase(tid_, p, L, lds);
    PROF_E(14, lds, tid_ == 0);
    if (REP_SUB == 103 && L == 0) gla_p3_phase(tid_, p, L, lds);
    PROF_B(15, lds, tid_ == 0);
    lru_phase<3>(tid_, p, L, lds);
    PROF_E(15, lds, tid_ == 0);
    if (REP_SUB == 104 && L == 0) lru_phase<3>(tid_, p, L, lds);
}

DEVI void phase_norm2(const int tid_, const Params& p, int L, unsigned char* lds, bool dry = false) {
    const int nrows = (L == 0) ? NT : NL;
    const int tid = tid_, w = tid >> 6, lane = tid & 63, fr = lane & 15, fq = lane >> 4;
    const float* H = (const float*)(p.ws + WS_H);
    bf16_t* U = (bf16_t*)(p.ws + WS_U);
    const float* mods = (const float*)(p.ws + WS_MODS);
    const float* gffn = p.in[7] + L * 2048;
    const bf16_t* WR = (const bf16_t*)(p.ws + WS_WRT) + (size_t)L * 48 * 2048;
    unsigned char* vt = lds;
    float* part = (float*)(lds + 65792);
    float* lgt = (float*)(lds + 65792 + 24576);
    unsigned* cnt = (unsigned*)(p.ws + WS_CTL) + (dry ? 8192 : CTL_COUNT) + L * 32;
    int* tokl = (int*)(p.ws + (dry ? WS_END : WS_TOKL));
    float* gatel = (float*)(p.ws + (dry ? WS_END + (size_t)32 * TOKCAP * 4 : WS_GATEL));
    unsigned char* wr2 = lds + 93440;
    __syncthreads();
#pragma unroll
    for (int i = 0; i < 2; ++i) { const int ch = tid + 512 * i; *(uint4*)(wr2 + ch * 16) = *(const uint4*)(WR + (size_t)32 * 2048 + ch * 8); }
    __syncthreads();
    bf16x8 Bf[8][2];
#pragma unroll
    for (int kk = 0; kk < 8; ++kk)
#pragma unroll
        for (int n = 0; n < 2; ++n) Bf[kk][n] = *(const bf16x8*)(WR + (size_t)(n * 16 + fr) * 2048 + w * 256 + kk * 32 + fq * 8);
    int* dec = (int*)(lds + 109824);
    int* lcnt = (int*)(lds + 109824 + 128 * 32);
    if (tid < 64) lcnt[tid] = 0;
    __syncthreads();
    int nloc = 0;
    float4 ha[8], hb[8];
    const int nit = nrows / 16;
    int it = blockIdx.x;
    if (it < nit) {
#pragma unroll
        for (int c = 0; c < 8; ++c) { ha[c] = *(const float4*)(H + (size_t)(it * 16 + w * 2) * D + c * 256 + lane * 4); hb[c] = *(const float4*)(H + (size_t)(it * 16 + w * 2 + 1) * D + c * 256 + lane * 4); }
    }
    for (; it < nit; it += gridDim.x) {
        lds_sync();
#define N2_ROW(hx, rr) do { \
            const int lr = w * 2 + (rr), row = it * 16 + lr; \
            const int mrow = row < NL ? (row >> 12) : 4; \
            const float* md = mods + (size_t)(L * 5 + mrow) * 12288; \
            float ss = 0.f; \
            _Pragma("unroll") for (int c = 0; c < 8; ++c) ss += hx[c].x * hx[c].x + hx[c].y * hx[c].y + hx[c].z * hx[c].z + hx[c].w * hx[c].w; \
            ss = wave_sum(ss, lane); \
            const float rstd = rsqrtf(ss * (1.f / 2048.f) + 1e-6f); \
            _Pragma("unroll") for (int c = 0; c < 8; ++c) { \
                const int col = c * 256 + lane * 4; \
                const float4 gm = *(const float4*)(gffn + col), sh = *(const float4*)(md + 3 * 2048 + col), sc = *(const float4*)(md + 4 * 2048 + col); \
                const float u0 = hx[c].x * rstd * gm.x * (1.f + sc.x) + sh.x, u1 = hx[c].y * rstd * gm.y * (1.f + sc.y) + sh.y; \
                const float u2 = hx[c].z * rstd * gm.z * (1.f + sc.z) + sh.z, u3 = hx[c].w * rstd * gm.w * (1.f + sc.w) + sh.w; \
                uint2 o; o.x = pk2(u0, u1); o.y = pk2(u2, u3); \
                *(uint2*)(U + (size_t)row * D + col) = o; \
                *(uint2*)(vt + lr * 4112 + col * 2) = o; \
                asm volatile("" ::: "memory"); } } while (0)
        N2_ROW(ha, 0);
        N2_ROW(hb, 1);
#undef N2_ROW
        if (it + (int)gridDim.x < nit) {
            const int itn = it + (int)gridDim.x;
#pragma unroll
            for (int c = 0; c < 8; ++c) { ha[c] = *(const float4*)(H + (size_t)(itn * 16 + w * 2) * D + c * 256 + lane * 4); hb[c] = *(const float4*)(H + (size_t)(itn * 16 + w * 2 + 1) * D + c * 256 + lane * 4); }
        }
        lds_sync();
        {
            f32x4 acc[3];
#pragma unroll
            for (int n = 0; n < 3; ++n) acc[n] = (f32x4){0.f, 0.f, 0.f, 0.f};
#pragma unroll
            for (int kk = 0; kk < 8; ++kk) {
                const int k0 = w * 256 + kk * 32 + fq * 8;
                const bf16x8 Af = *(const bf16x8*)(vt + fr * 4112 + k0 * 2);
                acc[0] = MFMA16(Af, Bf[kk][0], acc[0]);
                acc[1] = MFMA16(Af, Bf[kk][1], acc[1]);
                bf16x8 B2 = (bf16x8){0, 0, 0, 0, 0, 0, 0, 0};
                if (fr < 4) B2 = *(const bf16x8*)(wr2 + fr * 4096 + k0 * 2);
                acc[2] = MFMA16(Af, B2, acc[2]);
            }
#pragma unroll
            for (int n = 0; n < 3; ++n)
#pragma unroll
                for (int j = 0; j < 4; ++j) part[(w * 16 + fq * 4 + j) * 48 + n * 16 + fr] = acc[n][j];
        }
        lds_sync();
        for (int i = tid; i < 16 * 48; i += 512) {
            float s = 0.f;
#pragma unroll
            for (int ww = 0; ww < 8; ++ww) s += part[ww * 768 + i];
            lgt[i] = s;
        }
        lds_sync();
        if (tid < 16) {
            const int row = it * 16 + tid;
            const float* lg = lgt + tid * 48;
            float g[4];
#pragma unroll
            for (int j = 0; j < 4; ++j) g[j] = lg[j] + p.in[22][L * 4 + j];
            int gi = 0; float gm = g[0];
#pragma unroll
            for (int j = 1; j < 4; ++j) if (g[j] > gm) { gm = g[j]; gi = j; }
            float gs = 0.f;
#pragma unroll
            for (int j = 0; j < 4; ++j) gs += expf(g[j] - gm);
            const float pg = 1.f / gs;
            float e[8];
#pragma unroll
            for (int j = 0; j < 8; ++j) e[j] = lg[4 + gi * 8 + j] + p.in[24][L * 32 + gi * 8 + j];
            int i1 = 0; float m1 = e[0];
#pragma unroll
            for (int j = 1; j < 8; ++j) if (e[j] > m1) { m1 = e[j]; i1 = j; }
            int i2 = -1; float m2 = -3.4e38f;
#pragma unroll
            for (int j = 0; j < 8; ++j) if (j != i1 && e[j] > m2) { m2 = e[j]; i2 = j; }
            const float w1 = 1.f / (1.f + expf(m2 - m1)), w2 = 1.f - w1;
            const int e1 = gi * 8 + i1, e2 = gi * 8 + i2;
            const int r1 = atomicAdd(&lcnt[e1], 1), r2 = atomicAdd(&lcnt[e2], 1);
            int* dd = dec + (nloc * 16 + tid) * 8;
            dd[0] = row; dd[1] = e1; dd[2] = e2; dd[3] = r1; dd[4] = r2; dd[5] = __float_as_int(pg * w1); dd[6] = __float_as_int(pg * w2);
        }
        ++nloc;
    }
    lds_sync();
    if (tid < 32) { const int c = lcnt[tid]; lcnt[32 + tid] = c ? (int)atomicAdd(&cnt[tid], (unsigned)c) : 0; }
    lds_sync();
    for (int i = tid; i < nloc * 16; i += 512) {
        const int* dd = dec + i * 8;
        const int e1 = dd[1], e2 = dd[2];
        const size_t q1 = (size_t)e1 * TOKCAP + lcnt[32 + e1] + dd[3], q2 = (size_t)e2 * TOKCAP + lcnt[32 + e2] + dd[4];
        tokl[q1] = dd[0] * 2; gatel[q1] = __int_as_float(dd[5]);
        tokl[q2] = dd[0] * 2 + 1; gatel[q2] = __int_as_float(dd[6]);
    }
}

struct EpiUp {
    bf16_t* H1; int prow0, ncol0;
    DEVI void operator()(const f32x4 (&acc)[2][2][4][2], int wr, int wc, int fr, int fq, int tid, unsigned char* stg) const {
#pragma unroll
        for (int ai = 0; ai < 2; ++ai)
#pragma unroll
            for (int m = 0; m < 4; ++m) {
                const int rloc = ai * 128 + wr * 64 + m * 16 + fr;
#pragma unroll
                for (int n = 0; n < 2; ++n) {
                    const f32x4 a = acc[ai][0][m][n], c = acc[ai][1][m][n];
                    uint2 o; o.x = pk2(siluf_(a[0]) * c[0], siluf_(a[1]) * c[1]); o.y = pk2(siluf_(a[2]) * c[2], siluf_(a[3]) * c[3]);
                    *(uint2*)(stg + rloc * 272 + (wc * 32 + n * 16 + fq * 4) * 2) = o;
                }
            }
        lds_sync();
#pragma unroll 4
        for (int c = tid; c < 4096; c += 512) {
            const int r = c >> 4, cc = c & 15;
            *(uint4*)(H1 + (size_t)(prow0 + r) * 1024 + ncol0 + cc * 8) = *(const uint4*)(stg + r * 272 + cc * 16);
        }
        lds_sync();
    }
};
struct EpiDown {
    bf16_t* SL; const int* tokl; const float* gatel; int li0, cnt, bcol;
    DEVI void operator()(const f32x4 (&acc)[2][2][4][2], int wr, int wc, int fr, int fq, int tid, unsigned char* stg) const {
#pragma unroll
        for (int ai = 0; ai < 2; ++ai)
#pragma unroll
            for (int m = 0; m < 4; ++m) {
                const int rloc = ai * 128 + wr * 64 + m * 16 + fr, li = li0 + rloc;
                const float g = li < cnt ? gatel[li] : 0.f;
#pragma unroll
                for (int bj = 0; bj < 2; ++bj)
#pragma unroll
                    for (int n = 0; n < 2; ++n) {
                        const f32x4 v = acc[ai][bj][m][n] * g;
                        uint2 o; o.x = pk2(v[0], v[1]); o.y = pk2(v[2], v[3]);
                        *(uint2*)(stg + rloc * EP_RS + (bj * 128 + wc * 32 + n * 16 + fq * 4) * 2) = o;
                    }
            }
        lds_sync();
#pragma unroll 4
        for (int c = tid; c < 8192; c += 512) {
            const int r = c >> 5, cc = c & 31, li = li0 + r;
            if (li < cnt) *(uint4*)(SL + (size_t)tokl[li] * D + bcol + cc * 8) = *(const uint4*)(stg + r * EP_RS + cc * 16);
        }
        lds_sync();
    }
};

template <int DOWN>
DEVI void phase_moe(const int tid_, const Params& p, int L, unsigned char* lds) {
    bf16_t* shm = (bf16_t*)lds;
    int* tb = (int*)(lds + LDS_MISC + 256);
    const unsigned* cntg = (const unsigned*)(p.ws + WS_CTL) + CTL_COUNT + L * 32;
    __syncthreads();
    if (tid_ == 0) {
        int acc = 0;
        for (int e = 0; e < 32; ++e) { const int c = (int)cntg[e]; tb[64 + e] = c; tb[e] = acc; acc += (c + 255) >> 8; }
        tb[32] = acc;
    }
    __syncthreads();
    const int ntl = tb[32] * 8;
    const int* tokl = (const int*)(p.ws + WS_TOKL);
    bg_fill(tid_, p, lds, DOWN ? FILL_Q / 2 : FILL_Q);
    const int geff = (L == 0) ? (int)gridDim.x - NCONV_WG : (int)gridDim.x;
    if ((int)blockIdx.x >= geff) return;
    for (int i = 0;; ++i) {
        int u; if (!unit_of(i, ntl, u, geff)) break;
        int e = 0;
#pragma unroll 1
        for (int k = 1; k < 32; ++k) if (tb[k] * 8 <= u) e = k;
        const int q = u - tb[e] * 8, nte = tb[e + 1] - tb[e], nt = q / nte, mt = q % nte, cnt_e = tb[64 + e];
        const int prow0 = (tb[e] + mt) * 256;
        if (DOWN == 0) {
            unsigned ao[2][2];
#pragma unroll
            for (int ii = 0; ii < 2; ++ii) {
                int r, c; g_stage_rc(tid_ * 16 + ii * 8192, r, c);
#pragma unroll
                for (int hh = 0; hh < 2; ++hh) {
                    const int li = mt * 256 + hh * 128 + r;
                    const int tok = li < cnt_e ? (tokl[(size_t)e * TOKCAP + li] >> 1) : 0;
                    ao[hh][ii] = ((unsigned)tok * D + c) * 2u;
                }
            }
            const bf16_t* Bt = (const bf16_t*)(p.ws + WS_WUPT) + ((size_t)(L * 32 + e) * 2048 + nt * 256) * 2048;
            EpiUp epi{(bf16_t*)(p.ws + WS_H1), prow0, nt * 128};
            gemm_tile<true>(tid_, shm, (const bf16_t*)(p.ws + WS_U), D, ao[0][0], ao[0][1], ao[1][0], ao[1][1], Bt, 2048, epi);
        } else {
            unsigned a0, a1; aoff_plain(tid_, 1024, a0, a1);
            const bf16_t* Bt = (const bf16_t*)(p.ws + WS_WDNT) + ((size_t)(L * 32 + e) * 2048 + nt * 256) * 1024;
            EpiDown epi{(bf16_t*)(p.ws + WS_SLOTS), tokl + (size_t)e * TOKCAP, (const float*)(p.ws + WS_GATEL) + (size_t)e * TOKCAP, mt * 256, cnt_e, nt * 256};
            gemm_tile<false>(tid_, shm, (const bf16_t*)(p.ws + WS_H1) + (size_t)prow0 * 1024, 1024, a0, a1, 0u, 0u, Bt, 1024, epi);
        }
    }
}

extern __shared__ __attribute__((aligned(16))) unsigned char lds_raw[];

__global__ void __launch_bounds__(512, 2) hybrid_fwd(Params p_unused) {
    unsigned char* lds = lds_raw;
    int lo, hi;
    { Params q; load_params(q); lo = q.ph_lo; hi = q.ph_hi; }
    const int wv_ = __builtin_amdgcn_readfirstlane((int)(threadIdx.x >> 6));
    if (hi - lo > 1) {
        const bool t0 = (opaque_tid(wv_) == 0);
        if (t0) { *(uint4*)(lds + LDS_MISC) = make_uint4(0u, 0u, 0u, 0u); *(uint4*)(lds + LDS_MISC + 96) = make_uint4(0u, 0u, 0u, 0u); }
        __syncthreads();
        { Params q; load_params(q); (void)xcd_barrier_post((unsigned*)(q.ws + WS_CTL), (volatile LAS unsigned*)(lds + LDS_MISC), t0); }
    }
#ifndef PH_MASK
#define PH_MASK 0x7ff
#endif
#ifndef REP_PHASE
#define REP_PHASE -1
#endif
#ifndef REP_N
#define REP_N 1
#endif
#define PH_(fn, ...) do { asm volatile("; MARK_BEGIN " #fn); Params q__; load_params(q__); fn(opaque_tid(wv_), q__, ##__VA_ARGS__); asm volatile("; MARK_END " #fn); } while (0)
#define EN(j) ((PH_MASK >> (j)) & 1)
#define IN(k) (lo <= (k) && (k) < hi)
#define SEAM(k) do { if (IN(k) && IN((k) + 1)) { { Params qb_; load_params(qb_); bg_convert(opaque_tid(wv_), qb_, lds, (k)); } XcdBarrier bb_; Params q_; load_params(q_); \
    bb_.bar = (unsigned*)(q_.ws + WS_CTL); bb_.x = xb_xcc_id(); bb_.st = (volatile LAS unsigned*)(lds + LDS_MISC); xcd_barrier(bb_, opaque_tid(wv_) == 0); } } while (0)
    if (EN(0) && IN(0)) PH_(phase_prologue, lds);
    if (REP_PHASE == 0) for (int r_ = 0; r_ < REP_N; ++r_) PH_(phase_prologue, lds);
    SEAM(0);
    if (REP_SUB == 300) { for (int r_ = 0; r_ < 10; ++r_) SEAM(0); }
#define LAYER(L) do { constexpr int k0 = 1 + 9 * (L); \
        if (EN(1) && IN(k0 + 0)) PH_(phase_norm1, L); \
        if (REP_PHASE == k0 + 0) for (int r_ = 0; r_ < REP_N; ++r_) PH_(phase_norm1, L); \
        SEAM(k0 + 0); \
        if (EN(2) && IN(k0 + 1)) PH_(phase_gemm_in, L, (bf16_t*)lds); \
        if (REP_PHASE == k0 + 1) for (int r_ = 0; r_ < REP_N; ++r_) PH_(phase_gemm_in, L, (bf16_t*)lds); \
        SEAM(k0 + 1); \
        if (EN(3) && IN(k0 + 2)) PH_(phase_mix_a, L, lds); \
        if (REP_PHASE == k0 + 2) for (int r_ = 0; r_ < REP_N; ++r_) PH_(phase_mix_a, L, lds); \
        SEAM(k0 + 2); \
        if (EN(4) && IN(k0 + 3)) PH_(phase_mix_b); \
        if (REP_PHASE == k0 + 3) for (int r_ = 0; r_ < REP_N; ++r_) PH_(phase_mix_b); \
        SEAM(k0 + 3); \
        if (EN(5) && IN(k0 + 4)) PH_(phase_mix_c, L, lds); \
        if (REP_PHASE == k0 + 4) for (int r_ = 0; r_ < REP_N; ++r_) PH_(phase_mix_c, L, lds); \
        SEAM(k0 + 4); \
        if (EN(6) && IN(k0 + 5)) PH_(phase_gemm_out, L, (bf16_t*)lds); \
        if (REP_PHASE == k0 + 5) for (int r_ = 0; r_ < REP_N; ++r_) PH_(phase_gemm_out, L, (bf16_t*)lds); \
        SEAM(k0 + 5); \
        if (EN(7) && IN(k0 + 6)) PH_(phase_norm2, L, lds); \
        if (REP_PHASE == k0 + 6) for (int r_ = 0; r_ < REP_N; ++r_) PH_(phase_norm2, L, lds, true); \
        SEAM(k0 + 6); \
        if (EN(8) && IN(k0 + 7)) PH_(phase_moe<0>, L, lds); \
        if (REP_PHASE == k0 + 7) for (int r_ = 0; r_ < REP_N; ++r_) PH_(phase_moe<0>, L, lds); \
        SEAM(k0 + 7); \
        if (EN(9) && IN(k0 + 8)) PH_(phase_moe<1>, L, lds); \
        if (REP_PHASE == k0 + 8) for (int r_ = 0; r_ < REP_N; ++r_) PH_(phase_moe<1>, L, lds); \
        SEAM(k0 + 8); } while (0)
    LAYER(0);
    LAYER(1);
#undef LAYER
    if (EN(10) && IN(19)) PH_(phase_final);
    if (PROF_ID != 0 && blockIdx.x == 0 && opaque_tid(wv_) == 0) {
        const unsigned long long acc = PROF_WORD(lds)[0], t_start = __builtin_amdgcn_s_memrealtime();
        while (__builtin_amdgcn_s_memrealtime() - t_start < acc * PROF_AMP) __builtin_amdgcn_s_sleep(8);
    }
#undef IN
#undef SEAM
}

extern "C" void kernel_launch(void* const* d_in, const int* in_sizes, int n_in, void* d_out, int out_size, void* d_ws, size_t ws_size, hipStream_t stream) {
    static int grid = 0;
    if (grid == 0) {
        if (n_in != 29 || ws_size < WS_END) { fprintf(stderr, "kernel_launch: need 29 inputs and >= %zu bytes of workspace (got %d, %zu)\n", (size_t)WS_END, n_in, ws_size); grid = -1; return; }
        int dev = 0, cus = 0, per_cu = 0;
        if (hipGetDevice(&dev) != hipSuccess || hipDeviceGetAttribute(&cus, hipDeviceAttributeMultiprocessorCount, dev) != hipSuccess) { grid = -1; return; }
        if (hipFuncSetAttribute((const void*)hybrid_fwd, hipFuncAttributeMaxDynamicSharedMemorySize, LDS_BYTES) != hipSuccess) { fprintf(stderr, "kernel_launch: hipFuncSetAttribute failed\n"); grid = -1; return; }
        if (hipOccupancyMaxActiveBlocksPerMultiprocessor(&per_cu, (const void*)hybrid_fwd, 512, LDS_BYTES) != hipSuccess || per_cu < 1)
            fprintf(stderr, "kernel_launch: occupancy query reports %d workgroups per CU\n", per_cu);
        (void)hipGetLastError();
        grid = cus;
    }
    if (grid < 0) return;
    (void)hipMemsetAsync((char*)d_ws + WS_CTL, 0, 65536, stream);
    Params p{};
    for (int i = 0; i < 29; ++i) p.in[i] = (const float*)d_in[i];
    p.out = (float*)d_out; p.ws = (unsigned char*)d_ws;
#if MK_ONE_LAUNCH
    p.ph_lo = 0; p.ph_hi = 20;
    hipLaunchKernelGGL(hybrid_fwd, dim3(grid), dim3(512), LDS_BYTES, stream, p);
#else
    for (int k = 0; k < 20; ++k) {
        p.ph_lo = k; p.ph_hi = k + 1;
        hipLaunchKernelGGL(hybrid_fwd, dim3(grid), dim3(512), LDS_BYTES, stream, p);
    }
#endif
}
```

```cpp
#include <hip/hip_runtime.h>
#include <stdint.h>
#include <stdio.h>

#ifndef REP_SUB
#define REP_SUB -1
#endif
#ifndef BG_B0
#define BG_B0 8
#endif
#ifndef BG_B1
#define BG_B1 4
#endif
#ifndef NCONV_WG
#define NCONV_WG 0
#endif
#ifndef PROF_ID
#define PROF_ID 0
#endif
#ifndef PROF_AMP
#define PROF_AMP 4
#endif
#ifndef FILL_Q
#define FILL_Q 0
#endif
#ifndef MK_ONE_LAUNCH
#define MK_ONE_LAUNCH 1
#endif

typedef unsigned short bf16_t;
typedef short bf16x8 __attribute__((ext_vector_type(8)));
typedef float f32x4 __attribute__((ext_vector_type(4)));
#define DEVI __device__ __forceinline__

constexpr int D = 2048, NB = 4, SEQ = 4096, CTX = 256;
constexpr int NL = NB * SEQ, NC = NB * CTX, NT = NL + NC;
constexpr int NCH = 68;
constexpr int TT = SEQ + CTX;
constexpr int ZLD = 4096;
constexpr int ZQ = 0, ZK = 1024, ZGQ = 1536, ZGK = 1792, ZGR = 2560, ZLX = 3072, ZLG = 3584;
constexpr int NWIN = 4352;
constexpr int TOKCAP = NT;
constexpr int H1ROWS = 43008;

constexpr size_t al256(size_t x) { return (x + 255) & ~(size_t)255; }
constexpr size_t WS_CTL = 0;
constexpr size_t WS_MODS = 65536;
constexpr size_t WS_ROPEC = WS_MODS + al256((size_t)2 * 5 * 12288 * 4);
constexpr size_t WS_ROPES = WS_ROPEC + (size_t)4096 * 64 * 4;
constexpr size_t WS_ROPEF = WS_ROPES + (size_t)4096 * 64 * 4;
constexpr size_t WS_LRUWT = WS_ROPEF + 256;
constexpr size_t WS_WRT = WS_LRUWT + (size_t)2 * 8 * 256 * 64 * 2;
constexpr size_t WS_WINT = WS_WRT + (size_t)2 * 48 * 2048 * 2;
constexpr size_t WS_WOUTT = WS_WINT + (size_t)2 * NWIN * 2048 * 2;
constexpr size_t WS_WUPT = WS_WOUTT + (size_t)2 * 2048 * 2048 * 2;
constexpr size_t WS_WDNT = WS_WUPT + (size_t)2 * 32 * 2048 * 2048 * 2;
constexpr size_t WS_H = WS_WDNT + (size_t)2 * 32 * 2048 * 1024 * 2;
constexpr size_t WS_U = WS_H + (size_t)NT * D * 4;
constexpr size_t WS_Z = WS_U + (size_t)NT * D * 2;
constexpr size_t WS_GZ = WS_Z + (size_t)NT * ZLD * 2;
constexpr size_t WS_VT = WS_GZ + (size_t)NT * 32 * 4;
constexpr size_t WS_GVT = WS_VT + (size_t)8 * 128 * TT * 2;
constexpr size_t WS_MIX = WS_GVT + (size_t)16 * 128 * TT * 2;
constexpr size_t WS_CONTRIB = WS_MIX + (size_t)NT * D * 2;
constexpr size_t WS_SBEF = WS_CONTRIB + (size_t)32 * NCH * 8192 * 4;
constexpr size_t WS_ATOT = WS_SBEF + (size_t)32 * NCH * 8192 * 4;
constexpr size_t WS_LRUA = WS_ATOT + (size_t)32 * NCH * 64 * 4;
constexpr size_t WS_LRUB = WS_LRUA + (size_t)NB * NCH * 2 * 512 * 4;
constexpr size_t WS_LRUC = WS_LRUB + (size_t)NB * NCH * 2 * 512 * 4;
constexpr size_t WS_TOKL = WS_LRUC + (size_t)NB * NCH * 2 * 512 * 4;
constexpr size_t WS_GATEL = WS_TOKL + (size_t)32 * TOKCAP * 4;
constexpr size_t WS_H1 = WS_GATEL + (size_t)32 * TOKCAP * 4;
constexpr size_t WS_SLOTS = WS_H1 + (size_t)H1ROWS * 1024 * 2;
constexpr size_t WS_CUMG = WS_SLOTS + (size_t)NT * 2 * D * 2;
constexpr size_t WS_END = WS_CUMG + (size_t)NB * 4 * NCH * 2 * 4096 * 4;
constexpr int CTL_COUNT = 4096;

constexpr int LDS_BYTES = 155648;
constexpr int LDS_MISC = 139264;

struct Params {
    const float* in[29];
    float* out;
    unsigned char* ws;
    int ph_lo, ph_hi;
};

typedef __attribute__((address_space(1))) const float gcf_t;
typedef __attribute__((address_space(1))) float gf_t;
typedef __attribute__((address_space(1))) unsigned char guc_t;
struct ParamsK {
    gcf_t* in[29];
    gf_t* out;
    guc_t* ws;
    int ph_lo, ph_hi;
};
static_assert(sizeof(ParamsK) == sizeof(Params), "kernarg view");
__device__ __forceinline__ void load_params(Params& q) {
    const __attribute__((address_space(4))) ParamsK* kp = (const __attribute__((address_space(4))) ParamsK*)__builtin_amdgcn_kernarg_segment_ptr();
    asm volatile("" : "+s"(kp));
#pragma unroll
    for (int i = 0; i < 29; ++i) q.in[i] = (const float*)kp->in[i];
    q.out = (float*)kp->out; q.ws = (unsigned char*)kp->ws; q.ph_lo = kp->ph_lo; q.ph_hi = kp->ph_hi;
}

DEVI float bf2f(bf16_t v) { return __uint_as_float(((unsigned)v) << 16); }
DEVI float bflo(unsigned v) { return __uint_as_float(v << 16); }
DEVI float bfhi(unsigned v) { return __uint_as_float(v & 0xffff0000u); }
DEVI unsigned pk2(float lo, float hi) { unsigned r; asm("v_cvt_pk_bf16_f32 %0, %1, %2" : "=v"(r) : "v"(lo), "v"(hi)); return r; }
DEVI bf16_t f2bf(float f) { return (bf16_t)(pk2(f, 0.f) & 0xffffu); }
DEVI float shx(float v, int mask, int lane) { return __int_as_float(__builtin_amdgcn_ds_bpermute((lane ^ mask) << 2, __float_as_int(v))); }
DEVI float shidx(float v, int src) { return __int_as_float(__builtin_amdgcn_ds_bpermute(src << 2, __float_as_int(v))); }
DEVI float shup(float v, int off, int lane) { const int src = lane >= off ? lane - off : lane; return shidx(v, src); }
DEVI float wave_sum(float v, int lane) {
#pragma unroll
    for (int o = 32; o > 0; o >>= 1) v += shx(v, o, lane);
    return v;
}
DEVI float rcpf_(float x) { return __builtin_amdgcn_rcpf(x); }
DEVI float sigmoidf_(float x) { return rcpf_(1.f + __builtin_amdgcn_exp2f(-1.4426950408889634f * x)); }
DEVI float siluf_(float x) { return x * sigmoidf_(x); }
DEVI float gelu_tanh(float x) {
    const float y2 = 1.5957691216057308f * (x + 0.044715f * x * x * x);
    return x * sigmoidf_(y2);
}
DEVI float logsigmoidf_(float z) { return fminf(z, 0.f) - log1pf(expf(-fabsf(z))); }
DEVI bf16x8 mk8(unsigned a, unsigned b, unsigned c, unsigned d) {
    typedef unsigned u4 __attribute__((ext_vector_type(4)));
    u4 t = {a, b, c, d};
    return __builtin_bit_cast(bf16x8, t);
}
DEVI int hw_lane() { int l; asm volatile("v_mbcnt_lo_u32_b32 %0, -1, 0\n\tv_mbcnt_hi_u32_b32 %0, -1, %0" : "=v"(l)); return l; }
DEVI int opaque_tid(int wv) { int t = wv * 64 + hw_lane(); asm volatile("" : "+v"(t)); return t; }
DEVI void lds_sync() { asm volatile("s_waitcnt lgkmcnt(0)" ::: "memory"); __builtin_amdgcn_s_barrier(); asm volatile("" ::: "memory"); }
#define MFMA16(a, b, c) __builtin_amdgcn_mfma_f32_16x16x32_bf16((a), (b), (c), 0, 0, 0)

#define XB_TMO      128
#define XB_XCNT(j)  (256  + 64 * (j))
#define XB_XSUB(j)  (1280 + 64 * (j))
#define XB_XGEN(j)  (2304 + 64 * (j))
#define XB_TOP      3328
#define XB_TOPGEN   3392
#define XCD_BAR_WORDS 3456
#define XB_SPIN_CAP (1u << 18)
#define LAS __attribute__((address_space(3)))

__device__ __forceinline__ unsigned xb_ld(unsigned* p)              { return __hip_atomic_load(p, __ATOMIC_RELAXED, __HIP_MEMORY_SCOPE_AGENT); }
__device__ __forceinline__ unsigned xb_add(unsigned* p, unsigned v) { return __hip_atomic_fetch_add(p, v, __ATOMIC_RELAXED, __HIP_MEMORY_SCOPE_AGENT); }
__device__ __forceinline__ unsigned xb_xcc_id() { return (unsigned)__builtin_amdgcn_s_getreg((3 << 11) | 20) & 0xFu; }
#define XB_SPIN(cond, bar) do { unsigned _sp = 0; while (cond) { __builtin_amdgcn_s_sleep(1); \
    if ((++_sp & 255u) == 0u) { if (xb_ld(&(bar)[XB_TMO])) break; if (_sp > XB_SPIN_CAP) { atomicAdd(&(bar)[XB_TMO], 1u); break; } } } } while (0)

struct XcdBarrier {
    unsigned* bar; unsigned x;
    volatile LAS unsigned* st;
};
__device__ __forceinline__ XcdBarrier xcd_barrier_post(unsigned* bar, volatile LAS unsigned* st, bool t0) {
    XcdBarrier b; b.bar = bar; b.x = xb_xcc_id(); b.st = st;
    if (t0) (void)xb_add(&bar[XB_XCNT(b.x)], 1u);
    return b;
}
__device__ __forceinline__ void xcd_barrier_complete(unsigned* bar, unsigned x, unsigned& nloc, unsigned& nx) {
    const unsigned G = gridDim.x * gridDim.y * gridDim.z;
    unsigned sum, cnt, mine, sp = 0u;
    for (;;) {
        sum = 0u; cnt = 0u; mine = 0u;
#pragma unroll
        for (unsigned j = 0; j < 16; ++j) { const unsigned c = xb_ld(&bar[XB_XCNT(j)]); sum += c; cnt += (c > 0u) ? 1u : 0u; mine = (j == x) ? c : mine; }
        if (sum == G) break;
        __builtin_amdgcn_s_sleep(1);
        if ((++sp & 255u) == 0u) { if (xb_ld(&bar[XB_TMO])) break; if (sp > XB_SPIN_CAP) { atomicAdd(&bar[XB_TMO], 1u); break; } }
    }
    nloc = mine > 0u ? mine : 1u; nx = cnt > 0u ? cnt : 1u;
}
__device__ __forceinline__ void xcd_barrier(const XcdBarrier& b, bool t0) {
    asm volatile("s_waitcnt vmcnt(0)" ::: "memory");
    __syncthreads();
    if (t0) {
        unsigned* bar = b.bar;
        __builtin_amdgcn_s_waitcnt(0);
        unsigned nloc = b.st[0], nx = b.st[1];
        if (nloc == 0u) { xcd_barrier_complete(bar, b.x, nloc, nx); b.st[0] = nloc; b.st[1] = nx; }
        const unsigned old = xb_add(&bar[XB_XSUB(b.x)], 1u);
        const unsigned gen = old / nloc;
        if (old + 1u == (gen + 1u) * nloc) {
            __builtin_amdgcn_fence(__ATOMIC_RELEASE, "agent");
            asm volatile("s_waitcnt vmcnt(0)" ::: "memory");
            const unsigned og = xb_add(&bar[XB_TOP], 1u);
            const unsigned tg = og / nx;
            if (og + 1u == (tg + 1u) * nx) xb_add(&bar[XB_TOPGEN], 1u);
            else XB_SPIN(xb_ld(&bar[XB_TOPGEN]) == tg, bar);
            __builtin_amdgcn_fence(__ATOMIC_ACQUIRE, "agent");
            xb_add(&bar[XB_XGEN(b.x)], 1u);
            asm volatile("s_waitcnt vmcnt(0)" ::: "memory");
        } else {
            XB_SPIN(xb_ld(&bar[XB_XGEN(b.x)]) == gen, bar);
            __builtin_amdgcn_fence(__ATOMIC_ACQUIRE, "agent");
            asm volatile("s_waitcnt vmcnt(0)" ::: "memory");
        }
    }
    __syncthreads();
}

#define PROF_WORD(lds) ((volatile unsigned long long*)((lds) + LDS_MISC + 96))
#define PROF_B(id, lds, t0) do { if (PROF_ID == (id) && blockIdx.x == 0 && (t0)) PROF_WORD(lds)[1] = __builtin_amdgcn_s_memrealtime(); } while (0)
#define PROF_E(id, lds, t0) do { if (PROF_ID == (id) && blockIdx.x == 0 && (t0)) PROF_WORD(lds)[0] += __builtin_amdgcn_s_memrealtime() - PROF_WORD(lds)[1]; } while (0)
DEVI bool unit_of(int i, int nunits, int& u, int geff = 0) {
    const long Lx = (long)i * (geff ? geff : (int)gridDim.x) + blockIdx.x;
    if (Lx >= nunits) return false;
    const int w = (int)Lx, q = nunits / 8, r = nunits % 8, xcd = w % 8, off = w / 8;
    u = (xcd < r ? xcd * (q + 1) : r * (q + 1) + (xcd - r) * q) + off;
    return true;
}

constexpr int G_BK = 64, G_HALF = 128, G_HT = G_HALF * G_BK;
DEVI int g_lds_byte(int r, int c) {
    int st = (r >> 4) * 2 + (c >> 5), rr = r & 15, cc = c & 31, ob = rr * 64 + cc * 2;
    return st * 1024 + (ob ^ (((ob >> 9) & 1) << 5));
}
DEVI void g_stage_rc(int b, int& R, int& C) {
    int st = b / 1024, sb = b % 1024, swz = sb ^ (((sb >> 9) & 1) << 5);
    R = (st >> 1) * 16 + swz / 64; C = (st & 1) * 32 + (swz % 64) / 2;
}

template <bool GATHER, class Epi>
DEVI void gemm_tile(const int tid_, bf16_t* shm, const bf16_t* __restrict__ A, unsigned lda, unsigned a0, unsigned a1, unsigned a2, unsigned a3,
                    const bf16_t* __restrict__ Bt, int K, const Epi& epi) {
#define SA(b, h) (shm + ((b) * 2 + (h)) * G_HT)
#define SB(b, h) (shm + (4 + (b) * 2 + (h)) * G_HT)
#define STG_A(T, P, h, kt) do { const unsigned so_ = (unsigned)(kt) * 128u + ((GATHER || !(h)) ? 0u : 256u * lda); \
    __builtin_amdgcn_raw_ptr_buffer_load_lds(rsA, (LAS void*)((char*)(P) + ldsw), 16, (GATHER && (h)) ? a2 : a0, so_, 0, 0); \
    __builtin_amdgcn_raw_ptr_buffer_load_lds(rsA, (LAS void*)((char*)(P) + ldsw + 8192), 16, (GATHER && (h)) ? a3 : a1, so_, 0, 0); } while (0)
#define STG_B(T, P, h, kt) do { const unsigned so_ = (unsigned)(kt) * 128u + ((h) ? 256u * (unsigned)K : 0u); \
    __builtin_amdgcn_raw_ptr_buffer_load_lds(rsB, (LAS void*)((char*)(P) + ldsw), 16, b0, so_, 0, 0); \
    __builtin_amdgcn_raw_ptr_buffer_load_lds(rsB, (LAS void*)((char*)(P) + ldsw + 8192), 16, b1, so_, 0, 0); } while (0)
#define LDA(dst, b, h) for (int m = 0; m < 4; ++m) for (int k = 0; k < 2; ++k) \
    dst[m][k] = *reinterpret_cast<const bf16x8*>((char*)SA(b, h) + g_lds_byte(wr * 64 + m * 16 + fr, k * 32 + fq * 8))
#define LDB(dst, b, h) for (int n = 0; n < 2; ++n) for (int k = 0; k < 2; ++k) \
    dst[n][k] = *reinterpret_cast<const bf16x8*>((char*)SB(b, h) + g_lds_byte(wc * 32 + n * 16 + fr, k * 32 + fq * 8))
#define MMA(ai, bj, At_, Bt_) do { __builtin_amdgcn_s_setprio(1); \
    for (int m = 0; m < 4; ++m) for (int n = 0; n < 2; ++n) for (int k = 0; k < 2; ++k) \
        acc[ai][bj][m][n] = __builtin_amdgcn_mfma_f32_16x16x32_bf16(Bt_[n][k], At_[m][k], acc[ai][bj][m][n], 0, 0, 0); \
    __builtin_amdgcn_s_setprio(0); } while (0)
#define WAIT_V(n) asm volatile("s_waitcnt vmcnt(" #n ")" ::: "memory")
#define WAIT_L(n) asm volatile("s_waitcnt lgkmcnt(" #n ")" ::: "memory")
#define BAR __builtin_amdgcn_s_barrier()
#define SCHED __builtin_amdgcn_sched_barrier(0)
    unsigned b0, b1;
    { int r_, c_; g_stage_rc(tid_ * 16, r_, c_); b0 = (unsigned)(r_ * K + c_) * 2u; g_stage_rc(tid_ * 16 + 8192, r_, c_); b1 = (unsigned)(r_ * K + c_) * 2u; }
    const __amdgpu_buffer_rsrc_t rsA = __builtin_amdgcn_make_buffer_rsrc((void*)A, (short)0, 0x7fffffff, 0x00020000);
    const __amdgpu_buffer_rsrc_t rsB = __builtin_amdgcn_make_buffer_rsrc((void*)Bt, (short)0, 0x7fffffff, 0x00020000);
    const unsigned ldsw = (unsigned)__builtin_amdgcn_readfirstlane(tid_ >> 6) * 1024u;
    const int T = tid_;
    int wid = T >> 6, lane = T & 63, wr = wid >> 2, wc = wid & 3, fr = lane & 15, fq = lane >> 4;
    f32x4 acc[2][2][4][2] = {};
    bf16x8 At[4][2], B0[2][2], B1[2][2];
    const int nt = K / G_BK;
    STG_B(T, SB(0, 0), 0, 0); STG_A(T, SA(0, 0), 0, 0);
    STG_B(T, SB(0, 1), 1, 0); STG_A(T, SA(0, 1), 1, 0);
    if (wr == 1) BAR;
    WAIT_V(4); BAR;
    STG_B(T, SB(1, 0), 0, 1); STG_A(T, SA(1, 0), 0, 1); STG_B(T, SB(1, 1), 1, 1);
    WAIT_V(6); BAR;
    for (int t = 0; t < nt - 2; t += 2) {
        LDB(B0, 0, 0); SCHED; LDA(At, 0, 0); STG_A(T, SA(1, 1), 1, t + 1);
        WAIT_L(8); BAR; WAIT_L(0); MMA(0, 0, At, B0); BAR; SCHED;
        LDB(B1, 0, 1); STG_B(T, SB(0, 0), 0, t + 2);
        BAR; WAIT_L(0); MMA(0, 1, At, B1); BAR;
        LDA(At, 0, 1); STG_A(T, SA(0, 0), 0, t + 2);
        BAR; WAIT_L(0); MMA(1, 0, At, B0); BAR; SCHED;
        STG_B(T, SB(0, 1), 1, t + 2);
        WAIT_V(6); BAR; MMA(1, 1, At, B1); BAR;
        LDB(B0, 1, 0); SCHED; LDA(At, 1, 0); STG_A(T, SA(0, 1), 1, t + 2);
        WAIT_L(8); BAR; WAIT_L(0); MMA(0, 0, At, B0); BAR; SCHED;
        LDB(B1, 1, 1); STG_B(T, SB(1, 0), 0, t + 3);
        BAR; WAIT_L(0); MMA(0, 1, At, B1); BAR;
        LDA(At, 1, 1); STG_A(T, SA(1, 0), 0, t + 3);
        BAR; WAIT_L(0); MMA(1, 0, At, B0); BAR; SCHED;
        STG_B(T, SB(1, 1), 1, t + 3);
        WAIT_V(6); BAR; MMA(1, 1, At, B1); BAR;
    }
    int tz = tid_; asm volatile("" : "+v"(tz)); wid = tz >> 6; lane = tz & 63; wr = wid >> 2; wc = wid & 3; fr = lane & 15; fq = lane >> 4;
    { LDB(B0, 0, 0); WAIT_V(0); LDA(At, 0, 0); STG_A(tz, SA(1, 1), 1, nt - 1);
      BAR; WAIT_L(0); MMA(0, 0, At, B0); BAR;
      LDB(B1, 0, 1); BAR; WAIT_L(0); MMA(0, 1, At, B1); BAR;
      LDA(At, 0, 1); WAIT_V(4); BAR; WAIT_L(0); MMA(1, 0, At, B0); MMA(1, 1, At, B1); BAR; }
    { LDB(B0, 1, 0); LDA(At, 1, 0); WAIT_V(2); BAR; WAIT_L(0); MMA(0, 0, At, B0); BAR;
      LDB(B1, 1, 1); WAIT_V(0); BAR; WAIT_L(0); MMA(0, 1, At, B1); BAR;
      LDA(At, 1, 1); BAR; WAIT_L(0); MMA(1, 0, At, B0); MMA(1, 1, At, B1); BAR; }
    if (wr == 0) BAR;
    SCHED;
    epi(acc, wr, wc, fr, fq, tz, (unsigned char*)shm);
#undef SA
#undef SB
#undef STG_A
#undef STG_B
#undef LDA
#undef LDB
#undef MMA
}

DEVI void aoff_plain(const int tid_, int lda, unsigned& a0, unsigned& a1) {
    int r, c;
    g_stage_rc(tid_ * 16, r, c);        a0 = (unsigned)(r * lda + c) * 2u;
    g_stage_rc(tid_ * 16 + 8192, r, c); a1 = (unsigned)(r * lda + c) * 2u;
}

constexpr int NU_WIN = 2 * 68 * 16, NU_WOUT = 2 * 32 * 16, NU_UP = 64 * 32 * 16, NU_DN = 64 * 32 * 8;
constexpr int NU_CONV = NU_WIN + NU_WOUT + NU_UP + NU_DN;
constexpr int NU_ADA = 768, NU_ROPE = 512, NU_LRUW = 512, NU_WR = 384;
constexpr int NU_P0 = NU_CONV + NU_ADA + NU_ROPE + NU_LRUW + NU_WR;

DEVI void conv_decode(const Params& p, int u, const float*& srck, int& ld_src, int& c0, int& nv, bf16_t*& dstn, int& ld_dst) {
    if (u < NU_WIN) {
        const int L = u / 1088, rem = u % 1088, ntile = rem >> 4, ktile = rem & 15, n0 = ntile * 64;
        if (n0 < 3072) { c0 = n0; nv = 64; } else if (n0 < 4096) { c0 = n0 + 32; nv = 64; } else if (n0 == 4096) { c0 = 3072; nv = 32; } else { c0 = 0; nv = 0; }
        srck = p.in[8] + (size_t)L * 2048 * 4128 + (size_t)ktile * 128 * 4128; ld_src = 4128;
        dstn = (bf16_t*)(p.ws + WS_WINT) + ((size_t)L * NWIN + n0) * 2048 + ktile * 128; ld_dst = 2048;
    } else if (u < NU_WIN + NU_WOUT) {
        const int v = u - NU_WIN, L = v >> 9, rem = v & 511, ntile = rem >> 4, ktile = rem & 15;
        srck = p.in[20] + (size_t)L * 2048 * 2048 + (size_t)ktile * 128 * 2048; ld_src = 2048; c0 = ntile * 64; nv = 64;
        dstn = (bf16_t*)(p.ws + WS_WOUTT) + ((size_t)L * 2048 + ntile * 64) * 2048 + ktile * 128; ld_dst = 2048;
    } else if (u < NU_WIN + NU_WOUT + NU_UP) {
        const int v = u - NU_WIN - NU_WOUT, le = v >> 9, rem = v & 511, ntile = rem >> 4, ktile = rem & 15;
        const int nt = ntile >> 2, half = (ntile >> 1) & 1, i0 = (ntile & 1) * 64;
        srck = (half ? p.in[26] : p.in[25]) + (size_t)le * 2048 * 1024 + (size_t)ktile * 128 * 1024; ld_src = 1024; c0 = nt * 128 + i0; nv = 64;
        dstn = (bf16_t*)(p.ws + WS_WUPT) + ((size_t)le * 2048 + ntile * 64) * 2048 + ktile * 128; ld_dst = 2048;
    } else {
        const int v = u - NU_WIN - NU_WOUT - NU_UP, le = v >> 8, rem = v & 255, ntile = rem >> 3, ktile = rem & 7;
        srck = p.in[27] + (size_t)le * 1024 * 2048 + (size_t)ktile * 128 * 2048; ld_src = 2048; c0 = ntile * 64; nv = 64;
        dstn = (bf16_t*)(p.ws + WS_WDNT) + ((size_t)le * 2048 + ntile * 64) * 1024 + ktile * 128; ld_dst = 1024;
    }
}

constexpr int CTL_QHEAD = 4200, CTL_DONE = 4224;
constexpr int QE0 = 1088, QE1 = 1600, QE2 = 17984, QE3 = 26176, QE4 = 27264, QE5 = 27776, QE6 = 44160, QE7 = 52352;
static_assert(QE7 == NU_CONV, "queue length");
DEVI int q_to_unit(int q) {
    if (q < QE0) return q;
    if (q < QE1) return NU_WIN + (q - QE0);
    if (q < QE2) return NU_WIN + NU_WOUT + (q - QE1);
    if (q < QE3) return NU_WIN + NU_WOUT + NU_UP + (q - QE2);
    if (q < QE4) return 1088 + (q - QE3);
    if (q < QE5) return NU_WIN + 512 + (q - QE4);
    if (q < QE6) return NU_WIN + NU_WOUT + 16384 + (q - QE5);
    return NU_WIN + NU_WOUT + NU_UP + 8192 + (q - QE6);
}
DEVI int q_deadline(int k) {
    return k < 1 ? 0 : k < 5 ? QE0 : k < 7 ? QE1 : k < 8 ? QE2 : k < 10 ? QE3 : k < 14 ? QE4 : k < 16 ? QE5 : k < 17 ? QE6 : QE7;
}
typedef unsigned u32x4_t __attribute__((ext_vector_type(4)));
DEVI float4 ntld4(const float* p) { const f32x4 v = __builtin_nontemporal_load((const f32x4*)p); return make_float4(v[0], v[1], v[2], v[3]); }
DEVI void ntst4(const uint4& o, bf16_t* p) { u32x4_t v = {o.x, o.y, o.z, o.w}; __builtin_nontemporal_store(v, (u32x4_t*)p); }
DEVI void conv_run(const int tid_, const Params& p, float* T, int q0, int count) {
    const int t = tid_, n4 = t & 15, kr = t >> 4;
    float4 v0, v1, v2, v3, x0, x1, x2, x3;
    const float* srck; bf16_t* dstn; int ld_src, ld_dst, c0, nv;
    bf16_t* d1 = nullptr; int l1 = 0; bf16_t* d2 = nullptr; int l2 = 0;
#define CV_LOAD(a0_, a1_, a2_, a3_) do { const float* s_ = srck + c0 + n4 * 4; \
        a0_ = make_float4(0.f, 0.f, 0.f, 0.f); a1_ = a0_; a2_ = a0_; a3_ = a0_; \
        if (n4 * 4 < nv) { a0_ = ntld4((s_ + (size_t)(kr) * ld_src)); a1_ = ntld4((s_ + (size_t)(kr + 32) * ld_src)); \
                           a2_ = ntld4((s_ + (size_t)(kr + 64) * ld_src)); a3_ = ntld4((s_ + (size_t)(kr + 96) * ld_src)); } } while (0)
    conv_decode(p, q_to_unit(q0), srck, ld_src, c0, nv, dstn, ld_dst); d1 = dstn; l1 = ld_dst; CV_LOAD(v0, v1, v2, v3);
    x0 = make_float4(0.f, 0.f, 0.f, 0.f); x1 = x0; x2 = x0; x3 = x0;
    if (count > 1) { conv_decode(p, q_to_unit(q0 + 1), srck, ld_src, c0, nv, dstn, ld_dst); d2 = dstn; l2 = ld_dst; CV_LOAD(x0, x1, x2, x3); }
#pragma unroll 1
    for (int i = 0; i < count; ++i) {
        const float4 w0 = v0, w1 = v1, w2 = v2, w3 = v3;
        bf16_t* const dcur = d1; const int ldd = l1;
        v0 = x0; v1 = x1; v2 = x2; v3 = x3; d1 = d2; l1 = l2;
        if (i + 2 < count) { conv_decode(p, q_to_unit(q0 + i + 2), srck, ld_src, c0, nv, dstn, ld_dst); d2 = dstn; l2 = ld_dst; CV_LOAD(x0, x1, x2, x3); }
        lds_sync();
        { float* d = T + kr * 65 + n4 * 4; d[0] = w0.x; d[1] = w0.y; d[2] = w0.z; d[3] = w0.w; }
        { float* d = T + (kr + 32) * 65 + n4 * 4; d[0] = w1.x; d[1] = w1.y; d[2] = w1.z; d[3] = w1.w; }
        { float* d = T + (kr + 64) * 65 + n4 * 4; d[0] = w2.x; d[1] = w2.y; d[2] = w2.z; d[3] = w2.w; }
        { float* d = T + (kr + 96) * 65 + n4 * 4; d[0] = w3.x; d[1] = w3.y; d[2] = w3.z; d[3] = w3.w; }
        lds_sync();
#pragma unroll
        for (int i2 = 0; i2 < 2; ++i2) {
            const int kc = t & 15, n = (t >> 4) + 32 * i2;
            float f[8];
#pragma unroll
            for (int j = 0; j < 8; ++j) f[j] = T[(kc * 8 + j) * 65 + n];
            uint4 o; o.x = pk2(f[0], f[1]); o.y = pk2(f[2], f[3]); o.z = pk2(f[4], f[5]); o.w = pk2(f[6], f[7]);
            ntst4(o, dcur + (size_t)n * ldd + kc * 8);
        }
    }
#undef CV_LOAD
}
DEVI void bg_convert(const int tid_, const Params& p, unsigned char* lds, int k) {
    typedef __attribute__((address_space(1))) unsigned gu32_t;
    gu32_t* ctl = (gu32_t*)(p.ws + WS_CTL);
    volatile int* lw = (volatile int*)(lds + LDS_MISC + 64);
    float* T = (float*)lds;
    const int t = tid_;
    const int deadline = q_deadline(k), G = (int)gridDim.x;
#pragma unroll 1
    for (int stage = (k > 0 && q_deadline(k) == q_deadline(k - 1)) ? 1 : 0; stage < 2; ++stage) {
        if (stage == 1 && t == 0) (void)__hip_atomic_fetch_add(ctl + CTL_DONE + 64 * k, 1u, __ATOMIC_RELAXED, __HIP_MEMORY_SCOPE_AGENT);
        const int batch = (stage == 0) ? BG_B0 : BG_B1;
#pragma unroll 1
        for (;;) {
            if (t == 0) {
                int c = -1;
                const bool want = (stage == 0) ? ((int)__hip_atomic_load(ctl + CTL_QHEAD, __ATOMIC_RELAXED, __HIP_MEMORY_SCOPE_AGENT) < deadline)
                                               : ((int)__hip_atomic_load(ctl + CTL_DONE + 64 * k, __ATOMIC_RELAXED, __HIP_MEMORY_SCOPE_AGENT) < G);
                if (want) { c = (int)__hip_atomic_fetch_add(ctl + CTL_QHEAD, (unsigned)batch, __ATOMIC_RELAXED, __HIP_MEMORY_SCOPE_AGENT); if (c >= NU_CONV) c = -1; }
                lw[0] = c;
            }
            lds_sync();
            const int c = lw[0];
            lds_sync();
            if (c < 0) break;
            conv_run(tid_, p, T, c, (NU_CONV - c) < batch ? (NU_CONV - c) : batch);
        }
    }
}

DEVI void bg_fill(const int tid_, const Params& p, unsigned char* lds, int per_quarter) {
    typedef __attribute__((address_space(1))) unsigned gu32_t;
    gu32_t* ctl = (gu32_t*)(p.ws + WS_CTL);
    volatile int* lw = (volatile int*)(lds + LDS_MISC + 64);
    const int n = (int)(blockIdx.x & 3u) * per_quarter;
    if (n == 0) return;
    if (tid_ == 0) {
        int c = -1;
        if ((int)__hip_atomic_load(ctl + CTL_QHEAD, __ATOMIC_RELAXED, __HIP_MEMORY_SCOPE_AGENT) < NU_CONV) {
            c = (int)__hip_atomic_fetch_add(ctl + CTL_QHEAD, (unsigned)n, __ATOMIC_RELAXED, __HIP_MEMORY_SCOPE_AGENT); if (c >= NU_CONV) c = -1; }
        lw[0] = c;
    }
    lds_sync();
    const int c = lw[0];
    lds_sync();
    if (c >= 0) conv_run(tid_, p, (float*)lds, c, (NU_CONV - c) < n ? (NU_CONV - c) : n);
    lds_sync();
}

__constant__ double c_rope_inv[32] = {
    1.0, 0.7498942093324559, 0.5623413251903491, 0.4216965034285822, 0.31622776601683794, 0.23713737056616552, 0.1778279410038923, 0.1333521432163324,
    0.1, 0.07498942093324558, 0.05623413251903491, 0.042169650342858224, 0.03162277660168379, 0.023713737056616554, 0.01778279410038923, 0.01333521432163324,
    0.01, 0.007498942093324558, 0.005623413251903491, 0.004216965034285823, 0.0031622776601683794, 0.0023713737056616554, 0.0017782794100389228, 0.001333521432163324,
    0.001, 0.0007498942093324559, 0.0005623413251903491, 0.00042169650342858224, 0.00031622776601683794, 0.00023713737056616554, 0.00017782794100389227, 0.0001333521432163324};

DEVI void sincos_f64(double ang, float& sn, float& cs) {
    const double n = __builtin_rint(ang * 0.15915494309189535);
    double r = __builtin_fma(-n, 6.283185307179586, ang);
    r = __builtin_fma(-n, 2.4492935982947064e-16, r);
    const double x = 0.5 * r, x2 = x * x;
    double s = 1.0, c = 1.0;
#pragma unroll
    for (int k = 12; k >= 1; --k) {
        s = 1.0 - s * x2 * (1.0 / (double)((2 * k) * (2 * k + 1)));
        c = 1.0 - c * x2 * (1.0 / (double)((2 * k - 1) * (2 * k)));
    }
    s *= x;
    sn = (float)(2.0 * s * c); cs = (float)(1.0 - 2.0 * s * s);
}

DEVI void phase_prologue(const int tid_, const Params& p, unsigned char* lds) {
    float* T = (float*)lds;
    float* cond = (float*)(lds + 33280);
    float* red = (float*)(lds + 33280 + 40960);
    const int t = tid_;
    for (int i = t; i < 5 * 2048; i += 512) {
        const int r = i >> 11, k = i & 2047;
        const float c = r < 4 ? p.in[1][r * 2048 + k] : p.in[3][k];
        cond[i] = c / (1.f + expf(-c));
    }
    __syncthreads();
    __syncthreads();
    for (int u = NU_CONV + blockIdx.x; u < NU_P0; u += gridDim.x) {
        if (false) {
        } else if (u < NU_CONV + NU_ADA) {
            const int v = u - NU_CONV, L = v / 384, c0 = (v % 384) * 32;
            const float* W = p.in[4] + (size_t)L * 2048 * 12288;
            const int q = t & 7, kg = t >> 3;
            float acc[5][4];
#pragma unroll
            for (int r = 0; r < 5; ++r) { acc[r][0] = 0.f; acc[r][1] = 0.f; acc[r][2] = 0.f; acc[r][3] = 0.f; }
#pragma unroll 4
            for (int k = kg; k < 2048; k += 64) {
                const float4 w = *(const float4*)(W + (size_t)k * 12288 + c0 + q * 4);
#pragma unroll
                for (int r = 0; r < 5; ++r) {
                    const float cv = cond[r * 2048 + k];
                    acc[r][0] += cv * w.x; acc[r][1] += cv * w.y; acc[r][2] += cv * w.z; acc[r][3] += cv * w.w;
                }
            }
#pragma unroll
            for (int r = 0; r < 5; ++r)
#pragma unroll
                for (int j = 0; j < 4; ++j) {
                    float a = acc[r][j];
                    a += shx(a, 8, t & 63); a += shx(a, 16, t & 63); a += shx(a, 32, t & 63);
                    acc[r][j] = a;
                }
            const int lane = t & 63, wave = t >> 6;
            __syncthreads();
            if (lane < 8) {
#pragma unroll
                for (int r = 0; r < 5; ++r)
#pragma unroll
                    for (int j = 0; j < 4; ++j) red[(wave * 8 + lane) * 20 + r * 4 + j] = acc[r][j];
            }
            __syncthreads();
            if (t < 160) {
                const int qq = t / 20, rj = t % 20;
                float s = 0.f;
#pragma unroll
                for (int w = 0; w < 8; ++w) s += red[(w * 8 + qq) * 20 + rj];
                const int r = rj >> 2, j = rj & 3, col = c0 + qq * 4 + j;
                ((float*)(p.ws + WS_MODS))[(size_t)(L * 5 + r) * 12288 + col] = s + p.in[5][L * 12288 + col];
            }
        } else if (u < NU_CONV + NU_ADA + NU_ROPE) {
            const int idx = (u - NU_CONV - NU_ADA) * 512 + t, pos = idx >> 6, i = idx & 63;
            const int coord = i < 32 ? (pos >> 6) : (pos & 63);
            float sn, cs;
            sincos_f64((double)coord * c_rope_inv[i & 31], sn, cs);
            ((float*)(p.ws + WS_ROPEC))[idx] = cs;
            ((float*)(p.ws + WS_ROPES))[idx] = sn;
            if (idx < 32) ((float*)(p.ws + WS_ROPEF))[idx] = (float)(c_rope_inv[idx] * 0.15915494309189535);
        } else if (u < NU_CONV + NU_ADA + NU_ROPE + NU_LRUW) {
            const int idx = (u - NU_CONV - NU_ADA - NU_ROPE) * 512 + t;
            const int c = idx & 63, n = (idx >> 6) & 255, blk = (idx >> 14) & 7, L = idx >> 17;
            const int dg = n >> 6, dir = dg >> 1, gate = dg & 1, dd = n & 63;
            const float* src = gate ? p.in[17] : p.in[15];
            ((bf16_t*)(p.ws + WS_LRUWT))[idx] = f2bf(src[((size_t)((L * 2 + dir) * 8 + blk) * 64 + c) * 64 + dd]);
        } else {
            const int idx = (u - NU_CONV - NU_ADA - NU_ROPE - NU_LRUW) * 512 + t;
            const int k = idx & 2047, n = (idx >> 11) % 48, L = idx / (48 * 2048);
            float v = 0.f;
            if (n < 4) v = p.in[21][((size_t)L * 2048 + k) * 4 + n];
            else if (n < 36) v = p.in[23][((size_t)L * 2048 + k) * 32 + (n - 4)];
            ((bf16_t*)(p.ws + WS_WRT))[idx] = f2bf(v);
        }
    }
}

DEVI void phase_norm1(const int tid_, const Params& p, int L) {
    const int wave = tid_ >> 6, lane = tid_ & 63;
    float* H = (float*)(p.ws + WS_H);
    bf16_t* U = (bf16_t*)(p.ws + WS_U);
    const float* mods = (const float*)(p.ws + WS_MODS);
    const bf16_t* SL = (const bf16_t*)(p.ws + WS_SLOTS);
    const float* gmix = p.in[6] + L * 2048;
    float4 nx[8];
#define N1_SRC(r) (L == 0 ? ((r) < NL ? p.in[0] + (size_t)(r) * D : p.in[2] + (size_t)((r) - NL) * D) : H + (size_t)(r) * D)
    {
        const int r0 = blockIdx.x * 8 + wave;
        if (r0 < NT) { const float* s0 = N1_SRC(r0);
#pragma unroll
            for (int c = 0; c < 8; ++c) nx[c] = *(const float4*)(s0 + c * 256 + lane * 4); }
    }
    for (int row = blockIdx.x * 8 + wave; row < NT; row += gridDim.x * 8) {
        const int mrow = row < NL ? (row >> 12) : 4;
        const float* md = mods + (size_t)(L * 5 + mrow) * 12288;
        float4 hv[8];
#pragma unroll
        for (int c = 0; c < 8; ++c) hv[c] = nx[c];
        {
            const int rn = row + (int)gridDim.x * 8;
            if (rn < NT) { const float* s1 = N1_SRC(rn);
#pragma unroll
                for (int c = 0; c < 8; ++c) nx[c] = *(const float4*)(s1 + c * 256 + lane * 4); }
        }
        if (L == 1) {
            const float* g2 = mods + (size_t)(0 * 5 + mrow) * 12288 + 5 * 2048;
#pragma unroll
            for (int c = 0; c < 8; ++c) {
                const int col = c * 256 + lane * 4;
                const float4 g = *(const float4*)(g2 + col);
                const uint2 a = *(const uint2*)(SL + (size_t)(row * 2) * D + col), b = *(const uint2*)(SL + (size_t)(row * 2 + 1) * D + col);
                hv[c].x += g.x * (bflo(a.x) + bflo(b.x)); hv[c].y += g.y * (bfhi(a.x) + bfhi(b.x));
                hv[c].z += g.z * (bflo(a.y) + bflo(b.y)); hv[c].w += g.w * (bfhi(a.y) + bfhi(b.y));
            }
        }
        float ss = 0.f;
#pragma unroll
        for (int c = 0; c < 8; ++c) {
            if (L == 1) *(float4*)(H + (size_t)row * D + c * 256 + lane * 4) = hv[c];
            ss += hv[c].x * hv[c].x + hv[c].y * hv[c].y + hv[c].z * hv[c].z + hv[c].w * hv[c].w;
        }
        ss = wave_sum(ss, lane);
        const float rstd = rsqrtf(ss * (1.f / 2048.f) + 1e-6f);
#pragma unroll
        for (int c = 0; c < 8; ++c) {
            const int col = c * 256 + lane * 4;
            const float4 gm = *(const float4*)(gmix + col), sh = *(const float4*)(md + col), sc = *(const float4*)(md + 2048 + col);
            const float u0 = hv[c].x * rstd * gm.x * (1.f + sc.x) + sh.x, u1 = hv[c].y * rstd * gm.y * (1.f + sc.y) + sh.y;
            const float u2 = hv[c].z * rstd * gm.z * (1.f + sc.z) + sh.z, u3 = hv[c].w * rstd * gm.w * (1.f + sc.w) + sh.w;
            uint2 o; o.x = pk2(u0, u1); o.y = pk2(u2, u3);
            *(uint2*)(U + (size_t)row * D + col) = o;
        }
    }
#undef N1_SRC
}

DEVI void phase_final(const int tid_, const Params& p) {
    const int wave = tid_ >> 6, lane = tid_ & 63;
    const float* H = (const float*)(p.ws + WS_H);
    const float* mods = (const float*)(p.ws + WS_MODS);
    const bf16_t* SL = (const bf16_t*)(p.ws + WS_SLOTS);
    const float* gf = p.in[28];
    for (int row = blockIdx.x * 8 + wave; row < NL; row += gridDim.x * 8) {
        const int mrow = row >> 12;
        const float* g2 = mods + (size_t)(1 * 5 + mrow) * 12288 + 5 * 2048;
        float4 hv[8];
        float ss = 0.f;
#pragma unroll
        for (int c = 0; c < 8; ++c) {
            const int col = c * 256 + lane * 4;
            hv[c] = *(const float4*)(H + (size_t)row * D + col);
            const float4 g = *(const float4*)(g2 + col);
            const uint2 a = *(const uint2*)(SL + (size_t)(row * 2) * D + col), b = *(const uint2*)(SL + (size_t)(row * 2 + 1) * D + col);
            hv[c].x += g.x * (bflo(a.x) + bflo(b.x)); hv[c].y += g.y * (bfhi(a.x) + bfhi(b.x));
            hv[c].z += g.z * (bflo(a.y) + bflo(b.y)); hv[c].w += g.w * (bfhi(a.y) + bfhi(b.y));
            ss += hv[c].x * hv[c].x + hv[c].y * hv[c].y + hv[c].z * hv[c].z + hv[c].w * hv[c].w;
        }
        ss = wave_sum(ss, lane);
        const float rstd = rsqrtf(ss * (1.f / 2048.f) + 1e-6f);
#pragma unroll
        for (int c = 0; c < 8; ++c) {
            const int col = c * 256 + lane * 4;
            const float4 gm = *(const float4*)(gf + col);
            float4 o; o.x = hv[c].x * rstd * gm.x; o.y = hv[c].y * rstd * gm.y; o.z = hv[c].z * rstd * gm.z; o.w = hv[c].w * rstd * gm.w;
            *(float4*)(p.out + (size_t)row * D + col) = o;
        }
    }
}

constexpr int EP_RS = 528;
struct EpiIn {
    bf16_t* Z; float* GZ; bf16_t* VT; bf16_t* GVT; const float* RC; const float* RS; int brow, pn;
    DEVI void operator()(const f32x4 (&acc)[2][2][4][2], int wr, int wc, int fr, int fq, int tid, unsigned char* stg) const {
        if (pn == 16) {
#pragma unroll
            for (int ai = 0; ai < 2; ++ai)
#pragma unroll
                for (int m = 0; m < 4; ++m) {
                    const int row = brow + ai * 128 + wr * 64 + m * 16 + fr;
#pragma unroll
                    for (int n = 0; n < 2; ++n) { const int colt = wc * 32 + n * 16 + fq * 4; if (colt < 32) *(f32x4*)(GZ + (size_t)row * 32 + colt) = acc[ai][0][m][n]; }
                }
            return;
        }
        const bool tr = (pn == 5 || pn == 8 || pn == 9);
#pragma unroll
        for (int ai = 0; ai < 2; ++ai)
#pragma unroll
            for (int m = 0; m < 4; ++m) {
                const int rloc = ai * 128 + wr * 64 + m * 16 + fr, row = brow + rloc;
#pragma unroll
                for (int bj = 0; bj < 2; ++bj)
#pragma unroll
                    for (int n = 0; n < 2; ++n) {
                        const int colt = bj * 128 + wc * 32 + n * 16 + fq * 4;
                        const f32x4 v = acc[ai][bj][m][n];
                        float o0 = v[0], o1 = v[1], o2 = v[2], o3 = v[3];
                        if (pn <= 4) {
                            if (row < NL) {
                                const int tpos = row & 4095, i0 = (colt & 127) >> 1;
                                const float pos = (float)((i0 < 32) ? (tpos >> 6) : (tpos & 63));
                                const float r0 = pos * RC[i0 & 31], r1 = pos * RC[(i0 & 31) + 1];
                                const float c0 = __builtin_amdgcn_cosf(r0), s0 = __builtin_amdgcn_sinf(r0), c1 = __builtin_amdgcn_cosf(r1), s1 = __builtin_amdgcn_sinf(r1);
                                o0 = v[0] * c0 - v[1] * s0; o1 = v[0] * s0 + v[1] * c0;
                                o2 = v[2] * c1 - v[3] * s1; o3 = v[2] * s1 + v[3] * c1;
                            }
                            if (pn < 4) { o0 *= 0.12751743f; o1 *= 0.12751743f; o2 *= 0.12751743f; o3 *= 0.12751743f; }
                        }
                        if (!tr) { uint2 o; o.x = pk2(o0, o1); o.y = pk2(o2, o3); *(uint2*)(stg + rloc * EP_RS + colt * 2) = o; }
                        else {
                            const unsigned p01 = pk2(o0, o1), p23 = pk2(o2, o3);
                            *(bf16_t*)(stg + (colt + 0) * EP_RS + rloc * 2) = (bf16_t)(p01 & 0xffffu); *(bf16_t*)(stg + (colt + 1) * EP_RS + rloc * 2) = (bf16_t)(p01 >> 16);
                            *(bf16_t*)(stg + (colt + 2) * EP_RS + rloc * 2) = (bf16_t)(p23 & 0xffffu); *(bf16_t*)(stg + (colt + 3) * EP_RS + rloc * 2) = (bf16_t)(p23 >> 16);
                        }
                    }
            }
        lds_sync();
        if (!tr) {
#pragma unroll 4
            for (int c = tid; c < 8192; c += 512) {
                const int r = c >> 5, cc = c & 31;
                *(uint4*)(Z + (size_t)(brow + r) * ZLD + pn * 256 + cc * 8) = *(const uint4*)(stg + r * EP_RS + cc * 16);
            }
        } else {
            int bb, tpos0;
            if (brow < NL) { bb = brow >> 12; tpos0 = brow & 4095; } else { bb = (brow - NL) >> 8; tpos0 = 4096; }
#pragma unroll 4
            for (int c = tid; c < 8192; c += 512) {
                const int col = c >> 5, rc = c & 31;
                bf16_t* dst;
                if (pn == 5) dst = VT + ((size_t)((bb * 2 + (col >> 7)) * 128 + (col & 127))) * TT;
                else { const int cv = (pn - 8) * 256 + col; dst = GVT + ((size_t)((bb * 4 + (cv >> 7)) * 128 + (cv & 127))) * TT; }
                *(uint4*)(dst + tpos0 + rc * 8) = *(const uint4*)(stg + col * EP_RS + rc * 16);
            }
        }
        lds_sync();
    }
};

DEVI void dense_tile_of(int wgid, int nM, int nN, int& pm, int& pn) {
    const int nig = 8 * nN, gid = wgid / nig, fm = gid * 8, gsz = (nM - fm) < 8 ? (nM - fm) : 8;
    pm = fm + ((wgid % nig) % gsz); pn = (wgid % nig) / gsz;
}

DEVI void phase_gemm_in(const int tid_, const Params& p, int L, bf16_t* shm) {
    const int nM = NT / 256, nN = NWIN / 256;
    const bf16_t* U = (const bf16_t*)(p.ws + WS_U);
    bg_fill(tid_, p, (unsigned char*)shm, FILL_Q);
    const int geff = (int)gridDim.x - NCONV_WG;
    if ((int)blockIdx.x >= geff) return;
    for (int i = 0;; ++i) {
        int u; if (!unit_of(i, nM * nN, u, geff)) break;
        int pm, pn; dense_tile_of(u, nM, nN, pm, pn);
        if (L == 1 && pm >= NL / 256 && !(pn == 4 || pn == 5 || pn == 7 || pn == 8 || pn == 9 || pn == 12 || pn == 13 || pn == 16)) continue;
        unsigned a0, a1; aoff_plain(tid_, D, a0, a1);
        const bf16_t* Bt = (const bf16_t*)(p.ws + WS_WINT) + ((size_t)L * NWIN + pn * 256) * 2048;
        EpiIn epi{(bf16_t*)(p.ws + WS_Z), (float*)(p.ws + WS_GZ), (bf16_t*)(p.ws + WS_VT), (bf16_t*)(p.ws + WS_GVT),
                  (const float*)(p.ws + WS_ROPEF), (const float*)(p.ws + WS_ROPES), pm * 256, pn};
        if (REP_SUB == 200) { struct Twice { const EpiIn& e; DEVI void operator()(const f32x4 (&acc)[2][2][4][2], int wr, int wc, int fr, int fq, int tid, unsigned char* stg) const { e(acc, wr, wc, fr, fq, tid, stg); asm volatile("" ::: "memory"); e(acc, wr, wc, fr, fq, tid, stg); } } tw{epi};
            gemm_tile<false>(tid_, shm, U + (size_t)pm * 256 * D, D, a0, a1, 0u, 0u, Bt, 2048, tw); }
        else gemm_tile<false>(tid_, shm, U + (size_t)pm * 256 * D, D, a0, a1, 0u, 0u, Bt, 2048, epi);
    }
}

struct EpiOut {
    float* H; const float* mods; const float* x; const float* ctx; int L, brow, bcol;
    DEVI void operator()(const f32x4 (&acc)[2][2][4][2], int wr, int wc, int fr, int fq, int, unsigned char*) const {
#pragma unroll
        for (int ai = 0; ai < 2; ++ai)
#pragma unroll
            for (int m = 0; m < 4; ++m) {
                const int row = brow + ai * 128 + wr * 64 + m * 16 + fr;
                const int mrow = row < NL ? (row >> 12) : 4;
                const float* g1 = mods + (size_t)(L * 5 + mrow) * 12288 + 2 * 2048;
#pragma unroll
                for (int bj = 0; bj < 2; ++bj)
#pragma unroll
                    for (int n = 0; n < 2; ++n) {
                        const int col = bcol + bj * 128 + wc * 32 + n * 16 + fq * 4;
                        const f32x4 g = *(const f32x4*)(g1 + col);
                        f32x4* hp = (f32x4*)(H + (size_t)row * D + col);
                        const f32x4* rp = (L == 0) ? (const f32x4*)((row < NL ? x + (size_t)row * D : ctx + (size_t)(row - NL) * D) + col) : (const f32x4*)hp;
                        f32x4 h = *rp;
                        h += g * acc[ai][bj][m][n];
                        *hp = h;
                    }
            }
    }
};

DEVI void phase_gemm_out(const int tid_, const Params& p, int L, bf16_t* shm) {
    const int nM = (L == 0 ? NT : NL) / 256, nN = 8;
    const bf16_t* MIX = (const bf16_t*)(p.ws + WS_MIX);
    bg_fill(tid_, p, (unsigned char*)shm, FILL_Q);
    const int geff = (int)gridDim.x - NCONV_WG;
    if ((int)blockIdx.x >= geff) return;
    for (int i = 0;; ++i) {
        int u; if (!unit_of(i, nM * nN, u, geff)) break;
        int pm, pn; dense_tile_of(u, nM, nN, pm, pn);
        unsigned a0, a1; aoff_plain(tid_, D, a0, a1);
        const bf16_t* Bt = (const bf16_t*)(p.ws + WS_WOUTT) + ((size_t)L * 2048 + pn * 256) * 2048;
        EpiOut epi{(float*)(p.ws + WS_H), (const float*)(p.ws + WS_MODS), p.in[0], p.in[2], L, pm * 256, pn * 256};
        gemm_tile<false>(tid_, shm, MIX + (size_t)pm * 256 * D, D, a0, a1, 0u, 0u, Bt, 2048, epi);
    }
}

constexpr int AT_KSTR = 272, AT_VSTR = 144;
DEVI void attn_unit(const int tid_, const Params& p, int L, int a, unsigned char* lds) {
    const bf16_t* Z = (const bf16_t*)(p.ws + WS_Z);
    const bf16_t* VT = (const bf16_t*)(p.ws + WS_VT);
    bf16_t* MIX = (bf16_t*)(p.ws + WS_MIX);
    unsigned char* Ks = lds;
    unsigned char* Vs = lds + 64 * AT_KSTR;
    const int tid = tid_, w = tid >> 6, lane = tid & 63, fr = lane & 15, fq = lane >> 4;
    int b, qb, kvh; bool isctx;
    if (a < 512) { b = a >> 7; qb = (a >> 1) & 63; kvh = a & 1; isctx = false; }
    else { const int a2 = a - 512; b = a2 >> 3; qb = (a2 >> 1) & 3; kvh = a2 & 1; isctx = true; }
    const int row0 = isctx ? NL + b * 256 + qb * 64 : b * 4096 + qb * 64;
    const int head = kvh * 4 + (w >> 1), qh = w & 1;
    bf16x8 Qf[2][4];
#pragma unroll
    for (int nq = 0; nq < 2; ++nq)
#pragma unroll
        for (int ks = 0; ks < 4; ++ks)
            Qf[nq][ks] = *(const bf16x8*)(Z + (size_t)(row0 + qh * 32 + nq * 16 + fr) * ZLD + ZQ + head * 128 + ks * 32 + fq * 8);
    f32x4 ot[8][2];
#pragma unroll
    for (int i = 0; i < 8; ++i) { ot[i][0] = (f32x4){0.f, 0.f, 0.f, 0.f}; ot[i][1] = (f32x4){0.f, 0.f, 0.f, 0.f}; }
    float mrun[2] = {-1e30f, -1e30f}, lrun[2] = {0.f, 0.f};
    int lo, hi;
    if (isctx) { lo = 5; hi = 4; } else { lo = (2 - qb) > 0 ? (2 - qb) : 0; hi = (65 - qb) < 4 ? (65 - qb) : 4; }
    int ti = (lo <= hi) ? lo : 5;
    uint4 kreg0, kreg1, vreg0, vreg1;
    const int kch0 = tid, kch1 = tid + 512;
#define AT_LOAD(tile) do { \
    int krow0_, vt0_; \
    if ((tile) <= 4) { const int j_ = qb - 2 + (tile); krow0_ = b * 4096 + j_ * 64; vt0_ = j_ * 64; } \
    else { const int jj_ = (tile) - 5; krow0_ = NL + b * 256 + jj_ * 64; vt0_ = 4096 + jj_ * 64; } \
    kreg0 = *(const uint4*)(Z + (size_t)(krow0_ + (kch0 >> 4)) * ZLD + ZK + kvh * 128 + (kch0 & 15) * 8); \
    kreg1 = *(const uint4*)(Z + (size_t)(krow0_ + (kch1 >> 4)) * ZLD + ZK + kvh * 128 + (kch1 & 15) * 8); \
    vreg0 = *(const uint4*)(VT + ((size_t)((b * 2 + kvh) * 128 + (kch0 >> 3))) * TT + vt0_ + (kch0 & 7) * 8); \
    vreg1 = *(const uint4*)(VT + ((size_t)((b * 2 + kvh) * 128 + (kch1 >> 3))) * TT + vt0_ + (kch1 & 7) * 8); } while (0)
    AT_LOAD(ti);
    for (;;) {
        PROF_B(11, lds, tid == 0);
        __syncthreads();
        *(uint4*)(Ks + (kch0 >> 4) * AT_KSTR + (kch0 & 15) * 16) = kreg0;
        *(uint4*)(Ks + (kch1 >> 4) * AT_KSTR + (kch1 & 15) * 16) = kreg1;
        *(uint4*)(Vs + (kch0 >> 3) * AT_VSTR + (kch0 & 7) * 16) = vreg0;
        *(uint4*)(Vs + (kch1 >> 3) * AT_VSTR + (kch1 & 7) * 16) = vreg1;
        __syncthreads();
        PROF_E(11, lds, tid == 0);
        const int cur = ti;
        const int nxt = (cur == hi) ? 5 : cur + 1;
        if (nxt <= 8) AT_LOAD(nxt);
        f32x4 st[4][2];
#pragma unroll
        for (int mt = 0; mt < 4; ++mt) { st[mt][0] = (f32x4){0.f, 0.f, 0.f, 0.f}; st[mt][1] = (f32x4){0.f, 0.f, 0.f, 0.f}; }
        {
            bf16x8 Kc[4], Kn[4];
#pragma unroll
            for (int mt = 0; mt < 4; ++mt) Kc[mt] = *(const bf16x8*)(Ks + (mt * 16 + fr) * AT_KSTR + (fq * 8) * 2);
#pragma unroll
            for (int ks = 0; ks < 4; ++ks) {
                if (ks < 3) {
#pragma unroll
                    for (int mt = 0; mt < 4; ++mt) Kn[mt] = *(const bf16x8*)(Ks + (mt * 16 + fr) * AT_KSTR + ((ks + 1) * 32 + fq * 8) * 2);
                }
                __builtin_amdgcn_sched_barrier(0);
#pragma unroll
                for (int mt = 0; mt < 4; ++mt) {
                    st[mt][0] = MFMA16(Kc[mt], Qf[0][ks], st[mt][0]);
                    st[mt][1] = MFMA16(Kc[mt], Qf[1][ks], st[mt][1]);
                }
                __builtin_amdgcn_sched_barrier(0);
#pragma unroll
                for (int mt = 0; mt < 4; ++mt) Kc[mt] = Kn[mt];
            }
        }
        const int mtype = (cur == 0) ? 1 : ((cur == 4) ? 2 : 0);
        if (mtype != 0) {
#pragma unroll
            for (int mt = 0; mt < 4; ++mt)
#pragma unroll
                for (int nq = 0; nq < 2; ++nq)
#pragma unroll
                    for (int j = 0; j < 4; ++j) {
                        const int c = mt * 16 + fq * 4 + j, aq = qh * 32 + nq * 16 + fr;
                        const bool keep = (mtype == 1) ? (c >= aq) : (c <= aq);
                        if (!keep) st[mt][nq][j] = -1e30f;
                    }
        }
        bf16x8 Pf[2][2];
#pragma unroll
        for (int nq = 0; nq < 2; ++nq) {
            float mx = st[0][nq][0];
#pragma unroll
            for (int mt = 0; mt < 4; ++mt)
#pragma unroll
                for (int j = 0; j < 4; ++j) mx = fmaxf(mx, st[mt][nq][j]);
            mx = fmaxf(mx, shx(mx, 16, lane)); mx = fmaxf(mx, shx(mx, 32, lane));
            const bool upd = mx > mrun[nq] + 8.f;
            if (__builtin_amdgcn_ballot_w64(upd) != 0ull) {
                const float mn2 = upd ? mx : mrun[nq];
                const float al = __builtin_amdgcn_exp2f(mrun[nq] - mn2);
                mrun[nq] = mn2;
                lrun[nq] *= al;
#pragma unroll
                for (int i = 0; i < 8; ++i) ot[i][nq] *= al;
            }
            const float mn = mrun[nq];
            float ps = 0.f;
#pragma unroll
            for (int mt = 0; mt < 4; ++mt)
#pragma unroll
                for (int j = 0; j < 4; ++j) { const float pv = __builtin_amdgcn_exp2f(st[mt][nq][j] - mn); st[mt][nq][j] = pv; ps += pv; }
            lrun[nq] += ps;
#pragma unroll
            for (int k2 = 0; k2 < 2; ++k2)
                Pf[nq][k2] = mk8(pk2(st[2 * k2][nq][0], st[2 * k2][nq][1]), pk2(st[2 * k2][nq][2], st[2 * k2][nq][3]),
                                 pk2(st[2 * k2 + 1][nq][0], st[2 * k2 + 1][nq][1]), pk2(st[2 * k2 + 1][nq][2], st[2 * k2 + 1][nq][3]));
        }
        {
            uint2 va[4][2], vb[4][2];
#pragma unroll
            for (int i = 0; i < 4; ++i) { const unsigned char* vp = Vs + (i * 16 + fr) * AT_VSTR + (fq * 4) * 2; va[i][0] = *(const uint2*)vp; va[i][1] = *(const uint2*)(vp + 32); }
#pragma unroll
            for (int g = 0; g < 4; ++g) {
                if (g < 3) {
                    const int k2n = (g + 1) >> 1, mdn = ((g + 1) & 1) * 4;
#pragma unroll
                    for (int i = 0; i < 4; ++i) { const unsigned char* vp = Vs + ((mdn + i) * 16 + fr) * AT_VSTR + (k2n * 32 + fq * 4) * 2; vb[i][0] = *(const uint2*)vp; vb[i][1] = *(const uint2*)(vp + 32); }
                }
                __builtin_amdgcn_sched_barrier(0);
                const int k2 = g >> 1, md0 = (g & 1) * 4;
#pragma unroll
                for (int i = 0; i < 4; ++i) {
                    const bf16x8 Vf = mk8(va[i][0].x, va[i][0].y, va[i][1].x, va[i][1].y);
                    ot[md0 + i][0] = MFMA16(Vf, Pf[0][k2], ot[md0 + i][0]);
                    ot[md0 + i][1] = MFMA16(Vf, Pf[1][k2], ot[md0 + i][1]);
                }
                __builtin_amdgcn_sched_barrier(0);
#pragma unroll
                for (int i = 0; i < 4; ++i) { va[i][0] = vb[i][0]; va[i][1] = vb[i][1]; }
            }
        }
        if (nxt > 8) break;
        ti = nxt;
    }
#undef AT_LOAD
    const float sk = p.in[9][L * 8 + head] * 1.4426950408889634f;
#pragma unroll
    for (int nq = 0; nq < 2; ++nq) {
        float l = lrun[nq];
        l += shx(l, 16, lane); l += shx(l, 32, lane);
        const float mf = fmaxf(mrun[nq], sk);
        const float al = __builtin_amdgcn_exp2f(mrun[nq] - mf);
        const float lt = l * al + __builtin_amdgcn_exp2f(sk - mf);
        const float sc = al * rcpf_(lt);
        const int row = row0 + qh * 32 + nq * 16 + fr;
#pragma unroll
        for (int md = 0; md < 8; ++md) {
            const f32x4 o = ot[md][nq] * sc;
            uint2 pk; pk.x = pk2(o[0], o[1]); pk.y = pk2(o[2], o[3]);
            *(uint2*)(MIX + (size_t)row * D + head * 128 + md * 16 + fq * 4) = pk;
        }
    }
}

DEVI void gla_chunk_rows(int b, int ci, int& rowbase, int& tpos0) {
    if (ci < 4) { rowbase = NL + b * 256 + ci * 64; tpos0 = 4096 + ci * 64; } else { rowbase = b * 4096 + (ci - 4) * 64; tpos0 = (ci - 4) * 64; }
}
DEVI float logsig_fast(float z) { return fminf(z, 0.f) - __logf(1.f + __expf(-fabsf(z))); }
DEVI int scan_ci(int dir, int s) { return dir == 0 ? s : (s < 4 ? 3 - s : 71 - s); }

constexpr int GP_GZS = 0, GP_CUM = 8192, GP_TOT = 41472, GP_KT = 41984, GP_VT = 60416, GP_KSM = 78848, MX_TAB = 91648;
DEVI void gla_tables(const int tid_, const Params& p, int L, unsigned char* lds) {
    float* tab = (float*)(lds + MX_TAB);
    __syncthreads();
    for (int i = tid_; i < 8192; i += 512) tab[i] = p.in[10][(size_t)L * 8192 + i];
    tab[8192 + tid_] = p.in[11][L * 512 + tid_];
    __syncthreads();
}

DEVI void gla_p1_phase(const int tid_, const Params& p, int L, unsigned char* lds) {
    const bf16_t* Z = (const bf16_t*)(p.ws + WS_Z);
    const bf16_t* GVT = (const bf16_t*)(p.ws + WS_GVT);
    const float* GZ = (const float*)(p.ws + WS_GZ);
    float* gzs = (float*)(lds + GP_GZS); float* cum = (float*)(lds + GP_CUM); float* tot = (float*)(lds + GP_TOT);
    bf16_t* kT = (bf16_t*)(lds + GP_KT); unsigned char* vts = lds + GP_VT; bf16_t* ksm = (bf16_t*)(lds + GP_KSM);
    const float* tab = (const float*)(lds + MX_TAB);
    const int tid = tid_, w = tid >> 6, lane = tid & 63, fr = lane & 15, fq = lane >> 4;
    const int t = tid >> 3, d0 = (tid & 7) * 8;
    gla_tables(tid_, p, L, lds);
    const int nun = NB * 4 * NCH;
    uint4 pgz, pk, pv0, pv1;
#define G1_PREF(uu) do { const int ci_ = (uu) % NCH, bh_ = (uu) / NCH; int rb_, tp_; gla_chunk_rows(bh_ >> 2, ci_, rb_, tp_); \
    pgz = *(const uint4*)(GZ + (size_t)(rb_ + t) * 32 + (tid & 7) * 4); \
    pk = *(const uint4*)(Z + (size_t)(rb_ + t) * ZLD + ZGK + (bh_ & 3) * 64 + d0); \
    pv0 = *(const uint4*)(GVT + ((size_t)(bh_ * 128 + (tid >> 3))) * TT + tp_ + (tid & 7) * 8); \
    pv1 = *(const uint4*)(GVT + ((size_t)(bh_ * 128 + 64 + (tid >> 3))) * TT + tp_ + (tid & 7) * 8); } while (0)
    int u = blockIdx.x;
    if (u < nun) G1_PREF(u);
    for (; u < nun; u += gridDim.x) {
        const int ci = u % NCH, bh = u / NCH, h = bh & 3;
        lds_sync();
        {
            const int r0 = (tid & 7) * 4;
            gzs[(r0 + 0) * 64 + t] = __uint_as_float(pgz.x); gzs[(r0 + 1) * 64 + t] = __uint_as_float(pgz.y);
            gzs[(r0 + 2) * 64 + t] = __uint_as_float(pgz.z); gzs[(r0 + 3) * 64 + t] = __uint_as_float(pgz.w);
        }
        *(uint4*)(vts + (tid >> 3) * 144 + (tid & 7) * 16) = pv0;
        *(uint4*)(vts + (64 + (tid >> 3)) * 144 + (tid & 7) * 16) = pv1;
        *(uint4*)((unsigned char*)ksm + t * 144 + d0 * 2) = pk;
        lds_sync();
        if (u + (int)gridDim.x < nun) G1_PREF(u + (int)gridDim.x);
#pragma unroll
        for (int dir = 0; dir < 2; ++dir) {
            float z[8];
#pragma unroll
            for (int i = 0; i < 8; ++i) z[i] = tab[8192 + dir * 256 + h * 64 + d0 + i];
#pragma unroll
            for (int r = 0; r < 16; ++r) {
                const float g = gzs[(dir * 16 + r) * 64 + t];
                const float4 w0 = *(const float4*)(tab + (dir * 16 + r) * 256 + h * 64 + d0), w1 = *(const float4*)(tab + (dir * 16 + r) * 256 + h * 64 + d0 + 4);
                z[0] += g * w0.x; z[1] += g * w0.y; z[2] += g * w0.z; z[3] += g * w0.w; z[4] += g * w1.x; z[5] += g * w1.y; z[6] += g * w1.z; z[7] += g * w1.w;
            }
#pragma unroll
            for (int i = 0; i < 8; ++i) cum[(dir * 64 + t) * 65 + d0 + i] = logsig_fast(z[i]) * (1.f / 16.f);
        }
        lds_sync();
        if (tid < 128) {
            const int dir = tid >> 6, d = tid & 63;
            float vv[64];
#pragma unroll
            for (int s2 = 0; s2 < 64; ++s2) vv[s2] = cum[(dir * 64 + (dir ? 63 - s2 : s2)) * 65 + d];
            float a = 0.f;
#pragma unroll
            for (int s2 = 0; s2 < 64; ++s2) { a += vv[s2]; vv[s2] = a; }
#pragma unroll
            for (int s2 = 0; s2 < 64; ++s2) cum[(dir * 64 + (dir ? 63 - s2 : s2)) * 65 + d] = vv[s2];
            tot[tid] = a;
        }
        lds_sync();
        {
            float* CG = (float*)(p.ws + WS_CUMG) + ((size_t)u * 2) * 4096;
#pragma unroll
            for (int dir = 0; dir < 2; ++dir) {
                const float tt = tot[dir * 64 + lane];
                float kd[8];
#pragma unroll
                for (int i = 0; i < 8; ++i) {
                    const int ti = w * 8 + i;
                    const float cv = cum[(dir * 64 + ti) * 65 + lane];
                    kd[i] = bf2f(ksm[ti * 72 + lane]) * __expf(tt - cv);
                    CG[(size_t)dir * 4096 + ti * 64 + lane] = cv;
                }
                uint4 o; o.x = pk2(kd[0], kd[1]); o.y = pk2(kd[2], kd[3]); o.z = pk2(kd[4], kd[5]); o.w = pk2(kd[6], kd[7]);
                *(uint4*)((unsigned char*)kT + ((dir * 64 + lane) * 72 + w * 8) * 2) = o;
            }
        }
        lds_sync();
        {
            const bf16x8 Af0 = *(const bf16x8*)(vts + (w * 16 + fr) * 144 + (fq * 8) * 2);
            const bf16x8 Af1 = *(const bf16x8*)(vts + (w * 16 + fr) * 144 + (32 + fq * 8) * 2);
#pragma unroll
            for (int dir = 0; dir < 2; ++dir) {
                f32x4 acc[4];
#pragma unroll
                for (int n = 0; n < 4; ++n) {
                    acc[n] = (f32x4){0.f, 0.f, 0.f, 0.f};
                    const bf16x8 Bf0 = *(const bf16x8*)((const unsigned char*)kT + ((dir * 64 + n * 16 + fr) * 72 + fq * 8) * 2);
                    const bf16x8 Bf1 = *(const bf16x8*)((const unsigned char*)kT + ((dir * 64 + n * 16 + fr) * 72 + 32 + fq * 8) * 2);
                    acc[n] = MFMA16(Af0, Bf0, acc[n]);
                    acc[n] = MFMA16(Af1, Bf1, acc[n]);
                }
                const int sq = bh * 2 + dir;
                float* CT = (float*)(p.ws + WS_CONTRIB) + ((size_t)(sq * NCH + ci)) * 8192;
#pragma unroll
                for (int n = 0; n < 4; ++n)
#pragma unroll
                    for (int j = 0; j < 4; ++j) CT[(w * 16 + fq * 4 + j) * 64 + n * 16 + fr] = acc[n][j];
            }
            if (tid < 128) { const int dir = tid >> 6, d = tid & 63; ((float*)(p.ws + WS_ATOT))[((size_t)((bh * 2 + dir) * NCH + ci)) * 64 + d] = __expf(tot[tid]); }
        }
    }
#undef G1_PREF
}

DEVI void gla_scan(const int tid_, const Params& p) {
    const float* __restrict__ CT = (const float*)(p.ws + WS_CONTRIB);
    const float* __restrict__ AT = (const float*)(p.ws + WS_ATOT);
    unsigned* __restrict__ SB = (unsigned*)(p.ws + WS_SBEF);
    for (int idx = blockIdx.x * 512 + tid_; idx < 32 * 128 * 32; idx += gridDim.x * 512) {
        const int dp = idx & 31, dv = (idx >> 5) & 127, sq = idx >> 12, dir = sq & 1;
        const float* ctp = CT + (size_t)sq * NCH * 8192 + dv * 64 + dp * 2;
        const float* atp = AT + (size_t)sq * NCH * 64 + dp * 2;
        unsigned* sbp = SB + (size_t)sq * NCH * 4096 + dv * 32 + dp;
        float s0 = 0.f, s1 = 0.f;
        float2 c[4], a[4], cn[4], an[4];
#pragma unroll
        for (int q = 0; q < 4; ++q) { const int ci = scan_ci(dir, q); c[q] = *(const float2*)(ctp + (size_t)ci * 8192); a[q] = *(const float2*)(atp + (size_t)ci * 64); }
#pragma unroll 1
        for (int s = 0; s < NCH; s += 4) {
            if (s + 4 < NCH) {
#pragma unroll
                for (int q = 0; q < 4; ++q) { const int ci = scan_ci(dir, s + 4 + q); cn[q] = *(const float2*)(ctp + (size_t)ci * 8192); an[q] = *(const float2*)(atp + (size_t)ci * 64); }
            }
#pragma unroll
            for (int q = 0; q < 4; ++q) {
                const int ci = scan_ci(dir, s + q);
                sbp[(size_t)ci * 4096] = pk2(s0, s1);
                s0 = a[q].x * s0 + c[q].x; s1 = a[q].y * s1 + c[q].y;
            }
#pragma unroll
            for (int q = 0; q < 4; ++q) { c[q] = cn[q]; a[q] = an[q]; }
        }
    }
}

constexpr int G3_QS = 0, G3_KS = 18432, G3_SS = 36864, G3_VT = 73728, G3_PART = 92160, G3_OB = 92672;
DEVI void gla_p3_phase(const int tid_, const Params& p, int L, unsigned char* lds) {
    const bf16_t* Z = (const bf16_t*)(p.ws + WS_Z);
    const bf16_t* GVT = (const bf16_t*)(p.ws + WS_GVT);
    const float* CUMG = (const float*)(p.ws + WS_CUMG);
    const bf16_t* SBEF = (const bf16_t*)(p.ws + WS_SBEF);
    bf16_t* MIX = (bf16_t*)(p.ws + WS_MIX);
    unsigned char* qs = lds + G3_QS; unsigned char* ks = lds + G3_KS; unsigned char* ss = lds + G3_SS; unsigned char* vts = lds + G3_VT;
    float* part = (float*)(lds + G3_PART); float* ob = (float*)(lds + G3_OB);
    const int tid = tid_, w = tid >> 6, lane = tid & 63, fr = lane & 15, fq = lane >> 4;
    const int ntl = w & 3, dvh = w >> 2;
    const int t = tid >> 3, d0 = (tid & 7) * 8, dv0 = (tid & 7) * 16;
    const int cfirst = (L == 0) ? 0 : 4, ncl = NCH - cfirst, nun = NB * 4 * ncl;
    uint4 pq, pk, psf0, psf1, psb0, psb1, pv0, pv1, pg0, pg1;
    float4 pcf0, pcf1, pcb0, pcb1;
#define G3_PREF(uu) do { const int ci_ = cfirst + (uu) % ncl, bh_ = (uu) / ncl; int rb_, tp_; gla_chunk_rows(bh_ >> 2, ci_, rb_, tp_); \
    const size_t u1_ = (size_t)bh_ * NCH + ci_; \
    pq = *(const uint4*)(Z + (size_t)(rb_ + t) * ZLD + ZGQ + (bh_ & 3) * 64 + d0); \
    pk = *(const uint4*)(Z + (size_t)(rb_ + t) * ZLD + ZGK + (bh_ & 3) * 64 + d0); \
    pcf0 = *(const float4*)(CUMG + (u1_ * 2) * 4096 + t * 64 + d0); pcf1 = *(const float4*)(CUMG + (u1_ * 2) * 4096 + t * 64 + d0 + 4); \
    pcb0 = *(const float4*)(CUMG + (u1_ * 2 + 1) * 4096 + t * 64 + d0); pcb1 = *(const float4*)(CUMG + (u1_ * 2 + 1) * 4096 + t * 64 + d0 + 4); \
    { const bf16_t* sf_ = SBEF + ((size_t)((bh_ * 2) * NCH + ci_)) * 8192; const bf16_t* sb_ = SBEF + ((size_t)((bh_ * 2 + 1) * NCH + ci_)) * 8192; \
      psf0 = *(const uint4*)(sf_ + tid * 8); psf1 = *(const uint4*)(sf_ + 4096 + tid * 8); psb0 = *(const uint4*)(sb_ + tid * 8); psb1 = *(const uint4*)(sb_ + 4096 + tid * 8); } \
    pv0 = *(const uint4*)(GVT + ((size_t)(bh_ * 128 + (tid >> 3))) * TT + tp_ + (tid & 7) * 8); \
    pv1 = *(const uint4*)(GVT + ((size_t)(bh_ * 128 + 64 + (tid >> 3))) * TT + tp_ + (tid & 7) * 8); \
    pg0 = *(const uint4*)(Z + (size_t)(rb_ + t) * ZLD + ZGR + (bh_ & 3) * 128 + dv0); \
    pg1 = *(const uint4*)(Z + (size_t)(rb_ + t) * ZLD + ZGR + (bh_ & 3) * 128 + dv0 + 8); } while (0)
    int u = blockIdx.x;
    if (u < nun) G3_PREF(u);
    for (; u < nun; u += gridDim.x) {
        const int ci = cfirst + u % ncl, bh = u / ncl, h = bh & 3;
        int rowbase, tpos0; gla_chunk_rows(bh >> 2, ci, rowbase, tpos0);
        lds_sync();
        {
            const unsigned qw[4] = {pq.x, pq.y, pq.z, pq.w}, kw[4] = {pk.x, pk.y, pk.z, pk.w};
            const float cf[8] = {pcf0.x, pcf0.y, pcf0.z, pcf0.w, pcf1.x, pcf1.y, pcf1.z, pcf1.w};
            const float cb[8] = {pcb0.x, pcb0.y, pcb0.z, pcb0.w, pcb1.x, pcb1.y, pcb1.z, pcb1.w};
#pragma unroll
            for (int dir = 0; dir < 2; ++dir) {
                unsigned qo[4], ko[4];
#pragma unroll
                for (int i = 0; i < 4; ++i) {
                    const float c0 = dir ? cb[2 * i] : cf[2 * i], c1 = dir ? cb[2 * i + 1] : cf[2 * i + 1];
                    qo[i] = pk2(bflo(qw[i]) * 0.125f * __expf(c0), bfhi(qw[i]) * 0.125f * __expf(c1));
                    ko[i] = pk2(bflo(kw[i]) * __expf(fminf(-c0, 80.f)), bfhi(kw[i]) * __expf(fminf(-c1, 80.f)));
                }
                uint4 t4; t4.x = qo[0]; t4.y = qo[1]; t4.z = qo[2]; t4.w = qo[3];
                *(uint4*)(qs + (dir * 64 + t) * 144 + d0 * 2) = t4;
                t4.x = ko[0]; t4.y = ko[1]; t4.z = ko[2]; t4.w = ko[3];
                *(uint4*)(ks + (dir * 64 + t) * 144 + d0 * 2) = t4;
            }
            *(uint4*)(ss + (tid >> 3) * 144 + (tid & 7) * 16) = psf0;
            *(uint4*)(ss + (64 + (tid >> 3)) * 144 + (tid & 7) * 16) = psf1;
            *(uint4*)(ss + (128 + (tid >> 3)) * 144 + (tid & 7) * 16) = psb0;
            *(uint4*)(ss + (192 + (tid >> 3)) * 144 + (tid & 7) * 16) = psb1;
            *(uint4*)(vts + (tid >> 3) * 144 + (tid & 7) * 16) = pv0;
            *(uint4*)(vts + (64 + (tid >> 3)) * 144 + (tid & 7) * 16) = pv1;
        }
        const uint4 gr0 = pg0, gr1 = pg1;
        lds_sync();
        if (u + (int)gridDim.x < nun) G3_PREF(u + (int)gridDim.x);
        f32x4 oacc[4];
#pragma unroll
        for (int i = 0; i < 4; ++i) oacc[i] = (f32x4){0.f, 0.f, 0.f, 0.f};
#pragma unroll
        for (int dir = 0; dir < 2; ++dir) {
            bf16x8 Bq[2];
            f32x4 at[4];
#pragma unroll
            for (int m = 0; m < 4; ++m) at[m] = (f32x4){0.f, 0.f, 0.f, 0.f};
#pragma unroll
            for (int k_ = 0; k_ < 2; ++k_) {
                Bq[k_] = *(const bf16x8*)(qs + (dir * 64 + ntl * 16 + fr) * 144 + (k_ * 32 + fq * 8) * 2);
#pragma unroll
                for (int m = 0; m < 4; ++m) {
                    const bf16x8 Ak = *(const bf16x8*)(ks + (dir * 64 + m * 16 + fr) * 144 + (k_ * 32 + fq * 8) * 2);
                    at[m] = MFMA16(Ak, Bq[k_], at[m]);
                }
            }
            {
                const int tq = ntl * 16 + fr;
#pragma unroll
                for (int m = 0; m < 4; ++m)
#pragma unroll
                    for (int j = 0; j < 4; ++j) {
                        const int s = m * 16 + fq * 4 + j;
                        const bool keep = dir == 0 ? (s <= tq) : (s >= tq);
                        if (!keep) at[m][j] = 0.f;
                    }
            }
#pragma unroll
            for (int k2 = 0; k2 < 2; ++k2) {
                const bf16x8 Pf = mk8(pk2(at[2 * k2][0], at[2 * k2][1]), pk2(at[2 * k2][2], at[2 * k2][3]),
                                      pk2(at[2 * k2 + 1][0], at[2 * k2 + 1][1]), pk2(at[2 * k2 + 1][2], at[2 * k2 + 1][3]));
#pragma unroll
                for (int md = 0; md < 4; ++md) {
                    const unsigned char* vp = vts + (dvh * 64 + md * 16 + fr) * 144 + (k2 * 32 + fq * 4) * 2;
                    const uint2 v0 = *(const uint2*)vp, v1 = *(const uint2*)(vp + 32);
                    oacc[md] = MFMA16(mk8(v0.x, v0.y, v1.x, v1.y), Pf, oacc[md]);
                }
            }
#pragma unroll
            for (int k_ = 0; k_ < 2; ++k_)
#pragma unroll
                for (int md = 0; md < 4; ++md) {
                    const bf16x8 As = *(const bf16x8*)(ss + (dir * 128 + dvh * 64 + md * 16 + fr) * 144 + (k_ * 32 + fq * 8) * 2);
                    oacc[md] = MFMA16(As, Bq[k_], oacc[md]);
                }
        }
        float sq = 0.f;
#pragma unroll
        for (int md = 0; md < 4; ++md)
#pragma unroll
            for (int j = 0; j < 4; ++j) sq += oacc[md][j] * oacc[md][j];
        sq += shx(sq, 16, lane); sq += shx(sq, 32, lane);
        if (fq == 0) part[w * 16 + fr] = sq;
        lds_sync();
        {
            const float tot2 = part[ntl * 16 + fr] + part[(ntl + 4) * 16 + fr];
            const float rstd = rsqrtf(tot2 * (1.f / 128.f) + 1e-6f);
#pragma unroll
            for (int md = 0; md < 4; ++md)
#pragma unroll
                for (int j = 0; j < 4; ++j) ob[(ntl * 16 + fr) * 132 + dvh * 64 + md * 16 + fq * 4 + j] = oacc[md][j] * rstd;
        }
        lds_sync();
        {
            const float* gn = p.in[12] + L * 128;
            const unsigned rw[8] = {gr0.x, gr0.y, gr0.z, gr0.w, gr1.x, gr1.y, gr1.z, gr1.w};
            unsigned o[8];
#pragma unroll
            for (int i4 = 0; i4 < 4; ++i4) {
                const float4 ov = *(const float4*)(ob + t * 132 + dv0 + 4 * i4), gv = *(const float4*)(gn + dv0 + 4 * i4);
                o[2 * i4] = pk2(ov.x * gv.x * siluf_(bflo(rw[2 * i4])), ov.y * gv.y * siluf_(bfhi(rw[2 * i4])));
                o[2 * i4 + 1] = pk2(ov.z * gv.z * siluf_(bflo(rw[2 * i4 + 1])), ov.w * gv.w * siluf_(bfhi(rw[2 * i4 + 1])));
            }
            uint4 a4; a4.x = o[0]; a4.y = o[1]; a4.z = o[2]; a4.w = o[3];
            uint4 b4; b4.x = o[4]; b4.y = o[5]; b4.z = o[6]; b4.w = o[7];
            bf16_t* dst = MIX + (size_t)(rowbase + t) * D + 1024 + h * 128 + dv0;
            *(uint4*)dst = a4; *(uint4*)(dst + 8) = b4;
        }
    }
#undef G3_PREF
}

constexpr int LR_XCF = 17152, LR_XCB = 34560, LR_OUTB = 43776;
template <int CTRL> DEVI float dppf(float oldv, float v) { return __int_as_float(__builtin_amdgcn_update_dpp(__float_as_int(oldv), __float_as_int(v), CTRL, 0xf, 0xf, false)); }
template <int DIR> DEVI void lru_tile_scan(float& A, float& B) {
    constexpr int base = DIR ? 0x100 : 0x110;
    { const float A2 = dppf<base | 1>(1.f, A), B2 = dppf<base | 1>(0.f, B); B = A * B2 + B; A = A * A2; }
    { const float A2 = dppf<base | 2>(1.f, A), B2 = dppf<base | 2>(0.f, B); B = A * B2 + B; A = A * A2; }
    { const float A2 = dppf<base | 4>(1.f, A), B2 = dppf<base | 4>(0.f, B); B = A * B2 + B; A = A * A2; }
    { const float A2 = dppf<base | 8>(1.f, A), B2 = dppf<base | 8>(0.f, B); B = A * B2 + B; A = A * A2; }
}
template <int PASS, int DIR>
DEVI void lru_wave_scan(const float (&av)[4][4], const float (&uv)[4][4], const float carry, int lane, int fr, int cb, int fq,
                        float* outb, float* la_out, float* lb_out) {
    float hin = (PASS == 3) ? carry : 0.f, pin = 1.f;
    const int l1 = DIR ? lane + 16 : lane - 16, l2 = DIR ? lane + 32 : lane - 32;
    const bool ok1 = DIR ? (fq <= 2) : (fq >= 1), ok2 = DIR ? (fq <= 1) : (fq >= 2);
    const int lend = DIR ? fr : 48 + fr;
#pragma unroll
    for (int mi = 0; mi < 4; ++mi) {
        const int m = DIR ? 3 - mi : mi;
        float Aj[4], Bj[4];
        float A = 1.f, B = 0.f;
#pragma unroll
        for (int jj = 0; jj < 4; ++jj) {
            const int j = DIR ? 3 - jj : jj;
            B = av[m][j] * B + uv[m][j]; A = A * av[m][j];
            Aj[j] = A; Bj[j] = B;
        }
        float Ai = A, Bi = B;
        { const float A2 = shidx(Ai, l1 & 63), B2 = shidx(Bi, l1 & 63); if (ok1) { Bi = Ai * B2 + Bi; Ai = Ai * A2; } }
        { const float A2 = shidx(Ai, l2 & 63), B2 = shidx(Bi, l2 & 63); if (ok2) { Bi = Ai * B2 + Bi; Ai = Ai * A2; } }
        float Ae = shidx(Ai, l1 & 63), Be = shidx(Bi, l1 & 63);
        if (!ok1) { Ae = 1.f; Be = 0.f; }
        const float hlane = Be + Ae * hin;
#pragma unroll
        for (int j = 0; j < 4; ++j) {
            const float hf = Bj[j] + Aj[j] * hlane;
            if (PASS == 3) outb[(DIR * 64 + m * 16 + fq * 4 + j) * 65 + cb * 16 + fr] = hf;
        }
        const float hend = Bi + Ai * hin;
        hin = shidx(hend, lend);
        if (PASS == 1) pin = shidx(Ai * pin, lend);
    }
    if (PASS == 1 && fq == 0) { la_out[fr] = pin; lb_out[fr] = hin; }
}

template <int PASS>
DEVI void lru_phase(const int tid_, const Params& p, int L, unsigned char* lds) {
    const bf16_t* Z = (const bf16_t*)(p.ws + WS_Z);
    float* xs = (float*)lds; float* xcf = (float*)(lds + LR_XCF); unsigned char* xcb = lds + LR_XCB; float* outb = (float*)(lds + LR_OUTB);
    float* tab = (float*)(lds + MX_TAB);
    const int tid = tid_, w = tid >> 6, lane = tid & 63, fr = lane & 15, fq = lane >> 4;
    const int dir = w >> 2, cb = w & 3;
    const int t = tid >> 3, c0 = (tid & 7) * 8;
    const int cfirst = (PASS == 3 && L == 1) ? 4 : 0, ncl = NCH - cfirst, nun = NB * ncl * 8;
    __syncthreads();
    for (int i = tid; i < 2048; i += 512) tab[i] = p.in[13][(size_t)L * 2048 + i];
    tab[2048 + tid] = p.in[14][L * 512 + tid];
    for (int i = tid; i < 1024; i += 512) {
        tab[2560 + i] = p.in[16][L * 1024 + i]; tab[3584 + i] = p.in[18][L * 1024 + i];
        tab[4608 + i] = -8.f * log1pf(expf(-p.in[19][L * 1024 + i]));
    }
    __syncthreads();
    unsigned short pxr[11];
    uint4 plg;
    float pcar = 0.f;
#define LR_DEC(uu, blk_, ci_, b_) const int blk_ = (uu) & 7, ci_ = cfirst + ((uu) >> 3) % ncl, b_ = ((uu) >> 3) / ncl
#define LR_PREF(uu) do { LR_DEC(uu, blk_, ci_, b_); int sr_, sl_, t0_; \
    if (ci_ < 4) { sr_ = NL + b_ * 256; sl_ = 256; t0_ = ci_ * 64; } else { sr_ = b_ * 4096; sl_ = 4096; t0_ = (ci_ - 4) * 64; } \
    _Pragma("unroll") for (int k_ = 0; k_ < 11; ++k_) { const int tm_ = t0_ - 2 + w * 8 + k_; \
        pxr[k_] = (tm_ >= 0 && tm_ < sl_) ? Z[(size_t)(sr_ + tm_) * ZLD + ZLX + blk_ * 64 + lane] : (unsigned short)0; } \
    if (PASS == 3) { plg = *(const uint4*)(Z + (size_t)(sr_ + t0_ + t) * ZLD + ZLG + blk_ * 64 + c0); \
        pcar = ((const float*)(p.ws + WS_LRUC))[((size_t)((b_ * NCH + ci_) * 2 + dir)) * 512 + blk_ * 64 + cb * 16 + fr]; } } while (0)
    int u = blockIdx.x;
    if (u < nun) LR_PREF(u);
    for (; u < nun; u += gridDim.x) {
        LR_DEC(u, blk, ci, b);
        const int rowbase = (ci < 4) ? NL + b * 256 + ci * 64 : b * 4096 + (ci - 4) * 64;
        float xr[11];
#pragma unroll
        for (int k = 0; k < 11; ++k) xr[k] = bf2f(pxr[k]);
        const uint4 lgc = plg;
        const float carry = pcar;
        const bf16_t* WT = (const bf16_t*)(p.ws + WS_LRUWT) + (size_t)(L * 8 + blk) * 256 * 64;
        bf16x8 Bw[2][2];
#pragma unroll
        for (int g = 0; g < 2; ++g)
#pragma unroll
            for (int ks = 0; ks < 2; ++ks)
                Bw[g][ks] = *(const bf16x8*)(WT + (size_t)(((dir * 2 + g) * 4 + cb) * 16 + fr) * 64 + ks * 32 + fq * 8);
        if (u + (int)gridDim.x < nun) LR_PREF(u + (int)gridDim.x);
        lds_sync();
        {
            const int ch = blk * 64 + lane;
            const float cw0 = tab[ch], cw1 = tab[512 + ch], cw2 = tab[1024 + ch], cw3 = tab[1536 + ch], cbv = tab[2048 + ch];
#pragma unroll
            for (int i = 0; i < 8; ++i) {
                const float y = cbv + xr[i] * cw0 + xr[i + 1] * cw1 + xr[i + 2] * cw2 + xr[i + 3] * cw3;
                xcf[(w * 8 + i) * 68 + lane] = y;
                ((bf16_t*)xcb)[(w * 8 + i) * 72 + lane] = f2bf(y);
            }
        }
        lds_sync();
        float av[4][4], uv[4][4];
        {
            f32x4 ga[4], gx[4];
#pragma unroll
            for (int m = 0; m < 4; ++m) { ga[m] = (f32x4){0.f, 0.f, 0.f, 0.f}; gx[m] = (f32x4){0.f, 0.f, 0.f, 0.f}; }
#pragma unroll
            for (int ks = 0; ks < 2; ++ks)
#pragma unroll
                for (int m = 0; m < 4; ++m) {
                    const bf16x8 Af = *(const bf16x8*)(xcb + (m * 16 + fr) * 144 + (ks * 32 + fq * 8) * 2);
                    ga[m] = MFMA16(Af, Bw[0][ks], ga[m]);
                    gx[m] = MFMA16(Af, Bw[1][ks], gx[m]);
                }
            const int ch = blk * 64 + cb * 16 + fr;
            const float bal = tab[2560 + dir * 512 + ch], bxl = tab[3584 + dir * 512 + ch], cfl = tab[4608 + dir * 512 + ch];
#pragma unroll
            for (int m = 0; m < 4; ++m)
#pragma unroll
                for (int j = 0; j < 4; ++j) {
                    const float xl = xcf[(m * 16 + fq * 4 + j) * 68 + cb * 16 + fr];
                    const float la = cfl * sigmoidf_(ga[m][j] + bal);
                    const float a = __expf(la);
                    const float om = __builtin_fmaf(-a, a, 1.f);
                    av[m][j] = a;
                    uv[m][j] = __builtin_amdgcn_sqrtf(om) * sigmoidf_(gx[m][j] + bxl) * xl;
                }
        }
        {
            const size_t sbase = ((size_t)((b * NCH + ci) * 2 + dir)) * 512 + blk * 64 + cb * 16;
            float* la_out = (float*)(p.ws + WS_LRUA) + sbase; float* lb_out = (float*)(p.ws + WS_LRUB) + sbase;
            if (dir == 0) lru_wave_scan<PASS, 0>(av, uv, carry, lane, fr, cb, fq, outb, la_out, lb_out);
            else lru_wave_scan<PASS, 1>(av, uv, carry, lane, fr, cb, fq, outb, la_out, lb_out);
        }
        if (PASS == 3) {
            lds_sync();
            const unsigned lw[4] = {lgc.x, lgc.y, lgc.z, lgc.w};
            unsigned o[4];
#pragma unroll
            for (int i = 0; i < 4; ++i) {
                const float h0 = outb[t * 65 + c0 + 2 * i] + outb[(64 + t) * 65 + c0 + 2 * i];
                const float h1 = outb[t * 65 + c0 + 2 * i + 1] + outb[(64 + t) * 65 + c0 + 2 * i + 1];
                o[i] = pk2(h0 * gelu_tanh(bflo(lw[i])), h1 * gelu_tanh(bfhi(lw[i])));
            }
            uint4 o4; o4.x = o[0]; o4.y = o[1]; o4.z = o[2]; o4.w = o[3];
            *(uint4*)((bf16_t*)(p.ws + WS_MIX) + (size_t)(rowbase + t) * D + 1536 + blk * 64 + c0) = o4;
        }
    }
#undef LR_PREF
#undef LR_DEC
}

DEVI void lru_carry_scan(const int tid_, const Params& p) {
    const float* __restrict__ LA = (const float*)(p.ws + WS_LRUA);
    const float* __restrict__ LB = (const float*)(p.ws + WS_LRUB);
    float* __restrict__ LC = (float*)(p.ws + WS_LRUC);
    for (int idx = blockIdx.x * 512 + tid_; idx < 4096; idx += gridDim.x * 512) {
        const int ch = idx & 511, dir = (idx >> 9) & 1, b = idx >> 10;
        float hc = 0.f;
#pragma unroll 1
        for (int s = 0; s < NCH; s += 4) {
            float a[4], bb[4];
#pragma unroll
            for (int q = 0; q < 4; ++q) {
                const size_t si = ((size_t)((b * NCH + scan_ci(dir, s + q)) * 2 + dir)) * 512 + ch;
                a[q] = LA[si]; bb[q] = LB[si];
            }
#pragma unroll
            for (int q = 0; q < 4; ++q) {
                const size_t si = ((size_t)((b * NCH + scan_ci(dir, s + q)) * 2 + dir)) * 512 + ch;
                LC[si] = hc;
                hc = a[q] * hc + bb[q];
            }
        }
    }
}

DEVI void phase_mix_a(const int tid_, const Params& p, int L, unsigned char* lds) {
    const int na = (L == 0) ? 544 : 512;
    PROF_B(10, lds, tid_ == 0);
#pragma unroll 1
    for (int rep = 0; rep < ((REP_SUB == 100 && L == 0) ? 2 : 1); ++rep)
        for (int a = blockIdx.x; a < na; a += gridDim.x) attn_unit(tid_, p, L, a, lds);
    PROF_E(10, lds, tid_ == 0);
    PROF_B(12, lds, tid_ == 0);
    gla_p1_phase(tid_, p, L, lds);
    PROF_E(12, lds, tid_ == 0);
    if (REP_SUB == 101 && L == 0) gla_p1_phase(tid_, p, L, lds);
    PROF_B(13, lds, tid_ == 0);
    lru_phase<1>(tid_, p, L, lds);
    PROF_E(13, lds, tid_ == 0);
    if (REP_SUB == 102 && L == 0) lru_phase<1>(tid_, p, L, lds);
}
DEVI void phase_mix_b(const int tid_, const Params& p) { gla_scan(tid_, p); lru_carry_scan(tid_, p); }
DEVI void phase_mix_c(const int tid_, const Params& p, int L, unsigned char* lds) {
    PROF_B(14, lds, tid_ == 0);
    gla_p3_phase(tid_, p, L, lds);
    PROF_E(14, lds, tid_ == 0);
    if (REP_SUB == 103 && L == 0) gla_p3_phase(tid_, p, L, lds);
    PROF_B(15, lds, tid_ == 0);
    lru_phase<3>(tid_, p, L, lds);
    PROF_E(15, lds, tid_ == 0);
    if (REP_SUB == 104 && L == 0) lru_phase<3>(tid_, p, L, lds);
}

DEVI void phase_norm2(const int tid_, const Params& p, int L, unsigned char* lds, bool dry = false) {
    const int nrows = (L == 0) ? NT : NL;
    const int tid = tid_, w = tid >> 6, lane = tid & 63, fr = lane & 15, fq = lane >> 4;
    const float* H = (const float*)(p.ws + WS_H);
    bf16_t* U = (bf16_t*)(p.ws + WS_U);
    const float* mods = (const float*)(p.ws + WS_MODS);
    const float* gffn = p.in[7] + L * 2048;
    const bf16_t* WR = (const bf16_t*)(p.ws + WS_WRT) + (size_t)L * 48 * 2048;
    unsigned char* vt = lds;
    float* part = (float*)(lds + 65792);
    float* lgt = (float*)(lds + 65792 + 24576);
    unsigned* cnt = (unsigned*)(p.ws + WS_CTL) + (dry ? 8192 : CTL_COUNT) + L * 32;
    int* tokl = (int*)(p.ws + (dry ? WS_END : WS_TOKL));
    float* gatel = (float*)(p.ws + (dry ? WS_END + (size_t)32 * TOKCAP * 4 : WS_GATEL));
    unsigned char* wr2 = lds + 93440;
    __syncthreads();
#pragma unroll
    for (int i = 0; i < 2; ++i) { const int ch = tid + 512 * i; *(uint4*)(wr2 + ch * 16) = *(const uint4*)(WR + (size_t)32 * 2048 + ch * 8); }
    __syncthreads();
    bf16x8 Bf[8][2];
#pragma unroll
    for (int kk = 0; kk < 8; ++kk)
#pragma unroll
        for (int n = 0; n < 2; ++n) Bf[kk][n] = *(const bf16x8*)(WR + (size_t)(n * 16 + fr) * 2048 + w * 256 + kk * 32 + fq * 8);
    int* dec = (int*)(lds + 109824);
    int* lcnt = (int*)(lds + 109824 + 128 * 32);
    if (tid < 64) lcnt[tid] = 0;
    __syncthreads();
    int nloc = 0;
    float4 ha[8], hb[8];
    const int nit = nrows / 16;
    int it = blockIdx.x;
    if (it < nit) {
#pragma unroll
        for (int c = 0; c < 8; ++c) { ha[c] = *(const float4*)(H + (size_t)(it * 16 + w * 2) * D + c * 256 + lane * 4); hb[c] = *(const float4*)(H + (size_t)(it * 16 + w * 2 + 1) * D + c * 256 + lane * 4); }
    }
    for (; it < nit; it += gridDim.x) {
        lds_sync();
#define N2_ROW(hx, rr) do { \
            const int lr = w * 2 + (rr), row = it * 16 + lr; \
            const int mrow = row < NL ? (row >> 12) : 4; \
            const float* md = mods + (size_t)(L * 5 + mrow) * 12288; \
            float ss = 0.f; \
            _Pragma("unroll") for (int c = 0; c < 8; ++c) ss += hx[c].x * hx[c].x + hx[c].y * hx[c].y + hx[c].z * hx[c].z + hx[c].w * hx[c].w; \
            ss = wave_sum(ss, lane); \
            const float rstd = rsqrtf(ss * (1.f / 2048.f) + 1e-6f); \
            _Pragma("unroll") for (int c = 0; c < 8; ++c) { \
                const int col = c * 256 + lane * 4; \
                const float4 gm = *(const float4*)(gffn + col), sh = *(const float4*)(md + 3 * 2048 + col), sc = *(const float4*)(md + 4 * 2048 + col); \
                const float u0 = hx[c].x * rstd * gm.x * (1.f + sc.x) + sh.x, u1 = hx[c].y * rstd * gm.y * (1.f + sc.y) + sh.y; \
                const float u2 = hx[c].z * rstd * gm.z * (1.f + sc.z) + sh.z, u3 = hx[c].w * rstd * gm.w * (1.f + sc.w) + sh.w; \
                uint2 o; o.x = pk2(u0, u1); o.y = pk2(u2, u3); \
                *(uint2*)(U + (size_t)row * D + col) = o; \
                *(uint2*)(vt + lr * 4112 + col * 2) = o; \
                asm volatile("" ::: "memory"); } } while (0)
        N2_ROW(ha, 0);
        N2_ROW(hb, 1);
#undef N2_ROW
        if (it + (int)gridDim.x < nit) {
            const int itn = it + (int)gridDim.x;
#pragma unroll
            for (int c = 0; c < 8; ++c) { ha[c] = *(const float4*)(H + (size_t)(itn * 16 + w * 2) * D + c * 256 + lane * 4); hb[c] = *(const float4*)(H + (size_t)(itn * 16 + w * 2 + 1) * D + c * 256 + lane * 4); }
        }
        lds_sync();
        {
            f32x4 acc[3];
#pragma unroll
            for (int n = 0; n < 3; ++n) acc[n] = (f32x4){0.f, 0.f, 0.f, 0.f};
#pragma unroll
            for (int kk = 0; kk < 8; ++kk) {
                const int k0 = w * 256 + kk * 32 + fq * 8;
                const bf16x8 Af = *(const bf16x8*)(vt + fr * 4112 + k0 * 2);
                acc[0] = MFMA16(Af, Bf[kk][0], acc[0]);
                acc[1] = MFMA16(Af, Bf[kk][1], acc[1]);
                bf16x8 B2 = (bf16x8){0, 0, 0, 0, 0, 0, 0, 0};
                if (fr < 4) B2 = *(const bf16x8*)(wr2 + fr * 4096 + k0 * 2);
                acc[2] = MFMA16(Af, B2, acc[2]);
            }
#pragma unroll
            for (int n = 0; n < 3; ++n)
#pragma unroll
                for (int j = 0; j < 4; ++j) part[(w * 16 + fq * 4 + j) * 48 + n * 16 + fr] = acc[n][j];
        }
        lds_sync();
        for (int i = tid; i < 16 * 48; i += 512) {
            float s = 0.f;
#pragma unroll
            for (int ww = 0; ww < 8; ++ww) s += part[ww * 768 + i];
            lgt[i] = s;
        }
        lds_sync();
        if (tid < 16) {
            const int row = it * 16 + tid;
            const float* lg = lgt + tid * 48;
            float g[4];
#pragma unroll
            for (int j = 0; j < 4; ++j) g[j] = lg[j] + p.in[22][L * 4 + j];
            int gi = 0; float gm = g[0];
#pragma unroll
            for (int j = 1; j < 4; ++j) if (g[j] > gm) { gm = g[j]; gi = j; }
            float gs = 0.f;
#pragma unroll
            for (int j = 0; j < 4; ++j) gs += expf(g[j] - gm);
            const float pg = 1.f / gs;
            float e[8];
#pragma unroll
            for (int j = 0; j < 8; ++j) e[j] = lg[4 + gi * 8 + j] + p.in[24][L * 32 + gi * 8 + j];
            int i1 = 0; float m1 = e[0];
#pragma unroll
            for (int j = 1; j < 8; ++j) if (e[j] > m1) { m1 = e[j]; i1 = j; }
            int i2 = -1; float m2 = -3.4e38f;
#pragma unroll
            for (int j = 0; j < 8; ++j) if (j != i1 && e[j] > m2) { m2 = e[j]; i2 = j; }
            const float w1 = 1.f / (1.f + expf(m2 - m1)), w2 = 1.f - w1;
            const int e1 = gi * 8 + i1, e2 = gi * 8 + i2;
            const int r1 = atomicAdd(&lcnt[e1], 1), r2 = atomicAdd(&lcnt[e2], 1);
            int* dd = dec + (nloc * 16 + tid) * 8;
            dd[0] = row; dd[1] = e1; dd[2] = e2; dd[3] = r1; dd[4] = r2; dd[5] = __float_as_int(pg * w1); dd[6] = __float_as_int(pg * w2);
        }
        ++nloc;
    }
    lds_sync();
    if (tid < 32) { const int c = lcnt[tid]; lcnt[32 + tid] = c ? (int)atomicAdd(&cnt[tid], (unsigned)c) : 0; }
    lds_sync();
    for (int i = tid; i < nloc * 16; i += 512) {
        const int* dd = dec + i * 8;
        const int e1 = dd[1], e2 = dd[2];
        const size_t q1 = (size_t)e1 * TOKCAP + lcnt[32 + e1] + dd[3], q2 = (size_t)e2 * TOKCAP + lcnt[32 + e2] + dd[4];
        tokl[q1] = dd[0] * 2; gatel[q1] = __int_as_float(dd[5]);
        tokl[q2] = dd[0] * 2 + 1; gatel[q2] = __int_as_float(dd[6]);
    }
}

struct EpiUp {
    bf16_t* H1; int prow0, ncol0;
    DEVI void operator()(const f32x4 (&acc)[2][2][4][2], int wr, int wc, int fr, int fq, int tid, unsigned char* stg) const {
#pragma unroll
        for (int ai = 0; ai < 2; ++ai)
#pragma unroll
            for (int m = 0; m < 4; ++m) {
                const int rloc = ai * 128 + wr * 64 + m * 16 + fr;
#pragma unroll
                for (int n = 0; n < 2; ++n) {
                    const f32x4 a = acc[ai][0][m][n], c = acc[ai][1][m][n];
                    uint2 o; o.x = pk2(siluf_(a[0]) * c[0], siluf_(a[1]) * c[1]); o.y = pk2(siluf_(a[2]) * c[2], siluf_(a[3]) * c[3]);
                    *(uint2*)(stg + rloc * 272 + (wc * 32 + n * 16 + fq * 4) * 2) = o;
                }
            }
        lds_sync();
#pragma unroll 4
        for (int c = tid; c < 4096; c += 512) {
            const int r = c >> 4, cc = c & 15;
            *(uint4*)(H1 + (size_t)(prow0 + r) * 1024 + ncol0 + cc * 8) = *(const uint4*)(stg + r * 272 + cc * 16);
        }
        lds_sync();
    }
};
struct EpiDown {
    bf16_t* SL; const int* tokl; const float* gatel; int li0, cnt, bcol;
    DEVI void operator()(const f32x4 (&acc)[2][2][4][2], int wr, int wc, int fr, int fq, int tid, unsigned char* stg) const {
#pragma unroll
        for (int ai = 0; ai < 2; ++ai)
#pragma unroll
            for (int m = 0; m < 4; ++m) {
                const int rloc = ai * 128 + wr * 64 + m * 16 + fr, li = li0 + rloc;
                const float g = li < cnt ? gatel[li] : 0.f;
#pragma unroll
                for (int bj = 0; bj < 2; ++bj)
#pragma unroll
                    for (int n = 0; n < 2; ++n) {
                        const f32x4 v = acc[ai][bj][m][n] * g;
                        uint2 o; o.x = pk2(v[0], v[1]); o.y = pk2(v[2], v[3]);
                        *(uint2*)(stg + rloc * EP_RS + (bj * 128 + wc * 32 + n * 16 + fq * 4) * 2) = o;
                    }
            }
        lds_sync();
#pragma unroll 4
        for (int c = tid; c < 8192; c += 512) {
            const int r = c >> 5, cc = c & 31, li = li0 + r;
            if (li < cnt) *(uint4*)(SL + (size_t)tokl[li] * D + bcol + cc * 8) = *(const uint4*)(stg + r * EP_RS + cc * 16);
        }
        lds_sync();
    }
};

template <int DOWN>
DEVI void phase_moe(const int tid_, const Params& p, int L, unsigned char* lds) {
    bf16_t* shm = (bf16_t*)lds;
    int* tb = (int*)(lds + LDS_MISC + 256);
    const unsigned* cntg = (const unsigned*)(p.ws + WS_CTL) + CTL_COUNT + L * 32;
    __syncthreads();
    if (tid_ == 0) {
        int acc = 0;
        for (int e = 0; e < 32; ++e) { const int c = (int)cntg[e]; tb[64 + e] = c; tb[e] = acc; acc += (c + 255) >> 8; }
        tb[32] = acc;
    }
    __syncthreads();
    const int ntl = tb[32] * 8;
    const int* tokl = (const int*)(p.ws + WS_TOKL);
    bg_fill(tid_, p, lds, DOWN ? FILL_Q / 2 : FILL_Q);
    const int geff = (L == 0) ? (int)gridDim.x - NCONV_WG : (int)gridDim.x;
    if ((int)blockIdx.x >= geff) return;
    for (int i = 0;; ++i) {
        int u; if (!unit_of(i, ntl, u, geff)) break;
        int e = 0;
#pragma unroll 1
        for (int k = 1; k < 32; ++k) if (tb[k] * 8 <= u) e = k;
        const int q = u - tb[e] * 8, nte = tb[e + 1] - tb[e], nt = q / nte, mt = q % nte, cnt_e = tb[64 + e];
        const int prow0 = (tb[e] + mt) * 256;
        if (DOWN == 0) {
            unsigned ao[2][2];
#pragma unroll
            for (int ii = 0; ii < 2; ++ii) {
                int r, c; g_stage_rc(tid_ * 16 + ii * 8192, r, c);
#pragma unroll
                for (int hh = 0; hh < 2; ++hh) {
                    const int li = mt * 256 + hh * 128 + r;
                    const int tok = li < cnt_e ? (tokl[(size_t)e * TOKCAP + li] >> 1) : 0;
                    ao[hh][ii] = ((unsigned)tok * D + c) * 2u;
                }
            }
            const bf16_t* Bt = (const bf16_t*)(p.ws + WS_WUPT) + ((size_t)(L * 32 + e) * 2048 + nt * 256) * 2048;
            EpiUp epi{(bf16_t*)(p.ws + WS_H1), prow0, nt * 128};
            gemm_tile<true>(tid_, shm, (const bf16_t*)(p.ws + WS_U), D, ao[0][0], ao[0][1], ao[1][0], ao[1][1], Bt, 2048, epi);
        } else {
            unsigned a0, a1; aoff_plain(tid_, 1024, a0, a1);
            const bf16_t* Bt = (const bf16_t*)(p.ws + WS_WDNT) + ((size_t)(L * 32 + e) * 2048 + nt * 256) * 1024;
            EpiDown epi{(bf16_t*)(p.ws + WS_SLOTS), tokl + (size_t)e * TOKCAP, (const float*)(p.ws + WS_GATEL) + (size_t)e * TOKCAP, mt * 256, cnt_e, nt * 256};
            gemm_tile<false>(tid_, shm, (const bf16_t*)(p.ws + WS_H1) + (size_t)prow0 * 1024, 1024, a0, a1, 0u, 0u, Bt, 1024, epi);
        }
    }
}

extern __shared__ __attribute__((aligned(16))) unsigned char lds_raw[];

__global__ void __launch_bounds__(512, 2) hybrid_fwd(Params p_unused) {
    unsigned char* lds = lds_raw;
    int lo, hi;
    { Params q; load_params(q); lo = q.ph_lo; hi = q.ph_hi; }
    const int wv_ = __builtin_amdgcn_readfirstlane((int)(threadIdx.x >> 6));
    if (hi - lo > 1) {
        const bool t0 = (opaque_tid(wv_) == 0);
        if (t0) { *(uint4*)(lds + LDS_MISC) = make_uint4(0u, 0u, 0u, 0u); *(uint4*)(lds + LDS_MISC + 96) = make_uint4(0u, 0u, 0u, 0u); }
        __syncthreads();
        { Params q; load_params(q); (void)xcd_barrier_post((unsigned*)(q.ws + WS_CTL), (volatile LAS unsigned*)(lds + LDS_MISC), t0); }
    }
#ifndef PH_MASK
#define PH_MASK 0x7ff
#endif
#ifndef REP_PHASE
#define REP_PHASE -1
#endif
#ifndef REP_N
#define REP_N 1
#endif
#define PH_(fn, ...) do { asm volatile("; MARK_BEGIN " #fn); Params q__; load_params(q__); fn(opaque_tid(wv_), q__, ##__VA_ARGS__); asm volatile("; MARK_END " #fn); } while (0)
#define EN(j) ((PH_MASK >> (j)) & 1)
#define IN(k) (lo <= (k) && (k) < hi)
#define SEAM(k) do { if (IN(k) && IN((k) + 1)) { { Params qb_; load_params(qb_); bg_convert(opaque_tid(wv_), qb_, lds, (k)); } XcdBarrier bb_; Params q_; load_params(q_); \
    bb_.bar = (unsigned*)(q_.ws + WS_CTL); bb_.x = xb_xcc_id(); bb_.st = (volatile LAS unsigned*)(lds + LDS_MISC); xcd_barrier(bb_, opaque_tid(wv_) == 0); } } while (0)
    if (EN(0) && IN(0)) PH_(phase_prologue, lds);
    if (REP_PHASE == 0) for (int r_ = 0; r_ < REP_N; ++r_) PH_(phase_prologue, lds);
    SEAM(0);
    if (REP_SUB == 300) { for (int r_ = 0; r_ < 10; ++r_) SEAM(0); }
#define LAYER(L) do { constexpr int k0 = 1 + 9 * (L); \
        if (EN(1) && IN(k0 + 0)) PH_(phase_norm1, L); \
        if (REP_PHASE == k0 + 0) for (int r_ = 0; r_ < REP_N; ++r_) PH_(phase_norm1, L); \
        SEAM(k0 + 0); \
        if (EN(2) && IN(k0 + 1)) PH_(phase_gemm_in, L, (bf16_t*)lds); \
        if (REP_PHASE == k0 + 1) for (int r_ = 0; r_ < REP_N; ++r_) PH_(phase_gemm_in, L, (bf16_t*)lds); \
        SEAM(k0 + 1); \
        if (EN(3) && IN(k0 + 2)) PH_(phase_mix_a, L, lds); \
        if (REP_PHASE == k0 + 2) for (int r_ = 0; r_ < REP_N; ++r_) PH_(phase_mix_a, L, lds); \
        SEAM(k0 + 2); \
        if (EN(4) && IN(k0 + 3)) PH_(phase_mix_b); \
        if (REP_PHASE == k0 + 3) for (int r_ = 0; r_ < REP_N; ++r_) PH_(phase_mix_b); \
        SEAM(k0 + 3); \
        if (EN(5) && IN(k0 + 4)) PH_(phase_mix_c, L, lds); \
        if (REP_PHASE == k0 + 4) for (int r_ = 0; r_ < REP_N; ++r_) PH_(phase_mix_c, L, lds); \
        SEAM(k0 + 4); \
        if (EN(6) && IN(k0 + 5)) PH_(phase_gemm_out, L, (bf16_t*)lds); \
        if (REP_PHASE == k0 + 5) for (int r_ = 0; r_ < REP_N; ++r_) PH_(phase_gemm_out, L, (bf16_t*)lds); \
        SEAM(k0 + 5); \
        if (EN(7) && IN(k0 + 6)) PH_(phase_norm2, L, lds); \
        if (REP_PHASE == k0 + 6) for (int r_ = 0; r_ < REP_N; ++r_) PH_(phase_norm2, L, lds, true); \
        SEAM(k0 + 6); \
        if (EN(8) && IN(k0 + 7)) PH_(phase_moe<0>, L, lds); \
        if (REP_PHASE == k0 + 7) for (int r_ = 0; r_ < REP_N; ++r_) PH_(phase_moe<0>, L, lds); \
        SEAM(k0 + 7); \
        if (EN(9) && IN(k0 + 8)) PH_(phase_moe<1>, L, lds); \
        if (REP_PHASE == k0 + 8) for (int r_ = 0; r_ < REP_N; ++r_) PH_(phase_moe<1>, L, lds); \
        SEAM(k0 + 8); } while (0)
    LAYER(0);
    LAYER(1);
#undef LAYER
    if (EN(10) && IN(19)) PH_(phase_final);
    if (PROF_ID != 0 && blockIdx.x == 0 && opaque_tid(wv_) == 0) {
        const unsigned long long acc = PROF_WORD(lds)[0], t_start = __builtin_amdgcn_s_memrealtime();
        while (__builtin_amdgcn_s_memrealtime() - t_start < acc * PROF_AMP) __builtin_amdgcn_s_sleep(8);
    }
#undef IN
#undef SEAM
}

extern "C" void kernel_launch(void* const* d_in, const int* in_sizes, int n_in, void* d_out, int out_size, void* d_ws, size_t ws_size, hipStream_t stream) {
    static int grid = 0;
    if (grid == 0) {
        if (n_in != 29 || ws_size < WS_END) { fprintf(stderr, "kernel_launch: need 29 inputs and >= %zu bytes of workspace (got %d, %zu)\n", (size_t)WS_END, n_in, ws_size); grid = -1; return; }
        int dev = 0, cus = 0, per_cu = 0;
        if (hipGetDevice(&dev) != hipSuccess || hipDeviceGetAttribute(&cus, hipDeviceAttributeMultiprocessorCount, dev) != hipSuccess) { grid = -1; return; }
        if (hipFuncSetAttribute((const void*)hybrid_fwd, hipFuncAttributeMaxDynamicSharedMemorySize, LDS_BYTES) != hipSuccess) { fprintf(stderr, "kernel_launch: hipFuncSetAttribute failed\n"); grid = -1; return; }
        if (hipOccupancyMaxActiveBlocksPerMultiprocessor(&per_cu, (const void*)hybrid_fwd, 512, LDS_BYTES) != hipSuccess || per_cu < 1)
            fprintf(stderr, "kernel_launch: occupancy query reports %d workgroups per CU\n", per_cu);
        (void)hipGetLastError();
        grid = cus;
    }
    if (grid < 0) return;
    (void)hipMemsetAsync((char*)d_ws + WS_CTL, 0, 65536, stream);
    Params p{};
    for (int i = 0; i < 29; ++i) p.in[i] = (const float*)d_in[i];
    p.out = (float*)d_out; p.ws = (unsigned char*)d_ws;
#if MK_ONE_LAUNCH
    p.ph_lo = 0; p.ph_hi = 20;
    hipLaunchKernelGGL(hybrid_fwd, dim3(grid), dim3(512), LDS_BYTES, stream, p);
#else
    for (int k = 0; k < 20; ++k) {
        p.ph_lo = k; p.ph_hi = k + 1;
        hipLaunchKernelGGL(hybrid_fwd, dim3(grid), dim3(512), LDS_BYTES, stream, p);
    }
#endif
}
```

```cpp
#include <hip/hip_runtime.h>
#include <stdint.h>
#include <stdio.h>

#ifndef REP_SUB
#define REP_SUB -1
#endif
#ifndef BG_B0
#define BG_B0 8
#endif
#ifndef BG_B1
#define BG_B1 4
#endif
#ifndef NCONV_WG
#define NCONV_WG 0
#endif
#ifndef PROF_ID
#define PROF_ID 0
#endif
#ifndef PROF_AMP
#define PROF_AMP 4
#endif
#ifndef FILL_Q
#define FILL_Q 0
#endif
#ifndef MK_ONE_LAUNCH
#define MK_ONE_LAUNCH 1
#endif

typedef unsigned short bf16_t;
typedef short bf16x8 __attribute__((ext_vector_type(8)));
typedef float f32x4 __attribute__((ext_vector_type(4)));
#define DEVI __device__ __forceinline__

constexpr int D = 2048, NB = 4, SEQ = 4096, CTX = 256;
constexpr int NL = NB * SEQ, NC = NB * CTX, NT = NL + NC;
constexpr int NCH = 68;
constexpr int TT = SEQ + CTX;
constexpr int ZLD = 4096;
constexpr int ZQ = 0, ZK = 1024, ZGQ = 1536, ZGK = 1792, ZGR = 2560, ZLX = 3072, ZLG = 3584;
constexpr int NWIN = 4352;
constexpr int TOKCAP = NT;
constexpr int H1ROWS = 43008;

constexpr size_t al256(size_t x) { return (x + 255) & ~(size_t)255; }
constexpr size_t WS_CTL = 0;
constexpr size_t WS_MODS = 65536;
constexpr size_t WS_ROPEC = WS_MODS + al256((size_t)2 * 5 * 12288 * 4);
constexpr size_t WS_ROPES = WS_ROPEC + (size_t)4096 * 64 * 4;
constexpr size_t WS_ROPEF = WS_ROPES + (size_t)4096 * 64 * 4;
constexpr size_t WS_LRUWT = WS_ROPEF + 256;
constexpr size_t WS_WRT = WS_LRUWT + (size_t)2 * 8 * 256 * 64 * 2;
constexpr size_t WS_WINT = WS_WRT + (size_t)2 * 48 * 2048 * 2;
constexpr size_t WS_WOUTT = WS_WINT + (size_t)2 * NWIN * 2048 * 2;
constexpr size_t WS_WUPT = WS_WOUTT + (size_t)2 * 2048 * 2048 * 2;
constexpr size_t WS_WDNT = WS_WUPT + (size_t)2 * 32 * 2048 * 2048 * 2;
constexpr size_t WS_H = WS_WDNT + (size_t)2 * 32 * 2048 * 1024 * 2;
constexpr size_t WS_U = WS_H + (size_t)NT * D * 4;
constexpr size_t WS_Z = WS_U + (size_t)NT * D * 2;
constexpr size_t WS_GZ = WS_Z + (size_t)NT * ZLD * 2;
constexpr size_t WS_VT = WS_GZ + (size_t)NT * 32 * 4;
constexpr size_t WS_GVT = WS_VT + (size_t)8 * 128 * TT * 2;
constexpr size_t WS_MIX = WS_GVT + (size_t)16 * 128 * TT * 2;
constexpr size_t WS_CONTRIB = WS_MIX + (size_t)NT * D * 2;
constexpr size_t WS_SBEF = WS_CONTRIB + (size_t)32 * NCH * 8192 * 4;
constexpr size_t WS_ATOT = WS_SBEF + (size_t)32 * NCH * 8192 * 4;
constexpr size_t WS_LRUA = WS_ATOT + (size_t)32 * NCH * 64 * 4;
constexpr size_t WS_LRUB = WS_LRUA + (size_t)NB * NCH * 2 * 512 * 4;
constexpr size_t WS_LRUC = WS_LRUB + (size_t)NB * NCH * 2 * 512 * 4;
constexpr size_t WS_TOKL = WS_LRUC + (size_t)NB * NCH * 2 * 512 * 4;
constexpr size_t WS_GATEL = WS_TOKL + (size_t)32 * TOKCAP * 4;
constexpr size_t WS_H1 = WS_GATEL + (size_t)32 * TOKCAP * 4;
constexpr size_t WS_SLOTS = WS_H1 + (size_t)H1ROWS * 1024 * 2;
constexpr size_t WS_CUMG = WS_SLOTS + (size_t)NT * 2 * D * 2;
constexpr size_t WS_END = WS_CUMG + (size_t)NB * 4 * NCH * 2 * 4096 * 4;
constexpr int CTL_COUNT = 4096;

constexpr int LDS_BYTES = 155648;
constexpr int LDS_MISC = 139264;

struct Params {
    const float* in[29];
    float* out;
    unsigned char* ws;
    int ph_lo, ph_hi;
};

typedef __attribute__((address_space(1))) const float gcf_t;
typedef __attribute__((address_space(1))) float gf_t;
typedef __attribute__((address_space(1))) unsigned char guc_t;
struct ParamsK {
    gcf_t* in[29];
    gf_t* out;
    guc_t* ws;
    int ph_lo, ph_hi;
};
static_assert(sizeof(ParamsK) == sizeof(Params), "kernarg view");
__device__ __forceinline__ void load_params(Params& q) {
    const __attribute__((address_space(4))) ParamsK* kp = (const __attribute__((address_space(4))) ParamsK*)__builtin_amdgcn_kernarg_segment_ptr();
    asm volatile("" : "+s"(kp));
#pragma unroll
    for (int i = 0; i < 29; ++i) q.in[i] = (const float*)kp->in[i];
    q.out = (float*)kp->out; q.ws = (unsigned char*)kp->ws; q.ph_lo = kp->ph_lo; q.ph_hi = kp->ph_hi;
}

DEVI float bf2f(bf16_t v) { return __uint_as_float(((unsigned)v) << 16); }
DEVI float bflo(unsigned v) { return __uint_as_float(v << 16); }
DEVI float bfhi(unsigned v) { return __uint_as_float(v & 0xffff0000u); }
DEVI unsigned pk2(float lo, float hi) { unsigned r; asm("v_cvt_pk_bf16_f32 %0, %1, %2" : "=v"(r) : "v"(lo), "v"(hi)); return r; }
DEVI bf16_t f2bf(float f) { return (bf16_t)(pk2(f, 0.f) & 0xffffu); }
DEVI float shx(float v, int mask, int lane) { return __int_as_float(__builtin_amdgcn_ds_bpermute((lane ^ mask) << 2, __float_as_int(v))); }
DEVI float shidx(float v, int src) { return __int_as_float(__builtin_amdgcn_ds_bpermute(src << 2, __float_as_int(v))); }
DEVI float shup(float v, int off, int lane) { const int src = lane >= off ? lane - off : lane; return shidx(v, src); }
DEVI float wave_sum(float v, int lane) {
#pragma unroll
    for (int o = 32; o > 0; o >>= 1) v += shx(v, o, lane);
    return v;
}
DEVI float rcpf_(float x) { return __builtin_amdgcn_rcpf(x); }
DEVI float sigmoidf_(float x) { return rcpf_(1.f + __builtin_amdgcn_exp2f(-1.4426950408889634f * x)); }
DEVI float siluf_(float x) { return x * sigmoidf_(x); }
DEVI float gelu_tanh(float x) {
    const float y2 = 1.5957691216057308f * (x + 0.044715f * x * x * x);
    return x * sigmoidf_(y2);
}
DEVI float logsigmoidf_(float z) { return fminf(z, 0.f) - log1pf(expf(-fabsf(z))); }
DEVI bf16x8 mk8(unsigned a, unsigned b, unsigned c, unsigned d) {
    typedef unsigned u4 __attribute__((ext_vector_type(4)));
    u4 t = {a, b, c, d};
    return __builtin_bit_cast(bf16x8, t);
}
DEVI int hw_lane() { int l; asm volatile("v_mbcnt_lo_u32_b32 %0, -1, 0\n\tv_mbcnt_hi_u32_b32 %0, -1, %0" : "=v"(l)); return l; }
DEVI int opaque_tid(int wv) { int t = wv * 64 + hw_lane(); asm volatile("" : "+v"(t)); return t; }
DEVI void lds_sync() { asm volatile("s_waitcnt lgkmcnt(0)" ::: "memory"); __builtin_amdgcn_s_barrier(); asm volatile("" ::: "memory"); }
#define MFMA16(a, b, c) __builtin_amdgcn_mfma_f32_16x16x32_bf16((a), (b), (c), 0, 0, 0)

#define XB_TMO      128
#define XB_XCNT(j)  (256  + 64 * (j))
#define XB_XSUB(j)  (1280 + 64 * (j))
#define XB_XGEN(j)  (2304 + 64 * (j))
#define XB_TOP      3328
#define XB_TOPGEN   3392
#define XCD_BAR_WORDS 3456
#define XB_SPIN_CAP (1u << 18)
#define LAS __attribute__((address_space(3)))

__device__ __forceinline__ unsigned xb_ld(unsigned* p)              { return __hip_atomic_load(p, __ATOMIC_RELAXED, __HIP_MEMORY_SCOPE_AGENT); }
__device__ __forceinline__ unsigned xb_add(unsigned* p, unsigned v) { return __hip_atomic_fetch_add(p, v, __ATOMIC_RELAXED, __HIP_MEMORY_SCOPE_AGENT); }
__device__ __forceinline__ unsigned xb_xcc_id() { return (unsigned)__builtin_amdgcn_s_getreg((3 << 11) | 20) & 0xFu; }
#define XB_SPIN(cond, bar) do { unsigned _sp = 0; while (cond) { __builtin_amdgcn_s_sleep(1); \
    if ((++_sp & 255u) == 0u) { if (xb_ld(&(bar)[XB_TMO])) break; if (_sp > XB_SPIN_CAP) { atomicAdd(&(bar)[XB_TMO], 1u); break; } } } } while (0)

struct XcdBarrier {
    unsigned* bar; unsigned x;
    volatile LAS unsigned* st;
};
__device__ __forceinline__ XcdBarrier xcd_barrier_post(unsigned* bar, volatile LAS unsigned* st, bool t0) {
    XcdBarrier b; b.bar = bar; b.x = xb_xcc_id(); b.st = st;
    if (t0) (void)xb_add(&bar[XB_XCNT(b.x)], 1u);
    return b;
}
__device__ __forceinline__ void xcd_barrier_complete(unsigned* bar, unsigned x, unsigned& nloc, unsigned& nx) {
    const unsigned G = gridDim.x * gridDim.y * gridDim.z;
    unsigned sum, cnt, mine, sp = 0u;
    for (;;) {
        sum = 0u; cnt = 0u; mine = 0u;
#pragma unroll
        for (unsigned j = 0; j < 16; ++j) { const unsigned c = xb_ld(&bar[XB_XCNT(j)]); sum += c; cnt += (c > 0u) ? 1u : 0u; mine = (j == x) ? c : mine; }
        if (sum == G) break;
        __builtin_amdgcn_s_sleep(1);
        if ((++sp & 255u) == 0u) { if (xb_ld(&bar[XB_TMO])) break; if (sp > XB_SPIN_CAP) { atomicAdd(&bar[XB_TMO], 1u); break; } }
    }
    nloc = mine > 0u ? mine : 1u; nx = cnt > 0u ? cnt : 1u;
}
__device__ __forceinline__ void xcd_barrier(const XcdBarrier& b, bool t0) {
    asm volatile("s_waitcnt vmcnt(0)" ::: "memory");
    __syncthreads();
    if (t0) {
        unsigned* bar = b.bar;
        __builtin_amdgcn_s_waitcnt(0);
        unsigned nloc = b.st[0], nx = b.st[1];
        if (nloc == 0u) { xcd_barrier_complete(bar, b.x, nloc, nx); b.st[0] = nloc; b.st[1] = nx; }
        const unsigned old = xb_add(&bar[XB_XSUB(b.x)], 1u);
        const unsigned gen = old / nloc;
        if (old + 1u == (gen + 1u) * nloc) {
            __builtin_amdgcn_fence(__ATOMIC_RELEASE, "agent");
            asm volatile("s_waitcnt vmcnt(0)" ::: "memory");
            const unsigned og = xb_add(&bar[XB_TOP], 1u);
            const unsigned tg = og / nx;
            if (og + 1u == (tg + 1u) * nx) xb_add(&bar[XB_TOPGEN], 1u);
            else XB_SPIN(xb_ld(&bar[XB_TOPGEN]) == tg, bar);
            __builtin_amdgcn_fence(__ATOMIC_ACQUIRE, "agent");
            xb_add(&bar[XB_XGEN(b.x)], 1u);
            asm volatile("s_waitcnt vmcnt(0)" ::: "memory");
        } else {
            XB_SPIN(xb_ld(&bar[XB_XGEN(b.x)]) == gen, bar);
            __builtin_amdgcn_fence(__ATOMIC_ACQUIRE, "agent");
            asm volatile("s_waitcnt vmcnt(0)" ::: "memory");
        }
    }
    __syncthreads();
}

#define PROF_WORD(lds) ((volatile unsigned long long*)((lds) + LDS_MISC + 96))
#define PROF_B(id, lds, t0) do { if (PROF_ID == (id) && blockIdx.x == 0 && (t0)) PROF_WORD(lds)[1] = __builtin_amdgcn_s_memrealtime(); } while (0)
#define PROF_E(id, lds, t0) do { if (PROF_ID == (id) && blockIdx.x == 0 && (t0)) PROF_WORD(lds)[0] += __builtin_amdgcn_s_memrealtime() - PROF_WORD(lds)[1]; } while (0)
DEVI bool unit_of(int i, int nunits, int& u, int geff = 0) {
    const long Lx = (long)i * (geff ? geff : (int)gridDim.x) + blockIdx.x;
    if (Lx >= nunits) return false;
    const int w = (int)Lx, q = nunits / 8, r = nunits % 8, xcd = w % 8, off = w / 8;
    u = (xcd < r ? xcd * (q + 1) : r * (q + 1) + (xcd - r) * q) + off;
    return true;
}

constexpr int G_BK = 64, G_HALF = 128, G_HT = G_HALF * G_BK;
DEVI int g_lds_byte(int r, int c) {
    int st = (r >> 4) * 2 + (c >> 5), rr = r & 15, cc = c & 31, ob = rr * 64 + cc * 2;
    return st * 1024 + (ob ^ (((ob >> 9) & 1) << 5));
}
DEVI void g_stage_rc(int b, int& R, int& C) {
    int st = b / 1024, sb = b % 1024, swz = sb ^ (((sb >> 9) & 1) << 5);
    R = (st >> 1) * 16 + swz / 64; C = (st & 1) * 32 + (swz % 64) / 2;
}

template <bool GATHER, class Epi>
DEVI void gemm_tile(const int tid_, bf16_t* shm, const bf16_t* __restrict__ A, unsigned lda, unsigned a0, unsigned a1, unsigned a2, unsigned a3,
                    const bf16_t* __restrict__ Bt, int K, const Epi& epi) {
#define SA(b, h) (shm + ((b) * 2 + (h)) * G_HT)
#define SB(b, h) (shm + (4 + (b) * 2 + (h)) * G_HT)
#define STG_A(T, P, h, kt) do { const unsigned so_ = (unsigned)(kt) * 128u + ((GATHER || !(h)) ? 0u : 256u * lda); \
    __builtin_amdgcn_raw_ptr_buffer_load_lds(rsA, (LAS void*)((char*)(P) + ldsw), 16, (GATHER && (h)) ? a2 : a0, so_, 0, 0); \
    __builtin_amdgcn_raw_ptr_buffer_load_lds(rsA, (LAS void*)((char*)(P) + ldsw + 8192), 16, (GATHER && (h)) ? a3 : a1, so_, 0, 0); } while (0)
#define STG_B(T, P, h, kt) do { const unsigned so_ = (unsigned)(kt) * 128u + ((h) ? 256u * (unsigned)K : 0u); \
    __builtin_amdgcn_raw_ptr_buffer_load_lds(rsB, (LAS void*)((char*)(P) + ldsw), 16, b0, so_, 0, 0); \
    __builtin_amdgcn_raw_ptr_buffer_load_lds(rsB, (LAS void*)((char*)(P) + ldsw + 8192), 16, b1, so_, 0, 0); } while (0)
#define LDA(dst, b, h) for (int m = 0; m < 4; ++m) for (int k = 0; k < 2; ++k) \
    dst[m][k] = *reinterpret_cast<const bf16x8*>((char*)SA(b, h) + g_lds_byte(wr * 64 + m * 16 + fr, k * 32 + fq * 8))
#define LDB(dst, b, h) for (int n = 0; n < 2; ++n) for (int k = 0; k < 2; ++k) \
    dst[n][k] = *reinterpret_cast<const bf16x8*>((char*)SB(b, h) + g_lds_byte(wc * 32 + n * 16 + fr, k * 32 + fq * 8))
#define MMA(ai, bj, At_, Bt_) do { __builtin_amdgcn_s_setprio(1); \
    for (int m = 0; m < 4; ++m) for (int n = 0; n < 2; ++n) for (int k = 0; k < 2; ++k) \
        acc[ai][bj][m][n] = __builtin_amdgcn_mfma_f32_16x16x32_bf16(Bt_[n][k], At_[m][k], acc[ai][bj][m][n], 0, 0, 0); \
    __builtin_amdgcn_s_setprio(0); } while (0)
#define WAIT_V(n) asm volatile("s_waitcnt vmcnt(" #n ")" ::: "memory")
#define WAIT_L(n) asm volatile("s_waitcnt lgkmcnt(" #n ")" ::: "memory")
#define BAR __builtin_amdgcn_s_barrier()
#define SCHED __builtin_amdgcn_sched_barrier(0)
    unsigned b0, b1;
    { int r_, c_; g_stage_rc(tid_ * 16, r_, c_); b0 = (unsigned)(r_ * K + c_) * 2u; g_stage_rc(tid_ * 16 + 8192, r_, c_); b1 = (unsigned)(r_ * K + c_) * 2u; }
    const __amdgpu_buffer_rsrc_t rsA = __builtin_amdgcn_make_buffer_rsrc((void*)A, (short)0, 0x7fffffff, 0x00020000);
    const __amdgpu_buffer_rsrc_t rsB = __builtin_amdgcn_make_buffer_rsrc((void*)Bt, (short)0, 0x7fffffff, 0x00020000);
    const unsigned ldsw = (unsigned)__builtin_amdgcn_readfirstlane(tid_ >> 6) * 1024u;
    const int T = tid_;
    int wid = T >> 6, lane = T & 63, wr = wid >> 2, wc = wid & 3, fr = lane & 15, fq = lane >> 4;
    f32x4 acc[2][2][4][2] = {};
    bf16x8 At[4][2], B0[2][2], B1[2][2];
    const int nt = K / G_BK;
    STG_B(T, SB(0, 0), 0, 0); STG_A(T, SA(0, 0), 0, 0);
    STG_B(T, SB(0, 1), 1, 0); STG_A(T, SA(0, 1), 1, 0);
    if (wr == 1) BAR;
    WAIT_V(4); BAR;
    STG_B(T, SB(1, 0), 0, 1); STG_A(T, SA(1, 0), 0, 1); STG_B(T, SB(1, 1), 1, 1);
    WAIT_V(6); BAR;
    for (int t = 0; t < nt - 2; t += 2) {
        LDB(B0, 0, 0); SCHED; LDA(At, 0, 0); STG_A(T, SA(1, 1), 1, t + 1);
        WAIT_L(8); BAR; WAIT_L(0); MMA(0, 0, At, B0); BAR; SCHED;
        LDB(B1, 0, 1); STG_B(T, SB(0, 0), 0, t + 2);
        BAR; WAIT_L(0); MMA(0, 1, At, B1); BAR;
        LDA(At, 0, 1); STG_A(T, SA(0, 0), 0, t + 2);
        BAR; WAIT_L(0); MMA(1, 0, At, B0); BAR; SCHED;
        STG_B(T, SB(0, 1), 1, t + 2);
        WAIT_V(6); BAR; MMA(1, 1, At, B1); BAR;
        LDB(B0, 1, 0); SCHED; LDA(At, 1, 0); STG_A(T, SA(0, 1), 1, t + 2);
        WAIT_L(8); BAR; WAIT_L(0); MMA(0, 0, At, B0); BAR; SCHED;
        LDB(B1, 1, 1); STG_B(T, SB(1, 0), 0, t + 3);
        BAR; WAIT_L(0); MMA(0, 1, At, B1); BAR;
        LDA(At, 1, 1); STG_A(T, SA(1, 0), 0, t + 3);
        BAR; WAIT_L(0); MMA(1, 0, At, B0); BAR; SCHED;
        STG_B(T, SB(1, 1), 1, t + 3);
        WAIT_V(6); BAR; MMA(1, 1, At, B1); BAR;
    }
    int tz = tid_; asm volatile("" : "+v"(tz)); wid = tz >> 6; lane = tz & 63; wr = wid >> 2; wc = wid & 3; fr = lane & 15; fq = lane >> 4;
    { LDB(B0, 0, 0); WAIT_V(0); LDA(At, 0, 0); STG_A(tz, SA(1, 1), 1, nt - 1);
      BAR; WAIT_L(0); MMA(0, 0, At, B0); BAR;
      LDB(B1, 0, 1); BAR; WAIT_L(0); MMA(0, 1, At, B1); BAR;
      LDA(At, 0, 1); WAIT_V(4); BAR; WAIT_L(0); MMA(1, 0, At, B0); MMA(1, 1, At, B1); BAR; }
    { LDB(B0, 1, 0); LDA(At, 1, 0); WAIT_V(2); BAR; WAIT_L(0); MMA(0, 0, At, B0); BAR;
      LDB(B1, 1, 1); WAIT_V(0); BAR; WAIT_L(0); MMA(0, 1, At, B1); BAR;
      LDA(At, 1, 1); BAR; WAIT_L(0); MMA(1, 0, At, B0); MMA(1, 1, At, B1); BAR; }
    if (wr == 0) BAR;
    SCHED;
    epi(acc, wr, wc, fr, fq, tz, (unsigned char*)shm);
#undef SA
#undef SB
#undef STG_A
#undef STG_B
#undef LDA
#undef LDB
#undef MMA
}

DEVI void aoff_plain(const int tid_, int lda, unsigned& a0, unsigned& a1) {
    int r, c;
    g_stage_rc(tid_ * 16, r, c);        a0 = (unsigned)(r * lda + c) * 2u;
    g_stage_rc(tid_ * 16 + 8192, r, c); a1 = (unsigned)(r * lda + c) * 2u;
}

constexpr int NU_WIN = 2 * 68 * 16, NU_WOUT = 2 * 32 * 16, NU_UP = 64 * 32 * 16, NU_DN = 64 * 32 * 8;
constexpr int NU_CONV = NU_WIN + NU_WOUT + NU_UP + NU_DN;
constexpr int NU_ADA = 768, NU_ROPE = 1, NU_LRUW = 512, NU_WR = 384;
constexpr int NU_P0 = NU_CONV + NU_ADA + NU_ROPE + NU_LRUW + NU_WR;

DEVI void conv_decode(const Params& p, int u, const float*& srck, int& ld_src, int& c0, int& nv, bf16_t*& dstn, int& ld_dst) {
    if (u < NU_WIN) {
        const int L = u / 1088, rem = u % 1088, ntile = rem >> 4, ktile = rem & 15, n0 = ntile * 64;
        if (n0 < 3072) { c0 = n0; nv = 64; } else if (n0 < 4096) { c0 = n0 + 32; nv = 64; } else if (n0 == 4096) { c0 = 3072; nv = 32; } else { c0 = 0; nv = 0; }
        srck = p.in[8] + (size_t)L * 2048 * 4128 + (size_t)ktile * 128 * 4128; ld_src = 4128;
        dstn = (bf16_t*)(p.ws + WS_WINT) + ((size_t)L * NWIN + n0) * 2048 + ktile * 128; ld_dst = 2048;
    } else if (u < NU_WIN + NU_WOUT) {
        const int v = u - NU_WIN, L = v >> 9, rem = v & 511, ntile = rem >> 4, ktile = rem & 15;
        srck = p.in[20] + (size_t)L * 2048 * 2048 + (size_t)ktile * 128 * 2048; ld_src = 2048; c0 = ntile * 64; nv = 64;
        dstn = (bf16_t*)(p.ws + WS_WOUTT) + ((size_t)L * 2048 + ntile * 64) * 2048 + ktile * 128; ld_dst = 2048;
    } else if (u < NU_WIN + NU_WOUT + NU_UP) {
        const int v = u - NU_WIN - NU_WOUT, le = v >> 9, rem = v & 511, ntile = rem >> 4, ktile = rem & 15;
        const int nt = ntile >> 2, half = (ntile >> 1) & 1, i0 = (ntile & 1) * 64;
        srck = (half ? p.in[26] : p.in[25]) + (size_t)le * 2048 * 1024 + (size_t)ktile * 128 * 1024; ld_src = 1024; c0 = nt * 128 + i0; nv = 64;
        dstn = (bf16_t*)(p.ws + WS_WUPT) + ((size_t)le * 2048 + ntile * 64) * 2048 + ktile * 128; ld_dst = 2048;
    } else {
        const int v = u - NU_WIN - NU_WOUT - NU_UP, le = v >> 8, rem = v & 255, ntile = rem >> 3, ktile = rem & 7;
        srck = p.in[27] + (size_t)le * 1024 * 2048 + (size_t)ktile * 128 * 2048; ld_src = 2048; c0 = ntile * 64; nv = 64;
        dstn = (bf16_t*)(p.ws + WS_WDNT) + ((size_t)le * 2048 + ntile * 64) * 1024 + ktile * 128; ld_dst = 1024;
    }
}

constexpr int CTL_QHEAD = 4200, CTL_DONE = 4224;
constexpr int QE0 = 1088, QE1 = 1600, QE2 = 17984, QE3 = 26176, QE4 = 27264, QE5 = 27776, QE6 = 44160, QE7 = 52352;
static_assert(QE7 == NU_CONV, "queue length");
DEVI int q_to_unit(int q) {
    if (q < QE0) return q;
    if (q < QE1) return NU_WIN + (q - QE0);
    if (q < QE2) return NU_WIN + NU_WOUT + (q - QE1);
    if (q < QE3) return NU_WIN + NU_WOUT + NU_UP + (q - QE2);
    if (q < QE4) return 1088 + (q - QE3);
    if (q < QE5) return NU_WIN + 512 + (q - QE4);
    if (q < QE6) return NU_WIN + NU_WOUT + 16384 + (q - QE5);
    return NU_WIN + NU_WOUT + NU_UP + 8192 + (q - QE6);
}
DEVI int q_deadline(int k) {
    return k < 1 ? 0 : k < 5 ? QE0 : k < 7 ? QE1 : k < 8 ? QE2 : k < 10 ? QE3 : k < 14 ? QE4 : k < 16 ? QE5 : k < 17 ? QE6 : QE7;
}
typedef unsigned u32x4_t __attribute__((ext_vector_type(4)));
DEVI float4 ntld4(const float* p) { const f32x4 v = __builtin_nontemporal_load((const f32x4*)p); return make_float4(v[0], v[1], v[2], v[3]); }
DEVI void ntst4(const uint4& o, bf16_t* p) { u32x4_t v = {o.x, o.y, o.z, o.w}; __builtin_nontemporal_store(v, (u32x4_t*)p); }
DEVI void conv_run(const int tid_, const Params& p, float* T, int q0, int count) {
    const int t = tid_, n4 = t & 15, kr = t >> 4;
    float4 v0, v1, v2, v3, x0, x1, x2, x3;
    const float* srck; bf16_t* dstn; int ld_src, ld_dst, c0, nv;
    bf16_t* d1 = nullptr; int l1 = 0; bf16_t* d2 = nullptr; int l2 = 0;
#define CV_LOAD(a0_, a1_, a2_, a3_) do { const float* s_ = srck + c0 + n4 * 4; \
        a0_ = make_float4(0.f, 0.f, 0.f, 0.f); a1_ = a0_; a2_ = a0_; a3_ = a0_; \
        if (n4 * 4 < nv) { a0_ = ntld4((s_ + (size_t)(kr) * ld_src)); a1_ = ntld4((s_ + (size_t)(kr + 32) * ld_src)); \
                           a2_ = ntld4((s_ + (size_t)(kr + 64) * ld_src)); a3_ = ntld4((s_ + (size_t)(kr + 96) * ld_src)); } } while (0)
    conv_decode(p, q_to_unit(q0), srck, ld_src, c0, nv, dstn, ld_dst); d1 = dstn; l1 = ld_dst; CV_LOAD(v0, v1, v2, v3);
    x0 = make_float4(0.f, 0.f, 0.f, 0.f); x1 = x0; x2 = x0; x3 = x0;
    if (count > 1) { conv_decode(p, q_to_unit(q0 + 1), srck, ld_src, c0, nv, dstn, ld_dst); d2 = dstn; l2 = ld_dst; CV_LOAD(x0, x1, x2, x3); }
#pragma unroll 1
    for (int i = 0; i < count; ++i) {
        const float4 w0 = v0, w1 = v1, w2 = v2, w3 = v3;
        bf16_t* const dcur = d1; const int ldd = l1;
        v0 = x0; v1 = x1; v2 = x2; v3 = x3; d1 = d2; l1 = l2;
        if (i + 2 < count) { conv_decode(p, q_to_unit(q0 + i + 2), srck, ld_src, c0, nv, dstn, ld_dst); d2 = dstn; l2 = ld_dst; CV_LOAD(x0, x1, x2, x3); }
        lds_sync();
        { float* d = T + kr * 65 + n4 * 4; d[0] = w0.x; d[1] = w0.y; d[2] = w0.z; d[3] = w0.w; }
        { float* d = T + (kr + 32) * 65 + n4 * 4; d[0] = w1.x; d[1] = w1.y; d[2] = w1.z; d[3] = w1.w; }
        { float* d = T + (kr + 64) * 65 + n4 * 4; d[0] = w2.x; d[1] = w2.y; d[2] = w2.z; d[3] = w2.w; }
        { float* d = T + (kr + 96) * 65 + n4 * 4; d[0] = w3.x; d[1] = w3.y; d[2] = w3.z; d[3] = w3.w; }
        lds_sync();
#pragma unroll
        for (int i2 = 0; i2 < 2; ++i2) {
            const int kc = t & 15, n = (t >> 4) + 32 * i2;
            float f[8];
#pragma unroll
            for (int j = 0; j < 8; ++j) f[j] = T[(kc * 8 + j) * 65 + n];
            uint4 o; o.x = pk2(f[0], f[1]); o.y = pk2(f[2], f[3]); o.z = pk2(f[4], f[5]); o.w = pk2(f[6], f[7]);
            ntst4(o, dcur + (size_t)n * ldd + kc * 8);
        }
    }
#undef CV_LOAD
}
DEVI void bg_convert(const int tid_, const Params& p, unsigned char* lds, int k) {
    typedef __attribute__((address_space(1))) unsigned gu32_t;
    gu32_t* ctl = (gu32_t*)(p.ws + WS_CTL);
    volatile int* lw = (volatile int*)(lds + LDS_MISC + 64);
    float* T = (float*)lds;
    const int t = tid_;
    const int deadline = q_deadline(k), G = (int)gridDim.x;
#pragma unroll 1
    for (int stage = (k > 0 && q_deadline(k) == q_deadline(k - 1)) ? 1 : 0; stage < 2; ++stage) {
        if (stage == 1 && t == 0) (void)__hip_atomic_fetch_add(ctl + CTL_DONE + 64 * k, 1u, __ATOMIC_RELAXED, __HIP_MEMORY_SCOPE_AGENT);
        const int batch = (stage == 0) ? BG_B0 : BG_B1;
#pragma unroll 1
        for (;;) {
            if (t == 0) {
                int c = -1;
                const bool want = (stage == 0) ? ((int)__hip_atomic_load(ctl + CTL_QHEAD, __ATOMIC_RELAXED, __HIP_MEMORY_SCOPE_AGENT) < deadline)
                                               : ((int)__hip_atomic_load(ctl + CTL_DONE + 64 * k, __ATOMIC_RELAXED, __HIP_MEMORY_SCOPE_AGENT) < G);
                if (want) { c = (int)__hip_atomic_fetch_add(ctl + CTL_QHEAD, (unsigned)batch, __ATOMIC_RELAXED, __HIP_MEMORY_SCOPE_AGENT); if (c >= NU_CONV) c = -1; }
                lw[0] = c;
            }
            lds_sync();
            const int c = lw[0];
            lds_sync();
            if (c < 0) break;
            conv_run(tid_, p, T, c, (NU_CONV - c) < batch ? (NU_CONV - c) : batch);
        }
    }
}

DEVI void bg_fill(const int tid_, const Params& p, unsigned char* lds, int per_quarter) {
    typedef __attribute__((address_space(1))) unsigned gu32_t;
    gu32_t* ctl = (gu32_t*)(p.ws + WS_CTL);
    volatile int* lw = (volatile int*)(lds + LDS_MISC + 64);
    const int n = (int)(blockIdx.x & 3u) * per_quarter;
    if (n == 0) return;
    if (tid_ == 0) {
        int c = -1;
        if ((int)__hip_atomic_load(ctl + CTL_QHEAD, __ATOMIC_RELAXED, __HIP_MEMORY_SCOPE_AGENT) < NU_CONV) {
            c = (int)__hip_atomic_fetch_add(ctl + CTL_QHEAD, (unsigned)n, __ATOMIC_RELAXED, __HIP_MEMORY_SCOPE_AGENT); if (c >= NU_CONV) c = -1; }
        lw[0] = c;
    }
    lds_sync();
    const int c = lw[0];
    lds_sync();
    if (c >= 0) conv_run(tid_, p, (float*)lds, c, (NU_CONV - c) < n ? (NU_CONV - c) : n);
    lds_sync();
}

__constant__ double c_rope_inv[32] = {
    1.0, 0.7498942093324559, 0.5623413251903491, 0.4216965034285822, 0.31622776601683794, 0.23713737056616552, 0.1778279410038923, 0.1333521432163324,
    0.1, 0.07498942093324558, 0.05623413251903491, 0.042169650342858224, 0.03162277660168379, 0.023713737056616554, 0.01778279410038923, 0.01333521432163324,
    0.01, 0.007498942093324558, 0.005623413251903491, 0.004216965034285823, 0.0031622776601683794, 0.0023713737056616554, 0.0017782794100389228, 0.001333521432163324,
    0.001, 0.0007498942093324559, 0.0005623413251903491, 0.00042169650342858224, 0.00031622776601683794, 0.00023713737056616554, 0.00017782794100389227, 0.0001333521432163324};

DEVI void sincos_f64(double ang, float& sn, float& cs) {
    const double n = __builtin_rint(ang * 0.15915494309189535);
    double r = __builtin_fma(-n, 6.283185307179586, ang);
    r = __builtin_fma(-n, 2.4492935982947064e-16, r);
    const double x = 0.5 * r, x2 = x * x;
    double s = 1.0, c = 1.0;
#pragma unroll
    for (int k = 12; k >= 1; --k) {
        s = 1.0 - s * x2 * (1.0 / (double)((2 * k) * (2 * k + 1)));
        c = 1.0 - c * x2 * (1.0 / (double)((2 * k - 1) * (2 * k)));
    }
    s *= x;
    sn = (float)(2.0 * s * c); cs = (float)(1.0 - 2.0 * s * s);
}

DEVI void phase_prologue(const int tid_, const Params& p, unsigned char* lds) {
    float* T = (float*)lds;
    float* cond = (float*)(lds + 33280);
    float* red = (float*)(lds + 33280 + 40960);
    const int t = tid_;
    for (int i = t; i < 5 * 2048; i += 512) {
        const int r = i >> 11, k = i & 2047;
        const float c = r < 4 ? p.in[1][r * 2048 + k] : p.in[3][k];
        cond[i] = c / (1.f + expf(-c));
    }
    __syncthreads();
    __syncthreads();
    for (int u = NU_CONV + blockIdx.x; u < NU_P0; u += gridDim.x) {
        if (false) {
        } else if (u < NU_CONV + NU_ADA) {
            const int v = u - NU_CONV, L = v / 384, c0 = (v % 384) * 32;
            const float* W = p.in[4] + (size_t)L * 2048 * 12288;
            const int q = t & 7, kg = t >> 3;
            float acc[5][4];
#pragma unroll
            for (int r = 0; r < 5; ++r) { acc[r][0] = 0.f; acc[r][1] = 0.f; acc[r][2] = 0.f; acc[r][3] = 0.f; }
#pragma unroll 4
            for (int k = kg; k < 2048; k += 64) {
                const float4 w = *(const float4*)(W + (size_t)k * 12288 + c0 + q * 4);
#pragma unroll
                for (int r = 0; r < 5; ++r) {
                    const float cv = cond[r * 2048 + k];
                    acc[r][0] += cv * w.x; acc[r][1] += cv * w.y; acc[r][2] += cv * w.z; acc[r][3] += cv * w.w;
                }
            }
#pragma unroll
            for (int r = 0; r < 5; ++r)
#pragma unroll
                for (int j = 0; j < 4; ++j) {
                    float a = acc[r][j];
                    a += shx(a, 8, t & 63); a += shx(a, 16, t & 63); a += shx(a, 32, t & 63);
                    acc[r][j] = a;
                }
            const int lane = t & 63, wave = t >> 6;
            __syncthreads();
            if (lane < 8) {
#pragma unroll
                for (int r = 0; r < 5; ++r)
#pragma unroll
                    for (int j = 0; j < 4; ++j) red[(wave * 8 + lane) * 20 + r * 4 + j] = acc[r][j];
            }
            __syncthreads();
            if (t < 160) {
                const int qq = t / 20, rj = t % 20;
                float s = 0.f;
#pragma unroll
                for (int w = 0; w < 8; ++w) s += red[(w * 8 + qq) * 20 + rj];
                const int r = rj >> 2, j = rj & 3, col = c0 + qq * 4 + j;
                ((float*)(p.ws + WS_MODS))[(size_t)(L * 5 + r) * 12288 + col] = s + p.in[5][L * 12288 + col];
            }
        } else if (u < NU_CONV + NU_ADA + NU_ROPE) {
            const int idx = (u - NU_CONV - NU_ADA) * 512 + t;
            if (idx < 32) ((float*)(p.ws + WS_ROPEF))[idx] = (float)(c_rope_inv[idx] * 0.15915494309189535);
        } else if (u < NU_CONV + NU_ADA + NU_ROPE + NU_LRUW) {
            const int idx = (u - NU_CONV - NU_ADA - NU_ROPE) * 512 + t;
            const int c = idx & 63, n = (idx >> 6) & 255, blk = (idx >> 14) & 7, L = idx >> 17;
            const int dg = n >> 6, dir = dg >> 1, gate = dg & 1, dd = n & 63;
            const float* src = gate ? p.in[17] : p.in[15];
            ((bf16_t*)(p.ws + WS_LRUWT))[idx] = f2bf(src[((size_t)((L * 2 + dir) * 8 + blk) * 64 + c) * 64 + dd]);
        } else {
            const int idx = (u - NU_CONV - NU_ADA - NU_ROPE - NU_LRUW) * 512 + t;
            const int k = idx & 2047, n = (idx >> 11) % 48, L = idx / (48 * 2048);
            float v = 0.f;
            if (n < 4) v = p.in[21][((size_t)L * 2048 + k) * 4 + n];
            else if (n < 36) v = p.in[23][((size_t)L * 2048 + k) * 32 + (n - 4)];
            ((bf16_t*)(p.ws + WS_WRT))[idx] = f2bf(v);
        }
    }
}

DEVI void phase_norm1(const int tid_, const Params& p, int L) {
    const int wave = tid_ >> 6, lane = tid_ & 63;
    float* H = (float*)(p.ws + WS_H);
    bf16_t* U = (bf16_t*)(p.ws + WS_U);
    const float* mods = (const float*)(p.ws + WS_MODS);
    const bf16_t* SL = (const bf16_t*)(p.ws + WS_SLOTS);
    const float* gmix = p.in[6] + L * 2048;
    float4 nx[8];
#define N1_SRC(r) (L == 0 ? ((r) < NL ? p.in[0] + (size_t)(r) * D : p.in[2] + (size_t)((r) - NL) * D) : H + (size_t)(r) * D)
    {
        const int r0 = blockIdx.x * 8 + wave;
        if (r0 < NT) { const float* s0 = N1_SRC(r0);
#pragma unroll
            for (int c = 0; c < 8; ++c) nx[c] = *(const float4*)(s0 + c * 256 + lane * 4); }
    }
    for (int row = blockIdx.x * 8 + wave; row < NT; row += gridDim.x * 8) {
        const int mrow = row < NL ? (row >> 12) : 4;
        const float* md = mods + (size_t)(L * 5 + mrow) * 12288;
        float4 hv[8];
#pragma unroll
        for (int c = 0; c < 8; ++c) hv[c] = nx[c];
        {
            const int rn = row + (int)gridDim.x * 8;
            if (rn < NT) { const float* s1 = N1_SRC(rn);
#pragma unroll
                for (int c = 0; c < 8; ++c) nx[c] = *(const float4*)(s1 + c * 256 + lane * 4); }
        }
        if (L == 1) {
            const float* g2 = mods + (size_t)(0 * 5 + mrow) * 12288 + 5 * 2048;
#pragma unroll
            for (int c = 0; c < 8; ++c) {
                const int col = c * 256 + lane * 4;
                const float4 g = *(const float4*)(g2 + col);
                const uint2 a = *(const uint2*)(SL + (size_t)(row * 2) * D + col), b = *(const uint2*)(SL + (size_t)(row * 2 + 1) * D + col);
                hv[c].x += g.x * (bflo(a.x) + bflo(b.x)); hv[c].y += g.y * (bfhi(a.x) + bfhi(b.x));
                hv[c].z += g.z * (bflo(a.y) + bflo(b.y)); hv[c].w += g.w * (bfhi(a.y) + bfhi(b.y));
            }
        }
        float ss = 0.f;
#pragma unroll
        for (int c = 0; c < 8; ++c) {
            if (L == 1) *(float4*)(H + (size_t)row * D + c * 256 + lane * 4) = hv[c];
            ss += hv[c].x * hv[c].x + hv[c].y * hv[c].y + hv[c].z * hv[c].z + hv[c].w * hv[c].w;
        }
        ss = wave_sum(ss, lane);
        const float rstd = rsqrtf(ss * (1.f / 2048.f) + 1e-6f);
#pragma unroll
        for (int c = 0; c < 8; ++c) {
            const int col = c * 256 + lane * 4;
            const float4 gm = *(const float4*)(gmix + col), sh = *(const float4*)(md + col), sc = *(const float4*)(md + 2048 + col);
            const float u0 = hv[c].x * rstd * gm.x * (1.f + sc.x) + sh.x, u1 = hv[c].y * rstd * gm.y * (1.f + sc.y) + sh.y;
            const float u2 = hv[c].z * rstd * gm.z * (1.f + sc.z) + sh.z, u3 = hv[c].w * rstd * gm.w * (1.f + sc.w) + sh.w;
            uint2 o; o.x = pk2(u0, u1); o.y = pk2(u2, u3);
            *(uint2*)(U + (size_t)row * D + col) = o;
        }
    }
#undef N1_SRC
}

DEVI void phase_final(const int tid_, const Params& p) {
    const int wave = tid_ >> 6, lane = tid_ & 63;
    const float* H = (const float*)(p.ws + WS_H);
    const float* mods = (const float*)(p.ws + WS_MODS);
    const bf16_t* SL = (const bf16_t*)(p.ws + WS_SLOTS);
    const float* gf = p.in[28];
    for (int row = blockIdx.x * 8 + wave; row < NL; row += gridDim.x * 8) {
        const int mrow = row >> 12;
        const float* g2 = mods + (size_t)(1 * 5 + mrow) * 12288 + 5 * 2048;
        float4 hv[8];
        float ss = 0.f;
#pragma unroll
        for (int c = 0; c < 8; ++c) {
            const int col = c * 256 + lane * 4;
            hv[c] = *(const float4*)(H + (size_t)row * D + col);
            const float4 g = *(const float4*)(g2 + col);
            const uint2 a = *(const uint2*)(SL + (size_t)(row * 2) * D + col), b = *(const uint2*)(SL + (size_t)(row * 2 + 1) * D + col);
            hv[c].x += g.x * (bflo(a.x) + bflo(b.x)); hv[c].y += g.y * (bfhi(a.x) + bfhi(b.x));
            hv[c].z += g.z * (bflo(a.y) + bflo(b.y)); hv[c].w += g.w * (bfhi(a.y) + bfhi(b.y));
            ss += hv[c].x * hv[c].x + hv[c].y * hv[c].y + hv[c].z * hv[c].z + hv[c].w * hv[c].w;
        }
        ss = wave_sum(ss, lane);
        const float rstd = rsqrtf(ss * (1.f / 2048.f) + 1e-6f);
#pragma unroll
        for (int c = 0; c < 8; ++c) {
            const int col = c * 256 + lane * 4;
            const float4 gm = *(const float4*)(gf + col);
            float4 o; o.x = hv[c].x * rstd * gm.x; o.y = hv[c].y * rstd * gm.y; o.z = hv[c].z * rstd * gm.z; o.w = hv[c].w * rstd * gm.w;
            *(float4*)(p.out + (size_t)row * D + col) = o;
        }
    }
}

constexpr int EP_RS = 528;
struct EpiIn {
    bf16_t* Z; float* GZ; bf16_t* VT; bf16_t* GVT; const float* RC; const float* RS; int brow, pn;
    DEVI void operator()(const f32x4 (&acc)[2][2][4][2], int wr, int wc, int fr, int fq, int tid, unsigned char* stg) const {
        if (pn == 16) {
#pragma unroll
            for (int ai = 0; ai < 2; ++ai)
#pragma unroll
                for (int m = 0; m < 4; ++m) {
                    const int row = brow + ai * 128 + wr * 64 + m * 16 + fr;
#pragma unroll
                    for (int n = 0; n < 2; ++n) { const int colt = wc * 32 + n * 16 + fq * 4; if (colt < 32) *(f32x4*)(GZ + (size_t)row * 32 + colt) = acc[ai][0][m][n]; }
                }
            return;
        }
        const bool tr = (pn == 5 || pn == 8 || pn == 9);
#pragma unroll
        for (int ai = 0; ai < 2; ++ai)
#pragma unroll
            for (int m = 0; m < 4; ++m) {
                const int rloc = ai * 128 + wr * 64 + m * 16 + fr, row = brow + rloc;
#pragma unroll
                for (int bj = 0; bj < 2; ++bj)
#pragma unroll
                    for (int n = 0; n < 2; ++n) {
                        const int colt = bj * 128 + wc * 32 + n * 16 + fq * 4;
                        const f32x4 v = acc[ai][bj][m][n];
                        float o0 = v[0], o1 = v[1], o2 = v[2], o3 = v[3];
                        if (pn <= 4) {
                            if (row < NL) {
                                const int tpos = row & 4095, i0 = (colt & 127) >> 1;
                                const float pos = (float)((i0 < 32) ? (tpos >> 6) : (tpos & 63));
                                const float r0 = pos * RC[i0 & 31], r1 = pos * RC[(i0 & 31) + 1];
                                const float c0 = __builtin_amdgcn_cosf(r0), s0 = __builtin_amdgcn_sinf(r0), c1 = __builtin_amdgcn_cosf(r1), s1 = __builtin_amdgcn_sinf(r1);
                                o0 = v[0] * c0 - v[1] * s0; o1 = v[0] * s0 + v[1] * c0;
                                o2 = v[2] * c1 - v[3] * s1; o3 = v[2] * s1 + v[3] * c1;
                            }
                            if (pn < 4) { o0 *= 0.12751743f; o1 *= 0.12751743f; o2 *= 0.12751743f; o3 *= 0.12751743f; }
                        }
                        if (!tr) { uint2 o; o.x = pk2(o0, o1); o.y = pk2(o2, o3); *(uint2*)(stg + rloc * EP_RS + colt * 2) = o; }
                        else {
                            const unsigned p01 = pk2(o0, o1), p23 = pk2(o2, o3);
                            *(bf16_t*)(stg + (colt + 0) * EP_RS + rloc * 2) = (bf16_t)(p01 & 0xffffu); *(bf16_t*)(stg + (colt + 1) * EP_RS + rloc * 2) = (bf16_t)(p01 >> 16);
                            *(bf16_t*)(stg + (colt + 2) * EP_RS + rloc * 2) = (bf16_t)(p23 & 0xffffu); *(bf16_t*)(stg + (colt + 3) * EP_RS + rloc * 2) = (bf16_t)(p23 >> 16);
                        }
                    }
            }
        lds_sync();
        if (!tr) {
#pragma unroll 4
            for (int c = tid; c < 8192; c += 512) {
                const int r = c >> 5, cc = c & 31;
                *(uint4*)(Z + (size_t)(brow + r) * ZLD + pn * 256 + cc * 8) = *(const uint4*)(stg + r * EP_RS + cc * 16);
            }
        } else {
            int bb, tpos0;
            if (brow < NL) { bb = brow >> 12; tpos0 = brow & 4095; } else { bb = (brow - NL) >> 8; tpos0 = 4096; }
#pragma unroll 4
            for (int c = tid; c < 8192; c += 512) {
                const int col = c >> 5, rc = c & 31;
                bf16_t* dst;
                if (pn == 5) dst = VT + ((size_t)((bb * 2 + (col >> 7)) * 128 + (col & 127))) * TT;
                else { const int cv = (pn - 8) * 256 + col; dst = GVT + ((size_t)((bb * 4 + (cv >> 7)) * 128 + (cv & 127))) * TT; }
                *(uint4*)(dst + tpos0 + rc * 8) = *(const uint4*)(stg + col * EP_RS + rc * 16);
            }
        }
        lds_sync();
    }
};

DEVI void dense_tile_of(int wgid, int nM, int nN, int& pm, int& pn) {
    const int nig = 8 * nN, gid = wgid / nig, fm = gid * 8, gsz = (nM - fm) < 8 ? (nM - fm) : 8;
    pm = fm + ((wgid % nig) % gsz); pn = (wgid % nig) / gsz;
}

DEVI void phase_gemm_in(const int tid_, const Params& p, int L, bf16_t* shm) {
    const int nM = NT / 256, nN = NWIN / 256;
    const bf16_t* U = (const bf16_t*)(p.ws + WS_U);
    bg_fill(tid_, p, (unsigned char*)shm, FILL_Q);
    const int geff = (int)gridDim.x - NCONV_WG;
    if ((int)blockIdx.x >= geff) return;
    for (int i = 0;; ++i) {
        int u; if (!unit_of(i, nM * nN, u, geff)) break;
        int pm, pn; dense_tile_of(u, nM, nN, pm, pn);
        if (L == 1 && pm >= NL / 256 && !(pn == 4 || pn == 5 || pn == 7 || pn == 8 || pn == 9 || pn == 12 || pn == 13 || pn == 16)) continue;
        unsigned a0, a1; aoff_plain(tid_, D, a0, a1);
        const bf16_t* Bt = (const bf16_t*)(p.ws + WS_WINT) + ((size_t)L * NWIN + pn * 256) * 2048;
        EpiIn epi{(bf16_t*)(p.ws + WS_Z), (float*)(p.ws + WS_GZ), (bf16_t*)(p.ws + WS_VT), (bf16_t*)(p.ws + WS_GVT),
                  (const float*)(p.ws + WS_ROPEF), (const float*)(p.ws + WS_ROPES), pm * 256, pn};
        if (REP_SUB == 200) { struct Twice { const EpiIn& e; DEVI void operator()(const f32x4 (&acc)[2][2][4][2], int wr, int wc, int fr, int fq, int tid, unsigned char* stg) const { e(acc, wr, wc, fr, fq, tid, stg); asm volatile("" ::: "memory"); e(acc, wr, wc, fr, fq, tid, stg); } } tw{epi};
            gemm_tile<false>(tid_, shm, U + (size_t)pm * 256 * D, D, a0, a1, 0u, 0u, Bt, 2048, tw); }
        else gemm_tile<false>(tid_, shm, U + (size_t)pm * 256 * D, D, a0, a1, 0u, 0u, Bt, 2048, epi);
    }
}

struct EpiOut {
    float* H; const float* mods; const float* x; const float* ctx; int L, brow, bcol;
    DEVI void operator()(const f32x4 (&acc)[2][2][4][2], int wr, int wc, int fr, int fq, int, unsigned char*) const {
#pragma unroll
        for (int ai = 0; ai < 2; ++ai)
#pragma unroll
            for (int m = 0; m < 4; ++m) {
                const int row = brow + ai * 128 + wr * 64 + m * 16 + fr;
                const int mrow = row < NL ? (row >> 12) : 4;
                const float* g1 = mods + (size_t)(L * 5 + mrow) * 12288 + 2 * 2048;
#pragma unroll
                for (int bj = 0; bj < 2; ++bj)
#pragma unroll
                    for (int n = 0; n < 2; ++n) {
                        const int col = bcol + bj * 128 + wc * 32 + n * 16 + fq * 4;
                        const f32x4 g = *(const f32x4*)(g1 + col);
                        f32x4* hp = (f32x4*)(H + (size_t)row * D + col);
                        const f32x4* rp = (L == 0) ? (const f32x4*)((row < NL ? x + (size_t)row * D : ctx + (size_t)(row - NL) * D) + col) : (const f32x4*)hp;
                        f32x4 h = *rp;
                        h += g * acc[ai][bj][m][n];
                        *hp = h;
                    }
            }
    }
};

DEVI void phase_gemm_out(const int tid_, const Params& p, int L, bf16_t* shm) {
    const int nM = (L == 0 ? NT : NL) / 256, nN = 8;
    const bf16_t* MIX = (const bf16_t*)(p.ws + WS_MIX);
    bg_fill(tid_, p, (unsigned char*)shm, FILL_Q);
    const int geff = (int)gridDim.x - NCONV_WG;
    if ((int)blockIdx.x >= geff) return;
    for (int i = 0;; ++i) {
        int u; if (!unit_of(i, nM * nN, u, geff)) break;
        int pm, pn; dense_tile_of(u, nM, nN, pm, pn);
        unsigned a0, a1; aoff_plain(tid_, D, a0, a1);
        const bf16_t* Bt = (const bf16_t*)(p.ws + WS_WOUTT) + ((size_t)L * 2048 + pn * 256) * 2048;
        EpiOut epi{(float*)(p.ws + WS_H), (const float*)(p.ws + WS_MODS), p.in[0], p.in[2], L, pm * 256, pn * 256};
        gemm_tile<false>(tid_, shm, MIX + (size_t)pm * 256 * D, D, a0, a1, 0u, 0u, Bt, 2048, epi);
    }
}

constexpr int AT_KSTR = 272, AT_VSTR = 144;
DEVI void attn_unit(const int tid_, const Params& p, int L, int a, unsigned char* lds) {
    const bf16_t* Z = (const bf16_t*)(p.ws + WS_Z);
    const bf16_t* VT = (const bf16_t*)(p.ws + WS_VT);
    bf16_t* MIX = (bf16_t*)(p.ws + WS_MIX);
    unsigned char* Ks = lds;
    unsigned char* Vs = lds + 64 * AT_KSTR;
    const int tid = tid_, w = tid >> 6, lane = tid & 63, fr = lane & 15, fq = lane >> 4;
    int b, qb, kvh; bool isctx;
    if (a < 512) { b = a >> 7; qb = (a >> 1) & 63; kvh = a & 1; isctx = false; }
    else { const int a2 = a - 512; b = a2 >> 3; qb = (a2 >> 1) & 3; kvh = a2 & 1; isctx = true; }
    const int row0 = isctx ? NL + b * 256 + qb * 64 : b * 4096 + qb * 64;
    const int head = kvh * 4 + (w >> 1), qh = w & 1;
    bf16x8 Qf[2][4];
#pragma unroll
    for (int nq = 0; nq < 2; ++nq)
#pragma unroll
        for (int ks = 0; ks < 4; ++ks)
            Qf[nq][ks] = *(const bf16x8*)(Z + (size_t)(row0 + qh * 32 + nq * 16 + fr) * ZLD + ZQ + head * 128 + ks * 32 + fq * 8);
    f32x4 ot[8][2];
#pragma unroll
    for (int i = 0; i < 8; ++i) { ot[i][0] = (f32x4){0.f, 0.f, 0.f, 0.f}; ot[i][1] = (f32x4){0.f, 0.f, 0.f, 0.f}; }
    float mrun[2] = {-1e30f, -1e30f}, lrun[2] = {0.f, 0.f};
    int lo, hi;
    if (isctx) { lo = 5; hi = 4; } else { lo = (2 - qb) > 0 ? (2 - qb) : 0; hi = (65 - qb) < 4 ? (65 - qb) : 4; }
    int ti = (lo <= hi) ? lo : 5;
    uint4 kreg0, kreg1, vreg0, vreg1;
    const int kch0 = tid, kch1 = tid + 512;
#define AT_LOAD(tile) do { \
    int krow0_, vt0_; \
    if ((tile) <= 4) { const int j_ = qb - 2 + (tile); krow0_ = b * 4096 + j_ * 64; vt0_ = j_ * 64; } \
    else { const int jj_ = (tile) - 5; krow0_ = NL + b * 256 + jj_ * 64; vt0_ = 4096 + jj_ * 64; } \
    kreg0 = *(const uint4*)(Z + (size_t)(krow0_ + (kch0 >> 4)) * ZLD + ZK + kvh * 128 + (kch0 & 15) * 8); \
    kreg1 = *(const uint4*)(Z + (size_t)(krow0_ + (kch1 >> 4)) * ZLD + ZK + kvh * 128 + (kch1 & 15) * 8); \
    vreg0 = *(const uint4*)(VT + ((size_t)((b * 2 + kvh) * 128 + (kch0 >> 3))) * TT + vt0_ + (kch0 & 7) * 8); \
    vreg1 = *(const uint4*)(VT + ((size_t)((b * 2 + kvh) * 128 + (kch1 >> 3))) * TT + vt0_ + (kch1 & 7) * 8); } while (0)
    AT_LOAD(ti);
    for (;;) {
        PROF_B(11, lds, tid == 0);
        __syncthreads();
        *(uint4*)(Ks + (kch0 >> 4) * AT_KSTR + (kch0 & 15) * 16) = kreg0;
        *(uint4*)(Ks + (kch1 >> 4) * AT_KSTR + (kch1 & 15) * 16) = kreg1;
        *(uint4*)(Vs + (kch0 >> 3) * AT_VSTR + (kch0 & 7) * 16) = vreg0;
        *(uint4*)(Vs + (kch1 >> 3) * AT_VSTR + (kch1 & 7) * 16) = vreg1;
        __syncthreads();
        PROF_E(11, lds, tid == 0);
        const int cur = ti;
        const int nxt = (cur == hi) ? 5 : cur + 1;
        if (nxt <= 8) AT_LOAD(nxt);
        f32x4 st[4][2];
#pragma unroll
        for (int mt = 0; mt < 4; ++mt) { st[mt][0] = (f32x4){0.f, 0.f, 0.f, 0.f}; st[mt][1] = (f32x4){0.f, 0.f, 0.f, 0.f}; }
        {
            bf16x8 Kc[4], Kn[4];
#pragma unroll
            for (int mt = 0; mt < 4; ++mt) Kc[mt] = *(const bf16x8*)(Ks + (mt * 16 + fr) * AT_KSTR + (fq * 8) * 2);
#pragma unroll
            for (int ks = 0; ks < 4; ++ks) {
                if (ks < 3) {
#pragma unroll
                    for (int mt = 0; mt < 4; ++mt) Kn[mt] = *(const bf16x8*)(Ks + (mt * 16 + fr) * AT_KSTR + ((ks + 1) * 32 + fq * 8) * 2);
                }
                __builtin_amdgcn_sched_barrier(0);
#pragma unroll
                for (int mt = 0; mt < 4; ++mt) {
                    st[mt][0] = MFMA16(Kc[mt], Qf[0][ks], st[mt][0]);
                    st[mt][1] = MFMA16(Kc[mt], Qf[1][ks], st[mt][1]);
                }
                __builtin_amdgcn_sched_barrier(0);
#pragma unroll
                for (int mt = 0; mt < 4; ++mt) Kc[mt] = Kn[mt];
            }
        }
        const int mtype = (cur == 0) ? 1 : ((cur == 4) ? 2 : 0);
        if (mtype != 0) {
#pragma unroll
            for (int mt = 0; mt < 4; ++mt)
#pragma unroll
                for (int nq = 0; nq < 2; ++nq)
#pragma unroll
                    for (int j = 0; j < 4; ++j) {
                        const int c = mt * 16 + fq * 4 + j, aq = qh * 32 + nq * 16 + fr;
                        const bool keep = (mtype == 1) ? (c >= aq) : (c <= aq);
                        if (!keep) st[mt][nq][j] = -1e30f;
                    }
        }
        bf16x8 Pf[2][2];
#pragma unroll
        for (int nq = 0; nq < 2; ++nq) {
            float mx = st[0][nq][0];
#pragma unroll
            for (int mt = 0; mt < 4; ++mt)
#pragma unroll
                for (int j = 0; j < 4; ++j) mx = fmaxf(mx, st[mt][nq][j]);
            mx = fmaxf(mx, shx(mx, 16, lane)); mx = fmaxf(mx, shx(mx, 32, lane));
            const bool upd = mx > mrun[nq] + 8.f;
            if (__builtin_amdgcn_ballot_w64(upd) != 0ull) {
                const float mn2 = upd ? mx : mrun[nq];
                const float al = __builtin_amdgcn_exp2f(mrun[nq] - mn2);
                mrun[nq] = mn2;
                lrun[nq] *= al;
#pragma unroll
                for (int i = 0; i < 8; ++i) ot[i][nq] *= al;
            }
            const float mn = mrun[nq];
            float ps = 0.f;
#pragma unroll
            for (int mt = 0; mt < 4; ++mt)
#pragma unroll
                for (int j = 0; j < 4; ++j) { const float pv = __builtin_amdgcn_exp2f(st[mt][nq][j] - mn); st[mt][nq][j] = pv; ps += pv; }
            lrun[nq] += ps;
#pragma unroll
            for (int k2 = 0; k2 < 2; ++k2)
                Pf[nq][k2] = mk8(pk2(st[2 * k2][nq][0], st[2 * k2][nq][1]), pk2(st[2 * k2][nq][2], st[2 * k2][nq][3]),
                                 pk2(st[2 * k2 + 1][nq][0], st[2 * k2 + 1][nq][1]), pk2(st[2 * k2 + 1][nq][2], st[2 * k2 + 1][nq][3]));
        }
        {
            uint2 va[4][2], vb[4][2];
#pragma unroll
            for (int i = 0; i < 4; ++i) { const unsigned char* vp = Vs + (i * 16 + fr) * AT_VSTR + (fq * 4) * 2; va[i][0] = *(const uint2*)vp; va[i][1] = *(const uint2*)(vp + 32); }
#pragma unroll
            for (int g = 0; g < 4; ++g) {
                if (g < 3) {
                    const int k2n = (g + 1) >> 1, mdn = ((g + 1) & 1) * 4;
#pragma unroll
                    for (int i = 0; i < 4; ++i) { const unsigned char* vp = Vs + ((mdn + i) * 16 + fr) * AT_VSTR + (k2n * 32 + fq * 4) * 2; vb[i][0] = *(const uint2*)vp; vb[i][1] = *(const uint2*)(vp + 32); }
                }
                __builtin_amdgcn_sched_barrier(0);
                const int k2 = g >> 1, md0 = (g & 1) * 4;
#pragma unroll
                for (int i = 0; i < 4; ++i) {
                    const bf16x8 Vf = mk8(va[i][0].x, va[i][0].y, va[i][1].x, va[i][1].y);
                    ot[md0 + i][0] = MFMA16(Vf, Pf[0][k2], ot[md0 + i][0]);
                    ot[md0 + i][1] = MFMA16(Vf, Pf[1][k2], ot[md0 + i][1]);
                }
                __builtin_amdgcn_sched_barrier(0);
#pragma unroll
                for (int i = 0; i < 4; ++i) { va[i][0] = vb[i][0]; va[i][1] = vb[i][1]; }
            }
        }
        if (nxt > 8) break;
        ti = nxt;
    }
#undef AT_LOAD
    const float sk = p.in[9][L * 8 + head] * 1.4426950408889634f;
#pragma unroll
    for (int nq = 0; nq < 2; ++nq) {
        float l = lrun[nq];
        l += shx(l, 16, lane); l += shx(l, 32, lane);
        const float mf = fmaxf(mrun[nq], sk);
        const float al = __builtin_amdgcn_exp2f(mrun[nq] - mf);
        const float lt = l * al + __builtin_amdgcn_exp2f(sk - mf);
        const float sc = al * rcpf_(lt);
        const int row = row0 + qh * 32 + nq * 16 + fr;
#pragma unroll
        for (int md = 0; md < 8; ++md) {
            const f32x4 o = ot[md][nq] * sc;
            uint2 pk; pk.x = pk2(o[0], o[1]); pk.y = pk2(o[2], o[3]);
            *(uint2*)(MIX + (size_t)row * D + head * 128 + md * 16 + fq * 4) = pk;
        }
    }
}

DEVI void gla_chunk_rows(int b, int ci, int& rowbase, int& tpos0) {
    if (ci < 4) { rowbase = NL + b * 256 + ci * 64; tpos0 = 4096 + ci * 64; } else { rowbase = b * 4096 + (ci - 4) * 64; tpos0 = (ci - 4) * 64; }
}
DEVI float logsig_fast(float z) { return fminf(z, 0.f) - __logf(1.f + __expf(-fabsf(z))); }
DEVI int scan_ci(int dir, int s) { return dir == 0 ? s : (s < 4 ? 3 - s : 71 - s); }

constexpr int GP_GZS = 0, GP_CUM = 8192, GP_TOT = 41472, GP_KT = 41984, GP_VT = 60416, GP_KSM = 78848, MX_TAB = 91648;
DEVI void gla_tables(const int tid_, const Params& p, int L, unsigned char* lds) {
    float* tab = (float*)(lds + MX_TAB);
    __syncthreads();
    for (int i = tid_; i < 8192; i += 512) tab[i] = p.in[10][(size_t)L * 8192 + i];
    tab[8192 + tid_] = p.in[11][L * 512 + tid_];
    __syncthreads();
}

DEVI void gla_p1_phase(const int tid_, const Params& p, int L, unsigned char* lds) {
    const bf16_t* Z = (const bf16_t*)(p.ws + WS_Z);
    const bf16_t* GVT = (const bf16_t*)(p.ws + WS_GVT);
    const float* GZ = (const float*)(p.ws + WS_GZ);
    float* gzs = (float*)(lds + GP_GZS); float* cum = (float*)(lds + GP_CUM); float* tot = (float*)(lds + GP_TOT);
    bf16_t* kT = (bf16_t*)(lds + GP_KT); unsigned char* vts = lds + GP_VT; bf16_t* ksm = (bf16_t*)(lds + GP_KSM);
    const float* tab = (const float*)(lds + MX_TAB);
    const int tid = tid_, w = tid >> 6, lane = tid & 63, fr = lane & 15, fq = lane >> 4;
    const int t = tid >> 3, d0 = (tid & 7) * 8;
    gla_tables(tid_, p, L, lds);
    const int nun = NB * 4 * NCH;
    uint4 pgz, pk, pv0, pv1;
#define G1_PREF(uu) do { const int ci_ = (uu) % NCH, bh_ = (uu) / NCH; int rb_, tp_; gla_chunk_rows(bh_ >> 2, ci_, rb_, tp_); \
    pgz = *(const uint4*)(GZ + (size_t)(rb_ + t) * 32 + (tid & 7) * 4); \
    pk = *(const uint4*)(Z + (size_t)(rb_ + t) * ZLD + ZGK + (bh_ & 3) * 64 + d0); \
    pv0 = *(const uint4*)(GVT + ((size_t)(bh_ * 128 + (tid >> 3))) * TT + tp_ + (tid & 7) * 8); \
    pv1 = *(const uint4*)(GVT + ((size_t)(bh_ * 128 + 64 + (tid >> 3))) * TT + tp_ + (tid & 7) * 8); } while (0)
    int u = blockIdx.x;
    if (u < nun) G1_PREF(u);
    for (; u < nun; u += gridDim.x) {
        const int ci = u % NCH, bh = u / NCH, h = bh & 3;
        lds_sync();
        {
            const int r0 = (tid & 7) * 4;
            gzs[(r0 + 0) * 64 + t] = __uint_as_float(pgz.x); gzs[(r0 + 1) * 64 + t] = __uint_as_float(pgz.y);
            gzs[(r0 + 2) * 64 + t] = __uint_as_float(pgz.z); gzs[(r0 + 3) * 64 + t] = __uint_as_float(pgz.w);
        }
        *(uint4*)(vts + (tid >> 3) * 144 + (tid & 7) * 16) = pv0;
        *(uint4*)(vts + (64 + (tid >> 3)) * 144 + (tid & 7) * 16) = pv1;
        *(uint4*)((unsigned char*)ksm + t * 144 + d0 * 2) = pk;
        lds_sync();
        if (u + (int)gridDim.x < nun) G1_PREF(u + (int)gridDim.x);
#pragma unroll
        for (int dir = 0; dir < 2; ++dir) {
            float z[8];
#pragma unroll
            for (int i = 0; i < 8; ++i) z[i] = tab[8192 + dir * 256 + h * 64 + d0 + i];
#pragma unroll
            for (int r = 0; r < 16; ++r) {
                const float g = gzs[(dir * 16 + r) * 64 + t];
                const float4 w0 = *(const float4*)(tab + (dir * 16 + r) * 256 + h * 64 + d0), w1 = *(const float4*)(tab + (dir * 16 + r) * 256 + h * 64 + d0 + 4);
                z[0] += g * w0.x; z[1] += g * w0.y; z[2] += g * w0.z; z[3] += g * w0.w; z[4] += g * w1.x; z[5] += g * w1.y; z[6] += g * w1.z; z[7] += g * w1.w;
            }
#pragma unroll
            for (int i = 0; i < 8; ++i) cum[(dir * 64 + t) * 65 + d0 + i] = logsig_fast(z[i]) * (1.f / 16.f);
        }
        lds_sync();
        if (tid < 128) {
            const int dir = tid >> 6, d = tid & 63;
            float vv[64];
#pragma unroll
            for (int s2 = 0; s2 < 64; ++s2) vv[s2] = cum[(dir * 64 + (dir ? 63 - s2 : s2)) * 65 + d];
            float a = 0.f;
#pragma unroll
            for (int s2 = 0; s2 < 64; ++s2) { a += vv[s2]; vv[s2] = a; }
#pragma unroll
            for (int s2 = 0; s2 < 64; ++s2) cum[(dir * 64 + (dir ? 63 - s2 : s2)) * 65 + d] = vv[s2];
            tot[tid] = a;
        }
        lds_sync();
        {
            float* CG = (float*)(p.ws + WS_CUMG) + ((size_t)u * 2) * 4096;
#pragma unroll
            for (int dir = 0; dir < 2; ++dir) {
                const float tt = tot[dir * 64 + lane];
                float kd[8];
#pragma unroll
                for (int i = 0; i < 8; ++i) {
                    const int ti = w * 8 + i;
                    const float cv = cum[(dir * 64 + ti) * 65 + lane];
                    kd[i] = bf2f(ksm[ti * 72 + lane]) * __expf(tt - cv);
                    CG[(size_t)dir * 4096 + ti * 64 + lane] = cv;
                }
                uint4 o; o.x = pk2(kd[0], kd[1]); o.y = pk2(kd[2], kd[3]); o.z = pk2(kd[4], kd[5]); o.w = pk2(kd[6], kd[7]);
                *(uint4*)((unsigned char*)kT + ((dir * 64 + lane) * 72 + w * 8) * 2) = o;
            }
        }
        lds_sync();
        {
            const bf16x8 Af0 = *(const bf16x8*)(vts + (w * 16 + fr) * 144 + (fq * 8) * 2);
            const bf16x8 Af1 = *(const bf16x8*)(vts + (w * 16 + fr) * 144 + (32 + fq * 8) * 2);
#pragma unroll
            for (int dir = 0; dir < 2; ++dir) {
                f32x4 acc[4];
#pragma unroll
                for (int n = 0; n < 4; ++n) {
                    acc[n] = (f32x4){0.f, 0.f, 0.f, 0.f};
                    const bf16x8 Bf0 = *(const bf16x8*)((const unsigned char*)kT + ((dir * 64 + n * 16 + fr) * 72 + fq * 8) * 2);
                    const bf16x8 Bf1 = *(const bf16x8*)((const unsigned char*)kT + ((dir * 64 + n * 16 + fr) * 72 + 32 + fq * 8) * 2);
                    acc[n] = MFMA16(Af0, Bf0, acc[n]);
                    acc[n] = MFMA16(Af1, Bf1, acc[n]);
                }
                const int sq = bh * 2 + dir;
                float* CT = (float*)(p.ws + WS_CONTRIB) + ((size_t)(sq * NCH + ci)) * 8192;
#pragma unroll
                for (int n = 0; n < 4; ++n)
#pragma unroll
                    for (int j = 0; j < 4; ++j) CT[(w * 16 + fq * 4 + j) * 64 + n * 16 + fr] = acc[n][j];
            }
            if (tid < 128) { const int dir = tid >> 6, d = tid & 63; ((float*)(p.ws + WS_ATOT))[((size_t)((bh * 2 + dir) * NCH + ci)) * 64 + d] = __expf(tot[tid]); }
        }
    }
#undef G1_PREF
}

DEVI void gla_scan(const int tid_, const Params& p) {
    const float* __restrict__ CT = (const float*)(p.ws + WS_CONTRIB);
    const float* __restrict__ AT = (const float*)(p.ws + WS_ATOT);
    unsigned* __restrict__ SB = (unsigned*)(p.ws + WS_SBEF);
    for (int idx = blockIdx.x * 512 + tid_; idx < 32 * 128 * 32; idx += gridDim.x * 512) {
        const int dp = idx & 31, dv = (idx >> 5) & 127, sq = idx >> 12, dir = sq & 1;
        const float* ctp = CT + (size_t)sq * NCH * 8192 + dv * 64 + dp * 2;
        const float* atp = AT + (size_t)sq * NCH * 64 + dp * 2;
        unsigned* sbp = SB + (size_t)sq * NCH * 4096 + dv * 32 + dp;
        float s0 = 0.f, s1 = 0.f;
        constexpr int SB_ = 17;
        float2 c[SB_], a[SB_], cn[SB_], an[SB_];
#pragma unroll
        for (int q = 0; q < SB_; ++q) { const int ci = scan_ci(dir, q); c[q] = *(const float2*)(ctp + (size_t)ci * 8192); a[q] = *(const float2*)(atp + (size_t)ci * 64); }
#pragma unroll 1
        for (int s = 0; s < NCH; s += SB_) {
            if (s + SB_ < NCH) {
#pragma unroll
                for (int q = 0; q < SB_; ++q) { const int ci = scan_ci(dir, s + SB_ + q); cn[q] = *(const float2*)(ctp + (size_t)ci * 8192); an[q] = *(const float2*)(atp + (size_t)ci * 64); }
            }
#pragma unroll
            for (int q = 0; q < SB_; ++q) {
                const int ci = scan_ci(dir, s + q);
                sbp[(size_t)ci * 4096] = pk2(s0, s1);
                s0 = a[q].x * s0 + c[q].x; s1 = a[q].y * s1 + c[q].y;
            }
#pragma unroll
            for (int q = 0; q < SB_; ++q) { c[q] = cn[q]; a[q] = an[q]; }
        }
    }
}

constexpr int G3_QS = 0, G3_KS = 18432, G3_SS = 36864, G3_VT = 73728, G3_PART = 92160, G3_OB = 92672;
DEVI void gla_p3_phase(const int tid_, const Params& p, int L, unsigned char* lds) {
    const bf16_t* Z = (const bf16_t*)(p.ws + WS_Z);
    const bf16_t* GVT = (const bf16_t*)(p.ws + WS_GVT);
    const float* CUMG = (const float*)(p.ws + WS_CUMG);
    const bf16_t* SBEF = (const bf16_t*)(p.ws + WS_SBEF);
    bf16_t* MIX = (bf16_t*)(p.ws + WS_MIX);
    unsigned char* qs = lds + G3_QS; unsigned char* ks = lds + G3_KS; unsigned char* ss = lds + G3_SS; unsigned char* vts = lds + G3_VT;
    float* part = (float*)(lds + G3_PART); float* ob = (float*)(lds + G3_OB);
    const int tid = tid_, w = tid >> 6, lane = tid & 63, fr = lane & 15, fq = lane >> 4;
    const int ntl = w & 3, dvh = w >> 2;
    const int t = tid >> 3, d0 = (tid & 7) * 8, dv0 = (tid & 7) * 16;
    const int cfirst = (L == 0) ? 0 : 4, ncl = NCH - cfirst, nun = NB * 4 * ncl;
    uint4 pq, pk, psf0, psf1, psb0, psb1, pv0, pv1, pg0, pg1;
    float4 pcf0, pcf1, pcb0, pcb1;
#define G3_PREF(uu) do { const int ci_ = cfirst + (uu) % ncl, bh_ = (uu) / ncl; int rb_, tp_; gla_chunk_rows(bh_ >> 2, ci_, rb_, tp_); \
    const size_t u1_ = (size_t)bh_ * NCH + ci_; \
    pq = *(const uint4*)(Z + (size_t)(rb_ + t) * ZLD + ZGQ + (bh_ & 3) * 64 + d0); \
    pk = *(const uint4*)(Z + (size_t)(rb_ + t) * ZLD + ZGK + (bh_ & 3) * 64 + d0); \
    pcf0 = *(const float4*)(CUMG + (u1_ * 2) * 4096 + t * 64 + d0); pcf1 = *(const float4*)(CUMG + (u1_ * 2) * 4096 + t * 64 + d0 + 4); \
    pcb0 = *(const float4*)(CUMG + (u1_ * 2 + 1) * 4096 + t * 64 + d0); pcb1 = *(const float4*)(CUMG + (u1_ * 2 + 1) * 4096 + t * 64 + d0 + 4); \
    { const bf16_t* sf_ = SBEF + ((size_t)((bh_ * 2) * NCH + ci_)) * 8192; const bf16_t* sb_ = SBEF + ((size_t)((bh_ * 2 + 1) * NCH + ci_)) * 8192; \
      psf0 = *(const uint4*)(sf_ + tid * 8); psf1 = *(const uint4*)(sf_ + 4096 + tid * 8); psb0 = *(const uint4*)(sb_ + tid * 8); psb1 = *(const uint4*)(sb_ + 4096 + tid * 8); } \
    pv0 = *(const uint4*)(GVT + ((size_t)(bh_ * 128 + (tid >> 3))) * TT + tp_ + (tid & 7) * 8); \
    pv1 = *(const uint4*)(GVT + ((size_t)(bh_ * 128 + 64 + (tid >> 3))) * TT + tp_ + (tid & 7) * 8); \
    pg0 = *(const uint4*)(Z + (size_t)(rb_ + t) * ZLD + ZGR + (bh_ & 3) * 128 + dv0); \
    pg1 = *(const uint4*)(Z + (size_t)(rb_ + t) * ZLD + ZGR + (bh_ & 3) * 128 + dv0 + 8); } while (0)
    int u = blockIdx.x;
    if (u < nun) G3_PREF(u);
    for (; u < nun; u += gridDim.x) {
        const int ci = cfirst + u % ncl, bh = u / ncl, h = bh & 3;
        int rowbase, tpos0; gla_chunk_rows(bh >> 2, ci, rowbase, tpos0);
        lds_sync();
        {
            const unsigned qw[4] = {pq.x, pq.y, pq.z, pq.w}, kw[4] = {pk.x, pk.y, pk.z, pk.w};
            const float cf[8] = {pcf0.x, pcf0.y, pcf0.z, pcf0.w, pcf1.x, pcf1.y, pcf1.z, pcf1.w};
            const float cb[8] = {pcb0.x, pcb0.y, pcb0.z, pcb0.w, pcb1.x, pcb1.y, pcb1.z, pcb1.w};
#pragma unroll
            for (int dir = 0; dir < 2; ++dir) {
                unsigned qo[4], ko[4];
#pragma unroll
                for (int i = 0; i < 4; ++i) {
                    const float c0 = dir ? cb[2 * i] : cf[2 * i], c1 = dir ? cb[2 * i + 1] : cf[2 * i + 1];
                    qo[i] = pk2(bflo(qw[i]) * 0.125f * __expf(c0), bfhi(qw[i]) * 0.125f * __expf(c1));
                    ko[i] = pk2(bflo(kw[i]) * __expf(fminf(-c0, 80.f)), bfhi(kw[i]) * __expf(fminf(-c1, 80.f)));
                }
                uint4 t4; t4.x = qo[0]; t4.y = qo[1]; t4.z = qo[2]; t4.w = qo[3];
                *(uint4*)(qs + (dir * 64 + t) * 144 + d0 * 2) = t4;
                t4.x = ko[0]; t4.y = ko[1]; t4.z = ko[2]; t4.w = ko[3];
                *(uint4*)(ks + (dir * 64 + t) * 144 + d0 * 2) = t4;
            }
            *(uint4*)(ss + (tid >> 3) * 144 + (tid & 7) * 16) = psf0;
            *(uint4*)(ss + (64 + (tid >> 3)) * 144 + (tid & 7) * 16) = psf1;
            *(uint4*)(ss + (128 + (tid >> 3)) * 144 + (tid & 7) * 16) = psb0;
            *(uint4*)(ss + (192 + (tid >> 3)) * 144 + (tid & 7) * 16) = psb1;
            *(uint4*)(vts + (tid >> 3) * 144 + (tid & 7) * 16) = pv0;
            *(uint4*)(vts + (64 + (tid >> 3)) * 144 + (tid & 7) * 16) = pv1;
        }
        const uint4 gr0 = pg0, gr1 = pg1;
        lds_sync();
        if (u + (int)gridDim.x < nun) G3_PREF(u + (int)gridDim.x);
        f32x4 oacc[4];
#pragma unroll
        for (int i = 0; i < 4; ++i) oacc[i] = (f32x4){0.f, 0.f, 0.f, 0.f};
#pragma unroll
        for (int dir = 0; dir < 2; ++dir) {
            bf16x8 Bq[2];
            f32x4 at[4];
#pragma unroll
            for (int m = 0; m < 4; ++m) at[m] = (f32x4){0.f, 0.f, 0.f, 0.f};
#pragma unroll
            for (int k_ = 0; k_ < 2; ++k_) {
                Bq[k_] = *(const bf16x8*)(qs + (dir * 64 + ntl * 16 + fr) * 144 + (k_ * 32 + fq * 8) * 2);
#pragma unroll
                for (int m = 0; m < 4; ++m) {
                    const bf16x8 Ak = *(const bf16x8*)(ks + (dir * 64 + m * 16 + fr) * 144 + (k_ * 32 + fq * 8) * 2);
                    at[m] = MFMA16(Ak, Bq[k_], at[m]);
                }
            }
            {
                const int tq = ntl * 16 + fr;
#pragma unroll
                for (int m = 0; m < 4; ++m)
#pragma unroll
                    for (int j = 0; j < 4; ++j) {
                        const int s = m * 16 + fq * 4 + j;
                        const bool keep = dir == 0 ? (s <= tq) : (s >= tq);
                        if (!keep) at[m][j] = 0.f;
                    }
            }
#pragma unroll
            for (int k2 = 0; k2 < 2; ++k2) {
                const bf16x8 Pf = mk8(pk2(at[2 * k2][0], at[2 * k2][1]), pk2(at[2 * k2][2], at[2 * k2][3]),
                                      pk2(at[2 * k2 + 1][0], at[2 * k2 + 1][1]), pk2(at[2 * k2 + 1][2], at[2 * k2 + 1][3]));
#pragma unroll
                for (int md = 0; md < 4; ++md) {
                    const unsigned char* vp = vts + (dvh * 64 + md * 16 + fr) * 144 + (k2 * 32 + fq * 4) * 2;
                    const uint2 v0 = *(const uint2*)vp, v1 = *(const uint2*)(vp + 32);
                    oacc[md] = MFMA16(mk8(v0.x, v0.y, v1.x, v1.y), Pf, oacc[md]);
                }
            }
#pragma unroll
            for (int k_ = 0; k_ < 2; ++k_)
#pragma unroll
                for (int md = 0; md < 4; ++md) {
                    const bf16x8 As = *(const bf16x8*)(ss + (dir * 128 + dvh * 64 + md * 16 + fr) * 144 + (k_ * 32 + fq * 8) * 2);
                    oacc[md] = MFMA16(As, Bq[k_], oacc[md]);
                }
        }
        float sq = 0.f;
#pragma unroll
        for (int md = 0; md < 4; ++md)
#pragma unroll
            for (int j = 0; j < 4; ++j) sq += oacc[md][j] * oacc[md][j];
        sq += shx(sq, 16, lane); sq += shx(sq, 32, lane);
        if (fq == 0) part[w * 16 + fr] = sq;
        lds_sync();
        {
            const float tot2 = part[ntl * 16 + fr] + part[(ntl + 4) * 16 + fr];
            const float rstd = rsqrtf(tot2 * (1.f / 128.f) + 1e-6f);
#pragma unroll
            for (int md = 0; md < 4; ++md)
#pragma unroll
                for (int j = 0; j < 4; ++j) ob[(ntl * 16 + fr) * 132 + dvh * 64 + md * 16 + fq * 4 + j] = oacc[md][j] * rstd;
        }
        lds_sync();
        {
            const float* gn = p.in[12] + L * 128;
            const unsigned rw[8] = {gr0.x, gr0.y, gr0.z, gr0.w, gr1.x, gr1.y, gr1.z, gr1.w};
            unsigned o[8];
#pragma unroll
            for (int i4 = 0; i4 < 4; ++i4) {
                const float4 ov = *(const float4*)(ob + t * 132 + dv0 + 4 * i4), gv = *(const float4*)(gn + dv0 + 4 * i4);
                o[2 * i4] = pk2(ov.x * gv.x * siluf_(bflo(rw[2 * i4])), ov.y * gv.y * siluf_(bfhi(rw[2 * i4])));
                o[2 * i4 + 1] = pk2(ov.z * gv.z * siluf_(bflo(rw[2 * i4 + 1])), ov.w * gv.w * siluf_(bfhi(rw[2 * i4 + 1])));
            }
            uint4 a4; a4.x = o[0]; a4.y = o[1]; a4.z = o[2]; a4.w = o[3];
            uint4 b4; b4.x = o[4]; b4.y = o[5]; b4.z = o[6]; b4.w = o[7];
            bf16_t* dst = MIX + (size_t)(rowbase + t) * D + 1024 + h * 128 + dv0;
            *(uint4*)dst = a4; *(uint4*)(dst + 8) = b4;
        }
    }
#undef G3_PREF
}

constexpr int LR_XCF = 17152, LR_XCB = 34560, LR_OUTB = 43776;
template <int CTRL> DEVI float dppf(float oldv, float v) { return __int_as_float(__builtin_amdgcn_update_dpp(__float_as_int(oldv), __float_as_int(v), CTRL, 0xf, 0xf, false)); }
template <int DIR> DEVI void lru_tile_scan(float& A, float& B) {
    constexpr int base = DIR ? 0x100 : 0x110;
    { const float A2 = dppf<base | 1>(1.f, A), B2 = dppf<base | 1>(0.f, B); B = A * B2 + B; A = A * A2; }
    { const float A2 = dppf<base | 2>(1.f, A), B2 = dppf<base | 2>(0.f, B); B = A * B2 + B; A = A * A2; }
    { const float A2 = dppf<base | 4>(1.f, A), B2 = dppf<base | 4>(0.f, B); B = A * B2 + B; A = A * A2; }
    { const float A2 = dppf<base | 8>(1.f, A), B2 = dppf<base | 8>(0.f, B); B = A * B2 + B; A = A * A2; }
}
template <int PASS, int DIR>
DEVI void lru_wave_scan(const float (&av)[4][4], const float (&uv)[4][4], const float carry, int lane, int fr, int cb, int fq,
                        float* outb, float* la_out, float* lb_out) {
    float hin = (PASS == 3) ? carry : 0.f, pin = 1.f;
    const int l1 = DIR ? lane + 16 : lane - 16, l2 = DIR ? lane + 32 : lane - 32;
    const bool ok1 = DIR ? (fq <= 2) : (fq >= 1), ok2 = DIR ? (fq <= 1) : (fq >= 2);
    const int lend = DIR ? fr : 48 + fr;
#pragma unroll
    for (int mi = 0; mi < 4; ++mi) {
        const int m = DIR ? 3 - mi : mi;
        float Aj[4], Bj[4];
        float A = 1.f, B = 0.f;
#pragma unroll
        for (int jj = 0; jj < 4; ++jj) {
            const int j = DIR ? 3 - jj : jj;
            B = av[m][j] * B + uv[m][j]; A = A * av[m][j];
            Aj[j] = A; Bj[j] = B;
        }
        float Ai = A, Bi = B;
        { const float A2 = shidx(Ai, l1 & 63), B2 = shidx(Bi, l1 & 63); if (ok1) { Bi = Ai * B2 + Bi; Ai = Ai * A2; } }
        { const float A2 = shidx(Ai, l2 & 63), B2 = shidx(Bi, l2 & 63); if (ok2) { Bi = Ai * B2 + Bi; Ai = Ai * A2; } }
        float Ae = shidx(Ai, l1 & 63), Be = shidx(Bi, l1 & 63);
        if (!ok1) { Ae = 1.f; Be = 0.f; }
        const float hlane = Be + Ae * hin;
#pragma unroll
        for (int j = 0; j < 4; ++j) {
            const float hf = Bj[j] + Aj[j] * hlane;
            if (PASS == 3) outb[(DIR * 64 + m * 16 + fq * 4 + j) * 65 + cb * 16 + fr] = hf;
        }
        const float hend = Bi + Ai * hin;
        hin = shidx(hend, lend);
        if (PASS == 1) pin = shidx(Ai * pin, lend);
    }
    if (PASS == 1 && fq == 0) { la_out[fr] = pin; lb_out[fr] = hin; }
}

template <int PASS>
DEVI void lru_phase(const int tid_, const Params& p, int L, unsigned char* lds) {
    const bf16_t* Z = (const bf16_t*)(p.ws + WS_Z);
    float* xs = (float*)lds; float* xcf = (float*)(lds + LR_XCF); unsigned char* xcb = lds + LR_XCB; float* outb = (float*)(lds + LR_OUTB);
    float* tab = (float*)(lds + MX_TAB);
    const int tid = tid_, w = tid >> 6, lane = tid & 63, fr = lane & 15, fq = lane >> 4;
    const int dir = w >> 2, cb = w & 3;
    const int t = tid >> 3, c0 = (tid & 7) * 8;
    const int cfirst = (PASS == 3 && L == 1) ? 4 : 0, ncl = NCH - cfirst, nun = NB * ncl * 8;
    __syncthreads();
    for (int i = tid; i < 2048; i += 512) tab[i] = p.in[13][(size_t)L * 2048 + i];
    tab[2048 + tid] = p.in[14][L * 512 + tid];
    for (int i = tid; i < 1024; i += 512) {
        tab[2560 + i] = p.in[16][L * 1024 + i]; tab[3584 + i] = p.in[18][L * 1024 + i];
        tab[4608 + i] = -8.f * log1pf(expf(-p.in[19][L * 1024 + i]));
    }
    __syncthreads();
    unsigned short pxr[11];
    uint4 plg;
    float pcar = 0.f;
#define LR_DEC(uu, blk_, ci_, b_) const int blk_ = (uu) & 7, ci_ = cfirst + ((uu) >> 3) % ncl, b_ = ((uu) >> 3) / ncl
#define LR_PREF(uu) do { LR_DEC(uu, blk_, ci_, b_); int sr_, sl_, t0_; \
    if (ci_ < 4) { sr_ = NL + b_ * 256; sl_ = 256; t0_ = ci_ * 64; } else { sr_ = b_ * 4096; sl_ = 4096; t0_ = (ci_ - 4) * 64; } \
    _Pragma("unroll") for (int k_ = 0; k_ < 11; ++k_) { const int tm_ = t0_ - 2 + w * 8 + k_; \
        pxr[k_] = (tm_ >= 0 && tm_ < sl_) ? Z[(size_t)(sr_ + tm_) * ZLD + ZLX + blk_ * 64 + lane] : (unsigned short)0; } \
    if (PASS == 3) { plg = *(const uint4*)(Z + (size_t)(sr_ + t0_ + t) * ZLD + ZLG + blk_ * 64 + c0); \
        pcar = ((const float*)(p.ws + WS_LRUC))[((size_t)((b_ * NCH + ci_) * 2 + dir)) * 512 + blk_ * 64 + cb * 16 + fr]; } } while (0)
    int u = blockIdx.x;
    if (u < nun) LR_PREF(u);
    for (; u < nun; u += gridDim.x) {
        LR_DEC(u, blk, ci, b);
        const int rowbase = (ci < 4) ? NL + b * 256 + ci * 64 : b * 4096 + (ci - 4) * 64;
        float xr[11];
#pragma unroll
        for (int k = 0; k < 11; ++k) xr[k] = bf2f(pxr[k]);
        const uint4 lgc = plg;
        const float carry = pcar;
        const bf16_t* WT = (const bf16_t*)(p.ws + WS_LRUWT) + (size_t)(L * 8 + blk) * 256 * 64;
        bf16x8 Bw[2][2];
#pragma unroll
        for (int g = 0; g < 2; ++g)
#pragma unroll
            for (int ks = 0; ks < 2; ++ks)
                Bw[g][ks] = *(const bf16x8*)(WT + (size_t)(((dir * 2 + g) * 4 + cb) * 16 + fr) * 64 + ks * 32 + fq * 8);
        if (u + (int)gridDim.x < nun) LR_PREF(u + (int)gridDim.x);
        lds_sync();
        {
            const int ch = blk * 64 + lane;
            const float cw0 = tab[ch], cw1 = tab[512 + ch], cw2 = tab[1024 + ch], cw3 = tab[1536 + ch], cbv = tab[2048 + ch];
#pragma unroll
            for (int i = 0; i < 8; ++i) {
                const float y = cbv + xr[i] * cw0 + xr[i + 1] * cw1 + xr[i + 2] * cw2 + xr[i + 3] * cw3;
                xcf[(w * 8 + i) * 68 + lane] = y;
                ((bf16_t*)xcb)[(w * 8 + i) * 72 + lane] = f2bf(y);
            }
        }
        lds_sync();
        float av[4][4], uv[4][4];
        {
            f32x4 ga[4], gx[4];
#pragma unroll
            for (int m = 0; m < 4; ++m) { ga[m] = (f32x4){0.f, 0.f, 0.f, 0.f}; gx[m] = (f32x4){0.f, 0.f, 0.f, 0.f}; }
#pragma unroll
            for (int ks = 0; ks < 2; ++ks)
#pragma unroll
                for (int m = 0; m < 4; ++m) {
                    const bf16x8 Af = *(const bf16x8*)(xcb + (m * 16 + fr) * 144 + (ks * 32 + fq * 8) * 2);
                    ga[m] = MFMA16(Af, Bw[0][ks], ga[m]);
                    gx[m] = MFMA16(Af, Bw[1][ks], gx[m]);
                }
            const int ch = blk * 64 + cb * 16 + fr;
            const float bal = tab[2560 + dir * 512 + ch], bxl = tab[3584 + dir * 512 + ch], cfl = tab[4608 + dir * 512 + ch];
#pragma unroll
            for (int m = 0; m < 4; ++m)
#pragma unroll
                for (int j = 0; j < 4; ++j) {
                    const float xl = xcf[(m * 16 + fq * 4 + j) * 68 + cb * 16 + fr];
                    const float la = cfl * sigmoidf_(ga[m][j] + bal);
                    const float a = __expf(la);
                    const float om = __builtin_fmaf(-a, a, 1.f);
                    av[m][j] = a;
                    uv[m][j] = __builtin_amdgcn_sqrtf(om) * sigmoidf_(gx[m][j] + bxl) * xl;
                }
        }
        {
            const size_t sbase = ((size_t)((b * NCH + ci) * 2 + dir)) * 512 + blk * 64 + cb * 16;
            float* la_out = (float*)(p.ws + WS_LRUA) + sbase; float* lb_out = (float*)(p.ws + WS_LRUB) + sbase;
            if (dir == 0) lru_wave_scan<PASS, 0>(av, uv, carry, lane, fr, cb, fq, outb, la_out, lb_out);
            else lru_wave_scan<PASS, 1>(av, uv, carry, lane, fr, cb, fq, outb, la_out, lb_out);
        }
        if (PASS == 3) {
            lds_sync();
            const unsigned lw[4] = {lgc.x, lgc.y, lgc.z, lgc.w};
            unsigned o[4];
#pragma unroll
            for (int i = 0; i < 4; ++i) {
                const float h0 = outb[t * 65 + c0 + 2 * i] + outb[(64 + t) * 65 + c0 + 2 * i];
                const float h1 = outb[t * 65 + c0 + 2 * i + 1] + outb[(64 + t) * 65 + c0 + 2 * i + 1];
                o[i] = pk2(h0 * gelu_tanh(bflo(lw[i])), h1 * gelu_tanh(bfhi(lw[i])));
            }
            uint4 o4; o4.x = o[0]; o4.y = o[1]; o4.z = o[2]; o4.w = o[3];
            *(uint4*)((bf16_t*)(p.ws + WS_MIX) + (size_t)(rowbase + t) * D + 1536 + blk * 64 + c0) = o4;
        }
    }
#undef LR_PREF
#undef LR_DEC
}

DEVI void lru_carry_scan(const int tid_, const Params& p) {
    const float* __restrict__ LA = (const float*)(p.ws + WS_LRUA);
    const float* __restrict__ LB = (const float*)(p.ws + WS_LRUB);
    float* __restrict__ LC = (float*)(p.ws + WS_LRUC);
    for (int idx = blockIdx.x * 512 + tid_; idx < 4096; idx += gridDim.x * 512) {
        const int ch = idx & 511, dir = (idx >> 9) & 1, b = idx >> 10;
        float hc = 0.f;
#pragma unroll 1
        for (int s = 0; s < NCH; s += 4) {
            float a[4], bb[4];
#pragma unroll
            for (int q = 0; q < 4; ++q) {
                const size_t si = ((size_t)((b * NCH + scan_ci(dir, s + q)) * 2 + dir)) * 512 + ch;
                a[q] = LA[si]; bb[q] = LB[si];
            }
#pragma unroll
            for (int q = 0; q < 4; ++q) {
                const size_t si = ((size_t)((b * NCH + scan_ci(dir, s + q)) * 2 + dir)) * 512 + ch;
                LC[si] = hc;
                hc = a[q] * hc + bb[q];
            }
        }
    }
}

DEVI void phase_mix_a(const int tid_, const Params& p, int L, unsigned char* lds) {
    const int na = (L == 0) ? 544 : 512;
    PROF_B(10, lds, tid_ == 0);
#pragma unroll 1
    for (int rep = 0; rep < ((REP_SUB == 100 && L == 0) ? 2 : 1); ++rep)
        for (int a = blockIdx.x; a < na; a += gridDim.x) attn_unit(tid_, p, L, a, lds);
    PROF_E(10, lds, tid_ == 0);
    PROF_B(12, lds, tid_ == 0);
    gla_p1_phase(tid_, p, L, lds);
    PROF_E(12, lds, tid_ == 0);
    if (REP_SUB == 101 && L == 0) gla_p1_phase(tid_, p, L, lds);
    PROF_B(13, lds, tid_ == 0);
    lru_phase<1>(tid_, p, L, lds);
    PROF_E(13, lds, tid_ == 0);
    if (REP_SUB == 102 && L == 0) lru_phase<1>(tid_, p, L, lds);
}
DEVI void phase_mix_b(const int tid_, const Params& p) { gla_scan(tid_, p); lru_carry_scan(tid_, p); }
DEVI void phase_mix_c(const int tid_, const Params& p, int L, unsigned char* lds) {
    PROF_B(14, lds, tid_ == 0);
    gla_p3_phase(tid_, p, L, lds);
    PROF_E(14, lds, tid_ == 0);
    if (REP_SUB == 103 && L == 0) gla_p3_phase(tid_, p, L, lds);
    PROF_B(15, lds, tid_ == 0);
    lru_phase<3>(tid_, p, L, lds);
    PROF_E(15, lds, tid_ == 0);
    if (REP_SUB == 104 && L == 0) lru_phase<3>(tid_, p, L, lds);
}

DEVI void phase_norm2(const int tid_, const Params& p, int L, unsigned char* lds, bool dry = false) {
    const int nrows = (L == 0) ? NT : NL;
    const int tid = tid_, w = tid >> 6, lane = tid & 63, fr = lane & 15, fq = lane >> 4;
    const float* H = (const float*)(p.ws + WS_H);
    bf16_t* U = (bf16_t*)(p.ws + WS_U);
    const float* mods = (const float*)(p.ws + WS_MODS);
    const float* gffn = p.in[7] + L * 2048;
    const bf16_t* WR = (const bf16_t*)(p.ws + WS_WRT) + (size_t)L * 48 * 2048;
    unsigned char* vt = lds;
    float* part = (float*)(lds + 65792);
    float* lgt = (float*)(lds + 65792 + 24576);
    unsigned* cnt = (unsigned*)(p.ws + WS_CTL) + (dry ? 8192 : CTL_COUNT) + L * 32;
    int* tokl = (int*)(p.ws + (dry ? WS_END : WS_TOKL));
    float* gatel = (float*)(p.ws + (dry ? WS_END + (size_t)32 * TOKCAP * 4 : WS_GATEL));
    unsigned char* wr2 = lds + 93440;
    __syncthreads();
#pragma unroll
    for (int i = 0; i < 2; ++i) { const int ch = tid + 512 * i; *(uint4*)(wr2 + ch * 16) = *(const uint4*)(WR + (size_t)32 * 2048 + ch * 8); }
    __syncthreads();
    bf16x8 Bf[8][2];
#pragma unroll
    for (int kk = 0; kk < 8; ++kk)
#pragma unroll
        for (int n = 0; n < 2; ++n) Bf[kk][n] = *(const bf16x8*)(WR + (size_t)(n * 16 + fr) * 2048 + w * 256 + kk * 32 + fq * 8);
    int* dec = (int*)(lds + 109824);
    int* lcnt = (int*)(lds + 109824 + 128 * 32);
    if (tid < 64) lcnt[tid] = 0;
    __syncthreads();
    int nloc = 0;
    float4 ha[8], hb[8];
    const int nit = nrows / 16;
    int it = blockIdx.x;
    if (it < nit) {
#pragma unroll
        for (int c = 0; c < 8; ++c) { ha[c] = *(const float4*)(H + (size_t)(it * 16 + w * 2) * D + c * 256 + lane * 4); hb[c] = *(const float4*)(H + (size_t)(it * 16 + w * 2 + 1) * D + c * 256 + lane * 4); }
    }
    for (; it < nit; it += gridDim.x) {
        lds_sync();
#define N2_ROW(hx, rr) do { \
            const int lr = w * 2 + (rr), row = it * 16 + lr; \
            const int mrow = row < NL ? (row >> 12) : 4; \
            const float* md = mods + (size_t)(L * 5 + mrow) * 12288; \
            float ss = 0.f; \
            _Pragma("unroll") for (int c = 0; c < 8; ++c) ss += hx[c].x * hx[c].x + hx[c].y * hx[c].y + hx[c].z * hx[c].z + hx[c].w * hx[c].w; \
            ss = wave_sum(ss, lane); \
            const float rstd = rsqrtf(ss * (1.f / 2048.f) + 1e-6f); \
            _Pragma("unroll") for (int c = 0; c < 8; ++c) { \
                const int col = c * 256 + lane * 4; \
                const float4 gm = *(const float4*)(gffn + col), sh = *(const float4*)(md + 3 * 2048 + col), sc = *(const float4*)(md + 4 * 2048 + col); \
                const float u0 = hx[c].x * rstd * gm.x * (1.f + sc.x) + sh.x, u1 = hx[c].y * rstd * gm.y * (1.f + sc.y) + sh.y; \
                const float u2 = hx[c].z * rstd * gm.z * (1.f + sc.z) + sh.z, u3 = hx[c].w * rstd * gm.w * (1.f + sc.w) + sh.w; \
                uint2 o; o.x = pk2(u0, u1); o.y = pk2(u2, u3); \
                *(uint2*)(U + (size_t)row * D + col) = o; \
                *(uint2*)(vt + lr * 4112 + col * 2) = o; \
                asm volatile("" ::: "memory"); } } while (0)
        N2_ROW(ha, 0);
        N2_ROW(hb, 1);
#undef N2_ROW
        if (it + (int)gridDim.x < nit) {
            const int itn = it + (int)gridDim.x;
#pragma unroll
            for (int c = 0; c < 8; ++c) { ha[c] = *(const float4*)(H + (size_t)(itn * 16 + w * 2) * D + c * 256 + lane * 4); hb[c] = *(const float4*)(H + (size_t)(itn * 16 + w * 2 + 1) * D + c * 256 + lane * 4); }
        }
        lds_sync();
        {
            f32x4 acc[3];
#pragma unroll
            for (int n = 0; n < 3; ++n) acc[n] = (f32x4){0.f, 0.f, 0.f, 0.f};
#pragma unroll
            for (int kk = 0; kk < 8; ++kk) {
                const int k0 = w * 256 + kk * 32 + fq * 8;
                const bf16x8 Af = *(const bf16x8*)(vt + fr * 4112 + k0 * 2);
                acc[0] = MFMA16(Af, Bf[kk][0], acc[0]);
                acc[1] = MFMA16(Af, Bf[kk][1], acc[1]);
                bf16x8 B2 = (bf16x8){0, 0, 0, 0, 0, 0, 0, 0};
                if (fr < 4) B2 = *(const bf16x8*)(wr2 + fr * 4096 + k0 * 2);
                acc[2] = MFMA16(Af, B2, acc[2]);
            }
#pragma unroll
            for (int n = 0; n < 3; ++n)
#pragma unroll
                for (int j = 0; j < 4; ++j) part[(w * 16 + fq * 4 + j) * 48 + n * 16 + fr] = acc[n][j];
        }
        lds_sync();
        for (int i = tid; i < 16 * 48; i += 512) {
            float s = 0.f;
#pragma unroll
            for (int ww = 0; ww < 8; ++ww) s += part[ww * 768 + i];
            lgt[i] = s;
        }
        lds_sync();
        if (tid < 16) {
            const int row = it * 16 + tid;
            const float* lg = lgt + tid * 48;
            float g[4];
#pragma unroll
            for (int j = 0; j < 4; ++j) g[j] = lg[j] + p.in[22][L * 4 + j];
            int gi = 0; float gm = g[0];
#pragma unroll
            for (int j = 1; j < 4; ++j) if (g[j] > gm) { gm = g[j]; gi = j; }
            float gs = 0.f;
#pragma unroll
            for (int j = 0; j < 4; ++j) gs += expf(g[j] - gm);
            const float pg = 1.f / gs;
            float e[8];
#pragma unroll
            for (int j = 0; j < 8; ++j) e[j] = lg[4 + gi * 8 + j] + p.in[24][L * 32 + gi * 8 + j];
            int i1 = 0; float m1 = e[0];
#pragma unroll
            for (int j = 1; j < 8; ++j) if (e[j] > m1) { m1 = e[j]; i1 = j; }
            int i2 = -1; float m2 = -3.4e38f;
#pragma unroll
            for (int j = 0; j < 8; ++j) if (j != i1 && e[j] > m2) { m2 = e[j]; i2 = j; }
            const float w1 = 1.f / (1.f + expf(m2 - m1)), w2 = 1.f - w1;
            const int e1 = gi * 8 + i1, e2 = gi * 8 + i2;
            const int r1 = atomicAdd(&lcnt[e1], 1), r2 = atomicAdd(&lcnt[e2], 1);
            int* dd = dec + (nloc * 16 + tid) * 8;
            dd[0] = row; dd[1] = e1; dd[2] = e2; dd[3] = r1; dd[4] = r2; dd[5] = __float_as_int(pg * w1); dd[6] = __float_as_int(pg * w2);
        }
        ++nloc;
    }
    lds_sync();
    if (tid < 32) { const int c = lcnt[tid]; lcnt[32 + tid] = c ? (int)atomicAdd(&cnt[tid], (unsigned)c) : 0; }
    lds_sync();
    for (int i = tid; i < nloc * 16; i += 512) {
        const int* dd = dec + i * 8;
        const int e1 = dd[1], e2 = dd[2];
        const size_t q1 = (size_t)e1 * TOKCAP + lcnt[32 + e1] + dd[3], q2 = (size_t)e2 * TOKCAP + lcnt[32 + e2] + dd[4];
        tokl[q1] = dd[0] * 2; gatel[q1] = __int_as_float(dd[5]);
        tokl[q2] = dd[0] * 2 + 1; gatel[q2] = __int_as_float(dd[6]);
    }
}

struct EpiUp {
    bf16_t* H1; int prow0, ncol0;
    DEVI void operator()(const f32x4 (&acc)[2][2][4][2], int wr, int wc, int fr, int fq, int tid, unsigned char* stg) const {
#pragma unroll
        for (int ai = 0; ai < 2; ++ai)
#pragma unroll
            for (int m = 0; m < 4; ++m) {
                const int rloc = ai * 128 + wr * 64 + m * 16 + fr;
#pragma unroll
                for (int n = 0; n < 2; ++n) {
                    const f32x4 a = acc[ai][0][m][n], c = acc[ai][1][m][n];
                    uint2 o; o.x = pk2(siluf_(a[0]) * c[0], siluf_(a[1]) * c[1]); o.y = pk2(siluf_(a[2]) * c[2], siluf_(a[3]) * c[3]);
                    *(uint2*)(stg + rloc * 272 + (wc * 32 + n * 16 + fq * 4) * 2) = o;
                }
            }
        lds_sync();
#pragma unroll 4
        for (int c = tid; c < 4096; c += 512) {
            const int r = c >> 4, cc = c & 15;
            *(uint4*)(H1 + (size_t)(prow0 + r) * 1024 + ncol0 + cc * 8) = *(const uint4*)(stg + r * 272 + cc * 16);
        }
        lds_sync();
    }
};
struct EpiDown {
    bf16_t* SL; const int* tokl; const float* gatel; int li0, cnt, bcol;
    DEVI void operator()(const f32x4 (&acc)[2][2][4][2], int wr, int wc, int fr, int fq, int tid, unsigned char* stg) const {
#pragma unroll
        for (int ai = 0; ai < 2; ++ai)
#pragma unroll
            for (int m = 0; m < 4; ++m) {
                const int rloc = ai * 128 + wr * 64 + m * 16 + fr, li = li0 + rloc;
                const float g = li < cnt ? gatel[li] : 0.f;
#pragma unroll
                for (int bj = 0; bj < 2; ++bj)
#pragma unroll
                    for (int n = 0; n < 2; ++n) {
                        const f32x4 v = acc[ai][bj][m][n] * g;
                        uint2 o; o.x = pk2(v[0], v[1]); o.y = pk2(v[2], v[3]);
                        *(uint2*)(stg + rloc * EP_RS + (bj * 128 + wc * 32 + n * 16 + fq * 4) * 2) = o;
                    }
            }
        lds_sync();
#pragma unroll 4
        for (int c = tid; c < 8192; c += 512) {
            const int r = c >> 5, cc = c & 31, li = li0 + r;
            if (li < cnt) *(uint4*)(SL + (size_t)tokl[li] * D + bcol + cc * 8) = *(const uint4*)(stg + r * EP_RS + cc * 16);
        }
        lds_sync();
    }
};

template <int DOWN>
DEVI void phase_moe(const int tid_, const Params& p, int L, unsigned char* lds) {
    bf16_t* shm = (bf16_t*)lds;
    int* tb = (int*)(lds + LDS_MISC + 256);
    const unsigned* cntg = (const unsigned*)(p.ws + WS_CTL) + CTL_COUNT + L * 32;
    __syncthreads();
    if (tid_ == 0) {
        int acc = 0;
        for (int e = 0; e < 32; ++e) { const int c = (int)cntg[e]; tb[64 + e] = c; tb[e] = acc; acc += (c + 255) >> 8; }
        tb[32] = acc;
    }
    __syncthreads();
    const int ntl = tb[32] * 8;
    const int* tokl = (const int*)(p.ws + WS_TOKL);
    bg_fill(tid_, p, lds, DOWN ? FILL_Q / 2 : FILL_Q);
    const int geff = (L == 0) ? (int)gridDim.x - NCONV_WG : (int)gridDim.x;
    if ((int)blockIdx.x >= geff) return;
    for (int i = 0;; ++i) {
        int u; if (!unit_of(i, ntl, u, geff)) break;
        int e = 0;
#pragma unroll 1
        for (int k = 1; k < 32; ++k) if (tb[k] * 8 <= u) e = k;
        const int q = u - tb[e] * 8, nte = tb[e + 1] - tb[e], nt = q / nte, mt = q % nte, cnt_e = tb[64 + e];
        const int prow0 = (tb[e] + mt) * 256;
        if (DOWN == 0) {
            unsigned ao[2][2];
#pragma unroll
            for (int ii = 0; ii < 2; ++ii) {
                int r, c; g_stage_rc(tid_ * 16 + ii * 8192, r, c);
#pragma unroll
                for (int hh = 0; hh < 2; ++hh) {
                    const int li = mt * 256 + hh * 128 + r;
                    const int tok = li < cnt_e ? (tokl[(size_t)e * TOKCAP + li] >> 1) : 0;
                    ao[hh][ii] = ((unsigned)tok * D + c) * 2u;
                }
            }
            const bf16_t* Bt = (const bf16_t*)(p.ws + WS_WUPT) + ((size_t)(L * 32 + e) * 2048 + nt * 256) * 2048;
            EpiUp epi{(bf16_t*)(p.ws + WS_H1), prow0, nt * 128};
            gemm_tile<true>(tid_, shm, (const bf16_t*)(p.ws + WS_U), D, ao[0][0], ao[0][1], ao[1][0], ao[1][1], Bt, 2048, epi);
        } else {
            unsigned a0, a1; aoff_plain(tid_, 1024, a0, a1);
            const bf16_t* Bt = (const bf16_t*)(p.ws + WS_WDNT) + ((size_t)(L * 32 + e) * 2048 + nt * 256) * 1024;
            EpiDown epi{(bf16_t*)(p.ws + WS_SLOTS), tokl + (size_t)e * TOKCAP, (const float*)(p.ws + WS_GATEL) + (size_t)e * TOKCAP, mt * 256, cnt_e, nt * 256};
            gemm_tile<false>(tid_, shm, (const bf16_t*)(p.ws + WS_H1) + (size_t)prow0 * 1024, 1024, a0, a1, 0u, 0u, Bt, 1024, epi);
        }
    }
}

extern __shared__ __attribute__((aligned(16))) unsigned char lds_raw[];

__global__ void __launch_bounds__(512, 2) hybrid_fwd(Params p_unused) {
    unsigned char* lds = lds_raw;
    int lo, hi;
    { Params q; load_params(q); lo = q.ph_lo; hi = q.ph_hi; }
    const int wv_ = __builtin_amdgcn_readfirstlane((int)(threadIdx.x >> 6));
    if (hi - lo > 1) {
        const bool t0 = (opaque_tid(wv_) == 0);
        if (t0) { *(uint4*)(lds + LDS_MISC) = make_uint4(0u, 0u, 0u, 0u); *(uint4*)(lds + LDS_MISC + 96) = make_uint4(0u, 0u, 0u, 0u); }
        __syncthreads();
        { Params q; load_params(q); (void)xcd_barrier_post((unsigned*)(q.ws + WS_CTL), (volatile LAS unsigned*)(lds + LDS_MISC), t0); }
    }
#ifndef PH_MASK
#define PH_MASK 0x7ff
#endif
#ifndef REP_PHASE
#define REP_PHASE -1
#endif
#ifndef REP_N
#define REP_N 1
#endif
#define PH_(fn, ...) do { asm volatile("; MARK_BEGIN " #fn); Params q__; load_params(q__); fn(opaque_tid(wv_), q__, ##__VA_ARGS__); asm volatile("; MARK_END " #fn); } while (0)
#define EN(j) ((PH_MASK >> (j)) & 1)
#define IN(k) (lo <= (k) && (k) < hi)
#define SEAM(k) do { if (IN(k) && IN((k) + 1)) { { Params qb_; load_params(qb_); bg_convert(opaque_tid(wv_), qb_, lds, (k)); } XcdBarrier bb_; Params q_; load_params(q_); \
    bb_.bar = (unsigned*)(q_.ws + WS_CTL); bb_.x = xb_xcc_id(); bb_.st = (volatile LAS unsigned*)(lds + LDS_MISC); xcd_barrier(bb_, opaque_tid(wv_) == 0); } } while (0)
    if (EN(0) && IN(0)) PH_(phase_prologue, lds);
    if (REP_PHASE == 0) for (int r_ = 0; r_ < REP_N; ++r_) PH_(phase_prologue, lds);
    SEAM(0);
    if (REP_SUB == 300) { for (int r_ = 0; r_ < 10; ++r_) SEAM(0); }
#define LAYER(L) do { constexpr int k0 = 1 + 9 * (L); \
        if (EN(1) && IN(k0 + 0)) PH_(phase_norm1, L); \
        if (REP_PHASE == k0 + 0) for (int r_ = 0; r_ < REP_N; ++r_) PH_(phase_norm1, L); \
        SEAM(k0 + 0); \
        if (EN(2) && IN(k0 + 1)) PH_(phase_gemm_in, L, (bf16_t*)lds); \
        if (REP_PHASE == k0 + 1) for (int r_ = 0; r_ < REP_N; ++r_) PH_(phase_gemm_in, L, (bf16_t*)lds); \
        SEAM(k0 + 1); \
        if (EN(3) && IN(k0 + 2)) PH_(phase_mix_a, L, lds); \
        if (REP_PHASE == k0 + 2) for (int r_ = 0; r_ < REP_N; ++r_) PH_(phase_mix_a, L, lds); \
        SEAM(k0 + 2); \
        if (EN(4) && IN(k0 + 3)) PH_(phase_mix_b); \
        if (REP_PHASE == k0 + 3) for (int r_ = 0; r_ < REP_N; ++r_) PH_(phase_mix_b); \
        SEAM(k0 + 3); \
        if (EN(5) && IN(k0 + 4)) PH_(phase_mix_c, L, lds); \
        if (REP_PHASE == k0 + 4) for (int r_ = 0; r_ < REP_N; ++r_) PH_(phase_mix_c, L, lds); \
        SEAM(k0 + 4); \
        if (EN(6) && IN(k0 + 5)) PH_(phase_gemm_out, L, (bf16_t*)lds); \
        if (REP_PHASE == k0 + 5) for (int r_ = 0; r_ < REP_N; ++r_) PH_(phase_gemm_out, L, (bf16_t*)lds); \
        SEAM(k0 + 5); \
        if (EN(7) && IN(k0 + 6)) PH_(phase_norm2, L, lds); \
        if (REP_PHASE == k0 + 6) for (int r_ = 0; r_ < REP_N; ++r_) PH_(phase_norm2, L, lds, true); \
        SEAM(k0 + 6); \
        if (EN(8) && IN(k0 + 7)) PH_(phase_moe<0>, L, lds); \
        if (REP_PHASE == k0 + 7) for (int r_ = 0; r_ < REP_N; ++r_) PH_(phase_moe<0>, L, lds); \
        SEAM(k0 + 7); \
        if (EN(9) && IN(k0 + 8)) PH_(phase_moe<1>, L, lds); \
        if (REP_PHASE == k0 + 8) for (int r_ = 0; r_ < REP_N; ++r_) PH_(phase_moe<1>, L, lds); \
        SEAM(k0 + 8); } while (0)
    LAYER(0);
    LAYER(1);
#undef LAYER
    if (EN(10) && IN(19)) PH_(phase_final);
    if (PROF_ID != 0 && blockIdx.x == 0 && opaque_tid(wv_) == 0) {
        const unsigned long long acc = PROF_WORD(lds)[0], t_start = __builtin_amdgcn_s_memrealtime();
        while (__builtin_amdgcn_s_memrealtime() - t_start < acc * PROF_AMP) __builtin_amdgcn_s_sleep(8);
    }
#undef IN
#undef SEAM
}

extern "C" void kernel_launch(void* const* d_in, const int* in_sizes, int n_in, void* d_out, int out_size, void* d_ws, size_t ws_size, hipStream_t stream) {
    static int grid = 0;
    if (grid == 0) {
        if (n_in != 29 || ws_size < WS_END) { fprintf(stderr, "kernel_launch: need 29 inputs and >= %zu bytes of workspace (got %d, %zu)\n", (size_t)WS_END, n_in, ws_size); grid = -1; return; }
        int dev = 0, cus = 0, per_cu = 0;
        if (hipGetDevice(&dev) != hipSuccess || hipDeviceGetAttribute(&cus, hipDeviceAttributeMultiprocessorCount, dev) != hipSuccess) { grid = -1; return; }
        if (hipFuncSetAttribute((const void*)hybrid_fwd, hipFuncAttributeMaxDynamicSharedMemorySize, LDS_BYTES) != hipSuccess) { fprintf(stderr, "kernel_launch: hipFuncSetAttribute failed\n"); grid = -1; return; }
        if (hipOccupancyMaxActiveBlocksPerMultiprocessor(&per_cu, (const void*)hybrid_fwd, 512, LDS_BYTES) != hipSuccess || per_cu < 1)
            fprintf(stderr, "kernel_launch: occupancy query reports %d workgroups per CU\n", per_cu);
        (void)hipGetLastError();
        grid = cus;
    }
    if (grid < 0) return;
    (void)hipMemsetAsync((char*)d_ws + WS_CTL, 0, 65536, stream);
    Params p{};
    for (int i = 0; i < 29; ++i) p.in[i] = (const float*)d_in[i];
    p.out = (float*)d_out; p.ws = (unsigned char*)d_ws;
#if MK_ONE_LAUNCH
    p.ph_lo = 0; p.ph_hi = 20;
    hipLaunchKernelGGL(hybrid_fwd, dim3(grid), dim3(512), LDS_BYTES, stream, p);
#else
    for (int k = 0; k < 20; ++k) {
        p.ph_lo = k; p.ph_hi = k + 1;
        hipLaunchKernelGGL(hybrid_fwd, dim3(grid), dim3(512), LDS_BYTES, stream, p);
    }
#endif
}
```

```cpp
#include <hip/hip_runtime.h>
#include <stdint.h>
#include <stdio.h>

#ifndef REP_SUB
#define REP_SUB -1
#endif
#ifndef BG_B0
#define BG_B0 8
#endif
#ifndef BG_B1
#define BG_B1 4
#endif
#ifndef NCONV_WG
#define NCONV_WG 0
#endif
#ifndef PROF_ID
#define PROF_ID 0
#endif
#ifndef PROF_AMP
#define PROF_AMP 4
#endif
#ifndef FILL_Q
#define FILL_Q 0
#endif
#ifndef MK_ONE_LAUNCH
#define MK_ONE_LAUNCH 1
#endif

typedef unsigned short bf16_t;
typedef short bf16x8 __attribute__((ext_vector_type(8)));
typedef float f32x4 __attribute__((ext_vector_type(4)));
#define DEVI __device__ __forceinline__

constexpr int D = 2048, NB = 4, SEQ = 4096, CTX = 256;
constexpr int NL = NB * SEQ, NC = NB * CTX, NT = NL + NC;
constexpr int NCH = 68;
constexpr int TT = SEQ + CTX;
constexpr int ZLD = 4096;
constexpr int ZQ = 0, ZK = 1024, ZGQ = 1536, ZGK = 1792, ZGR = 2560, ZLX = 3072, ZLG = 3584;
constexpr int NWIN = 4352;
constexpr int TOKCAP = NT;
constexpr int H1ROWS = 43008;

constexpr size_t al256(size_t x) { return (x + 255) & ~(size_t)255; }
constexpr size_t WS_CTL = 0;
constexpr size_t WS_MODS = 65536;
constexpr size_t WS_ROPEC = WS_MODS + al256((size_t)2 * 5 * 12288 * 4);
constexpr size_t WS_ROPES = WS_ROPEC + (size_t)4096 * 64 * 4;
constexpr size_t WS_ROPEF = WS_ROPES + (size_t)4096 * 64 * 4;
constexpr size_t WS_LRUWT = WS_ROPEF + 256;
constexpr size_t WS_WRT = WS_LRUWT + (size_t)2 * 8 * 256 * 64 * 2;
constexpr size_t WS_WINT = WS_WRT + (size_t)2 * 48 * 2048 * 2;
constexpr size_t WS_WOUTT = WS_WINT + (size_t)2 * NWIN * 2048 * 2;
constexpr size_t WS_WUPT = WS_WOUTT + (size_t)2 * 2048 * 2048 * 2;
constexpr size_t WS_WDNT = WS_WUPT + (size_t)2 * 32 * 2048 * 2048 * 2;
constexpr size_t WS_H = WS_WDNT + (size_t)2 * 32 * 2048 * 1024 * 2;
constexpr size_t WS_U = WS_H + (size_t)NT * D * 4;
constexpr size_t WS_Z = WS_U + (size_t)NT * D * 2;
constexpr size_t WS_GZ = WS_Z + (size_t)NT * ZLD * 2;
constexpr size_t WS_VT = WS_GZ + (size_t)NT * 32 * 4;
constexpr size_t WS_GVT = WS_VT + (size_t)8 * 128 * TT * 2;
constexpr size_t WS_MIX = WS_GVT + (size_t)16 * 128 * TT * 2;
constexpr size_t WS_CONTRIB = WS_MIX + (size_t)NT * D * 2;
constexpr size_t WS_SBEF = WS_CONTRIB + (size_t)32 * NCH * 8192 * 4;
constexpr size_t WS_ATOT = WS_SBEF + (size_t)32 * NCH * 8192 * 4;
constexpr size_t WS_LRUA = WS_ATOT + (size_t)32 * NCH * 64 * 4;
constexpr size_t WS_LRUB = WS_LRUA + (size_t)NB * NCH * 2 * 512 * 4;
constexpr size_t WS_LRUC = WS_LRUB + (size_t)NB * NCH * 2 * 512 * 4;
constexpr size_t WS_TOKL = WS_LRUC + (size_t)NB * NCH * 2 * 512 * 4;
constexpr size_t WS_GATEL = WS_TOKL + (size_t)32 * TOKCAP * 4;
constexpr size_t WS_H1 = WS_GATEL + (size_t)32 * TOKCAP * 4;
constexpr size_t WS_SLOTS = WS_H1 + (size_t)H1ROWS * 1024 * 2;
constexpr size_t WS_CUMG = WS_SLOTS + (size_t)NT * 2 * D * 2;
constexpr size_t WS_END = WS_CUMG + (size_t)NB * 4 * NCH * 2 * 4096 * 4;
constexpr int CTL_COUNT = 4096;

constexpr int LDS_BYTES = 155648;
constexpr int LDS_MISC = 139264;

struct Params {
    const float* in[29];
    float* out;
    unsigned char* ws;
    int ph_lo, ph_hi;
};

typedef __attribute__((address_space(1))) const float gcf_t;
typedef __attribute__((address_space(1))) float gf_t;
typedef __attribute__((address_space(1))) unsigned char guc_t;
struct ParamsK {
    gcf_t* in[29];
    gf_t* out;
    guc_t* ws;
    int ph_lo, ph_hi;
};
static_assert(sizeof(ParamsK) == sizeof(Params), "kernarg view");
__device__ __forceinline__ void load_params(Params& q) {
    const __attribute__((address_space(4))) ParamsK* kp = (const __attribute__((address_space(4))) ParamsK*)__builtin_amdgcn_kernarg_segment_ptr();
    asm volatile("" : "+s"(kp));
#pragma unroll
    for (int i = 0; i < 29; ++i) q.in[i] = (const float*)kp->in[i];
    q.out = (float*)kp->out; q.ws = (unsigned char*)kp->ws; q.ph_lo = kp->ph_lo; q.ph_hi = kp->ph_hi;
}

DEVI float bf2f(bf16_t v) { return __uint_as_float(((unsigned)v) << 16); }
DEVI float bflo(unsigned v) { return __uint_as_float(v << 16); }
DEVI float bfhi(unsigned v) { return __uint_as_float(v & 0xffff0000u); }
DEVI unsigned pk2(float lo, float hi) { unsigned r; asm("v_cvt_pk_bf16_f32 %0, %1, %2" : "=v"(r) : "v"(lo), "v"(hi)); return r; }
DEVI bf16_t f2bf(float f) { return (bf16_t)(pk2(f, 0.f) & 0xffffu); }
DEVI float shx(float v, int mask, int lane) { return __int_as_float(__builtin_amdgcn_ds_bpermute((lane ^ mask) << 2, __float_as_int(v))); }
DEVI float shidx(float v, int src) { return __int_as_float(__builtin_amdgcn_ds_bpermute(src << 2, __float_as_int(v))); }
DEVI float shup(float v, int off, int lane) { const int src = lane >= off ? lane - off : lane; return shidx(v, src); }
DEVI float wave_sum(float v, int lane) {
#pragma unroll
    for (int o = 32; o > 0; o >>= 1) v += shx(v, o, lane);
    return v;
}
DEVI float rcpf_(float x) { return __builtin_amdgcn_rcpf(x); }
DEVI float sigmoidf_(float x) { return rcpf_(1.f + __builtin_amdgcn_exp2f(-1.4426950408889634f * x)); }
DEVI float siluf_(float x) { return x * sigmoidf_(x); }
DEVI float gelu_tanh(float x) {
    const float y2 = 1.5957691216057308f * (x + 0.044715f * x * x * x);
    return x * sigmoidf_(y2);
}
DEVI float logsigmoidf_(float z) { return fminf(z, 0.f) - log1pf(expf(-fabsf(z))); }
DEVI bf16x8 mk8(unsigned a, unsigned b, unsigned c, unsigned d) {
    typedef unsigned u4 __attribute__((ext_vector_type(4)));
    u4 t = {a, b, c, d};
    return __builtin_bit_cast(bf16x8, t);
}
DEVI int hw_lane() { int l; asm volatile("v_mbcnt_lo_u32_b32 %0, -1, 0\n\tv_mbcnt_hi_u32_b32 %0, -1, %0" : "=v"(l)); return l; }
DEVI int opaque_tid(int wv) { int t = wv * 64 + hw_lane(); asm volatile("" : "+v"(t)); return t; }
DEVI void lds_sync() { asm volatile("s_waitcnt lgkmcnt(0)" ::: "memory"); __builtin_amdgcn_s_barrier(); asm volatile("" ::: "memory"); }
#define MFMA16(a, b, c) __builtin_amdgcn_mfma_f32_16x16x32_bf16((a), (b), (c), 0, 0, 0)

#define XB_TMO      128
#define XB_XCNT(j)  (256  + 64 * (j))
#define XB_XSUB(j)  (1280 + 64 * (j))
#define XB_XGEN(j)  (2304 + 64 * (j))
#define XB_TOP      3328
#define XB_TOPGEN   3392
#define XCD_BAR_WORDS 3456
#define XB_SPIN_CAP (1u << 18)
#define LAS __attribute__((address_space(3)))

__device__ __forceinline__ unsigned xb_ld(unsigned* p)              { return __hip_atomic_load(p, __ATOMIC_RELAXED, __HIP_MEMORY_SCOPE_AGENT); }
__device__ __forceinline__ unsigned xb_add(unsigned* p, unsigned v) { return __hip_atomic_fetch_add(p, v, __ATOMIC_RELAXED, __HIP_MEMORY_SCOPE_AGENT); }
__device__ __forceinline__ unsigned xb_xcc_id() { return (unsigned)__builtin_amdgcn_s_getreg((3 << 11) | 20) & 0xFu; }
#define XB_SPIN(cond, bar) do { unsigned _sp = 0; while (cond) { __builtin_amdgcn_s_sleep(1); \
    if ((++_sp & 255u) == 0u) { if (xb_ld(&(bar)[XB_TMO])) break; if (_sp > XB_SPIN_CAP) { atomicAdd(&(bar)[XB_TMO], 1u); break; } } } } while (0)

struct XcdBarrier {
    unsigned* bar; unsigned x;
    volatile LAS unsigned* st;
};
__device__ __forceinline__ XcdBarrier xcd_barrier_post(unsigned* bar, volatile LAS unsigned* st, bool t0) {
    XcdBarrier b; b.bar = bar; b.x = xb_xcc_id(); b.st = st;
    if (t0) (void)xb_add(&bar[XB_XCNT(b.x)], 1u);
    return b;
}
__device__ __forceinline__ void xcd_barrier_complete(unsigned* bar, unsigned x, unsigned& nloc, unsigned& nx) {
    const unsigned G = gridDim.x * gridDim.y * gridDim.z;
    unsigned sum, cnt, mine, sp = 0u;
    for (;;) {
        sum = 0u; cnt = 0u; mine = 0u;
#pragma unroll
        for (unsigned j = 0; j < 16; ++j) { const unsigned c = xb_ld(&bar[XB_XCNT(j)]); sum += c; cnt += (c > 0u) ? 1u : 0u; mine = (j == x) ? c : mine; }
        if (sum == G) break;
        __builtin_amdgcn_s_sleep(1);
        if ((++sp & 255u) == 0u) { if (xb_ld(&bar[XB_TMO])) break; if (sp > XB_SPIN_CAP) { atomicAdd(&bar[XB_TMO], 1u); break; } }
    }
    nloc = mine > 0u ? mine : 1u; nx = cnt > 0u ? cnt : 1u;
}
__device__ __forceinline__ void xcd_barrier(const XcdBarrier& b, bool t0) {
    asm volatile("s_waitcnt vmcnt(0)" ::: "memory");
    __syncthreads();
    if (t0) {
        unsigned* bar = b.bar;
        __builtin_amdgcn_s_waitcnt(0);
        unsigned nloc = b.st[0], nx = b.st[1];
        if (nloc == 0u) { xcd_barrier_complete(bar, b.x, nloc, nx); b.st[0] = nloc; b.st[1] = nx; }
        const unsigned old = xb_add(&bar[XB_XSUB(b.x)], 1u);
        const unsigned gen = old / nloc;
        if (old + 1u == (gen + 1u) * nloc) {
            __builtin_amdgcn_fence(__ATOMIC_RELEASE, "agent");
            asm volatile("s_waitcnt vmcnt(0)" ::: "memory");
            const unsigned og = xb_add(&bar[XB_TOP], 1u);
            const unsigned tg = og / nx;
            if (og + 1u == (tg + 1u) * nx) xb_add(&bar[XB_TOPGEN], 1u);
            else XB_SPIN(xb_ld(&bar[XB_TOPGEN]) == tg, bar);
            __builtin_amdgcn_fence(__ATOMIC_ACQUIRE, "agent");
            xb_add(&bar[XB_XGEN(b.x)], 1u);
            asm volatile("s_waitcnt vmcnt(0)" ::: "memory");
        } else {
            XB_SPIN(xb_ld(&bar[XB_XGEN(b.x)]) == gen, bar);
            __builtin_amdgcn_fence(__ATOMIC_ACQUIRE, "agent");
            asm volatile("s_waitcnt vmcnt(0)" ::: "memory");
        }
    }
    __syncthreads();
}

#define PROF_WORD(lds) ((volatile unsigned long long*)((lds) + LDS_MISC + 96))
#define PROF_B(id, lds, t0) do { if (PROF_ID == (id) && blockIdx.x == 0 && (t0)) PROF_WORD(lds)[1] = __builtin_amdgcn_s_memrealtime(); } while (0)
#define PROF_E(id, lds, t0) do { if (PROF_ID == (id) && blockIdx.x == 0 && (t0)) PROF_WORD(lds)[0] += __builtin_amdgcn_s_memrealtime() - PROF_WORD(lds)[1]; } while (0)
DEVI bool unit_of(int i, int nunits, int& u, int geff = 0) {
    const long Lx = (long)i * (geff ? geff : (int)gridDim.x) + blockIdx.x;
    if (Lx >= nunits) return false;
    const int w = (int)Lx, q = nunits / 8, r = nunits % 8, xcd = w % 8, off = w / 8;
    u = (xcd < r ? xcd * (q + 1) : r * (q + 1) + (xcd - r) * q) + off;
    return true;
}

constexpr int G_BK = 64, G_HALF = 128, G_HT = G_HALF * G_BK;
DEVI int g_lds_byte(int r, int c) {
    int st = (r >> 4) * 2 + (c >> 5), rr = r & 15, cc = c & 31, ob = rr * 64 + cc * 2;
    return st * 1024 + (ob ^ (((ob >> 9) & 1) << 5));
}
DEVI void g_stage_rc(int b, int& R, int& C) {
    int st = b / 1024, sb = b % 1024, swz = sb ^ (((sb >> 9) & 1) << 5);
    R = (st >> 1) * 16 + swz / 64; C = (st & 1) * 32 + (swz % 64) / 2;
}

template <bool GATHER, int HALF, class Epi>
DEVI void gemm_tile(const int tid_, bf16_t* shm, const bf16_t* __restrict__ A, unsigned lda, unsigned a0, unsigned a1, unsigned a2, unsigned a3,
                    const bf16_t* __restrict__ Bt, int K, const Epi& epi) {
#define SA(b, h) (shm + ((b) * 2 + (h)) * G_HT)
#define SB(b, h) (shm + (4 + (b) * 2 + (h)) * G_HT)
#define STG_A(T, P, h, kt) do { if (HALF == 1 && (h)) break; const unsigned so_ = (unsigned)(kt) * 128u + ((GATHER || !(h)) ? 0u : 256u * lda); \
    __builtin_amdgcn_raw_ptr_buffer_load_lds(rsA, (LAS void*)((char*)(P) + ldsw), 16, (GATHER && (h)) ? a2 : a0, so_, 0, 0); \
    __builtin_amdgcn_raw_ptr_buffer_load_lds(rsA, (LAS void*)((char*)(P) + ldsw + 8192), 16, (GATHER && (h)) ? a3 : a1, so_, 0, 0); } while (0)
#define STG_B(T, P, h, kt) do { if (HALF == 2 && (h)) break; const unsigned so_ = (unsigned)(kt) * 128u + ((h) ? 256u * (unsigned)K : 0u); \
    __builtin_amdgcn_raw_ptr_buffer_load_lds(rsB, (LAS void*)((char*)(P) + ldsw), 16, b0, so_, 0, 0); \
    __builtin_amdgcn_raw_ptr_buffer_load_lds(rsB, (LAS void*)((char*)(P) + ldsw + 8192), 16, b1, so_, 0, 0); } while (0)
#define LDA(dst, b, h) if (!(HALF == 1 && (h))) for (int m = 0; m < 4; ++m) for (int k = 0; k < 2; ++k) \
    dst[m][k] = *reinterpret_cast<const bf16x8*>((char*)SA(b, h) + g_lds_byte(wr * 64 + m * 16 + fr, k * 32 + fq * 8))
#define LDB(dst, b, h) if (!(HALF == 2 && (h))) for (int n = 0; n < 2; ++n) for (int k = 0; k < 2; ++k) \
    dst[n][k] = *reinterpret_cast<const bf16x8*>((char*)SB(b, h) + g_lds_byte(wc * 32 + n * 16 + fr, k * 32 + fq * 8))
#define MMA(ai, bj, At_, Bt_) do { if ((HALF == 1 && (ai)) || (HALF == 2 && (bj))) break; __builtin_amdgcn_s_setprio(1); \
    for (int m = 0; m < 4; ++m) for (int n = 0; n < 2; ++n) for (int k = 0; k < 2; ++k) \
        acc[ai][bj][m][n] = __builtin_amdgcn_mfma_f32_16x16x32_bf16(Bt_[n][k], At_[m][k], acc[ai][bj][m][n], 0, 0, 0); \
    __builtin_amdgcn_s_setprio(0); } while (0)
#define WAIT_V(n) asm volatile("s_waitcnt vmcnt(" #n ")" ::: "memory")
#define WAIT_L(n) asm volatile("s_waitcnt lgkmcnt(" #n ")" ::: "memory")
#define BAR __builtin_amdgcn_s_barrier()
#define SCHED __builtin_amdgcn_sched_barrier(0)
    unsigned b0, b1;
    { int r_, c_; g_stage_rc(tid_ * 16, r_, c_); b0 = (unsigned)(r_ * K + c_) * 2u; g_stage_rc(tid_ * 16 + 8192, r_, c_); b1 = (unsigned)(r_ * K + c_) * 2u; }
    const __amdgpu_buffer_rsrc_t rsA = __builtin_amdgcn_make_buffer_rsrc((void*)A, (short)0, 0x7fffffff, 0x00020000);
    const __amdgpu_buffer_rsrc_t rsB = __builtin_amdgcn_make_buffer_rsrc((void*)Bt, (short)0, 0x7fffffff, 0x00020000);
    const unsigned ldsw = (unsigned)__builtin_amdgcn_readfirstlane(tid_ >> 6) * 1024u;
    const int T = tid_;
    int wid = T >> 6, lane = T & 63, wr = wid >> 2, wc = wid & 3, fr = lane & 15, fq = lane >> 4;
    f32x4 acc[2][2][4][2] = {};
    bf16x8 At[4][2], B0[2][2], B1[2][2];
    const int nt = K / G_BK;
    STG_B(T, SB(0, 0), 0, 0); STG_A(T, SA(0, 0), 0, 0);
    STG_B(T, SB(0, 1), 1, 0); STG_A(T, SA(0, 1), 1, 0);
    if (wr == 1) BAR;
    if (HALF) WAIT_V(2); else WAIT_V(4);
    BAR;
    STG_B(T, SB(1, 0), 0, 1); STG_A(T, SA(1, 0), 0, 1); STG_B(T, SB(1, 1), 1, 1);
    if (HALF == 2) WAIT_V(4); else WAIT_V(6);
    BAR;
    for (int t = 0; t < nt - 2; t += 2) {
        LDB(B0, 0, 0); SCHED; LDA(At, 0, 0); STG_A(T, SA(1, 1), 1, t + 1);
        WAIT_L(8); BAR; WAIT_L(0); MMA(0, 0, At, B0); BAR; SCHED;
        LDB(B1, 0, 1); STG_B(T, SB(0, 0), 0, t + 2);
        BAR; WAIT_L(0); MMA(0, 1, At, B1); BAR;
        LDA(At, 0, 1); STG_A(T, SA(0, 0), 0, t + 2);
        BAR; WAIT_L(0); MMA(1, 0, At, B0); BAR; SCHED;
        STG_B(T, SB(0, 1), 1, t + 2);
        if (HALF == 2) WAIT_V(4); else WAIT_V(6);
        BAR; MMA(1, 1, At, B1); BAR;
        LDB(B0, 1, 0); SCHED; LDA(At, 1, 0); STG_A(T, SA(0, 1), 1, t + 2);
        WAIT_L(8); BAR; WAIT_L(0); MMA(0, 0, At, B0); BAR; SCHED;
        LDB(B1, 1, 1); STG_B(T, SB(1, 0), 0, t + 3);
        BAR; WAIT_L(0); MMA(0, 1, At, B1); BAR;
        LDA(At, 1, 1); STG_A(T, SA(1, 0), 0, t + 3);
        BAR; WAIT_L(0); MMA(1, 0, At, B0); BAR; SCHED;
        STG_B(T, SB(1, 1), 1, t + 3);
        if (HALF == 2) WAIT_V(4); else WAIT_V(6);
        BAR; MMA(1, 1, At, B1); BAR;
    }
    int tz = tid_; asm volatile("" : "+v"(tz)); wid = tz >> 6; lane = tz & 63; wr = wid >> 2; wc = wid & 3; fr = lane & 15; fq = lane >> 4;
    { LDB(B0, 0, 0); WAIT_V(0); LDA(At, 0, 0); STG_A(tz, SA(1, 1), 1, nt - 1);
      BAR; WAIT_L(0); MMA(0, 0, At, B0); BAR;
      LDB(B1, 0, 1); BAR; WAIT_L(0); MMA(0, 1, At, B1); BAR;
      LDA(At, 0, 1); WAIT_V(4); BAR; WAIT_L(0); MMA(1, 0, At, B0); MMA(1, 1, At, B1); BAR; }
    { LDB(B0, 1, 0); LDA(At, 1, 0); WAIT_V(2); BAR; WAIT_L(0); MMA(0, 0, At, B0); BAR;
      LDB(B1, 1, 1); WAIT_V(0); BAR; WAIT_L(0); MMA(0, 1, At, B1); BAR;
      LDA(At, 1, 1); BAR; WAIT_L(0); MMA(1, 0, At, B0); MMA(1, 1, At, B1); BAR; }
    if (wr == 0) BAR;
    SCHED;
    epi(acc, wr, wc, fr, fq, tz, (unsigned char*)shm);
#undef SA
#undef SB
#undef STG_A
#undef STG_B
#undef LDA
#undef LDB
#undef MMA
}

DEVI void aoff_plain(const int tid_, int lda, unsigned& a0, unsigned& a1) {
    int r, c;
    g_stage_rc(tid_ * 16, r, c);        a0 = (unsigned)(r * lda + c) * 2u;
    g_stage_rc(tid_ * 16 + 8192, r, c); a1 = (unsigned)(r * lda + c) * 2u;
}

constexpr int NU_WIN = 2 * 68 * 16, NU_WOUT = 2 * 32 * 16, NU_UP = 64 * 32 * 16, NU_DN = 64 * 32 * 8;
constexpr int NU_CONV = NU_WIN + NU_WOUT + NU_UP + NU_DN;
constexpr int NU_ADA = 768, NU_ROPE = 1, NU_LRUW = 512, NU_WR = 384;
constexpr int NU_P0 = NU_CONV + NU_ADA + NU_ROPE + NU_LRUW + NU_WR;

DEVI void conv_decode(const Params& p, int u, const float*& srck, int& ld_src, int& c0, int& nv, bf16_t*& dstn, int& ld_dst) {
    if (u < NU_WIN) {
        const int L = u / 1088, rem = u % 1088, ntile = rem >> 4, ktile = rem & 15, n0 = ntile * 64;
        if (n0 < 3072) { c0 = n0; nv = 64; } else if (n0 < 4096) { c0 = n0 + 32; nv = 64; } else if (n0 == 4096) { c0 = 3072; nv = 32; } else { c0 = 0; nv = 0; }
        srck = p.in[8] + (size_t)L * 2048 * 4128 + (size_t)ktile * 128 * 4128; ld_src = 4128;
        dstn = (bf16_t*)(p.ws + WS_WINT) + ((size_t)L * NWIN + n0) * 2048 + ktile * 128; ld_dst = 2048;
    } else if (u < NU_WIN + NU_WOUT) {
        const int v = u - NU_WIN, L = v >> 9, rem = v & 511, ntile = rem >> 4, ktile = rem & 15;
        srck = p.in[20] + (size_t)L * 2048 * 2048 + (size_t)ktile * 128 * 2048; ld_src = 2048; c0 = ntile * 64; nv = 64;
        dstn = (bf16_t*)(p.ws + WS_WOUTT) + ((size_t)L * 2048 + ntile * 64) * 2048 + ktile * 128; ld_dst = 2048;
    } else if (u < NU_WIN + NU_WOUT + NU_UP) {
        const int v = u - NU_WIN - NU_WOUT, le = v >> 9, rem = v & 511, ntile = rem >> 4, ktile = rem & 15;
        const int nt = ntile >> 2, half = (ntile >> 1) & 1, i0 = (ntile & 1) * 64;
        srck = (half ? p.in[26] : p.in[25]) + (size_t)le * 2048 * 1024 + (size_t)ktile * 128 * 1024; ld_src = 1024; c0 = nt * 128 + i0; nv = 64;
        dstn = (bf16_t*)(p.ws + WS_WUPT) + ((size_t)le * 2048 + ntile * 64) * 2048 + ktile * 128; ld_dst = 2048;
    } else {
        const int v = u - NU_WIN - NU_WOUT - NU_UP, le = v >> 8, rem = v & 255, ntile = rem >> 3, ktile = rem & 7;
        srck = p.in[27] + (size_t)le * 1024 * 2048 + (size_t)ktile * 128 * 2048; ld_src = 2048; c0 = ntile * 64; nv = 64;
        dstn = (bf16_t*)(p.ws + WS_WDNT) + ((size_t)le * 2048 + ntile * 64) * 1024 + ktile * 128; ld_dst = 1024;
    }
}

constexpr int CTL_QHEAD = 4200, CTL_DONE = 4224;
constexpr int QE0 = 1088, QE1 = 1600, QE2 = 17984, QE3 = 26176, QE4 = 27264, QE5 = 27776, QE6 = 44160, QE7 = 52352;
static_assert(QE7 == NU_CONV, "queue length");
DEVI int q_to_unit(int q) {
    if (q < QE0) return q;
    if (q < QE1) return NU_WIN + (q - QE0);
    if (q < QE2) return NU_WIN + NU_WOUT + (q - QE1);
    if (q < QE3) return NU_WIN + NU_WOUT + NU_UP + (q - QE2);
    if (q < QE4) return 1088 + (q - QE3);
    if (q < QE5) return NU_WIN + 512 + (q - QE4);
    if (q < QE6) return NU_WIN + NU_WOUT + 16384 + (q - QE5);
    return NU_WIN + NU_WOUT + NU_UP + 8192 + (q - QE6);
}
DEVI int q_deadline(int k) {
    return k < 1 ? 0 : k < 5 ? QE0 : k < 7 ? QE1 : k < 8 ? QE2 : k < 10 ? QE3 : k < 14 ? QE4 : k < 16 ? QE5 : k < 17 ? QE6 : QE7;
}
typedef unsigned u32x4_t __attribute__((ext_vector_type(4)));
DEVI float4 ntld4(const float* p) { const f32x4 v = __builtin_nontemporal_load((const f32x4*)p); return make_float4(v[0], v[1], v[2], v[3]); }
DEVI void ntst4(const uint4& o, bf16_t* p) { u32x4_t v = {o.x, o.y, o.z, o.w}; __builtin_nontemporal_store(v, (u32x4_t*)p); }
DEVI void conv_run(const int tid_, const Params& p, float* T, int q0, int count) {
    const int t = tid_, n4 = t & 15, kr = t >> 4;
    unsigned* TP = (unsigned*)T;
    float4 v0, v1, v2, v3, x0, x1, x2, x3;
    const float* srck; bf16_t* dstn; int ld_src, ld_dst, c0, nv;
    bf16_t* d1 = nullptr; int l1 = 0; bf16_t* d2 = nullptr; int l2 = 0;
#define CV_LOAD(a0_, a1_, a2_, a3_) do { const float* s_ = srck + c0 + n4 * 4; \
        a0_ = make_float4(0.f, 0.f, 0.f, 0.f); a1_ = a0_; a2_ = a0_; a3_ = a0_; \
        if (n4 * 4 < nv) { a0_ = ntld4((s_ + (size_t)(2 * kr) * ld_src)); a1_ = ntld4((s_ + (size_t)(2 * kr + 1) * ld_src)); \
                           a2_ = ntld4((s_ + (size_t)(2 * kr + 64) * ld_src)); a3_ = ntld4((s_ + (size_t)(2 * kr + 65) * ld_src)); } } while (0)
    conv_decode(p, q_to_unit(q0), srck, ld_src, c0, nv, dstn, ld_dst); d1 = dstn; l1 = ld_dst; CV_LOAD(v0, v1, v2, v3);
    x0 = make_float4(0.f, 0.f, 0.f, 0.f); x1 = x0; x2 = x0; x3 = x0;
    if (count > 1) { conv_decode(p, q_to_unit(q0 + 1), srck, ld_src, c0, nv, dstn, ld_dst); d2 = dstn; l2 = ld_dst; CV_LOAD(x0, x1, x2, x3); }
#pragma unroll 1
    for (int i = 0; i < count; ++i) {
        const float4 w0 = v0, w1 = v1, w2 = v2, w3 = v3;
        bf16_t* const dcur = d1; const int ldd = l1;
        v0 = x0; v1 = x1; v2 = x2; v3 = x3; d1 = d2; l1 = l2;
        if (i + 2 < count) { conv_decode(p, q_to_unit(q0 + i + 2), srck, ld_src, c0, nv, dstn, ld_dst); d2 = dstn; l2 = ld_dst; CV_LOAD(x0, x1, x2, x3); }
        unsigned* tp = TP + (i & 1) * (64 * 65);
        {
            unsigned* d = tp + (n4 * 4) * 65 + kr;
            d[0] = pk2(w0.x, w1.x); d[65] = pk2(w0.y, w1.y); d[130] = pk2(w0.z, w1.z); d[195] = pk2(w0.w, w1.w);
            d[32] = pk2(w2.x, w3.x); d[65 + 32] = pk2(w2.y, w3.y); d[130 + 32] = pk2(w2.z, w3.z); d[195 + 32] = pk2(w2.w, w3.w);
        }
        lds_sync();
        {
            const int kc = t & 7, n = t >> 3;
            const unsigned* r = tp + n * 65 + kc * 4;
            uint4 o0, o1;
            o0.x = r[0]; o0.y = r[1]; o0.z = r[2]; o0.w = r[3];
            o1.x = r[32]; o1.y = r[33]; o1.z = r[34]; o1.w = r[35];
            ntst4(o0, dcur + (size_t)n * ldd + kc * 8);
            ntst4(o1, dcur + (size_t)n * ldd + 64 + kc * 8);
        }
    }
    lds_sync();
#undef CV_LOAD
}
DEVI void bg_convert(const int tid_, const Params& p, unsigned char* lds, int k) {
    typedef __attribute__((address_space(1))) unsigned gu32_t;
    gu32_t* ctl = (gu32_t*)(p.ws + WS_CTL);
    volatile int* lw = (volatile int*)(lds + LDS_MISC + 64);
    float* T = (float*)lds;
    const int t = tid_;
    const int deadline = q_deadline(k), G = (int)gridDim.x;
#pragma unroll 1
    for (int stage = (k > 0 && q_deadline(k) == q_deadline(k - 1)) ? 1 : 0; stage < 2; ++stage) {
        if (stage == 1 && t == 0) (void)__hip_atomic_fetch_add(ctl + CTL_DONE + 64 * k, 1u, __ATOMIC_RELAXED, __HIP_MEMORY_SCOPE_AGENT);
        const int batch = (stage == 0) ? BG_B0 : BG_B1;
#pragma unroll 1
        for (;;) {
            if (t == 0) {
                int c = -1;
                const bool want = (stage == 0) ? ((int)__hip_atomic_load(ctl + CTL_QHEAD, __ATOMIC_RELAXED, __HIP_MEMORY_SCOPE_AGENT) < deadline)
                                               : ((int)__hip_atomic_load(ctl + CTL_DONE + 64 * k, __ATOMIC_RELAXED, __HIP_MEMORY_SCOPE_AGENT) < G);
                if (want) { c = (int)__hip_atomic_fetch_add(ctl + CTL_QHEAD, (unsigned)batch, __ATOMIC_RELAXED, __HIP_MEMORY_SCOPE_AGENT); if (c >= NU_CONV) c = -1; }
                lw[0] = c;
            }
            lds_sync();
            const int c = lw[0];
            lds_sync();
            if (c < 0) break;
            conv_run(tid_, p, T, c, (NU_CONV - c) < batch ? (NU_CONV - c) : batch);
        }
    }
}

DEVI void seam_sync(const int tid_, const Params& p, unsigned char* lds, int k) {
    typedef __attribute__((address_space(1))) unsigned gu32_t;
    gu32_t* ctl = (gu32_t*)(p.ws + WS_CTL);
    unsigned* bar = (unsigned*)(p.ws + WS_CTL);
    volatile int* lw = (volatile int*)(lds + LDS_MISC + 64);
    volatile LAS unsigned* st = (volatile LAS unsigned*)(lds + LDS_MISC);
    float* T = (float*)lds;
    const int t = tid_;
    const int deadline = q_deadline(k);
    __syncthreads();
    int have = (int)st[3] - 1;
    __syncthreads();
    if (t == 0) st[3] = 0u;
    if (have >= 0 && have < deadline) { conv_run(tid_, p, T, have, (NU_CONV - have) < BG_B1 ? (NU_CONV - have) : BG_B1); have = -1; }
    if (!(k > 0 && q_deadline(k) == q_deadline(k - 1))) {
#pragma unroll 1
        for (;;) {
            if (t == 0) {
                int c = -1;
                if ((int)__hip_atomic_load(ctl + CTL_QHEAD, __ATOMIC_RELAXED, __HIP_MEMORY_SCOPE_AGENT) < deadline) {
                    c = (int)__hip_atomic_fetch_add(ctl + CTL_QHEAD, (unsigned)BG_B0, __ATOMIC_RELAXED, __HIP_MEMORY_SCOPE_AGENT); if (c >= NU_CONV) c = -1; }
                lw[0] = c;
            }
            lds_sync();
            const int c = lw[0];
            lds_sync();
            if (c < 0) break;
            conv_run(tid_, p, T, c, (NU_CONV - c) < BG_B0 ? (NU_CONV - c) : BG_B0);
        }
    }
    asm volatile("s_waitcnt vmcnt(0)" ::: "memory");
    __syncthreads();
    if (t == 0) {
        __builtin_amdgcn_s_waitcnt(0);
        const unsigned x = xb_xcc_id();
        unsigned nloc = st[0], nx = st[1];
        if (nloc == 0u) { xcd_barrier_complete(bar, x, nloc, nx); st[0] = nloc; st[1] = nx; }
        const unsigned old = xb_add(&bar[XB_XSUB(x)], 1u);
        const unsigned gen = old / nloc;
        if (old + 1u == (gen + 1u) * nloc) {
            __builtin_amdgcn_fence(__ATOMIC_RELEASE, "agent");
            asm volatile("s_waitcnt vmcnt(0)" ::: "memory");
            const unsigned og = xb_add(&bar[XB_TOP], 1u);
            const unsigned tg = og / nx;
            if (og + 1u == (tg + 1u) * nx) (void)xb_add(&bar[XB_TOPGEN], 1u);
        }
        st[2] = gen;
    }
#pragma unroll 1
    for (;;) {
        if (t == 0) {
            const unsigned gen = st[2];
            const unsigned g = xb_ld(&bar[XB_TOPGEN]);
            int c = have;
            if (have < 0) { c = (int)__hip_atomic_fetch_add(ctl + CTL_QHEAD, (unsigned)BG_B1, __ATOMIC_RELAXED, __HIP_MEMORY_SCOPE_AGENT); if (c >= NU_CONV) c = -1; }
            const int fin = (g > gen) ? 1 : 0;
            if (fin && c >= 0) st[3] = (unsigned)(c + 1);
            lw[0] = c; lw[1] = fin;
        }
        lds_sync();
        const int c = lw[0], fin = lw[1];
        lds_sync();
        have = -1;
        if (fin) break;
        if (c < 0) {
            if (t == 0) { const unsigned gen = st[2]; XB_SPIN(xb_ld(&bar[XB_TOPGEN]) <= gen, bar); }
            break;
        }
        conv_run(tid_, p, T, c, (NU_CONV - c) < BG_B1 ? (NU_CONV - c) : BG_B1);
    }
    if (t == 0) { __builtin_amdgcn_fence(__ATOMIC_ACQUIRE, "agent"); asm volatile("s_waitcnt vmcnt(0)" ::: "memory"); }
    __syncthreads();
}

DEVI void bg_fill(const int tid_, const Params& p, unsigned char* lds, int per_quarter) {
    typedef __attribute__((address_space(1))) unsigned gu32_t;
    gu32_t* ctl = (gu32_t*)(p.ws + WS_CTL);
    volatile int* lw = (volatile int*)(lds + LDS_MISC + 64);
    const int n = (int)(blockIdx.x & 3u) * per_quarter;
    if (n == 0) return;
    if (tid_ == 0) {
        int c = -1;
        if ((int)__hip_atomic_load(ctl + CTL_QHEAD, __ATOMIC_RELAXED, __HIP_MEMORY_SCOPE_AGENT) < NU_CONV) {
            c = (int)__hip_atomic_fetch_add(ctl + CTL_QHEAD, (unsigned)n, __ATOMIC_RELAXED, __HIP_MEMORY_SCOPE_AGENT); if (c >= NU_CONV) c = -1; }
        lw[0] = c;
    }
    lds_sync();
    const int c = lw[0];
    lds_sync();
    if (c >= 0) conv_run(tid_, p, (float*)lds, c, (NU_CONV - c) < n ? (NU_CONV - c) : n);
    lds_sync();
}

__constant__ double c_rope_inv[32] = {
    1.0, 0.7498942093324559, 0.5623413251903491, 0.4216965034285822, 0.31622776601683794, 0.23713737056616552, 0.1778279410038923, 0.1333521432163324,
    0.1, 0.07498942093324558, 0.05623413251903491, 0.042169650342858224, 0.03162277660168379, 0.023713737056616554, 0.01778279410038923, 0.01333521432163324,
    0.01, 0.007498942093324558, 0.005623413251903491, 0.004216965034285823, 0.0031622776601683794, 0.0023713737056616554, 0.0017782794100389228, 0.001333521432163324,
    0.001, 0.0007498942093324559, 0.0005623413251903491, 0.00042169650342858224, 0.00031622776601683794, 0.00023713737056616554, 0.00017782794100389227, 0.0001333521432163324};

DEVI void sincos_f64(double ang, float& sn, float& cs) {
    const double n = __builtin_rint(ang * 0.15915494309189535);
    double r = __builtin_fma(-n, 6.283185307179586, ang);
    r = __builtin_fma(-n, 2.4492935982947064e-16, r);
    const double x = 0.5 * r, x2 = x * x;
    double s = 1.0, c = 1.0;
#pragma unroll
    for (int k = 12; k >= 1; --k) {
        s = 1.0 - s * x2 * (1.0 / (double)((2 * k) * (2 * k + 1)));
        c = 1.0 - c * x2 * (1.0 / (double)((2 * k - 1) * (2 * k)));
    }
    s *= x;
    sn = (float)(2.0 * s * c); cs = (float)(1.0 - 2.0 * s * s);
}

DEVI void phase_prologue(const int tid_, const Params& p, unsigned char* lds) {
    float* T = (float*)lds;
    float* cond = (float*)(lds + 33280);
    float* red = (float*)(lds + 33280 + 40960);
    const int t = tid_;
    for (int i = t; i < 5 * 2048; i += 512) {
        const int r = i >> 11, k = i & 2047;
        const float c = r < 4 ? p.in[1][r * 2048 + k] : p.in[3][k];
        cond[i] = c / (1.f + expf(-c));
    }
    __syncthreads();
    __syncthreads();
    for (int u = NU_CONV + blockIdx.x; u < NU_P0; u += gridDim.x) {
        if (false) {
        } else if (u < NU_CONV + NU_ADA) {
            const int v = u - NU_CONV, L = v / 384, c0 = (v % 384) * 32;
            const float* W = p.in[4] + (size_t)L * 2048 * 12288;
            const int q = t & 7, kg = t >> 3;
            float acc[5][4];
#pragma unroll
            for (int r = 0; r < 5; ++r) { acc[r][0] = 0.f; acc[r][1] = 0.f; acc[r][2] = 0.f; acc[r][3] = 0.f; }
#pragma unroll 8
            for (int k = kg; k < 2048; k += 64) {
                const float4 w = *(const float4*)(W + (size_t)k * 12288 + c0 + q * 4);
#pragma unroll
                for (int r = 0; r < 5; ++r) {
                    const float cv = cond[r * 2048 + k];
                    acc[r][0] += cv * w.x; acc[r][1] += cv * w.y; acc[r][2] += cv * w.z; acc[r][3] += cv * w.w;
                }
            }
#pragma unroll
            for (int r = 0; r < 5; ++r)
#pragma unroll
                for (int j = 0; j < 4; ++j) {
                    float a = acc[r][j];
                    a += shx(a, 8, t & 63); a += shx(a, 16, t & 63); a += shx(a, 32, t & 63);
                    acc[r][j] = a;
                }
            const int lane = t & 63, wave = t >> 6;
            __syncthreads();
            if (lane < 8) {
#pragma unroll
                for (int r = 0; r < 5; ++r)
#pragma unroll
                    for (int j = 0; j < 4; ++j) red[(wave * 8 + lane) * 20 + r * 4 + j] = acc[r][j];
            }
            __syncthreads();
            if (t < 160) {
                const int qq = t / 20, rj = t % 20;
                float s = 0.f;
#pragma unroll
                for (int w = 0; w < 8; ++w) s += red[(w * 8 + qq) * 20 + rj];
                const int r = rj >> 2, j = rj & 3, col = c0 + qq * 4 + j;
                ((float*)(p.ws + WS_MODS))[(size_t)(L * 5 + r) * 12288 + col] = s + p.in[5][L * 12288 + col];
            }
        } else if (u < NU_CONV + NU_ADA + NU_ROPE) {
            const int idx = (u - NU_CONV - NU_ADA) * 512 + t;
            if (idx < 32) ((float*)(p.ws + WS_ROPEF))[idx] = (float)(c_rope_inv[idx] * 0.15915494309189535);
        } else if (u < NU_CONV + NU_ADA + NU_ROPE + NU_LRUW) {
            const int idx = (u - NU_CONV - NU_ADA - NU_ROPE) * 512 + t;
            const int c = idx & 63, n = (idx >> 6) & 255, blk = (idx >> 14) & 7, L = idx >> 17;
            const int dg = n >> 6, dir = dg >> 1, gate = dg & 1, dd = n & 63;
            const float* src = gate ? p.in[17] : p.in[15];
            ((bf16_t*)(p.ws + WS_LRUWT))[idx] = f2bf(src[((size_t)((L * 2 + dir) * 8 + blk) * 64 + c) * 64 + dd]);
        } else {
            const int idx = (u - NU_CONV - NU_ADA - NU_ROPE - NU_LRUW) * 512 + t;
            const int k = idx & 2047, n = (idx >> 11) % 48, L = idx / (48 * 2048);
            float v = 0.f;
            if (n < 4) v = p.in[21][((size_t)L * 2048 + k) * 4 + n];
            else if (n < 36) v = p.in[23][((size_t)L * 2048 + k) * 32 + (n - 4)];
            ((bf16_t*)(p.ws + WS_WRT))[idx] = f2bf(v);
        }
    }
}

DEVI void phase_norm1(const int tid_, const Params& p, int L, unsigned char* lds) {
    const int wave = tid_ >> 6, lane = tid_ & 63;
    float* vtab = (float*)lds;
    __syncthreads();
    for (int i = tid_; i < 512 * 16; i += 512) {
        const int v = i >> 9, c4 = (i & 511) * 4;
        const float* src;
        if (v == 0) src = p.in[6] + L * 2048;
        else if (v < 6) src = (const float*)(p.ws + WS_MODS) + (size_t)(L * 5 + (v - 1)) * 12288;
        else if (v < 11) src = (const float*)(p.ws + WS_MODS) + (size_t)(L * 5 + (v - 6)) * 12288 + 2048;
        else src = (const float*)(p.ws + WS_MODS) + (size_t)(0 * 5 + (v - 11)) * 12288 + 5 * 2048;
        *(float4*)(vtab + v * 2048 + c4) = *(const float4*)(src + c4);
    }
    __syncthreads();
    bf16_t* H = (bf16_t*)(p.ws + WS_H);
    bf16_t* U = (bf16_t*)(p.ws + WS_U);
    const float* mods = (const float*)(p.ws + WS_MODS);
    const bf16_t* SL = (const bf16_t*)(p.ws + WS_SLOTS);
    const float* gmix = p.in[6] + L * 2048;
    float4 nx[8];
    uint2 sa[8], sb[8];
#define N1_LOAD(r) do { if (L == 0) { const float* s_ = (r) < NL ? p.in[0] + (size_t)(r) * D : p.in[2] + (size_t)((r) - NL) * D; \
            _Pragma("unroll") for (int c = 0; c < 8; ++c) nx[c] = *(const float4*)(s_ + c * 256 + lane * 4); } \
        else { const bf16_t* s_ = H + (size_t)(r) * D; \
            _Pragma("unroll") for (int c = 0; c < 8; ++c) { const uint2 q_ = *(const uint2*)(s_ + c * 256 + lane * 4); nx[c].x = __uint_as_float(q_.x); nx[c].y = __uint_as_float(q_.y); \
                sa[c] = *(const uint2*)(SL + (size_t)((r) * 2) * D + c * 256 + lane * 4); sb[c] = *(const uint2*)(SL + (size_t)((r) * 2 + 1) * D + c * 256 + lane * 4); } } } while (0)
    {
        const int r0 = blockIdx.x * 8 + wave;
        if (r0 < NT) N1_LOAD(r0);
    }
    for (int row = blockIdx.x * 8 + wave; row < NT; row += gridDim.x * 8) {
        const int mrow = row < NL ? (row >> 12) : 4;
        const float* md = mods + (size_t)(L * 5 + mrow) * 12288;
        float4 hv[8];
        uint2 ca[8], cb[8];
#pragma unroll
        for (int c = 0; c < 8; ++c) {
            if (L == 0) hv[c] = nx[c];
            else { const unsigned qx = __float_as_uint(nx[c].x), qy = __float_as_uint(nx[c].y); hv[c] = make_float4(bflo(qx), bfhi(qx), bflo(qy), bfhi(qy)); ca[c] = sa[c]; cb[c] = sb[c]; }
        }
        {
            const int rn = row + (int)gridDim.x * 8;
            if (rn < NT) N1_LOAD(rn);
        }
        if (L == 1) {
            const float* g2 = vtab + (11 + mrow) * 2048;
#pragma unroll
            for (int c = 0; c < 8; ++c) {
                const int col = c * 256 + lane * 4;
                const float4 g = *(const float4*)(g2 + col);
                const uint2 a = ca[c], b = cb[c];
                hv[c].x += g.x * (bflo(a.x) + bflo(b.x)); hv[c].y += g.y * (bfhi(a.x) + bfhi(b.x));
                hv[c].z += g.z * (bflo(a.y) + bflo(b.y)); hv[c].w += g.w * (bfhi(a.y) + bfhi(b.y));
            }
        }
        float ss = 0.f;
#pragma unroll
        for (int c = 0; c < 8; ++c) {
            if (L == 1) { uint2 o; o.x = pk2(hv[c].x, hv[c].y); o.y = pk2(hv[c].z, hv[c].w); *(uint2*)(H + (size_t)row * D + c * 256 + lane * 4) = o; }
            ss += hv[c].x * hv[c].x + hv[c].y * hv[c].y + hv[c].z * hv[c].z + hv[c].w * hv[c].w;
        }
        ss = wave_sum(ss, lane);
        const float rstd = rsqrtf(ss * (1.f / 2048.f) + 1e-6f);
#pragma unroll
        for (int c = 0; c < 8; ++c) {
            const int col = c * 256 + lane * 4;
            const float4 gm = *(const float4*)(vtab + col), sh = *(const float4*)(vtab + (1 + mrow) * 2048 + col), sc = *(const float4*)(vtab + (6 + mrow) * 2048 + col);
            const float u0 = hv[c].x * rstd * gm.x * (1.f + sc.x) + sh.x, u1 = hv[c].y * rstd * gm.y * (1.f + sc.y) + sh.y;
            const float u2 = hv[c].z * rstd * gm.z * (1.f + sc.z) + sh.z, u3 = hv[c].w * rstd * gm.w * (1.f + sc.w) + sh.w;
            uint2 o; o.x = pk2(u0, u1); o.y = pk2(u2, u3);
            *(uint2*)(U + (size_t)row * D + col) = o;
        }
    }
#undef N1_LOAD
}

DEVI void phase_final(const int tid_, const Params& p, unsigned char* lds) {
    const int wave = tid_ >> 6, lane = tid_ & 63;
    float* vtab = (float*)lds;
    __syncthreads();
    for (int i = tid_; i < 512 * 5; i += 512) {
        const int v = i >> 9, c4 = (i & 511) * 4;
        const float* src = v == 0 ? p.in[28] : (const float*)(p.ws + WS_MODS) + (size_t)(1 * 5 + (v - 1)) * 12288 + 5 * 2048;
        *(float4*)(vtab + v * 2048 + c4) = *(const float4*)(src + c4);
    }
    __syncthreads();
    const bf16_t* H = (const bf16_t*)(p.ws + WS_H);
    const float* mods = (const float*)(p.ws + WS_MODS);
    const bf16_t* SL = (const bf16_t*)(p.ws + WS_SLOTS);
    const float* gf = p.in[28];
    uint2 nh[8], na[8], nb[8];
#define FN_LOAD(r) do { _Pragma("unroll") for (int c = 0; c < 8; ++c) { const int col_ = c * 256 + lane * 4; \
        nh[c] = *(const uint2*)(H + (size_t)(r) * D + col_); na[c] = *(const uint2*)(SL + (size_t)((r) * 2) * D + col_); nb[c] = *(const uint2*)(SL + (size_t)((r) * 2 + 1) * D + col_); } } while (0)
    { const int r0 = blockIdx.x * 8 + wave; if (r0 < NL) FN_LOAD(r0); }
    for (int row = blockIdx.x * 8 + wave; row < NL; row += gridDim.x * 8) {
        const int mrow = row >> 12;
        const float* g2 = vtab + (1 + mrow) * 2048;
        float4 hv[8];
        uint2 ca[8], cb[8];
#pragma unroll
        for (int c = 0; c < 8; ++c) { hv[c] = make_float4(bflo(nh[c].x), bfhi(nh[c].x), bflo(nh[c].y), bfhi(nh[c].y)); ca[c] = na[c]; cb[c] = nb[c]; }
        { const int rn = row + (int)gridDim.x * 8; if (rn < NL) FN_LOAD(rn); }
        float ss = 0.f;
#pragma unroll
        for (int c = 0; c < 8; ++c) {
            const int col = c * 256 + lane * 4;
            const float4 g = *(const float4*)(g2 + col);
            const uint2 a = ca[c], b = cb[c];
            hv[c].x += g.x * (bflo(a.x) + bflo(b.x)); hv[c].y += g.y * (bfhi(a.x) + bfhi(b.x));
            hv[c].z += g.z * (bflo(a.y) + bflo(b.y)); hv[c].w += g.w * (bfhi(a.y) + bfhi(b.y));
            ss += hv[c].x * hv[c].x + hv[c].y * hv[c].y + hv[c].z * hv[c].z + hv[c].w * hv[c].w;
        }
        ss = wave_sum(ss, lane);
        const float rstd = rsqrtf(ss * (1.f / 2048.f) + 1e-6f);
#pragma unroll
        for (int c = 0; c < 8; ++c) {
            const int col = c * 256 + lane * 4;
            const float4 gm = *(const float4*)(vtab + col);
            float4 o; o.x = hv[c].x * rstd * gm.x; o.y = hv[c].y * rstd * gm.y; o.z = hv[c].z * rstd * gm.z; o.w = hv[c].w * rstd * gm.w;
            *(float4*)(p.out + (size_t)row * D + col) = o;
        }
    }
#undef FN_LOAD
}

constexpr int EP_RS = 528;
struct EpiIn {
    bf16_t* Z; float* GZ; bf16_t* VT; bf16_t* GVT; const float* RC; const float* RS; int brow, pn;
    DEVI void operator()(const f32x4 (&acc)[2][2][4][2], int wr, int wc, int fr, int fq, int tid, unsigned char* stg) const {
        if (pn == 16) {
#pragma unroll
            for (int ai = 0; ai < 2; ++ai)
#pragma unroll
                for (int m = 0; m < 4; ++m) {
                    const int row = brow + ai * 128 + wr * 64 + m * 16 + fr;
#pragma unroll
                    for (int n = 0; n < 2; ++n) { const int colt = wc * 32 + n * 16 + fq * 4; if (colt < 32) *(f32x4*)(GZ + (size_t)row * 32 + colt) = acc[ai][0][m][n]; }
                }
            return;
        }
        const bool tr = (pn == 5 || pn == 8 || pn == 9);
#pragma unroll
        for (int ai = 0; ai < 2; ++ai)
#pragma unroll
            for (int m = 0; m < 4; ++m) {
                const int rloc = ai * 128 + wr * 64 + m * 16 + fr, row = brow + rloc;
#pragma unroll
                for (int bj = 0; bj < 2; ++bj)
#pragma unroll
                    for (int n = 0; n < 2; ++n) {
                        const int colt = bj * 128 + wc * 32 + n * 16 + fq * 4;
                        const f32x4 v = acc[ai][bj][m][n];
                        float o0 = v[0], o1 = v[1], o2 = v[2], o3 = v[3];
                        if (pn <= 4) {
                            if (row < NL) {
                                const int tpos = row & 4095, i0 = (colt & 127) >> 1;
                                const float pos = (float)((i0 < 32) ? (tpos >> 6) : (tpos & 63));
                                const float r0 = pos * RC[i0 & 31], r1 = pos * RC[(i0 & 31) + 1];
                                const float c0 = __builtin_amdgcn_cosf(r0), s0 = __builtin_amdgcn_sinf(r0), c1 = __builtin_amdgcn_cosf(r1), s1 = __builtin_amdgcn_sinf(r1);
                                o0 = v[0] * c0 - v[1] * s0; o1 = v[0] * s0 + v[1] * c0;
                                o2 = v[2] * c1 - v[3] * s1; o3 = v[2] * s1 + v[3] * c1;
                            }
                            if (pn < 4) { o0 *= 0.12751743f; o1 *= 0.12751743f; o2 *= 0.12751743f; o3 *= 0.12751743f; }
                        }
                        if (!tr) { uint2 o; o.x = pk2(o0, o1); o.y = pk2(o2, o3); *(uint2*)(stg + rloc * EP_RS + colt * 2) = o; }
                        else {
                            const unsigned p01 = pk2(o0, o1), p23 = pk2(o2, o3);
                            *(bf16_t*)(stg + (colt + 0) * EP_RS + rloc * 2) = (bf16_t)(p01 & 0xffffu); *(bf16_t*)(stg + (colt + 1) * EP_RS + rloc * 2) = (bf16_t)(p01 >> 16);
                            *(bf16_t*)(stg + (colt + 2) * EP_RS + rloc * 2) = (bf16_t)(p23 & 0xffffu); *(bf16_t*)(stg + (colt + 3) * EP_RS + rloc * 2) = (bf16_t)(p23 >> 16);
                        }
                    }
            }
        lds_sync();
        if (!tr) {
#pragma unroll 4
            for (int c = tid; c < 8192; c += 512) {
                const int r = c >> 5, cc = c & 31;
                *(uint4*)(Z + (size_t)(brow + r) * ZLD + pn * 256 + cc * 8) = *(const uint4*)(stg + r * EP_RS + cc * 16);
            }
        } else {
            int bb, tpos0;
            if (brow < NL) { bb = brow >> 12; tpos0 = brow & 4095; } else { bb = (brow - NL) >> 8; tpos0 = 4096; }
#pragma unroll 4
            for (int c = tid; c < 8192; c += 512) {
                const int col = c >> 5, rc = c & 31;
                bf16_t* dst;
                if (pn == 5) dst = VT + ((size_t)((bb * 2 + (col >> 7)) * 128 + (col & 127))) * TT;
                else { const int cv = (pn - 8) * 256 + col; dst = GVT + ((size_t)((bb * 4 + (cv >> 7)) * 128 + (cv & 127))) * TT; }
                *(uint4*)(dst + tpos0 + rc * 8) = *(const uint4*)(stg + col * EP_RS + rc * 16);
            }
        }
        lds_sync();
    }
};

DEVI void dense_tile_of(int wgid, int nM, int nN, int& pm, int& pn) {
    const int nig = 8 * nN, gid = wgid / nig, fm = gid * 8, gsz = (nM - fm) < 8 ? (nM - fm) : 8;
    pm = fm + ((wgid % nig) % gsz); pn = (wgid % nig) / gsz;
}

DEVI void phase_gemm_in(const int tid_, const Params& p, int L, bf16_t* shm) {
    const int nM = NT / 256, nN = NWIN / 256;
    const bf16_t* U = (const bf16_t*)(p.ws + WS_U);
    bg_fill(tid_, p, (unsigned char*)shm, FILL_Q);
    const int geff = (int)gridDim.x - NCONV_WG;
    if ((int)blockIdx.x >= geff) return;
    for (int i = 0;; ++i) {
        int u; if (!unit_of(i, nM * nN, u, geff)) break;
        int pm, pn; dense_tile_of(u, nM, nN, pm, pn);
        if (L == 1 && pm >= NL / 256 && !(pn == 4 || pn == 5 || pn == 7 || pn == 8 || pn == 9 || pn == 12 || pn == 13 || pn == 16)) continue;
        unsigned a0, a1; aoff_plain(tid_, D, a0, a1);
        const bf16_t* Bt = (const bf16_t*)(p.ws + WS_WINT) + ((size_t)L * NWIN + pn * 256) * 2048;
        EpiIn epi{(bf16_t*)(p.ws + WS_Z), (float*)(p.ws + WS_GZ), (bf16_t*)(p.ws + WS_VT), (bf16_t*)(p.ws + WS_GVT),
                  (const float*)(p.ws + WS_ROPEF), (const float*)(p.ws + WS_ROPES), pm * 256, pn};
        if (pn == 16) gemm_tile<false, 2>(tid_, shm, U + (size_t)pm * 256 * D, D, a0, a1, 0u, 0u, Bt, 2048, epi);
        else gemm_tile<false, 0>(tid_, shm, U + (size_t)pm * 256 * D, D, a0, a1, 0u, 0u, Bt, 2048, epi);
    }
}

struct EpiOut {
    bf16_t* H; const float* mods; const float* x; const float* ctx; int L, brow, bcol;
    DEVI void operator()(const f32x4 (&acc)[2][2][4][2], int wr, int wc, int fr, int fq, int tid, unsigned char* stg) const {
#pragma unroll
        for (int ai = 0; ai < 2; ++ai)
#pragma unroll
            for (int m = 0; m < 4; ++m) {
                const int rloc = ai * 128 + wr * 64 + m * 16 + fr, row = brow + rloc;
                const float* g1 = (const float*)(stg + LDS_MISC + 2048);
#pragma unroll
                for (int bj = 0; bj < 2; ++bj)
#pragma unroll
                    for (int n = 0; n < 2; ++n) {
                        const int colt = bj * 128 + wc * 32 + n * 16 + fq * 4;
                        const f32x4 g = *(const f32x4*)(g1 + colt);
                        const f32x4 v = g * acc[ai][bj][m][n];
                        uint2 o; o.x = pk2(v[0], v[1]); o.y = pk2(v[2], v[3]);
                        *(uint2*)(stg + rloc * EP_RS + colt * 2) = o;
                    }
            }
        lds_sync();
        if (L == 0) {
            float4 ra[16], rb[16];
#pragma unroll
            for (int j = 0; j < 16; ++j) {
                const int c = tid + j * 512, r = c >> 5, cc = c & 31, row = brow + r;
                const float* rp = (row < NL ? x + (size_t)row * D : ctx + (size_t)(row - NL) * D) + bcol + cc * 8;
                ra[j] = *(const float4*)rp; rb[j] = *(const float4*)(rp + 4);
            }
#pragma unroll
            for (int j = 0; j < 16; ++j) {
                const int c = tid + j * 512, r = c >> 5, cc = c & 31, row = brow + r;
                const uint4 d = *(const uint4*)(stg + r * EP_RS + cc * 16);
                uint4 o;
                o.x = pk2(ra[j].x + bflo(d.x), ra[j].y + bfhi(d.x)); o.y = pk2(ra[j].z + bflo(d.y), ra[j].w + bfhi(d.y));
                o.z = pk2(rb[j].x + bflo(d.z), rb[j].y + bfhi(d.z)); o.w = pk2(rb[j].z + bflo(d.w), rb[j].w + bfhi(d.w));
                *(uint4*)(H + (size_t)row * D + bcol + cc * 8) = o;
            }
        } else {
            uint4 hb[16];
#pragma unroll
            for (int j = 0; j < 16; ++j) { const int c = tid + j * 512, r = c >> 5, cc = c & 31; hb[j] = *(const uint4*)(H + (size_t)(brow + r) * D + bcol + cc * 8); }
#pragma unroll
            for (int j = 0; j < 16; ++j) {
                const int c = tid + j * 512, r = c >> 5, cc = c & 31;
                const uint4 d = *(const uint4*)(stg + r * EP_RS + cc * 16);
                uint4 o;
                o.x = pk2(bflo(hb[j].x) + bflo(d.x), bfhi(hb[j].x) + bfhi(d.x)); o.y = pk2(bflo(hb[j].y) + bflo(d.y), bfhi(hb[j].y) + bfhi(d.y));
                o.z = pk2(bflo(hb[j].z) + bflo(d.z), bfhi(hb[j].z) + bfhi(d.z)); o.w = pk2(bflo(hb[j].w) + bflo(d.w), bfhi(hb[j].w) + bfhi(d.w));
                *(uint4*)(H + (size_t)(brow + r) * D + bcol + cc * 8) = o;
            }
        }
        lds_sync();
    }
};

DEVI void phase_gemm_out(const int tid_, const Params& p, int L, bf16_t* shm) {
    const int nM = (L == 0 ? NT : NL) / 256, nN = 8;
    const bf16_t* MIX = (const bf16_t*)(p.ws + WS_MIX);
    bg_fill(tid_, p, (unsigned char*)shm, FILL_Q);
    const int geff = (int)gridDim.x - NCONV_WG;
    if ((int)blockIdx.x >= geff) return;
    for (int i = 0;; ++i) {
        int u; if (!unit_of(i, nM * nN, u, geff)) break;
        int pm, pn; dense_tile_of(u, nM, nN, pm, pn);
        unsigned a0, a1; aoff_plain(tid_, D, a0, a1);
        const bf16_t* Bt = (const bf16_t*)(p.ws + WS_WOUTT) + ((size_t)L * 2048 + pn * 256) * 2048;
        EpiOut epi{(bf16_t*)(p.ws + WS_H), (const float*)(p.ws + WS_MODS), p.in[0], p.in[2], L, pm * 256, pn * 256};
        {
            const unsigned wvu = (unsigned)__builtin_amdgcn_readfirstlane(tid_ >> 6);
            if (wvu < 4u) {
                const int mrow = pm < NL / 256 ? (pm >> 4) : 4;
                const float* src = (const float*)(p.ws + WS_MODS) + (size_t)(L * 5 + mrow) * 12288 + 2 * 2048 + pn * 256;
                const __amdgpu_buffer_rsrc_t rs = __builtin_amdgcn_make_buffer_rsrc((void*)src, (short)0, 0x7fffffff, 0x00020000);
                __builtin_amdgcn_raw_ptr_buffer_load_lds(rs, (LAS void*)((unsigned char*)shm + LDS_MISC + 2048 + wvu * 256), 4, (wvu * 64u + ((unsigned)tid_ & 63u)) * 4u, 0, 0, 0);
            }
        }
        gemm_tile<false, 0>(tid_, shm, MIX + (size_t)pm * 256 * D, D, a0, a1, 0u, 0u, Bt, 2048, epi);
    }
}

constexpr int AT_KSTR = 272, AT_VSTR = 144;
DEVI void attn_unit(const int tid_, const Params& p, int L, int a, unsigned char* lds) {
    const bf16_t* Z = (const bf16_t*)(p.ws + WS_Z);
    const bf16_t* VT = (const bf16_t*)(p.ws + WS_VT);
    bf16_t* MIX = (bf16_t*)(p.ws + WS_MIX);
    unsigned char* Ks = lds;
    unsigned char* Vs = lds + 64 * AT_KSTR;
    const int tid = tid_, w = tid >> 6, lane = tid & 63, fr = lane & 15, fq = lane >> 4;
    int b, qb, kvh; bool isctx;
    if (a < 512) { b = a >> 7; qb = (a >> 1) & 63; kvh = a & 1; isctx = false; }
    else { const int a2 = a - 512; b = a2 >> 3; qb = (a2 >> 1) & 3; kvh = a2 & 1; isctx = true; }
    const int row0 = isctx ? NL + b * 256 + qb * 64 : b * 4096 + qb * 64;
    const int head = kvh * 4 + (w >> 1), qh = w & 1;
    bf16x8 Qf[2][4];
#pragma unroll
    for (int nq = 0; nq < 2; ++nq)
#pragma unroll
        for (int ks = 0; ks < 4; ++ks)
            Qf[nq][ks] = *(const bf16x8*)(Z + (size_t)(row0 + qh * 32 + nq * 16 + fr) * ZLD + ZQ + head * 128 + ks * 32 + fq * 8);
    const float sk_raw = p.in[9][L * 8 + head];
    f32x4 ot[8][2];
#pragma unroll
    for (int i = 0; i < 8; ++i) { ot[i][0] = (f32x4){0.f, 0.f, 0.f, 0.f}; ot[i][1] = (f32x4){0.f, 0.f, 0.f, 0.f}; }
    float mrun[2] = {-1e30f, -1e30f}, lrun[2] = {0.f, 0.f};
    int lo, hi;
    if (isctx) { lo = 5; hi = 4; } else { lo = (2 - qb) > 0 ? (2 - qb) : 0; hi = (65 - qb) < 4 ? (65 - qb) : 4; }
    int ti = (lo <= hi) ? lo : 5;
    uint4 kreg0, kreg1, vreg0, vreg1;
    const int kch0 = tid, kch1 = tid + 512;
#define AT_LOAD(tile) do { \
    int krow0_, vt0_; \
    if ((tile) <= 4) { const int j_ = qb - 2 + (tile); krow0_ = b * 4096 + j_ * 64; vt0_ = j_ * 64; } \
    else { const int jj_ = (tile) - 5; krow0_ = NL + b * 256 + jj_ * 64; vt0_ = 4096 + jj_ * 64; } \
    kreg0 = *(const uint4*)(Z + (size_t)(krow0_ + (kch0 >> 4)) * ZLD + ZK + kvh * 128 + (kch0 & 15) * 8); \
    kreg1 = *(const uint4*)(Z + (size_t)(krow0_ + (kch1 >> 4)) * ZLD + ZK + kvh * 128 + (kch1 & 15) * 8); \
    vreg0 = *(const uint4*)(VT + ((size_t)((b * 2 + kvh) * 128 + (kch0 >> 3))) * TT + vt0_ + (kch0 & 7) * 8); \
    vreg1 = *(const uint4*)(VT + ((size_t)((b * 2 + kvh) * 128 + (kch1 >> 3))) * TT + vt0_ + (kch1 & 7) * 8); } while (0)
    AT_LOAD(ti);
    for (;;) {
        PROF_B(11, lds, tid == 0);
        __syncthreads();
        *(uint4*)(Ks + (kch0 >> 4) * AT_KSTR + (kch0 & 15) * 16) = kreg0;
        *(uint4*)(Ks + (kch1 >> 4) * AT_KSTR + (kch1 & 15) * 16) = kreg1;
        *(uint4*)(Vs + (kch0 >> 3) * AT_VSTR + (kch0 & 7) * 16) = vreg0;
        *(uint4*)(Vs + (kch1 >> 3) * AT_VSTR + (kch1 & 7) * 16) = vreg1;
        __syncthreads();
        PROF_E(11, lds, tid == 0);
        const int cur = ti;
        const int nxt = (cur == hi) ? 5 : cur + 1;
        if (nxt <= 8) AT_LOAD(nxt);
        f32x4 st[4][2];
#pragma unroll
        for (int mt = 0; mt < 4; ++mt) { st[mt][0] = (f32x4){0.f, 0.f, 0.f, 0.f}; st[mt][1] = (f32x4){0.f, 0.f, 0.f, 0.f}; }
        {
            bf16x8 Kc[4], Kn[4];
#pragma unroll
            for (int mt = 0; mt < 4; ++mt) Kc[mt] = *(const bf16x8*)(Ks + (mt * 16 + fr) * AT_KSTR + (fq * 8) * 2);
#pragma unroll
            for (int ks = 0; ks < 4; ++ks) {
                if (ks < 3) {
#pragma unroll
                    for (int mt = 0; mt < 4; ++mt) Kn[mt] = *(const bf16x8*)(Ks + (mt * 16 + fr) * AT_KSTR + ((ks + 1) * 32 + fq * 8) * 2);
                }
                __builtin_amdgcn_sched_barrier(0);
#pragma unroll
                for (int mt = 0; mt < 4; ++mt) {
                    st[mt][0] = MFMA16(Kc[mt], Qf[0][ks], st[mt][0]);
                    st[mt][1] = MFMA16(Kc[mt], Qf[1][ks], st[mt][1]);
                }
                __builtin_amdgcn_sched_barrier(0);
#pragma unroll
                for (int mt = 0; mt < 4; ++mt) Kc[mt] = Kn[mt];
            }
        }
        const int mtype = (cur == 0) ? 1 : ((cur == 4) ? 2 : 0);
        if (mtype != 0) {
#pragma unroll
            for (int mt = 0; mt < 4; ++mt)
#pragma unroll
                for (int nq = 0; nq < 2; ++nq)
#pragma unroll
                    for (int j = 0; j < 4; ++j) {
                        const int c = mt * 16 + fq * 4 + j, aq = qh * 32 + nq * 16 + fr;
                        const bool keep = (mtype == 1) ? (c >= aq) : (c <= aq);
                        if (!keep) st[mt][nq][j] = -1e30f;
                    }
        }
        bf16x8 Pf[2][2];
#pragma unroll
        for (int nq = 0; nq < 2; ++nq) {
            float mx = st[0][nq][0];
#pragma unroll
            for (int mt = 0; mt < 4; ++mt)
#pragma unroll
                for (int j = 0; j < 4; ++j) mx = fmaxf(mx, st[mt][nq][j]);
            mx = fmaxf(mx, shx(mx, 16, lane)); mx = fmaxf(mx, shx(mx, 32, lane));
            const bool upd = mx > mrun[nq] + 8.f;
            if (__builtin_amdgcn_ballot_w64(upd) != 0ull) {
                const float mn2 = upd ? mx : mrun[nq];
                const float al = __builtin_amdgcn_exp2f(mrun[nq] - mn2);
                mrun[nq] = mn2;
                lrun[nq] *= al;
#pragma unroll
                for (int i = 0; i < 8; ++i) ot[i][nq] *= al;
            }
            const float mn = mrun[nq];
            float ps = 0.f;
#pragma unroll
            for (int mt = 0; mt < 4; ++mt)
#pragma unroll
                for (int j = 0; j < 4; ++j) { const float pv = __builtin_amdgcn_exp2f(st[mt][nq][j] - mn); st[mt][nq][j] = pv; ps += pv; }
            lrun[nq] += ps;
#pragma unroll
            for (int k2 = 0; k2 < 2; ++k2)
                Pf[nq][k2] = mk8(pk2(st[2 * k2][nq][0], st[2 * k2][nq][1]), pk2(st[2 * k2][nq][2], st[2 * k2][nq][3]),
                                 pk2(st[2 * k2 + 1][nq][0], st[2 * k2 + 1][nq][1]), pk2(st[2 * k2 + 1][nq][2], st[2 * k2 + 1][nq][3]));
        }
        {
            uint2 va[4][2], vb[4][2];
#pragma unroll
            for (int i = 0; i < 4; ++i) { const unsigned char* vp = Vs + (i * 16 + fr) * AT_VSTR + (fq * 4) * 2; va[i][0] = *(const uint2*)vp; va[i][1] = *(const uint2*)(vp + 32); }
#pragma unroll
            for (int g = 0; g < 4; ++g) {
                if (g < 3) {
                    const int k2n = (g + 1) >> 1, mdn = ((g + 1) & 1) * 4;
#pragma unroll
                    for (int i = 0; i < 4; ++i) { const unsigned char* vp = Vs + ((mdn + i) * 16 + fr) * AT_VSTR + (k2n * 32 + fq * 4) * 2; vb[i][0] = *(const uint2*)vp; vb[i][1] = *(const uint2*)(vp + 32); }
                }
                __builtin_amdgcn_sched_barrier(0);
                const int k2 = g >> 1, md0 = (g & 1) * 4;
#pragma unroll
                for (int i = 0; i < 4; ++i) {
                    const bf16x8 Vf = mk8(va[i][0].x, va[i][0].y, va[i][1].x, va[i][1].y);
                    ot[md0 + i][0] = MFMA16(Vf, Pf[0][k2], ot[md0 + i][0]);
                    ot[md0 + i][1] = MFMA16(Vf, Pf[1][k2], ot[md0 + i][1]);
                }
                __builtin_amdgcn_sched_barrier(0);
#pragma unroll
                for (int i = 0; i < 4; ++i) { va[i][0] = vb[i][0]; va[i][1] = vb[i][1]; }
            }
        }
        if (nxt > 8) break;
        ti = nxt;
    }
#undef AT_LOAD
    const float sk = sk_raw * 1.4426950408889634f;
#pragma unroll
    for (int nq = 0; nq < 2; ++nq) {
        float l = lrun[nq];
        l += shx(l, 16, lane); l += shx(l, 32, lane);
        const float mf = fmaxf(mrun[nq], sk);
        const float al = __builtin_amdgcn_exp2f(mrun[nq] - mf);
        const float lt = l * al + __builtin_amdgcn_exp2f(sk - mf);
        const float sc = al * rcpf_(lt);
        const int row = row0 + qh * 32 + nq * 16 + fr;
#pragma unroll
        for (int md = 0; md < 8; ++md) {
            const f32x4 o = ot[md][nq] * sc;
            uint2 pk; pk.x = pk2(o[0], o[1]); pk.y = pk2(o[2], o[3]);
            *(uint2*)(MIX + (size_t)row * D + head * 128 + md * 16 + fq * 4) = pk;
        }
    }
}

DEVI void gla_chunk_rows(int b, int ci, int& rowbase, int& tpos0) {
    if (ci < 4) { rowbase = NL + b * 256 + ci * 64; tpos0 = 4096 + ci * 64; } else { rowbase = b * 4096 + (ci - 4) * 64; tpos0 = (ci - 4) * 64; }
}
DEVI float logsig_fast(float z) { return fminf(z, 0.f) - __logf(1.f + __expf(-fabsf(z))); }
DEVI int scan_ci(int dir, int s) { return dir == 0 ? s : (s < 4 ? 3 - s : 71 - s); }

constexpr int GP_GZS = 0, GP_CUM = 10240, GP_TOT = 43520, GP_KT = 44032, GP_VT = 62464, GP_KSM = 80896, MX_TAB = 91648;
DEVI void gla_tables(const int tid_, const Params& p, int L, unsigned char* lds) {
    bf16_t* tabh = (bf16_t*)(lds + MX_TAB); bf16_t* tabl = (bf16_t*)(lds + MX_TAB + 16384); float* bias = (float*)(lds + MX_TAB + 32768);
    __syncthreads();
    for (int j = tid_; j < 8192; j += 512) {
        const int hd = j & 255, k = (j >> 8) & 15, dirp = j >> 12, h = hd >> 6, d = hd & 63;
        const float wv = p.in[10][(size_t)((L * 2 + dirp) * 16 + k) * 256 + hd];
        const int i = (h << 11) | ((dirp * 64 + d) << 4) | k;
        const bf16_t hi = f2bf(wv);
        tabh[i] = hi; tabl[i] = f2bf(wv - bf2f(hi));
    }
    bias[tid_] = p.in[11][L * 512 + tid_];
    __syncthreads();
}

DEVI void gla_p1_phase(const int tid_, const Params& p, int L, unsigned char* lds) {
    const bf16_t* Z = (const bf16_t*)(p.ws + WS_Z);
    const bf16_t* GVT = (const bf16_t*)(p.ws + WS_GVT);
    const float* GZ = (const float*)(p.ws + WS_GZ);
    unsigned char* gzh = lds + GP_GZS; unsigned char* gzl = lds + GP_GZS + 5120; float* cum = (float*)(lds + GP_CUM); float* tot = (float*)(lds + GP_TOT);
    bf16_t* kT = (bf16_t*)(lds + GP_KT); unsigned char* vts = lds + GP_VT; bf16_t* ksm = (bf16_t*)(lds + GP_KSM);
    const unsigned char* tabh = lds + MX_TAB; const unsigned char* tabl = lds + MX_TAB + 16384; const float* bias = (const float*)(lds + MX_TAB + 32768);
    const int tid = tid_, w = tid >> 6, lane = tid & 63, fr = lane & 15, fq = lane >> 4;
    const int t = tid >> 3, d0 = (tid & 7) * 8;
    gla_tables(tid_, p, L, lds);
    const int nun = NB * 4 * NCH;
    uint4 pgz, pk, pv0, pv1;
#define G1_PREF(uu) do { const int ci_ = (uu) % NCH, bh_ = (uu) / NCH; int rb_, tp_; gla_chunk_rows(bh_ >> 2, ci_, rb_, tp_); \
    pgz = *(const uint4*)(GZ + (size_t)(rb_ + t) * 32 + (tid & 7) * 4); \
    pk = *(const uint4*)(Z + (size_t)(rb_ + t) * ZLD + ZGK + (bh_ & 3) * 64 + d0); \
    pv0 = *(const uint4*)(GVT + ((size_t)(bh_ * 128 + (tid >> 3))) * TT + tp_ + (tid & 7) * 8); \
    pv1 = *(const uint4*)(GVT + ((size_t)(bh_ * 128 + 64 + (tid >> 3))) * TT + tp_ + (tid & 7) * 8); } while (0)
    int u = blockIdx.x;
    if (u < nun) G1_PREF(u);
    for (; u < nun; u += gridDim.x) {
        const int ci = u % NCH, bh = u / NCH, h = bh & 3;
        lds_sync();
        {
            const float x0 = __uint_as_float(pgz.x), x1 = __uint_as_float(pgz.y), x2 = __uint_as_float(pgz.z), x3 = __uint_as_float(pgz.w);
            uint2 hi; hi.x = pk2(x0, x1); hi.y = pk2(x2, x3);
            uint2 lo; lo.x = pk2(x0 - bflo(hi.x), x1 - bfhi(hi.x)); lo.y = pk2(x2 - bflo(hi.y), x3 - bfhi(hi.y));
            *(uint2*)(gzh + t * 80 + (tid & 7) * 8) = hi; *(uint2*)(gzl + t * 80 + (tid & 7) * 8) = lo;
        }
        *(uint4*)(vts + (tid >> 3) * 144 + (tid & 7) * 16) = pv0;
        *(uint4*)(vts + (64 + (tid >> 3)) * 144 + (tid & 7) * 16) = pv1;
        *(uint4*)((unsigned char*)ksm + t * 144 + d0 * 2) = pk;
        lds_sync();
        if (u + (int)gridDim.x < nun) G1_PREF(u + (int)gridDim.x);
        {
            const int dirp = w >> 2, dd = (w & 3) * 16 + fr;
            bf16x8 Bh = (bf16x8){0, 0, 0, 0, 0, 0, 0, 0}, Bl = Bh;
            if ((fq >> 1) == dirp) {
                const int off = (((h * 128 + w * 16 + fr) * 16) + (fq & 1) * 8) * 2;
                Bh = *(const bf16x8*)(tabh + off); Bl = *(const bf16x8*)(tabl + off);
            }
            const float bz = bias[dirp * 256 + h * 64 + dd];
#pragma unroll
            for (int m = 0; m < 4; ++m) {
                const bf16x8 Ah = *(const bf16x8*)(gzh + (m * 16 + fr) * 80 + fq * 16), Al = *(const bf16x8*)(gzl + (m * 16 + fr) * 80 + fq * 16);
                f32x4 z = (f32x4){0.f, 0.f, 0.f, 0.f};
                z = MFMA16(Ah, Bh, z); z = MFMA16(Al, Bh, z); z = MFMA16(Ah, Bl, z);
#pragma unroll
                for (int j = 0; j < 4; ++j) cum[(dirp * 64 + m * 16 + fq * 4 + j) * 65 + dd] = logsig_fast(z[j] + bz) * (1.f / 16.f);
            }
        }
        lds_sync();
        if (tid < 128) {
            const int dir = tid >> 6, d = tid & 63;
            float vv[64];
#pragma unroll
            for (int s2 = 0; s2 < 64; ++s2) vv[s2] = cum[(dir * 64 + (dir ? 63 - s2 : s2)) * 65 + d];
            float a = 0.f;
#pragma unroll
            for (int s2 = 0; s2 < 64; ++s2) { a += vv[s2]; vv[s2] = a; }
#pragma unroll
            for (int s2 = 0; s2 < 64; ++s2) cum[(dir * 64 + (dir ? 63 - s2 : s2)) * 65 + d] = vv[s2];
            tot[tid] = a;
        }
        lds_sync();
        {
            float* CG = (float*)(p.ws + WS_CUMG) + ((size_t)u * 2) * 4096;
#pragma unroll
            for (int dir = 0; dir < 2; ++dir) {
                const float tt = tot[dir * 64 + lane];
                float kd[8];
#pragma unroll
                for (int i = 0; i < 8; ++i) {
                    const int ti = w * 8 + i;
                    const float cv = cum[(dir * 64 + ti) * 65 + lane];
                    kd[i] = bf2f(ksm[ti * 72 + lane]) * __expf(tt - cv);
                    CG[(size_t)dir * 4096 + ti * 64 + lane] = cv;
                }
                uint4 o; o.x = pk2(kd[0], kd[1]); o.y = pk2(kd[2], kd[3]); o.z = pk2(kd[4], kd[5]); o.w = pk2(kd[6], kd[7]);
                *(uint4*)((unsigned char*)kT + ((dir * 64 + lane) * 72 + w * 8) * 2) = o;
            }
        }
        lds_sync();
        {
            const bf16x8 Af0 = *(const bf16x8*)(vts + (w * 16 + fr) * 144 + (fq * 8) * 2);
            const bf16x8 Af1 = *(const bf16x8*)(vts + (w * 16 + fr) * 144 + (32 + fq * 8) * 2);
#pragma unroll
            for (int dir = 0; dir < 2; ++dir) {
                f32x4 acc[4];
#pragma unroll
                for (int n = 0; n < 4; ++n) {
                    acc[n] = (f32x4){0.f, 0.f, 0.f, 0.f};
                    const bf16x8 Bf0 = *(const bf16x8*)((const unsigned char*)kT + ((dir * 64 + n * 16 + fr) * 72 + fq * 8) * 2);
                    const bf16x8 Bf1 = *(const bf16x8*)((const unsigned char*)kT + ((dir * 64 + n * 16 + fr) * 72 + 32 + fq * 8) * 2);
                    acc[n] = MFMA16(Bf0, Af0, acc[n]);
                    acc[n] = MFMA16(Bf1, Af1, acc[n]);
                }
                const int sq = bh * 2 + dir;
                bf16_t* CT = (bf16_t*)(p.ws + WS_CONTRIB) + ((size_t)(sq * NCH + ci)) * 8192;
#pragma unroll
                for (int n = 0; n < 4; ++n) asm volatile("s_nop 7\n\ts_nop 7" : "+v"(acc[n]));
#pragma unroll
                for (int n = 0; n < 4; ++n) { uint2 o; o.x = pk2(acc[n][0], acc[n][1]); o.y = pk2(acc[n][2], acc[n][3]); *(uint2*)(CT + (w * 16 + fr) * 64 + n * 16 + fq * 4) = o; }
            }
            if (tid < 128) { const int dir = tid >> 6, d = tid & 63; ((float*)(p.ws + WS_ATOT))[((size_t)((bh * 2 + dir) * NCH + ci)) * 64 + d] = __expf(tot[tid]); }
        }
    }
#undef G1_PREF
}

DEVI void gla_scan(const int tid_, const Params& p) {
    const unsigned* __restrict__ CT = (const unsigned*)(p.ws + WS_CONTRIB);
    const float* __restrict__ AT = (const float*)(p.ws + WS_ATOT);
    unsigned* __restrict__ SB = (unsigned*)(p.ws + WS_SBEF);
    for (int idx = blockIdx.x * 512 + tid_; idx < 32 * 128 * 32; idx += gridDim.x * 512) {
        const int dp = idx & 31, dv = (idx >> 5) & 127, sq = idx >> 12, dir = sq & 1;
        const unsigned* ctp = CT + (size_t)sq * NCH * 4096 + dv * 32 + dp;
        const float* atp = AT + (size_t)sq * NCH * 64 + dp * 2;
        unsigned* sbp = SB + (size_t)sq * NCH * 4096 + dv * 32 + dp;
        float s0 = 0.f, s1 = 0.f;
        constexpr int SB_ = 17;
        unsigned c[SB_], cn[SB_]; float2 a[SB_], an[SB_];
#pragma unroll
        for (int q = 0; q < SB_; ++q) { const int ci = scan_ci(dir, q); c[q] = ctp[(size_t)ci * 4096]; a[q] = *(const float2*)(atp + (size_t)ci * 64); }
#pragma unroll 1
        for (int s = 0; s < NCH; s += SB_) {
            if (s + SB_ < NCH) {
#pragma unroll
                for (int q = 0; q < SB_; ++q) { const int ci = scan_ci(dir, s + SB_ + q); cn[q] = ctp[(size_t)ci * 4096]; an[q] = *(const float2*)(atp + (size_t)ci * 64); }
            }
#pragma unroll
            for (int q = 0; q < SB_; ++q) {
                const int ci = scan_ci(dir, s + q);
                sbp[(size_t)ci * 4096] = pk2(s0, s1);
                s0 = a[q].x * s0 + bflo(c[q]); s1 = a[q].y * s1 + bfhi(c[q]);
            }
#pragma unroll
            for (int q = 0; q < SB_; ++q) { c[q] = cn[q]; a[q] = an[q]; }
        }
    }
}

constexpr int G3_QS = 0, G3_KS = 18432, G3_SS = 36864, G3_VT = 73728, G3_PART = 92160, G3_OB = 92672;
DEVI void gla_p3_phase(const int tid_, const Params& p, int L, unsigned char* lds) {
    const bf16_t* Z = (const bf16_t*)(p.ws + WS_Z);
    const bf16_t* GVT = (const bf16_t*)(p.ws + WS_GVT);
    const float* CUMG = (const float*)(p.ws + WS_CUMG);
    const bf16_t* SBEF = (const bf16_t*)(p.ws + WS_SBEF);
    bf16_t* MIX = (bf16_t*)(p.ws + WS_MIX);
    unsigned char* qs = lds + G3_QS; unsigned char* ks = lds + G3_KS; unsigned char* ss = lds + G3_SS; unsigned char* vts = lds + G3_VT;
    float* part = (float*)(lds + G3_PART); float* ob = (float*)(lds + G3_OB);
    const int tid = tid_, w = tid >> 6, lane = tid & 63, fr = lane & 15, fq = lane >> 4;
    const int ntl = w & 3, dvh = w >> 2;
    const int t = tid >> 3, d0 = (tid & 7) * 8, dv0 = (tid & 7) * 16;
    const int cfirst = (L == 0) ? 0 : 4, ncl = NCH - cfirst, nun = NB * 4 * ncl;
    uint4 pq, pk, psf0, psf1, psb0, psb1, pv0, pv1, pg0, pg1;
    float4 pcf0, pcf1, pcb0, pcb1;
#define G3_PREF(uu) do { const int ci_ = cfirst + (uu) % ncl, bh_ = (uu) / ncl; int rb_, tp_; gla_chunk_rows(bh_ >> 2, ci_, rb_, tp_); \
    const size_t u1_ = (size_t)bh_ * NCH + ci_; \
    pq = *(const uint4*)(Z + (size_t)(rb_ + t) * ZLD + ZGQ + (bh_ & 3) * 64 + d0); \
    pk = *(const uint4*)(Z + (size_t)(rb_ + t) * ZLD + ZGK + (bh_ & 3) * 64 + d0); \
    pcf0 = *(const float4*)(CUMG + (u1_ * 2) * 4096 + t * 64 + d0); pcf1 = *(const float4*)(CUMG + (u1_ * 2) * 4096 + t * 64 + d0 + 4); \
    pcb0 = *(const float4*)(CUMG + (u1_ * 2 + 1) * 4096 + t * 64 + d0); pcb1 = *(const float4*)(CUMG + (u1_ * 2 + 1) * 4096 + t * 64 + d0 + 4); \
    { const bf16_t* sf_ = SBEF + ((size_t)((bh_ * 2) * NCH + ci_)) * 8192; const bf16_t* sb_ = SBEF + ((size_t)((bh_ * 2 + 1) * NCH + ci_)) * 8192; \
      psf0 = *(const uint4*)(sf_ + tid * 8); psf1 = *(const uint4*)(sf_ + 4096 + tid * 8); psb0 = *(const uint4*)(sb_ + tid * 8); psb1 = *(const uint4*)(sb_ + 4096 + tid * 8); } \
    pv0 = *(const uint4*)(GVT + ((size_t)(bh_ * 128 + (tid >> 3))) * TT + tp_ + (tid & 7) * 8); \
    pv1 = *(const uint4*)(GVT + ((size_t)(bh_ * 128 + 64 + (tid >> 3))) * TT + tp_ + (tid & 7) * 8); \
    pg0 = *(const uint4*)(Z + (size_t)(rb_ + t) * ZLD + ZGR + (bh_ & 3) * 128 + dv0); \
    pg1 = *(const uint4*)(Z + (size_t)(rb_ + t) * ZLD + ZGR + (bh_ & 3) * 128 + dv0 + 8); } while (0)
    float4 gnv[4];
#pragma unroll
    for (int i4 = 0; i4 < 4; ++i4) gnv[i4] = *(const float4*)(p.in[12] + L * 128 + dv0 + 4 * i4);
    int u = blockIdx.x;
    if (u < nun) G3_PREF(u);
    for (; u < nun; u += gridDim.x) {
        const int ci = cfirst + u % ncl, bh = u / ncl, h = bh & 3;
        int rowbase, tpos0; gla_chunk_rows(bh >> 2, ci, rowbase, tpos0);
        lds_sync();
        {
            const unsigned qw[4] = {pq.x, pq.y, pq.z, pq.w}, kw[4] = {pk.x, pk.y, pk.z, pk.w};
            const float cf[8] = {pcf0.x, pcf0.y, pcf0.z, pcf0.w, pcf1.x, pcf1.y, pcf1.z, pcf1.w};
            const float cb[8] = {pcb0.x, pcb0.y, pcb0.z, pcb0.w, pcb1.x, pcb1.y, pcb1.z, pcb1.w};
#pragma unroll
            for (int dir = 0; dir < 2; ++dir) {
                unsigned qo[4], ko[4];
#pragma unroll
                for (int i = 0; i < 4; ++i) {
                    const float c0 = dir ? cb[2 * i] : cf[2 * i], c1 = dir ? cb[2 * i + 1] : cf[2 * i + 1];
                    qo[i] = pk2(bflo(qw[i]) * 0.125f * __expf(c0), bfhi(qw[i]) * 0.125f * __expf(c1));
                    ko[i] = pk2(bflo(kw[i]) * __expf(fminf(-c0, 80.f)), bfhi(kw[i]) * __expf(fminf(-c1, 80.f)));
                }
                uint4 t4; t4.x = qo[0]; t4.y = qo[1]; t4.z = qo[2]; t4.w = qo[3];
                *(uint4*)(qs + (dir * 64 + t) * 144 + d0 * 2) = t4;
                t4.x = ko[0]; t4.y = ko[1]; t4.z = ko[2]; t4.w = ko[3];
                *(uint4*)(ks + (dir * 64 + t) * 144 + d0 * 2) = t4;
            }
            *(uint4*)(ss + (tid >> 3) * 144 + (tid & 7) * 16) = psf0;
            *(uint4*)(ss + (64 + (tid >> 3)) * 144 + (tid & 7) * 16) = psf1;
            *(uint4*)(ss + (128 + (tid >> 3)) * 144 + (tid & 7) * 16) = psb0;
            *(uint4*)(ss + (192 + (tid >> 3)) * 144 + (tid & 7) * 16) = psb1;
            *(uint4*)(vts + (tid >> 3) * 144 + (tid & 7) * 16) = pv0;
            *(uint4*)(vts + (64 + (tid >> 3)) * 144 + (tid & 7) * 16) = pv1;
        }
        const uint4 gr0 = pg0, gr1 = pg1;
        lds_sync();
        if (u + (int)gridDim.x < nun) G3_PREF(u + (int)gridDim.x);
        f32x4 oacc[4];
#pragma unroll
        for (int i = 0; i < 4; ++i) oacc[i] = (f32x4){0.f, 0.f, 0.f, 0.f};
#pragma unroll
        for (int dir = 0; dir < 2; ++dir) {
            bf16x8 Bq[2];
            f32x4 at[4];
#pragma unroll
            for (int m = 0; m < 4; ++m) at[m] = (f32x4){0.f, 0.f, 0.f, 0.f};
#pragma unroll
            for (int k_ = 0; k_ < 2; ++k_) {
                Bq[k_] = *(const bf16x8*)(qs + (dir * 64 + ntl * 16 + fr) * 144 + (k_ * 32 + fq * 8) * 2);
#pragma unroll
                for (int m = 0; m < 4; ++m) {
                    const bf16x8 Ak = *(const bf16x8*)(ks + (dir * 64 + m * 16 + fr) * 144 + (k_ * 32 + fq * 8) * 2);
                    at[m] = MFMA16(Ak, Bq[k_], at[m]);
                }
            }
            {
                const int tq = ntl * 16 + fr;
#pragma unroll
                for (int m = 0; m < 4; ++m)
#pragma unroll
                    for (int j = 0; j < 4; ++j) {
                        const int s = m * 16 + fq * 4 + j;
                        const bool keep = dir == 0 ? (s <= tq) : (s >= tq);
                        if (!keep) at[m][j] = 0.f;
                    }
            }
#pragma unroll
            for (int k2 = 0; k2 < 2; ++k2) {
                const bf16x8 Pf = mk8(pk2(at[2 * k2][0], at[2 * k2][1]), pk2(at[2 * k2][2], at[2 * k2][3]),
                                      pk2(at[2 * k2 + 1][0], at[2 * k2 + 1][1]), pk2(at[2 * k2 + 1][2], at[2 * k2 + 1][3]));
#pragma unroll
                for (int md = 0; md < 4; ++md) {
                    const unsigned char* vp = vts + (dvh * 64 + md * 16 + fr) * 144 + (k2 * 32 + fq * 4) * 2;
                    const uint2 v0 = *(const uint2*)vp, v1 = *(const uint2*)(vp + 32);
                    oacc[md] = MFMA16(mk8(v0.x, v0.y, v1.x, v1.y), Pf, oacc[md]);
                }
            }
#pragma unroll
            for (int k_ = 0; k_ < 2; ++k_)
#pragma unroll
                for (int md = 0; md < 4; ++md) {
                    const bf16x8 As = *(const bf16x8*)(ss + (dir * 128 + dvh * 64 + md * 16 + fr) * 144 + (k_ * 32 + fq * 8) * 2);
                    oacc[md] = MFMA16(As, Bq[k_], oacc[md]);
                }
        }
        float sq = 0.f;
#pragma unroll
        for (int md = 0; md < 4; ++md)
#pragma unroll
            for (int j = 0; j < 4; ++j) sq += oacc[md][j] * oacc[md][j];
        sq += shx(sq, 16, lane); sq += shx(sq, 32, lane);
        if (fq == 0) part[w * 16 + fr] = sq;
        lds_sync();
        {
            const float tot2 = part[ntl * 16 + fr] + part[(ntl + 4) * 16 + fr];
            const float rstd = rsqrtf(tot2 * (1.f / 128.f) + 1e-6f);
#pragma unroll
            for (int md = 0; md < 4; ++md)
#pragma unroll
                for (int j = 0; j < 4; ++j) ob[(ntl * 16 + fr) * 132 + dvh * 64 + md * 16 + fq * 4 + j] = oacc[md][j] * rstd;
        }
        lds_sync();
        {
            const unsigned rw[8] = {gr0.x, gr0.y, gr0.z, gr0.w, gr1.x, gr1.y, gr1.z, gr1.w};
            unsigned o[8];
#pragma unroll
            for (int i4 = 0; i4 < 4; ++i4) {
                const float4 ov = *(const float4*)(ob + t * 132 + dv0 + 4 * i4), gv = gnv[i4];
                o[2 * i4] = pk2(ov.x * gv.x * siluf_(bflo(rw[2 * i4])), ov.y * gv.y * siluf_(bfhi(rw[2 * i4])));
                o[2 * i4 + 1] = pk2(ov.z * gv.z * siluf_(bflo(rw[2 * i4 + 1])), ov.w * gv.w * siluf_(bfhi(rw[2 * i4 + 1])));
            }
            uint4 a4; a4.x = o[0]; a4.y = o[1]; a4.z = o[2]; a4.w = o[3];
            uint4 b4; b4.x = o[4]; b4.y = o[5]; b4.z = o[6]; b4.w = o[7];
            bf16_t* dst = MIX + (size_t)(rowbase + t) * D + 1024 + h * 128 + dv0;
            *(uint4*)dst = a4; *(uint4*)(dst + 8) = b4;
        }
    }
#undef G3_PREF
}

constexpr int LR_XCF = 17152, LR_XCB = 34560, LR_OUTB = 43776;
template <int CTRL> DEVI float dppf(float oldv, float v) { return __int_as_float(__builtin_amdgcn_update_dpp(__float_as_int(oldv), __float_as_int(v), CTRL, 0xf, 0xf, false)); }
template <int DIR> DEVI void lru_tile_scan(float& A, float& B) {
    constexpr int base = DIR ? 0x100 : 0x110;
    { const float A2 = dppf<base | 1>(1.f, A), B2 = dppf<base | 1>(0.f, B); B = A * B2 + B; A = A * A2; }
    { const float A2 = dppf<base | 2>(1.f, A), B2 = dppf<base | 2>(0.f, B); B = A * B2 + B; A = A * A2; }
    { const float A2 = dppf<base | 4>(1.f, A), B2 = dppf<base | 4>(0.f, B); B = A * B2 + B; A = A * A2; }
    { const float A2 = dppf<base | 8>(1.f, A), B2 = dppf<base | 8>(0.f, B); B = A * B2 + B; A = A * A2; }
}
template <int PASS, int DIR>
DEVI void lru_wave_scan(const float (&av)[4][4], const float (&uv)[4][4], const float carry, int lane, int fr, int cb, int fq,
                        float* outb, float* la_out, float* lb_out) {
    float hin = (PASS == 3) ? carry : 0.f, pin = 1.f;
    const int l1 = DIR ? lane + 16 : lane - 16, l2 = DIR ? lane + 32 : lane - 32;
    const bool ok1 = DIR ? (fq <= 2) : (fq >= 1), ok2 = DIR ? (fq <= 1) : (fq >= 2);
    const int lend = DIR ? fr : 48 + fr;
#pragma unroll
    for (int mi = 0; mi < 4; ++mi) {
        const int m = DIR ? 3 - mi : mi;
        float Aj[4], Bj[4];
        float A = 1.f, B = 0.f;
#pragma unroll
        for (int jj = 0; jj < 4; ++jj) {
            const int j = DIR ? 3 - jj : jj;
            B = av[m][j] * B + uv[m][j]; A = A * av[m][j];
            Aj[j] = A; Bj[j] = B;
        }
        float Ai = A, Bi = B;
        { const float A2 = shidx(Ai, l1 & 63), B2 = shidx(Bi, l1 & 63); if (ok1) { Bi = Ai * B2 + Bi; Ai = Ai * A2; } }
        { const float A2 = shidx(Ai, l2 & 63), B2 = shidx(Bi, l2 & 63); if (ok2) { Bi = Ai * B2 + Bi; Ai = Ai * A2; } }
        float Ae = shidx(Ai, l1 & 63), Be = shidx(Bi, l1 & 63);
        if (!ok1) { Ae = 1.f; Be = 0.f; }
        const float hlane = Be + Ae * hin;
#pragma unroll
        for (int j = 0; j < 4; ++j) {
            const float hf = Bj[j] + Aj[j] * hlane;
            if (PASS == 3) outb[(DIR * 64 + m * 16 + fq * 4 + j) * 65 + cb * 16 + fr] = hf;
        }
        const float hend = Bi + Ai * hin;
        hin = shidx(hend, lend);
        if (PASS == 1) pin = shidx(Ai * pin, lend);
    }
    if (PASS == 1 && fq == 0) { la_out[fr] = pin; lb_out[fr] = hin; }
}

template <int PASS>
DEVI void lru_phase(const int tid_, const Params& p, int L, unsigned char* lds) {
    const bf16_t* Z = (const bf16_t*)(p.ws + WS_Z);
    float* xs = (float*)lds; float* xcf = (float*)(lds + LR_XCF); unsigned char* xcb = lds + LR_XCB; float* outb = (float*)(lds + LR_OUTB);
    float* tab = (float*)(lds + MX_TAB);
    const int tid = tid_, w = tid >> 6, lane = tid & 63, fr = lane & 15, fq = lane >> 4;
    const int dir = w >> 2, cb = w & 3;
    const int t = tid >> 3, c0 = (tid & 7) * 8;
    const int cfirst = (PASS == 3 && L == 1) ? 4 : 0, ncl = NCH - cfirst, nun = NB * ncl * 8;
    __syncthreads();
    for (int i = tid; i < 2048; i += 512) tab[i] = p.in[13][(size_t)L * 2048 + i];
    tab[2048 + tid] = p.in[14][L * 512 + tid];
    for (int i = tid; i < 1024; i += 512) {
        tab[2560 + i] = p.in[16][L * 1024 + i]; tab[3584 + i] = p.in[18][L * 1024 + i];
        tab[4608 + i] = -8.f * log1pf(expf(-p.in[19][L * 1024 + i]));
    }
    __syncthreads();
    unsigned short pxr[11];
    uint4 plg;
    float pcar = 0.f;
#define LR_DEC(uu, blk_, ci_, b_) const int blk_ = (uu) & 7, ci_ = cfirst + ((uu) >> 3) % ncl, b_ = ((uu) >> 3) / ncl
#define LR_PREF(uu) do { LR_DEC(uu, blk_, ci_, b_); int sr_, sl_, t0_; \
    if (ci_ < 4) { sr_ = NL + b_ * 256; sl_ = 256; t0_ = ci_ * 64; } else { sr_ = b_ * 4096; sl_ = 4096; t0_ = (ci_ - 4) * 64; } \
    _Pragma("unroll") for (int k_ = 0; k_ < 11; ++k_) { const int tm_ = t0_ - 2 + w * 8 + k_; \
        pxr[k_] = (tm_ >= 0 && tm_ < sl_) ? Z[(size_t)(sr_ + tm_) * ZLD + ZLX + blk_ * 64 + lane] : (unsigned short)0; } \
    if (PASS == 3) { plg = *(const uint4*)(Z + (size_t)(sr_ + t0_ + t) * ZLD + ZLG + blk_ * 64 + c0); \
        pcar = ((const float*)(p.ws + WS_LRUC))[((size_t)((b_ * NCH + ci_) * 2 + dir)) * 512 + blk_ * 64 + cb * 16 + fr]; } } while (0)
    int u = blockIdx.x;
    if (u < nun) LR_PREF(u);
    bf16x8 Bw[2][2] = {};
    int bwblk = -1, cblk = -1;
    float cw0 = 0.f, cw1 = 0.f, cw2 = 0.f, cw3 = 0.f, cbv = 0.f, bal = 0.f, bxl = 0.f, cfl = 0.f;
    for (; u < nun; u += gridDim.x) {
        LR_DEC(u, blk, ci, b);
        const int rowbase = (ci < 4) ? NL + b * 256 + ci * 64 : b * 4096 + (ci - 4) * 64;
        float xr[11];
#pragma unroll
        for (int k = 0; k < 11; ++k) xr[k] = bf2f(pxr[k]);
        const uint4 lgc = plg;
        const float carry = pcar;
        if (blk != bwblk) {
            const bf16_t* WT = (const bf16_t*)(p.ws + WS_LRUWT) + (size_t)(L * 8 + blk) * 256 * 64;
#pragma unroll
            for (int g = 0; g < 2; ++g)
#pragma unroll
                for (int ks = 0; ks < 2; ++ks)
                    Bw[g][ks] = *(const bf16x8*)(WT + (size_t)(((dir * 2 + g) * 4 + cb) * 16 + fr) * 64 + ks * 32 + fq * 8);
            bwblk = blk;
        }
        if (u + (int)gridDim.x < nun) LR_PREF(u + (int)gridDim.x);
        lds_sync();
        {
            if (blk != cblk) { const int ch = blk * 64 + lane; cw0 = tab[ch]; cw1 = tab[512 + ch]; cw2 = tab[1024 + ch]; cw3 = tab[1536 + ch]; cbv = tab[2048 + ch];
                               const int ch2 = blk * 64 + cb * 16 + fr; bal = tab[2560 + dir * 512 + ch2]; bxl = tab[3584 + dir * 512 + ch2]; cfl = tab[4608 + dir * 512 + ch2]; cblk = blk; }
#pragma unroll
            for (int i = 0; i < 8; ++i) {
                const float y = cbv + xr[i] * cw0 + xr[i + 1] * cw1 + xr[i + 2] * cw2 + xr[i + 3] * cw3;
                xcf[(w * 8 + i) * 68 + lane] = y;
                ((bf16_t*)xcb)[(w * 8 + i) * 72 + lane] = f2bf(y);
            }
        }
        lds_sync();
        float av[4][4], uv[4][4];
        {
            f32x4 ga[4], gx[4];
#pragma unroll
            for (int m = 0; m < 4; ++m) { ga[m] = (f32x4){0.f, 0.f, 0.f, 0.f}; gx[m] = (f32x4){0.f, 0.f, 0.f, 0.f}; }
#pragma unroll
            for (int ks = 0; ks < 2; ++ks)
#pragma unroll
                for (int m = 0; m < 4; ++m) {
                    const bf16x8 Af = *(const bf16x8*)(xcb + (m * 16 + fr) * 144 + (ks * 32 + fq * 8) * 2);
                    ga[m] = MFMA16(Af, Bw[0][ks], ga[m]);
                    gx[m] = MFMA16(Af, Bw[1][ks], gx[m]);
                }
#pragma unroll
            for (int m = 0; m < 4; ++m)
#pragma unroll
                for (int j = 0; j < 4; ++j) {
                    const float xl = xcf[(m * 16 + fq * 4 + j) * 68 + cb * 16 + fr];
                    const float la = cfl * sigmoidf_(ga[m][j] + bal);
                    const float a = __expf(la);
                    const float om = __builtin_fmaf(-a, a, 1.f);
                    av[m][j] = a;
                    uv[m][j] = __builtin_amdgcn_sqrtf(om) * sigmoidf_(gx[m][j] + bxl) * xl;
                }
        }
        {
            const size_t sbase = ((size_t)((b * NCH + ci) * 2 + dir)) * 512 + blk * 64 + cb * 16;
            float* la_out = (float*)(p.ws + WS_LRUA) + sbase; float* lb_out = (float*)(p.ws + WS_LRUB) + sbase;
            if (dir == 0) lru_wave_scan<PASS, 0>(av, uv, carry, lane, fr, cb, fq, outb, la_out, lb_out);
            else lru_wave_scan<PASS, 1>(av, uv, carry, lane, fr, cb, fq, outb, la_out, lb_out);
        }
        if (PASS == 3) {
            lds_sync();
            const unsigned lw[4] = {lgc.x, lgc.y, lgc.z, lgc.w};
            unsigned o[4];
#pragma unroll
            for (int i = 0; i < 4; ++i) {
                const float h0 = outb[t * 65 + c0 + 2 * i] + outb[(64 + t) * 65 + c0 + 2 * i];
                const float h1 = outb[t * 65 + c0 + 2 * i + 1] + outb[(64 + t) * 65 + c0 + 2 * i + 1];
                o[i] = pk2(h0 * gelu_tanh(bflo(lw[i])), h1 * gelu_tanh(bfhi(lw[i])));
            }
            uint4 o4; o4.x = o[0]; o4.y = o[1]; o4.z = o[2]; o4.w = o[3];
            *(uint4*)((bf16_t*)(p.ws + WS_MIX) + (size_t)(rowbase + t) * D + 1536 + blk * 64 + c0) = o4;
        }
    }
#undef LR_PREF
#undef LR_DEC
}

DEVI void lru_carry_scan(const int tid_, const Params& p) {
    const float* __restrict__ LA = (const float*)(p.ws + WS_LRUA);
    const float* __restrict__ LB = (const float*)(p.ws + WS_LRUB);
    float* __restrict__ LC = (float*)(p.ws + WS_LRUC);
    for (int idx = blockIdx.x * 512 + tid_; idx < 4096; idx += gridDim.x * 512) {
        const int ch = idx & 511, dir = (idx >> 9) & 1, b = idx >> 10;
        float hc = 0.f;
#pragma unroll 1
        for (int s = 0; s < NCH; s += 4) {
            float a[4], bb[4];
#pragma unroll
            for (int q = 0; q < 4; ++q) {
                const size_t si = ((size_t)((b * NCH + scan_ci(dir, s + q)) * 2 + dir)) * 512 + ch;
                a[q] = LA[si]; bb[q] = LB[si];
            }
#pragma unroll
            for (int q = 0; q < 4; ++q) {
                const size_t si = ((size_t)((b * NCH + scan_ci(dir, s + q)) * 2 + dir)) * 512 + ch;
                LC[si] = hc;
                hc = a[q] * hc + bb[q];
            }
        }
    }
}

DEVI void phase_mix_a(const int tid_, const Params& p, int L, unsigned char* lds) {
    const int na = (L == 0) ? 544 : 512;
    PROF_B(10, lds, tid_ == 0);
#pragma unroll 1
    for (int rep = 0; rep < ((REP_SUB == 100 && L == 0) ? 2 : 1); ++rep)
        for (int a = blockIdx.x; a < na; a += gridDim.x) attn_unit(tid_, p, L, a, lds);
    PROF_E(10, lds, tid_ == 0);
    PROF_B(12, lds, tid_ == 0);
    gla_p1_phase(tid_, p, L, lds);
    PROF_E(12, lds, tid_ == 0);
    if (REP_SUB == 101 && L == 0) gla_p1_phase(tid_, p, L, lds);
    PROF_B(13, lds, tid_ == 0);
    lru_phase<1>(tid_, p, L, lds);
    PROF_E(13, lds, tid_ == 0);
    if (REP_SUB == 102 && L == 0) lru_phase<1>(tid_, p, L, lds);
}
DEVI void phase_mix_b(const int tid_, const Params& p) { gla_scan(tid_, p); lru_carry_scan(tid_, p); }
DEVI void phase_mix_c(const int tid_, const Params& p, int L, unsigned char* lds) {
    PROF_B(14, lds, tid_ == 0);
    gla_p3_phase(tid_, p, L, lds);
    PROF_E(14, lds, tid_ == 0);
    if (REP_SUB == 103 && L == 0) gla_p3_phase(tid_, p, L, lds);
    PROF_B(15, lds, tid_ == 0);
    lru_phase<3>(tid_, p, L, lds);
    PROF_E(15, lds, tid_ == 0);
    if (REP_SUB == 104 && L == 0) lru_phase<3>(tid_, p, L, lds);
}

DEVI void phase_norm2(const int tid_, const Params& p, int L, unsigned char* lds, bool dry = false) {
    const int nrows = (L == 0) ? NT : NL;
    const int tid = tid_, w = tid >> 6, lane = tid & 63, fr = lane & 15, fq = lane >> 4;
    const bf16_t* H = (const bf16_t*)(p.ws + WS_H);
    bf16_t* U = (bf16_t*)(p.ws + WS_U);
    const float* mods = (const float*)(p.ws + WS_MODS);
    const float* gffn = p.in[7] + L * 2048;
    const bf16_t* WR = (const bf16_t*)(p.ws + WS_WRT) + (size_t)L * 48 * 2048;
    unsigned char* vt = lds;
    float* part = (float*)(lds + 65792);
    float* lgt = (float*)(lds + 65792 + 24576);
    unsigned* cnt = (unsigned*)(p.ws + WS_CTL) + (dry ? 8192 : CTL_COUNT) + L * 32;
    int* tokl = (int*)(p.ws + (dry ? WS_END : WS_TOKL));
    float* gatel = (float*)(p.ws + (dry ? WS_END + (size_t)32 * TOKCAP * 4 : WS_GATEL));
    unsigned char* wr2 = lds + 93440;
    __syncthreads();
#pragma unroll
    for (int i = 0; i < 2; ++i) { const int ch = tid + 512 * i; *(uint4*)(wr2 + ch * 16) = *(const uint4*)(WR + (size_t)32 * 2048 + ch * 8); }
    __syncthreads();
    bf16x8 Bf[8][2];
#pragma unroll
    for (int kk = 0; kk < 8; ++kk)
#pragma unroll
        for (int n = 0; n < 2; ++n) Bf[kk][n] = *(const bf16x8*)(WR + (size_t)(n * 16 + fr) * 2048 + w * 256 + kk * 32 + fq * 8);
    int* dec = (int*)(lds + 109824);
    int* lcnt = (int*)(lds + 109824 + 128 * 32);
    if (tid < 64) lcnt[tid] = 0;
    float* rb = (float*)(lds + 138752);
    if (tid < 4) rb[tid] = p.in[22][L * 4 + tid];
    else if (tid < 36) rb[tid] = p.in[24][L * 32 + tid - 4];
    float* mtab = (float*)(lds + 114176);
    *(float4*)(mtab + tid * 4) = *(const float4*)(gffn + tid * 4);
    float4 psh, psc;
#define N2_MODS(itx) do { const int mr_ = ((itx) * 16 < NL) ? (((itx) * 16) >> 12) : 4; const float* md_ = mods + (size_t)(L * 5 + mr_) * 12288; \
        psh = *(const float4*)(md_ + 3 * 2048 + tid * 4); psc = *(const float4*)(md_ + 4 * 2048 + tid * 4); } while (0)
    if ((int)blockIdx.x < nrows / 16) { N2_MODS((int)blockIdx.x); *(float4*)(mtab + 2048 + tid * 4) = psh; *(float4*)(mtab + 4096 + tid * 4) = psc; }
    __syncthreads();
    int nloc = 0;
    uint2 ha[8], hb[8], ga_[8], gb_[8];
    const int nit = nrows / 16;
    int it = blockIdx.x;
    if (it < nit) {
#pragma unroll
        for (int c = 0; c < 8; ++c) { ha[c] = *(const uint2*)(H + (size_t)(it * 16 + w * 2) * D + c * 256 + lane * 4); hb[c] = *(const uint2*)(H + (size_t)(it * 16 + w * 2 + 1) * D + c * 256 + lane * 4); }
    }
    if (it + (int)gridDim.x < nit) {
        const int it1 = it + (int)gridDim.x;
#pragma unroll
        for (int c = 0; c < 8; ++c) { ga_[c] = *(const uint2*)(H + (size_t)(it1 * 16 + w * 2) * D + c * 256 + lane * 4); gb_[c] = *(const uint2*)(H + (size_t)(it1 * 16 + w * 2 + 1) * D + c * 256 + lane * 4); }
    }
    for (; it < nit; it += gridDim.x) {
        lds_sync();
#define N2_ROW(hx, rr) do { \
            const int lr = w * 2 + (rr), row = it * 16 + lr; \
            float ss = 0.f; \
            _Pragma("unroll") for (int c = 0; c < 8; ++c) { const float h0 = bflo(hx[c].x), h1 = bfhi(hx[c].x), h2 = bflo(hx[c].y), h3 = bfhi(hx[c].y); ss += h0 * h0 + h1 * h1 + h2 * h2 + h3 * h3; } \
            ss = wave_sum(ss, lane); \
            const float rstd = rsqrtf(ss * (1.f / 2048.f) + 1e-6f); \
            _Pragma("unroll") for (int c = 0; c < 8; ++c) { \
                const int col = c * 256 + lane * 4; \
                const float h0 = bflo(hx[c].x), h1 = bfhi(hx[c].x), h2 = bflo(hx[c].y), h3 = bfhi(hx[c].y); \
                const float4 gm = *(const float4*)(mtab + col), sh = *(const float4*)(mtab + 2048 + col), sc = *(const float4*)(mtab + 4096 + col); \
                const float u0 = h0 * rstd * gm.x * (1.f + sc.x) + sh.x, u1 = h1 * rstd * gm.y * (1.f + sc.y) + sh.y; \
                const float u2 = h2 * rstd * gm.z * (1.f + sc.z) + sh.z, u3 = h3 * rstd * gm.w * (1.f + sc.w) + sh.w; \
                uint2 o; o.x = pk2(u0, u1); o.y = pk2(u2, u3); \
                *(uint2*)(U + (size_t)row * D + col) = o; \
                *(uint2*)(vt + lr * 4112 + col * 2) = o; } } while (0)
        N2_ROW(ha, 0);
        N2_ROW(hb, 1);
#undef N2_ROW
        if (it + (int)gridDim.x < nit) {
            const int itn = it + (int)gridDim.x;
#pragma unroll
            for (int c = 0; c < 8; ++c) { ha[c] = ga_[c]; hb[c] = gb_[c]; }
            if (itn + (int)gridDim.x < nit) {
                const int it2 = itn + (int)gridDim.x;
#pragma unroll
                for (int c = 0; c < 8; ++c) { ga_[c] = *(const uint2*)(H + (size_t)(it2 * 16 + w * 2) * D + c * 256 + lane * 4); gb_[c] = *(const uint2*)(H + (size_t)(it2 * 16 + w * 2 + 1) * D + c * 256 + lane * 4); }
            }
            N2_MODS(itn);
        }
        lds_sync();
        if (it + (int)gridDim.x < nit) { *(float4*)(mtab + 2048 + tid * 4) = psh; *(float4*)(mtab + 4096 + tid * 4) = psc; }
        {
            f32x4 acc[3];
#pragma unroll
            for (int n = 0; n < 3; ++n) acc[n] = (f32x4){0.f, 0.f, 0.f, 0.f};
#pragma unroll
            for (int kk = 0; kk < 8; ++kk) {
                const int k0 = w * 256 + kk * 32 + fq * 8;
                const bf16x8 Af = *(const bf16x8*)(vt + fr * 4112 + k0 * 2);
                acc[0] = MFMA16(Af, Bf[kk][0], acc[0]);
                acc[1] = MFMA16(Af, Bf[kk][1], acc[1]);
                bf16x8 B2 = (bf16x8){0, 0, 0, 0, 0, 0, 0, 0};
                if (fr < 4) B2 = *(const bf16x8*)(wr2 + fr * 4096 + k0 * 2);
                acc[2] = MFMA16(Af, B2, acc[2]);
            }
#pragma unroll
            for (int n = 0; n < 3; ++n)
#pragma unroll
                for (int j = 0; j < 4; ++j) part[(w * 16 + fq * 4 + j) * 48 + n * 16 + fr] = acc[n][j];
        }
        lds_sync();
        for (int i = tid; i < 16 * 48; i += 512) {
            float s = 0.f;
#pragma unroll
            for (int ww = 0; ww < 8; ++ww) s += part[ww * 768 + i];
            lgt[i] = s;
        }
        lds_sync();
        if (tid < 16) {
            const int row = it * 16 + tid;
            const float* lg = lgt + tid * 48;
            float g[4];
#pragma unroll
            for (int j = 0; j < 4; ++j) g[j] = lg[j] + rb[j];
            int gi = 0; float gm = g[0];
#pragma unroll
            for (int j = 1; j < 4; ++j) if (g[j] > gm) { gm = g[j]; gi = j; }
            float gs = 0.f;
#pragma unroll
            for (int j = 0; j < 4; ++j) gs += expf(g[j] - gm);
            const float pg = 1.f / gs;
            float e[8];
#pragma unroll
            for (int j = 0; j < 8; ++j) e[j] = lg[4 + gi * 8 + j] + rb[4 + gi * 8 + j];
            int i1 = 0; float m1 = e[0];
#pragma unroll
            for (int j = 1; j < 8; ++j) if (e[j] > m1) { m1 = e[j]; i1 = j; }
            int i2 = -1; float m2 = -3.4e38f;
#pragma unroll
            for (int j = 0; j < 8; ++j) if (j != i1 && e[j] > m2) { m2 = e[j]; i2 = j; }
            const float w1 = 1.f / (1.f + expf(m2 - m1)), w2 = 1.f - w1;
            const int e1 = gi * 8 + i1, e2 = gi * 8 + i2;
            const int r1 = atomicAdd(&lcnt[e1], 1), r2 = atomicAdd(&lcnt[e2], 1);
            int* dd = dec + (nloc * 16 + tid) * 8;
            dd[0] = row; dd[1] = e1; dd[2] = e2; dd[3] = r1; dd[4] = r2; dd[5] = __float_as_int(pg * w1); dd[6] = __float_as_int(pg * w2);
        }
        ++nloc;
    }
    lds_sync();
    if (tid < 32) { const int c = lcnt[tid]; lcnt[32 + tid] = c ? (int)atomicAdd(&cnt[tid], (unsigned)c) : 0; }
    lds_sync();
    for (int i = tid; i < nloc * 16; i += 512) {
        const int* dd = dec + i * 8;
        const int e1 = dd[1], e2 = dd[2];
        const size_t q1 = (size_t)e1 * TOKCAP + lcnt[32 + e1] + dd[3], q2 = (size_t)e2 * TOKCAP + lcnt[32 + e2] + dd[4];
        tokl[q1] = dd[0] * 2; gatel[q1] = __int_as_float(dd[5]);
        tokl[q2] = dd[0] * 2 + 1; gatel[q2] = __int_as_float(dd[6]);
    }
}

#undef N2_MODS
struct EpiUp {
    bf16_t* H1; int prow0, ncol0;
    DEVI void operator()(const f32x4 (&acc)[2][2][4][2], int wr, int wc, int fr, int fq, int tid, unsigned char* stg) const {
#pragma unroll
        for (int ai = 0; ai < 2; ++ai)
#pragma unroll
            for (int m = 0; m < 4; ++m) {
                const int rloc = ai * 128 + wr * 64 + m * 16 + fr;
#pragma unroll
                for (int n = 0; n < 2; ++n) {
                    const f32x4 a = acc[ai][0][m][n], c = acc[ai][1][m][n];
                    uint2 o; o.x = pk2(siluf_(a[0]) * c[0], siluf_(a[1]) * c[1]); o.y = pk2(siluf_(a[2]) * c[2], siluf_(a[3]) * c[3]);
                    *(uint2*)(stg + rloc * 272 + (wc * 32 + n * 16 + fq * 4) * 2) = o;
                }
            }
        lds_sync();
#pragma unroll 4
        for (int c = tid; c < 4096; c += 512) {
            const int r = c >> 4, cc = c & 15;
            *(uint4*)(H1 + (size_t)(prow0 + r) * 1024 + ncol0 + cc * 8) = *(const uint4*)(stg + r * 272 + cc * 16);
        }
        lds_sync();
    }
};
struct EpiDown {
    bf16_t* SL; const int* tokl; const float* gatel; int li0, cnt, bcol;
    DEVI void operator()(const f32x4 (&acc)[2][2][4][2], int wr, int wc, int fr, int fq, int tid, unsigned char* stg) const {
        const int* tk = (const int*)(stg + LDS_MISC + 2048); const float* gs = (const float*)(stg + LDS_MISC + 3072);
#pragma unroll
        for (int ai = 0; ai < 2; ++ai)
#pragma unroll
            for (int m = 0; m < 4; ++m) {
                const int rloc = ai * 128 + wr * 64 + m * 16 + fr, li = li0 + rloc;
                const float g = li < cnt ? gs[rloc] : 0.f;
#pragma unroll
                for (int bj = 0; bj < 2; ++bj)
#pragma unroll
                    for (int n = 0; n < 2; ++n) {
                        const f32x4 v = acc[ai][bj][m][n] * g;
                        uint2 o; o.x = pk2(v[0], v[1]); o.y = pk2(v[2], v[3]);
                        *(uint2*)(stg + rloc * EP_RS + (bj * 128 + wc * 32 + n * 16 + fq * 4) * 2) = o;
                    }
            }
        lds_sync();
#pragma unroll 4
        for (int c = tid; c < 8192; c += 512) {
            const int r = c >> 5, cc = c & 31, li = li0 + r;
            if (li < cnt) *(uint4*)(SL + (size_t)tk[r] * D + bcol + cc * 8) = *(const uint4*)(stg + r * EP_RS + cc * 16);
        }
        lds_sync();
    }
};

template <int DOWN>
DEVI void phase_moe(const int tid_, const Params& p, int L, unsigned char* lds) {
    bf16_t* shm = (bf16_t*)lds;
    int* tb = (int*)(lds + LDS_MISC + 256);
    const unsigned* cntg = (const unsigned*)(p.ws + WS_CTL) + CTL_COUNT + L * 32;
    __syncthreads();
    if (tid_ < 32) tb[64 + tid_] = (int)cntg[tid_];
    __syncthreads();
    if (tid_ < 64) {
        const int ln = tid_ & 63;
        const int nte_ = (ln < 32) ? ((tb[64 + (ln & 31)] + 255) >> 8) : 0;
        float inc = (float)nte_;
#pragma unroll
        for (int off = 1; off < 32; off <<= 1) { const float o_ = shup(inc, off, ln); if (ln >= off) inc += o_; }
        if (ln < 32) tb[ln] = (int)inc - nte_;
        if (ln == 31) tb[32] = (int)inc;
    }
    __syncthreads();
    const int ntl = tb[32] * 8;
    const int* tokl = (const int*)(p.ws + WS_TOKL);
    bg_fill(tid_, p, lds, DOWN ? FILL_Q / 2 : FILL_Q);
    const int geff = (L == 0) ? (int)gridDim.x - NCONV_WG : (int)gridDim.x;
    if ((int)blockIdx.x >= geff) return;
    int tokc[2][2] = {{0, 0}, {0, 0}};
    for (int i = 0;; ++i) {
        int u; if (!unit_of(i, ntl, u, geff)) break;
        const int tbv = ((tid_ & 63) < 32) ? tb[tid_ & 31] * 8 : 0x7fffffff;
        const int e = __builtin_popcountll(__ballot(tbv <= u)) - 1;
        const int q = u - tb[e] * 8, nte = tb[e + 1] - tb[e], nt = q / nte, mt = q % nte, cnt_e = tb[64 + e];
        const int prow0 = (tb[e] + mt) * 256;
        if (DOWN == 0) {
#define UP_TOKS(dst, e_, mt_, cnt_) do { _Pragma("unroll") for (int ii = 0; ii < 2; ++ii) { int r_, c_; g_stage_rc(tid_ * 16 + ii * 8192, r_, c_); \
                _Pragma("unroll") for (int hh = 0; hh < 2; ++hh) { const int li_ = (mt_) * 256 + hh * 128 + r_; \
                    dst[hh][ii] = li_ < (cnt_) ? tokl[(size_t)(e_) * TOKCAP + li_] : 0; } } } while (0)
            if (i == 0) UP_TOKS(tokc, e, mt, cnt_e);
            unsigned ao[2][2];
#pragma unroll
            for (int ii = 0; ii < 2; ++ii) {
                int r, c; g_stage_rc(tid_ * 16 + ii * 8192, r, c);
#pragma unroll
                for (int hh = 0; hh < 2; ++hh) ao[hh][ii] = ((unsigned)(tokc[hh][ii] >> 1) * D + c) * 2u;
            }
            { int u2; if (unit_of(i + 1, ntl, u2, geff)) {
                const int e2 = __builtin_popcountll(__ballot(tbv <= u2)) - 1;
                const int q2 = u2 - tb[e2] * 8, nte2 = tb[e2 + 1] - tb[e2], mt2 = q2 % nte2, cnt2 = tb[64 + e2];
                UP_TOKS(tokc, e2, mt2, cnt2); } }
#undef UP_TOKS
            const bf16_t* Bt = (const bf16_t*)(p.ws + WS_WUPT) + ((size_t)(L * 32 + e) * 2048 + nt * 256) * 2048;
            EpiUp epi{(bf16_t*)(p.ws + WS_H1), prow0, nt * 128};
            if (cnt_e - mt * 256 <= 128) gemm_tile<true, 1>(tid_, shm, (const bf16_t*)(p.ws + WS_U), D, ao[0][0], ao[0][1], ao[1][0], ao[1][1], Bt, 2048, epi);
            else gemm_tile<true, 0>(tid_, shm, (const bf16_t*)(p.ws + WS_U), D, ao[0][0], ao[0][1], ao[1][0], ao[1][1], Bt, 2048, epi);
        } else {
            unsigned a0, a1; aoff_plain(tid_, 1024, a0, a1);
            {
                const unsigned wvu = (unsigned)__builtin_amdgcn_readfirstlane(tid_ >> 6);
                const void* src = (wvu < 4u) ? (const void*)(tokl + (size_t)e * TOKCAP + mt * 256) : (const void*)((const float*)(p.ws + WS_GATEL) + (size_t)e * TOKCAP + mt * 256);
                const __amdgpu_buffer_rsrc_t rs = __builtin_amdgcn_make_buffer_rsrc((void*)src, (short)0, 0x7fffffff, 0x00020000);
                __builtin_amdgcn_raw_ptr_buffer_load_lds(rs, (LAS void*)(lds + LDS_MISC + 2048 + wvu * 256), 4, ((wvu & 3u) * 64u + ((unsigned)tid_ & 63u)) * 4u, 0, 0, 0);
            }
            const bf16_t* Bt = (const bf16_t*)(p.ws + WS_WDNT) + ((size_t)(L * 32 + e) * 2048 + nt * 256) * 1024;
            EpiDown epi{(bf16_t*)(p.ws + WS_SLOTS), tokl + (size_t)e * TOKCAP, (const float*)(p.ws + WS_GATEL) + (size_t)e * TOKCAP, mt * 256, cnt_e, nt * 256};
            if (cnt_e - mt * 256 <= 128) gemm_tile<false, 1>(tid_, shm, (const bf16_t*)(p.ws + WS_H1) + (size_t)prow0 * 1024, 1024, a0, a1, 0u, 0u, Bt, 1024, epi);
            else gemm_tile<false, 0>(tid_, shm, (const bf16_t*)(p.ws + WS_H1) + (size_t)prow0 * 1024, 1024, a0, a1, 0u, 0u, Bt, 1024, epi);
        }
    }
}

extern __shared__ __attribute__((aligned(16))) unsigned char lds_raw[];

__global__ void __launch_bounds__(512, 2) hybrid_fwd(Params p_unused) {
    unsigned char* lds = lds_raw;
    int lo, hi;
    { Params q; load_params(q); lo = q.ph_lo; hi = q.ph_hi; }
    const int wv_ = __builtin_amdgcn_readfirstlane((int)(threadIdx.x >> 6));
    if (hi - lo > 1) {
        const bool t0 = (opaque_tid(wv_) == 0);
        if (t0) { *(uint4*)(lds + LDS_MISC) = make_uint4(0u, 0u, 0u, 0u); *(uint4*)(lds + LDS_MISC + 96) = make_uint4(0u, 0u, 0u, 0u); }
        __syncthreads();
        { Params q; load_params(q); (void)xcd_barrier_post((unsigned*)(q.ws + WS_CTL), (volatile LAS unsigned*)(lds + LDS_MISC), t0); }
    }
#ifndef PH_MASK
#define PH_MASK 0x7ff
#endif
#ifndef REP_PHASE
#define REP_PHASE -1
#endif
#ifndef REP_N
#define REP_N 1
#endif
#define PH_(fn, ...) do { asm volatile("; MARK_BEGIN " #fn); Params q__; load_params(q__); fn(opaque_tid(wv_), q__, ##__VA_ARGS__); asm volatile("; MARK_END " #fn); } while (0)
#define EN(j) ((PH_MASK >> (j)) & 1)
#define IN(k) (lo <= (k) && (k) < hi)
#define SEAM(k) do { if (IN(k) && IN((k) + 1)) { Params qb_; load_params(qb_); seam_sync(opaque_tid(wv_), qb_, lds, (k)); } } while (0)
    if (EN(0) && IN(0)) PH_(phase_prologue, lds);
    if (REP_PHASE == 0) for (int r_ = 0; r_ < REP_N; ++r_) PH_(phase_prologue, lds);
    SEAM(0);
    if (REP_SUB == 300) { for (int r_ = 0; r_ < 10; ++r_) SEAM(0); }
#define LAYER(L) do { constexpr int k0 = 1 + 9 * (L); \
        if (EN(1) && IN(k0 + 0)) PH_(phase_norm1, L, lds); \
        if (REP_PHASE == k0 + 0) for (int r_ = 0; r_ < REP_N; ++r_) PH_(phase_norm1, L, lds); \
        SEAM(k0 + 0); \
        if (EN(2) && IN(k0 + 1)) PH_(phase_gemm_in, L, (bf16_t*)lds); \
        if (REP_PHASE == k0 + 1) for (int r_ = 0; r_ < REP_N; ++r_) PH_(phase_gemm_in, L, (bf16_t*)lds); \
        SEAM(k0 + 1); \
        if (EN(3) && IN(k0 + 2)) PH_(phase_mix_a, L, lds); \
        if (REP_PHASE == k0 + 2) for (int r_ = 0; r_ < REP_N; ++r_) PH_(phase_mix_a, L, lds); \
        SEAM(k0 + 2); \
        if (EN(4) && IN(k0 + 3)) PH_(phase_mix_b); \
        if (REP_PHASE == k0 + 3) for (int r_ = 0; r_ < REP_N; ++r_) PH_(phase_mix_b); \
        SEAM(k0 + 3); \
        if (EN(5) && IN(k0 + 4)) PH_(phase_mix_c, L, lds); \
        if (REP_PHASE == k0 + 4) for (int r_ = 0; r_ < REP_N; ++r_) PH_(phase_mix_c, L, lds); \
        SEAM(k0 + 4); \
        if (EN(6) && IN(k0 + 5)) PH_(phase_gemm_out, L, (bf16_t*)lds); \
        if (REP_PHASE == k0 + 5) for (int r_ = 0; r_ < REP_N; ++r_) PH_(phase_gemm_out, L, (bf16_t*)lds); \
        SEAM(k0 + 5); \
        if (EN(7) && IN(k0 + 6)) PH_(phase_norm2, L, lds); \
        if (REP_PHASE == k0 + 6) for (int r_ = 0; r_ < REP_N; ++r_) PH_(phase_norm2, L, lds, true); \
        SEAM(k0 + 6); \
        if (EN(8) && IN(k0 + 7)) PH_(phase_moe<0>, L, lds); \
        if (REP_PHASE == k0 + 7) for (int r_ = 0; r_ < REP_N; ++r_) PH_(phase_moe<0>, L, lds); \
        SEAM(k0 + 7); \
        if (EN(9) && IN(k0 + 8)) PH_(phase_moe<1>, L, lds); \
        if (REP_PHASE == k0 + 8) for (int r_ = 0; r_ < REP_N; ++r_) PH_(phase_moe<1>, L, lds); \
        SEAM(k0 + 8); } while (0)
    LAYER(0);
    LAYER(1);
#undef LAYER
    if (EN(10) && IN(19)) PH_(phase_final, lds);
    if (PROF_ID != 0 && blockIdx.x == 0 && opaque_tid(wv_) == 0) {
        const unsigned long long acc = PROF_WORD(lds)[0], t_start = __builtin_amdgcn_s_memrealtime();
        while (__builtin_amdgcn_s_memrealtime() - t_start < acc * PROF_AMP) __builtin_amdgcn_s_sleep(8);
    }
#undef IN
#undef SEAM
}

extern "C" void kernel_launch(void* const* d_in, const int* in_sizes, int n_in, void* d_out, int out_size, void* d_ws, size_t ws_size, hipStream_t stream) {
    static int grid = 0;
    if (grid == 0) {
        if (n_in != 29 || ws_size < WS_END) { fprintf(stderr, "kernel_launch: need 29 inputs and >= %zu bytes of workspace (got %d, %zu)\n", (size_t)WS_END, n_in, ws_size); grid = -1; return; }
        int dev = 0, cus = 0, per_cu = 0;
        if (hipGetDevice(&dev) != hipSuccess || hipDeviceGetAttribute(&cus, hipDeviceAttributeMultiprocessorCount, dev) != hipSuccess) { grid = -1; return; }
        if (hipFuncSetAttribute((const void*)hybrid_fwd, hipFuncAttributeMaxDynamicSharedMemorySize, LDS_BYTES) != hipSuccess) { fprintf(stderr, "kernel_launch: hipFuncSetAttribute failed\n"); grid = -1; return; }
        if (hipOccupancyMaxActiveBlocksPerMultiprocessor(&per_cu, (const void*)hybrid_fwd, 512, LDS_BYTES) != hipSuccess || per_cu < 1)
            fprintf(stderr, "kernel_launch: occupancy query reports %d workgroups per CU\n", per_cu);
        (void)hipGetLastError();
        grid = cus;
    }
    if (grid < 0) return;
    (void)hipMemsetAsync((char*)d_ws + WS_CTL, 0, 65536, stream);
    Params p{};
    for (int i = 0; i < 29; ++i) p.in[i] = (const float*)d_in[i];
    p.out = (float*)d_out; p.ws = (unsigned char*)d_ws;
#if MK_ONE_LAUNCH
    p.ph_lo = 0; p.ph_hi = 20;
    hipLaunchKernelGGL(hybrid_fwd, dim3(grid), dim3(512), LDS_BYTES, stream, p);
#else
    for (int k = 0; k < 20; ++k) {
        p.ph_lo = k; p.ph_hi = k + 1;
        hipLaunchKernelGGL(hybrid_fwd, dim3(grid), dim3(512), LDS_BYTES, stream, p);
    }
#endif
}
```
